# Optimizing an MI355X kernel written in HIP

```python
import jax, jax.numpy as jnp
from jax import lax
import numpy as np

D_MODEL = 1024
BATCH = 4
SEQ = 8192
DEPTH = 2

GRID_W = 64
CTX_LEN = 256
EPS = 1e-6
CHUNK = 64
CONV_W = 4
CONV_LEFT = 2

GLA_HEADS = 4
GLA_DK = 64
GLA_DV = 128
GLA_KW = GLA_HEADS * GLA_DK
GLA_VW = GLA_HEADS * GLA_DV
GLA_RANK = 16
GLA_TAU = 16.0

RG_WIDTH = 512
RG_BLOCKS = 8
RG_BS = RG_WIDTH // RG_BLOCKS
RG_C = 8.0

AB_SIZES = (GLA_KW, GLA_KW, GLA_VW, GLA_VW, GLA_RANK, GLA_RANK, RG_WIDTH, RG_WIDTH)
AB_IN = sum(AB_SIZES)
AB_SPLITS = tuple(int(s) for s in np.cumsum(AB_SIZES)[:-1])
AB_MIX = GLA_VW + RG_WIDTH

M_INNER = 2 * D_MODEL
M_HEADS = 4
M_DH = M_INNER // M_HEADS
M_QKV_BS = 4
M_QKV_NB = M_INNER // M_QKV_BS

N_EXPERTS = 16
EXPERT_FF = D_MODEL
EC_CAPACITY = 2

kernel_name = 'hybrid_gla_rglru_mlstm_ec_moe_prefix'

f32 = jnp.float32


def rmsnorm(t, g):
    t32 = t.astype(f32)
    y = t32 * lax.rsqrt(jnp.mean(t32 * t32, axis=-1, keepdims=True) + EPS)
    return (y * g.astype(f32)).astype(t.dtype)


def head_norm(t, g, n_heads, center):
    B, L, W = t.shape
    th = t.astype(f32).reshape(B, L, n_heads, W // n_heads)
    if center:
        th = th - jnp.mean(th, axis=-1, keepdims=True)
    th = th * lax.rsqrt(jnp.mean(th * th, axis=-1, keepdims=True) + EPS)
    return th.reshape(B, L, W) * g.astype(f32)


def short_conv(t, w, b, n_seg, seg_len):
    B, L, C = t.shape
    ts = t.reshape(B, n_seg, seg_len, C)
    tp = jnp.pad(ts, ((0, 0), (0, 0), (CONV_LEFT, CONV_W - 1 - CONV_LEFT), (0, 0)))
    y = b + tp[:, :, 0:seg_len] * w[0]
    for j in range(1, CONV_W):
        y = y + tp[:, :, j:j + seg_len] * w[j]
    return y.reshape(B, L, C)


def block_diag(t, w):
    B, L, _ = t.shape
    nb, bi, bo = w.shape
    return jnp.einsum('blni,nio->blno', t.reshape(B, L, nb, bi), w).reshape(B, L, nb * bo)


def to_chunks(t):
    B, L = t.shape[:2]
    return jnp.moveaxis(t.reshape((B, L // CHUNK, CHUNK) + t.shape[2:]), 1, 0)


def from_chunks(t):
    n, B = t.shape[:2]
    return jnp.moveaxis(t, 0, 1).reshape((B, n * CHUNK) + t.shape[3:])


def gla_run(inputs, S0):
    causal = jnp.tril(jnp.ones((CHUNK, CHUNK), bool))

    def step(S, inp):
        qc, kc, vc, lac = inp
        b = jnp.cumsum(lac, axis=1)
        o_inter = jnp.einsum('bthk,bhkv->bthv', qc * jnp.exp(b), S)
        diff = b[:, :, None] - b[:, None]
        decay = jnp.exp(jnp.where(causal[None, :, :, None, None], diff, -jnp.inf))
        attn = jnp.einsum('bthk,bshk,btshk->btsh', qc, kc, decay)
        o = o_inter + jnp.einsum('btsh,bshv->bthv', attn, vc)
        b_last = b[:, -1]
        S_new = jnp.exp(b_last)[..., None] * S + jnp.einsum(
            'bshk,bshv->bhkv', kc * jnp.exp(b_last[:, None] - b), vc)
        return S_new, o

    S, o = lax.scan(step, S0, tuple(to_chunks(t) for t in inputs))
    return from_chunks(o), S


def lru_run(inputs, h0):
    a, u = inputs

    def comb(p, q):
        a1, u1 = p
        a2, u2 = q
        return a1 * a2, a2 * u1 + u2

    A, H = lax.associative_scan(comb, (a, u), axis=1)
    h = H + A * h0[:, None]
    return h, h[:, -1]


def mlstm_run(inputs, state):
    causal = jnp.tril(jnp.ones((CHUNK, CHUNK), bool))

    def step(carry, inp):
        C, nv, m = carry
        qc, kc, vc, lic, lfc = inp
        b = jnp.cumsum(lfc, axis=1)
        w_inter = b + m[:, None]
        w_intra = b[:, :, None] - b[:, None] + lic[:, None]
        w_intra = jnp.where(causal[None, :, :, None], w_intra, -jnp.inf)
        m_t = jnp.maximum(w_inter, jnp.max(w_intra, axis=2))
        d_inter = jnp.exp(w_inter - m_t)
        s = jnp.einsum('bthd,bshd->btsh', qc, kc) * jnp.exp(w_intra - m_t[:, :, None])
        num = d_inter[..., None] * jnp.einsum('bthk,bhkv->bthv', qc, C) + jnp.einsum('btsh,bshv->bthv', s, vc)
        den = d_inter * jnp.einsum('bthk,bhk->bth', qc, nv) + jnp.sum(s, axis=2)
        h = num / jnp.maximum(jnp.abs(den), jnp.exp(-m_t))[..., None]
        m_new = m_t[:, -1]
        g_inter = jnp.exp(b[:, -1] + m - m_new)
        kw = kc * jnp.exp(b[:, -1:] - b + lic - m_new[:, None])[..., None]
        C_new = g_inter[..., None, None] * C + jnp.einsum('bshk,bshv->bhkv', kw, vc)
        n_new = g_inter[..., None] * nv + jnp.sum(kw, axis=1)
        return (C_new, n_new, m_new), h

    state, h = lax.scan(step, state, tuple(to_chunks(t) for t in inputs))
    return from_chunks(h), state


def bidirectional_prefix_scan(run, ctx_f, lat_f, ctx_b, lat_b, state0, need_ctx):
    rev = lambda ts: tuple(jnp.flip(t, axis=1) for t in ts)
    out_cf, st_f = run(ctx_f, state0)
    out_lf, _ = run(lat_f, st_f)
    out_cb, st_b = run(rev(ctx_b), state0)
    out_lb, _ = run(rev(lat_b), st_b)
    lat = out_lf + jnp.flip(out_lb, axis=1)
    ctx = (out_cf + jnp.flip(out_cb, axis=1)) if need_ctx else None
    return ctx, lat


def gla_rglru_mixer(cn, xn, rows, need_ctx, w_in, gla_wa2, gla_ba, gla_norm_g, rg_conv_w, rg_conv_b,
                    rg_wr, rg_br, rg_wi, rg_bi, rg_lambda, w_out):
    def features(t, n_seg, seg_len):
        B, L, _ = t.shape
        q, k, v, g, lr_f, lr_b, rg_g, rg_x = jnp.split(t @ w_in, AB_SPLITS, axis=-1)
        q = (q.reshape(B, L, GLA_HEADS, GLA_DK) * GLA_DK ** -0.5).astype(f32)
        k = k.reshape(B, L, GLA_HEADS, GLA_DK).astype(f32)
        v = v.reshape(B, L, GLA_HEADS, GLA_DV).astype(f32)

        def log_decay(lr, d):
            z = (lr @ gla_wa2[d] + gla_ba[d]).astype(f32)
            return (jax.nn.log_sigmoid(z) / GLA_TAU).reshape(B, L, GLA_HEADS, GLA_DK)

        xb = short_conv(rg_x, rg_conv_w, rg_conv_b, n_seg, seg_len).astype(f32)

        def lru_inputs(d):
            r = jax.nn.sigmoid(block_diag(xb, rg_wr[d].astype(f32)) + rg_br[d])
            i = jax.nn.sigmoid(block_diag(xb, rg_wi[d].astype(f32)) + rg_bi[d])
            log_a = -RG_C * jax.nn.softplus(-rg_lambda[d].astype(f32)) * r
            return (jnp.exp(log_a), jnp.sqrt(-jnp.expm1(2.0 * log_a)) * (i * xb))

        return ((q, k, v, log_decay(lr_f, 0)), (q, k, v, log_decay(lr_b, 1)),
                lru_inputs(0), lru_inputs(1), g, rg_g)

    cf = features(cn, 1, cn.shape[1])
    lf = features(xn, rows, GRID_W)
    B = xn.shape[0]
    s0 = jnp.zeros((B, GLA_HEADS, GLA_DK, GLA_DV), f32)
    gla_c, gla_l = bidirectional_prefix_scan(gla_run, cf[0], lf[0], cf[1], lf[1], s0, need_ctx)
    h0 = jnp.zeros((B, RG_WIDTH), f32)
    lru_c, lru_l = bidirectional_prefix_scan(lru_run, cf[2], lf[2], cf[3], lf[3], h0, need_ctx)

    def merge(o_gla, h_lru, g, rg_g):
        B_, L = g.shape[:2]
        o = head_norm(o_gla.reshape(B_, L, GLA_VW), gla_norm_g, GLA_HEADS, False).astype(g.dtype) * jax.nn.silu(g)
        r = h_lru.astype(g.dtype) * jax.nn.gelu(rg_g)
        return jnp.concatenate([o, r], axis=-1) @ w_out

    y_lat = merge(gla_l, lru_l, lf[4], lf[5])
    y_ctx = merge(gla_c, lru_c, cf[4], cf[5]) if need_ctx else None
    return y_ctx, y_lat


def mlstm_mixer(cn, xn, rows, need_ctx, w_up, conv_w, conv_b, wq, wk, wv, w_gates, b_gates, skip, norm_g, w_down):
    def features(t, n_seg, seg_len):
        B, L, _ = t.shape
        xm, z = jnp.split(t @ w_up, 2, axis=-1)
        xc = jax.nn.silu(short_conv(xm, conv_w, conv_b, n_seg, seg_len))
        q = block_diag(xc, wq)
        k = block_diag(xc, wk) * M_DH ** -0.5
        v = block_diag(xm, wv)
        qkv = jnp.concatenate([q, k, v], axis=-1)
        heads = lambda a: a.reshape(B, L, M_HEADS, M_DH).astype(f32)

        def gates(d):
            gt = (qkv @ w_gates[d] + b_gates[d]).astype(f32)
            return gt[..., :M_HEADS], jax.nn.log_sigmoid(gt[..., M_HEADS:])

        qh, kh, vh = heads(q), heads(k), heads(v)
        li_f, lf_f = gates(0)
        li_b, lf_b = gates(1)
        return (qh, kh, vh, li_f, lf_f), (qh, kh, vh, li_b, lf_b), xc, z

    cf = features(cn, 1, cn.shape[1])
    lf = features(xn, rows, GRID_W)
    B = xn.shape[0]
    state0 = (jnp.zeros((B, M_HEADS, M_DH, M_DH), f32), jnp.zeros((B, M_HEADS, M_DH), f32),
              jnp.zeros((B, M_HEADS), f32))
    h_c, h_l = bidirectional_prefix_scan(mlstm_run, cf[0], lf[0], cf[1], lf[1], state0, need_ctx)

    def merge(h, xc, z):
        B_, L = z.shape[:2]
        hn = head_norm(h.reshape(B_, L, M_INNER), norm_g, M_HEADS, True).astype(z.dtype)
        return ((hn + skip * xc) * jax.nn.silu(z)) @ w_down

    y_lat = merge(h_l, lf[2], lf[3])
    y_ctx = merge(h_c, cf[2], cf[3]) if need_ctx else None
    return y_ctx, y_lat


def expert_choice_ffn(t, router_w, w_gate, w_up, w_down):
    B, L, D = t.shape
    cap = EC_CAPACITY * L // N_EXPERTS
    probs = jax.nn.softmax((t @ router_w).astype(f32), axis=-1)
    gate, idx = lax.top_k(jnp.swapaxes(probs, 1, 2), cap)
    xe = jax.vmap(lambda tb, ib: tb[ib])(t, idx)
    hdn = jax.nn.silu(jnp.einsum('becd,edf->becf', xe, w_gate)) * jnp.einsum('becd,edf->becf', xe, w_up)
    ye = jnp.einsum('becf,efd->becd', hdn, w_down) * gate[..., None].astype(t.dtype)
    return jax.vmap(lambda ib, yb: jnp.zeros((L, D), yb.dtype).at[ib.reshape(-1)].add(yb.reshape(-1, D)))(idx, ye)


def setup_inputs(seed: int = 0) -> dict:
    key = jax.random.key(seed)
    keys = jax.random.split(key, 40)
    D = D_MODEL
    NE = (DEPTH + 1) // 2
    NO = DEPTH // 2

    def nrm(i, shape, scale=1.0):
        return jax.random.normal(keys[i], shape, f32) * scale

    def gain(i, shape):
        return 1.0 + nrm(i, shape, 0.05)

    a_c = jax.random.uniform(keys[17], (NE, 2, RG_WIDTH), f32, 0.9, 0.999)
    a_base = a_c ** (1.0 / RG_C)
    rg_lambda = jnp.log(a_base) - jnp.log1p(-a_base)
    f_bias = jnp.broadcast_to(jnp.linspace(3.0, 6.0, M_HEADS, dtype=f32), (NO, 2, M_HEADS)) + nrm(27, (NO, 2, M_HEADS), 0.01)
    i_bias = nrm(28, (NO, 2, M_HEADS), 0.1)
    return {
        'x': nrm(0, (BATCH, SEQ, D)),
        'c': nrm(1, (BATCH, D)),
        'ctx': nrm(2, (BATCH, CTX_LEN, D)),
        'c_ctx': nrm(3, (D,)),
        'mod_w': nrm(4, (DEPTH, D, 6 * D), 0.5 * D ** -0.5),
        'mod_b': nrm(5, (DEPTH, 6 * D), 0.02),
        'norm1_g': gain(6, (DEPTH, D)),
        'norm2_g': gain(7, (DEPTH, D)),
        'ab_w_in': nrm(8, (NE, D, AB_IN), D ** -0.5),
        'gla_wa2': nrm(9, (NE, 2, GLA_RANK, GLA_KW), GLA_RANK ** -0.5),
        'gla_ba': nrm(10, (NE, 2, GLA_KW), 0.1),
        'gla_norm_g': gain(11, (NE, GLA_VW)),
        'rg_conv_w': nrm(12, (NE, CONV_W, RG_WIDTH), CONV_W ** -0.5),
        'rg_conv_b': nrm(13, (NE, RG_WIDTH), 0.01),
        'rg_wr': nrm(14, (NE, 2, RG_BLOCKS, RG_BS, RG_BS), RG_BS ** -0.5),
        'rg_br': nrm(15, (NE, 2, RG_WIDTH), 0.1),
        'rg_wi': nrm(16, (NE, 2, RG_BLOCKS, RG_BS, RG_BS), RG_BS ** -0.5),
        'rg_bi': nrm(18, (NE, 2, RG_WIDTH), 0.1),
        'rg_lambda': rg_lambda,
        'ab_w_out': nrm(19, (NE, AB_MIX, D), AB_MIX ** -0.5),
        'm_w_up': nrm(20, (NO, D, 2 * M_INNER), D ** -0.5),
        'm_conv_w': nrm(21, (NO, CONV_W, M_INNER), CONV_W ** -0.5),
        'm_conv_b': nrm(22, (NO, M_INNER), 0.01),
        'm_wq': nrm(23, (NO, M_QKV_NB, M_QKV_BS, M_QKV_BS), M_QKV_BS ** -0.5),
        'm_wk': nrm(24, (NO, M_QKV_NB, M_QKV_BS, M_QKV_BS), M_QKV_BS ** -0.5),
        'm_wv': nrm(25, (NO, M_QKV_NB, M_QKV_BS, M_QKV_BS), M_QKV_BS ** -0.5),
        'm_w_gates': nrm(26, (NO, 2, 3 * M_INNER, 2 * M_HEADS), 0.1 * (3 * M_INNER) ** -0.5),
        'm_b_gates': jnp.concatenate([i_bias, f_bias], axis=-1),
        'm_skip': gain(29, (NO, M_INNER)),
        'm_norm_g': gain(30, (NO, M_INNER)),
        'm_w_down': nrm(31, (NO, M_INNER, D), M_INNER ** -0.5),
        'router_w': nrm(32, (DEPTH, D, N_EXPERTS), D ** -0.5),
        'exp_w_gate': nrm(33, (DEPTH, N_EXPERTS, D, EXPERT_FF), D ** -0.5),
        'exp_w_up': nrm(34, (DEPTH, N_EXPERTS, D, EXPERT_FF), D ** -0.5),
        'exp_w_down': nrm(35, (DEPTH, N_EXPERTS, EXPERT_FF, D), EXPERT_FF ** -0.5),
        'final_g': gain(36, (D,)),
    }


def reference(x, c, ctx, c_ctx, mod_w, mod_b, norm1_g, norm2_g, ab_w_in, gla_wa2, gla_ba, gla_norm_g,
              rg_conv_w, rg_conv_b, rg_wr, rg_br, rg_wi, rg_bi, rg_lambda, ab_w_out, m_w_up, m_conv_w,
              m_conv_b, m_wq, m_wk, m_wv, m_w_gates, m_b_gates, m_skip, m_norm_g, m_w_down, router_w,
              exp_w_gate, exp_w_up, exp_w_down, final_g):
    rows = x.shape[1] // GRID_W
    for layer in range(DEPTH):
        need_ctx = layer < DEPTH - 1
        mods = jnp.split(jax.nn.silu(c) @ mod_w[layer] + mod_b[layer], 6, axis=-1)
        sh1, sc1, g1, sh2, sc2, g2 = [m[:, None, :] for m in mods]
        csh1, csc1, cg1, csh2, csc2, cg2 = jnp.split(jax.nn.silu(c_ctx) @ mod_w[layer] + mod_b[layer], 6, axis=-1)
        xn = rmsnorm(x, norm1_g[layer]) * (1 + sc1) + sh1
        cn = rmsnorm(ctx, norm1_g[layer]) * (1 + csc1) + csh1
        if layer % 2 == 0:
            e = layer // 2
            y_ctx, y_lat = gla_rglru_mixer(cn, xn, rows, need_ctx, ab_w_in[e], gla_wa2[e], gla_ba[e], gla_norm_g[e],
                                           rg_conv_w[e], rg_conv_b[e], rg_wr[e], rg_br[e], rg_wi[e], rg_bi[e],
                                           rg_lambda[e], ab_w_out[e])
        else:
            o = layer // 2
            y_ctx, y_lat = mlstm_mixer(cn, xn, rows, need_ctx, m_w_up[o], m_conv_w[o], m_conv_b[o], m_wq[o], m_wk[o],
                                       m_wv[o], m_w_gates[o], m_b_gates[o], m_skip[o], m_norm_g[o], m_w_down[o])
        x = x + g1 * y_lat
        x = x + g2 * expert_choice_ffn(rmsnorm(x, norm2_g[layer]) * (1 + sc2) + sh2, router_w[layer],
                                       exp_w_gate[layer], exp_w_up[layer], exp_w_down[layer])
        if need_ctx:
            ctx = ctx + cg1 * y_ctx
            ctx = ctx + cg2 * expert_choice_ffn(rmsnorm(ctx, norm2_g[layer]) * (1 + csc2) + csh2, router_w[layer],
                                                exp_w_gate[layer], exp_w_up[layer], exp_w_down[layer])
    return rmsnorm(x, final_g)
```

```cpp
#include <hip/hip_runtime.h>
#include <hip/hip_cooperative_groups.h>
#include <cstdio>
#include <cstdint>
namespace cg = cooperative_groups;

#define LAS __attribute__((address_space(3)))
#define DI __device__ __forceinline__
typedef unsigned short bf16_t;
typedef short bf16x8 __attribute__((ext_vector_type(8)));
typedef short s16x4 __attribute__((ext_vector_type(4)));
typedef float f32x4 __attribute__((ext_vector_type(4)));
typedef float f32x2 __attribute__((ext_vector_type(2)));
typedef unsigned u32x4 __attribute__((ext_vector_type(4)));
typedef unsigned u32x2 __attribute__((ext_vector_type(2)));
typedef LAS char* lds_t;

constexpr int D = 1024, NBATCH = 4, SEQ = 8192, CTXL = 256;
constexpr int NLAT = NBATCH * SEQ;
constexpr int NCTX = NBATCH * CTXL;
constexpr int NTOK = NLAT + NCTX;
constexpr int NCH = NTOK / 64;
constexpr int NCHL = NLAT / 64;
constexpr int ABIN = 2592;
constexpr int PC_Q = 0, PC_K = 256, PC_V = 512, PC_G = 1024, PC_LRF = 1536, PC_LRB = 1552, PC_RGG = 1568, PC_RGX = 2080;
constexpr float EPS = 1e-6f;
constexpr int NTHREADS = 512;
constexpr int LDS_BYTES = 160 * 1024;
#define DBG_MODE 1
#define DBG_STOP 23
#define DBG_COL0 0

constexpr size_t OFF_MODS = 0;
constexpr size_t OFF_GCAT = 245760;
constexpr size_t OFF_MMAT = 376832;
constexpr size_t OFF_ACT = 1u << 20;
constexpr size_t ACT_BYTES = (size_t)NTOK * 1024 * 2;
constexpr size_t OFF_ARENA = OFF_ACT + ACT_BYTES;
constexpr size_t A_P = 0;
constexpr size_t A_U = A_P + (size_t)NTOK * ABIN * 2;
constexpr size_t A_LA = A_U + (size_t)NCH * 2 * 4 * 8192 * 4;
constexpr size_t A_UU = A_LA + (size_t)NTOK * 2 * 512 * 4;
constexpr size_t A_DEC = A_UU + (size_t)NTOK * 2 * 512 * 2;
constexpr size_t A_AGGA = A_DEC + (size_t)NCH * 2 * 256 * 4;
constexpr size_t A_AGGH = A_AGGA + (size_t)NCH * 2 * 512 * 4;
constexpr size_t A_L0_END = A_AGGH + (size_t)NCH * 2 * 512 * 4;
constexpr size_t A_X = 0;
constexpr size_t A_PT = A_X + (size_t)NTOK * 1024 * 4;
constexpr size_t A_PE = A_PT + (size_t)NTOK * 16 * 4;
constexpr size_t A_ROWID = A_PE + (size_t)NTOK * 16 * 4;
constexpr size_t A_ROWTOK = A_ROWID + (size_t)NTOK * 16 * 4;
constexpr size_t A_HDN = A_ROWTOK + (size_t)16 * 4352 * 4;
constexpr size_t A_Y = A_HDN + (size_t)16 * 4352 * 1024 * 2;
constexpr size_t A_MOE0_END = A_Y + (size_t)16 * 4352 * 1024 * 2;
constexpr size_t A_XM = A_X + (size_t)NTOK * 1024 * 4;
constexpr size_t A_XC = A_XM + (size_t)NTOK * 2048 * 2;
constexpr size_t A_HB = A_XC + (size_t)NTOK * 2048 * 2;
constexpr size_t A_L1_END = A_HB + (size_t)NLAT * 2048 * 2;
constexpr size_t ACT_RAWS = 0;
constexpr size_t ACT_GP = ACT_RAWS + (size_t)NCH * 4 * 4096 * 2;
constexpr size_t ACT_CTXV = ACT_GP + (size_t)NTOK * 64 * 4;
constexpr size_t WS_NEED = OFF_ARENA + (A_L1_END > A_L0_END ? A_L1_END : A_L0_END);
static_assert(A_MOE0_END < A_L1_END, "arena");
static_assert(ACT_CTXV + (size_t)NCTX * 2048 * 2 <= ACT_BYTES, "act region");

struct Params {
    const float *x, *c, *ctx, *c_ctx, *mod_w, *mod_b, *norm1_g, *norm2_g, *ab_w_in, *gla_wa2, *gla_ba, *gla_norm_g;
    const float *rg_conv_w, *rg_conv_b, *rg_wr, *rg_br, *rg_wi, *rg_bi, *rg_lambda, *ab_w_out, *m_w_up, *m_conv_w, *m_conv_b;
    const float *m_wq, *m_wk, *m_wv, *m_w_gates, *m_b_gates, *m_skip, *m_norm_g, *m_w_down, *router_w, *exp_w_gate, *exp_w_up, *exp_w_down, *final_g;
    float* out;
    char* ws;
    int ph_lo, ph_hi;
};

typedef const Params __attribute__((address_space(4)))* PP;

DI int get_tid() { int t = threadIdx.x; asm volatile("" : "+v"(t)); return t; }
DI int get_bid() { int b = blockIdx.x; asm volatile("" : "+s"(b)); return b; }
DI float bf2f(bf16_t h) { return __uint_as_float((unsigned)h << 16); }
DI bf16_t f2bf(float x) { unsigned u = __float_as_uint(x); u += 0x7fffu + ((u >> 16) & 1u); return (bf16_t)(u >> 16); }
typedef __bf16 bf16x2_t __attribute__((ext_vector_type(2)));
DI unsigned pk2n(float lo, float hi) { const f32x2 v = {lo, hi}; return __builtin_bit_cast(unsigned, __builtin_convertvector(v, bf16x2_t)); }
DI unsigned pk2(float lo, float hi) { return pk2n(lo, hi); }
DI float lo_bf(unsigned u) { return __uint_as_float(u << 16); }
DI float hi_bf(unsigned u) { return __uint_as_float(u & 0xffff0000u); }
DI float sigmoidf_(float x) { return 1.f / (1.f + __expf(-x)); }
DI float siluf_(float x) { return x / (1.f + __expf(-x)); }
DI float log_sigmoidf_(float z) { return fminf(z, 0.f) - log1pf(__expf(-fabsf(z))); }
DI float softplusf_(float z) { return fmaxf(z, 0.f) + log1pf(__expf(-fabsf(z))); }
DI float gelu_tanh(float x) { const float u = 0.7978845608028654f * (x + 0.044715f * x * x * x); return 0.5f * x * (1.f + tanhf(u)); }
DI float wave_sum(float v) {
#pragma unroll
    for (int o = 32; o > 0; o >>= 1) v += __shfl_xor(v, o);
    return v;
}
DI f32x4 mfma16(bf16x8 a, bf16x8 b, f32x4 c) { return __builtin_amdgcn_mfma_f32_16x16x32_bf16(a, b, c, 0, 0, 0); }

DI bf16x8 frag_row(const LAS bf16_t* tile, int ld, int r0, int k0, int lane) {
    return *(const LAS bf16x8*)(tile + (r0 + (lane & 15)) * ld + k0 + 8 * (lane >> 4));
}
DI bf16x8 frag_tr(const LAS bf16_t* tile, int ld, int k0, int c0, int lane) {
    const int g = lane >> 4, i = lane & 15, q = i >> 2, p = i & 3;
    const LAS bf16_t* base = tile + (k0 + 8 * g + q) * ld + c0 + 4 * p;
    const s16x4 lo = __builtin_amdgcn_ds_read_tr16_b64_v4i16((LAS s16x4*)base);
    const s16x4 hi = __builtin_amdgcn_ds_read_tr16_b64_v4i16((LAS s16x4*)(base + 4 * ld));
    return __builtin_shufflevector(lo, hi, 0, 1, 2, 3, 4, 5, 6, 7);
}
DI const float* mods_ptr(PP p, int layer, int s, int which) { return (const float*)(p->ws + OFF_MODS) + ((size_t)(layer * 5 + s) * 6 + which) * 1024; }
DI int row_set(int r) { return r < NLAT ? (r >> 13) : 4; }

template <int BN, class ARow, class BCol, class Epi>
DI void gemm_unit(lds_t lds, int K, int ldb, ARow arow, BCol bcol, Epi epi) {
    constexpr int BK = 32;
    constexpr int NT = BN / 64;
    constexpr int LDA = BK + 8, LDB = BN + 16;
    constexpr int A_BYTES = 256 * LDA * 2, B_BYTES = BK * LDB * 2;
    static_assert(2 * A_BYTES + 2 * B_BYTES <= LDS_BYTES, "gemm lds");
    const int tid = get_tid(), lane = tid & 63, w = tid >> 6, wr = w >> 2, wc = w & 3;
    constexpr int ACH = BK / 8, ARP = NTHREADS / ACH, AP = 256 / ARP;
    const int achunk = tid % ACH, arow0 = tid / ACH;
    const bf16_t* ap[AP];
#pragma unroll
    for (int q = 0; q < AP; ++q) ap[q] = arow(arow0 + ARP * q);
    constexpr int CG = BN / 8, KR = NTHREADS / CG, BP = BK / KR;
    const int bc8 = tid % CG, bk0 = tid / CG;
    const float* bp = bcol(bc8 * 8);
    u32x4 areg[AP];
    f32x4 breg[BP][2];
    auto gload = [&](int kt) {
        const int k0 = kt * BK;
#pragma unroll
        for (int q = 0; q < AP; ++q) areg[q] = ap[q] ? *(const u32x4*)(ap[q] + k0 + achunk * 8) : (u32x4){0u, 0u, 0u, 0u};
#pragma unroll
        for (int q = 0; q < BP; ++q) {
            if (bp) { const float* s = bp + (size_t)(k0 + bk0 + KR * q) * ldb; breg[q][0] = *(const f32x4*)s; breg[q][1] = *(const f32x4*)(s + 4); }
            else { breg[q][0] = (f32x4){0.f, 0.f, 0.f, 0.f}; breg[q][1] = breg[q][0]; }
        }
    };
    auto lstore = [&](int buf) {
        LAS bf16_t* As = (LAS bf16_t*)(lds + buf * A_BYTES);
        LAS bf16_t* Bs = (LAS bf16_t*)(lds + 2 * A_BYTES + buf * B_BYTES);
#pragma unroll
        for (int q = 0; q < AP; ++q) *(LAS u32x4*)(As + (arow0 + ARP * q) * LDA + achunk * 8) = areg[q];
#pragma unroll
        for (int q = 0; q < BP; ++q) {
            u32x4 v; v.x = pk2(breg[q][0][0], breg[q][0][1]); v.y = pk2(breg[q][0][2], breg[q][0][3]); v.z = pk2(breg[q][1][0], breg[q][1][1]); v.w = pk2(breg[q][1][2], breg[q][1][3]);
            *(LAS u32x4*)(Bs + (bk0 + KR * q) * LDB + bc8 * 8) = v;
        }
    };
    f32x4 acc[8][NT];
#pragma unroll
    for (int mi = 0; mi < 8; ++mi)
#pragma unroll
        for (int ni = 0; ni < NT; ++ni) acc[mi][ni] = (f32x4){0.f, 0.f, 0.f, 0.f};
    const int nk = K / BK;
    gload(0);
    for (int kt = 0; kt < nk; ++kt) {
        lstore(kt & 1);
        __syncthreads();
        if (kt + 1 < nk) gload(kt + 1);
        const LAS bf16_t* As = (const LAS bf16_t*)(lds + (kt & 1) * A_BYTES);
        const LAS bf16_t* Bs = (const LAS bf16_t*)(lds + 2 * A_BYTES + (kt & 1) * B_BYTES);
#pragma unroll
        for (int ks = 0; ks < BK / 32; ++ks) {
            bf16x8 wb[NT];
#pragma unroll
            for (int ni = 0; ni < NT; ++ni) wb[ni] = frag_tr(Bs, LDB, ks * 32, wc * (BN / 4) + ni * 16, lane);
#pragma unroll
            for (int mi = 0; mi < 8; ++mi) {
                const bf16x8 xa = frag_row(As, LDA, wr * 128 + mi * 16, ks * 32, lane);
#pragma unroll
                for (int ni = 0; ni < NT; ++ni) acc[mi][ni] = mfma16(wb[ni], xa, acc[mi][ni]);
            }
        }
    }
    epi(acc, wr, wc, lane);
    __syncthreads();
}

template <int NT, class F>
DI void epi_each(const f32x4 (&acc)[8][NT], int wr, int wc, int lane, F f) {
#pragma unroll
    for (int mi = 0; mi < 8; ++mi)
#pragma unroll
        for (int ni = 0; ni < NT; ++ni) f(wr * 128 + mi * 16 + (lane & 15), wc * (NT * 16) + ni * 16 + 4 * (lane >> 4), acc[mi][ni]);
}
DI void store_bf16x4(bf16_t* dst, f32x4 v) { u32x2 o; o.x = pk2(v[0], v[1]); o.y = pk2(v[2], v[3]); *(u32x2*)dst = o; }

DI void row_load_f32(const float* src, f32x4 (&v)[4], int lane) {
#pragma unroll
    for (int i = 0; i < 4; ++i) v[i] = *(const f32x4*)(src + 4 * lane + 256 * i);
}
DI float row_sumsq(const f32x4 (&v)[4]) {
    float s = 0.f;
#pragma unroll
    for (int i = 0; i < 4; ++i) s += v[i][0] * v[i][0] + v[i][1] * v[i][1] + v[i][2] * v[i][2] + v[i][3] * v[i][3];
    return wave_sum(s);
}
DI void row_modulate(f32x4 (&v)[4], float rs, const float* g, const float* sc, const float* sh, int lane) {
#pragma unroll
    for (int i = 0; i < 4; ++i) {
        const int c = 4 * lane + 256 * i;
        const f32x4 gg = *(const f32x4*)(g + c), ss = *(const f32x4*)(sc + c), hh = *(const f32x4*)(sh + c);
#pragma unroll
        for (int j = 0; j < 4; ++j) v[i][j] = v[i][j] * rs * gg[j] * (1.f + ss[j]) + hh[j];
    }
}
DI void row_store_bf16(bf16_t* dst, const f32x4 (&v)[4], int lane) {
#pragma unroll
    for (int i = 0; i < 4; ++i) store_bf16x4(dst + 4 * lane + 256 * i, v[i]);
}

DI void phase_mods(PP p, lds_t lds) {
    const int tid = get_tid();
    LAS float* sil = (LAS float*)lds;
    LAS float* red = sil + 5 * 1024;
    for (int u = get_bid(); u < 192 + 32; u += gridDim.x) {
        if (u < 192) {
            const int layer = u / 96, c0 = (u % 96) * 64;
            for (int i = tid; i < 5 * 1024; i += NTHREADS) { const int s = i >> 10, k = i & 1023; const float cv = s < 4 ? p->c[s * 1024 + k] : p->c_ctx[k]; sil[i] = siluf_(cv); }
            __syncthreads();
            const int col = tid & 63, kp = tid >> 6;
            float a[5] = {0.f, 0.f, 0.f, 0.f, 0.f};
            const float* wp = p->mod_w + (size_t)layer * 1024 * 6144 + c0 + col;
            for (int k = kp * 128; k < kp * 128 + 128; ++k) {
                const float wv = wp[(size_t)k * 6144];
#pragma unroll
                for (int s = 0; s < 5; ++s) a[s] += sil[s * 1024 + k] * wv;
            }
#pragma unroll
            for (int s = 0; s < 5; ++s) red[(kp * 5 + s) * 64 + col] = a[s];
            __syncthreads();
            if (tid < 320) {
                const int s = tid >> 6, cc = tid & 63;
                float t = p->mod_b[layer * 6144 + c0 + cc];
#pragma unroll
                for (int k = 0; k < 8; ++k) t += red[(k * 5 + s) * 64 + cc];
                ((float*)(p->ws + OFF_MODS))[(size_t)(layer * 5 + s) * 6144 + c0 + cc] = t;
            }
            __syncthreads();
        } else {
            const int f0 = (u - 192) * 64;
            const int fl = tid >> 3, dgp = (tid & 7) * 2, f = f0 + fl, n = f >> 2, i = f & 3;
            bf16_t* gxc = (bf16_t*)(p->ws + OFF_GCAT);
            bf16_t* gxm = gxc + 2048 * 16;
#pragma unroll
            for (int e = 0; e < 2; ++e) {
                const int dg = dgp + e, d = dg >> 3, g = dg & 7;
                const float* wg = p->m_w_gates + (size_t)d * 6144 * 8;
                float a = 0.f, b = 0.f;
#pragma unroll
                for (int o = 0; o < 4; ++o) {
                    a += p->m_wq[n * 16 + i * 4 + o] * wg[(size_t)(4 * n + o) * 8 + g];
                    a += p->m_wk[n * 16 + i * 4 + o] * wg[(size_t)(2048 + 4 * n + o) * 8 + g] * 0.04419417382415922f;
                    b += p->m_wv[n * 16 + i * 4 + o] * wg[(size_t)(4096 + 4 * n + o) * 8 + g];
                }
                gxc[f * 16 + dg] = f2bf(a); gxm[f * 16 + dg] = f2bf(b);
            }
            if (tid < 256) {
                const int nn = (f0 >> 2) + (tid >> 4), e = tid & 15, ii = e >> 2, jj = e & 3;
                float a = 0.f;
#pragma unroll
                for (int o = 0; o < 4; ++o) a += p->m_wq[nn * 16 + ii * 4 + o] * p->m_wk[nn * 16 + jj * 4 + o];
                ((float*)(p->ws + OFF_MMAT))[nn * 16 + e] = a * 0.04419417382415922f;
            }
        }
    }
}

template <class Src>
DI void phase_norm(PP p, int layer, int nrows, Src src) {
    const int lane = get_tid() & 63, gw = get_bid() * 8 + (get_tid() >> 6), nw = gridDim.x * 8;
    bf16_t* act = (bf16_t*)(p->ws + OFF_ACT);
    for (int r = gw; r < nrows; r += nw) {
        f32x4 v[4];
        row_load_f32(src(r), v, lane);
        const float rs = rsqrtf(row_sumsq(v) * (1.f / 1024.f) + EPS);
        const int s = row_set(r);
        row_modulate(v, rs, p->norm1_g + layer * 1024, mods_ptr(p, layer, s, 1), mods_ptr(p, layer, s, 0), lane);
        row_store_bf16(act + (size_t)r * 1024, v, lane);
    }
}

DI void phase_inproj(PP p, lds_t lds) {
    const bf16_t* act = (const bf16_t*)(p->ws + OFF_ACT);
    bf16_t* P = (bf16_t*)(p->ws + OFF_ARENA + A_P);
    constexpr int NM = NTOK / 256, NN = 11;
    for (int u = get_bid(); u < NM * NN; u += gridDim.x) {
        const int pn = u / NM, pm = u % NM;
        gemm_unit<256>(lds, 1024, ABIN,
            [&](int r) { return act + (size_t)(pm * 256 + r) * 1024; },
            [&](int j) -> const float* { const int c = pn * 256 + j; return c < ABIN ? p->ab_w_in + c : nullptr; },
            [&](const f32x4 (&acc)[8][4], int wr, int wc, int lane) {
                epi_each<4>(acc, wr, wc, lane, [&](int r, int c, f32x4 v) { const int col = pn * 256 + c; if (col < ABIN) store_bf16x4(P + (size_t)(pm * 256 + r) * ABIN + col, v); });
            });
    }
}


DI void gla_bcum(LAS float* bc, const LAS float* lrt, const LAS float* wat, const LAS float* bat, int d) {
    const int tid = get_tid();
    {
        const int c = tid & 63, tq = tid >> 6;
        float wcol[16];
#pragma unroll
        for (int r = 0; r < 16; ++r) wcol[r] = wat[r * 64 + c];
        const float bias = bat[c];
        for (int t = tq * 8; t < tq * 8 + 8; ++t) {
            float z = bias;
#pragma unroll
            for (int r = 0; r < 16; ++r) z += lrt[t * 16 + r] * wcol[r];
            bc[t * 64 + c] = log_sigmoidf_(z) * (1.f / 16.f);
        }
    }
    __syncthreads();
    if (tid < 64) {
        float run = 0.f;
        if (d == 0) { for (int t = 0; t < 64; ++t) { run += bc[t * 64 + tid]; bc[t * 64 + tid] = run; } }
        else { for (int t = 63; t >= 0; --t) { run += bc[t * 64 + tid]; bc[t * 64 + tid] = run; } }
    }
    __syncthreads();
}
DI void gla_load_decay_inputs(PP p, const bf16_t* P, int r0, int h, LAS float* lrt, LAS float* wat, LAS float* bat) {
    const int tid = get_tid();
    if (tid < 256) {
        const int d = tid >> 7, t = (tid >> 1) & 63, half = tid & 1;
        const u32x4 v = *(const u32x4*)(P + (size_t)(r0 + t) * ABIN + PC_LRF + d * 16 + half * 8);
        LAS float* o = lrt + (d * 64 + t) * 16 + half * 8;
        o[0] = lo_bf(v.x); o[1] = hi_bf(v.x); o[2] = lo_bf(v.y); o[3] = hi_bf(v.y); o[4] = lo_bf(v.z); o[5] = hi_bf(v.z); o[6] = lo_bf(v.w); o[7] = hi_bf(v.w);
    }
    {
        const int i = tid * 4, d = i >> 10, r = (i >> 6) & 15, c = i & 63;
        *(LAS f32x4*)(wat + i) = *(const f32x4*)(p->gla_wa2 + (size_t)(d * 16 + r) * 256 + h * 64 + c);
    }
    if (tid < 128) bat[tid] = p->gla_ba[(tid >> 6) * 256 + h * 64 + (tid & 63)];
}

DI void phase_g1(PP p, lds_t lds) {
    const int tid = get_tid(), lane = tid & 63, w = tid >> 6;
    const bf16_t* P = (const bf16_t*)(p->ws + OFF_ARENA + A_P);
    float* U = (float*)(p->ws + OFF_ARENA + A_U);
    float* DEC = (float*)(p->ws + OFF_ARENA + A_DEC);
    float* LA = (float*)(p->ws + OFF_ARENA + A_LA);
    bf16_t* UU = (bf16_t*)(p->ws + OFF_ARENA + A_UU);
    float* AGGA = (float*)(p->ws + OFF_ARENA + A_AGGA);
    float* AGGH = (float*)(p->ws + OFF_ARENA + A_AGGH);
    constexpr int NGLA = NCH * 4, NLRU = NCH * 4;
    for (int task = get_bid(); task < NGLA + NLRU; task += gridDim.x) {
        if (task < NGLA) {
            const int ch = task >> 2, h = task & 3, r0 = ch * 64;
            LAS float* lrt = (LAS float*)lds;
            LAS float* wat = lrt + 2048;
            LAS float* bat = wat + 2048;
            LAS float* bc = bat + 128;
            LAS bf16_t* kt = (LAS bf16_t*)(bc + 8192);
            LAS bf16_t* ktd = kt + 64 * 72;
            LAS bf16_t* vt = ktd + 2 * 64 * 72;
            gla_load_decay_inputs(p, P, r0, h, lrt, wat, bat);
            { const int row = tid >> 3, chunk = tid & 7; *(LAS u32x4*)(kt + row * 72 + chunk * 8) = *(const u32x4*)(P + (size_t)(r0 + row) * ABIN + PC_K + h * 64 + chunk * 8); }
#pragma unroll
            for (int q = 0; q < 2; ++q) { const int i = tid + 512 * q, row = i >> 4, chunk = i & 15; *(LAS u32x4*)(vt + row * 136 + chunk * 8) = *(const u32x4*)(P + (size_t)(r0 + row) * ABIN + PC_V + h * 128 + chunk * 8); }
            __syncthreads();
            gla_bcum(bc, lrt, wat, bat, 0);
            gla_bcum(bc + 4096, lrt + 1024, wat + 1024, bat + 64, 1);
            {
                const int t = tid >> 3, c8 = (tid & 7) * 8;
#pragma unroll
                for (int d = 0; d < 2; ++d) {
                    const LAS float* b = bc + d * 4096;
                    const int tl = d == 0 ? 63 : 0;
                    float o[8];
#pragma unroll
                    for (int j = 0; j < 8; ++j) o[j] = bf2f(kt[t * 72 + c8 + j]) * __expf(b[tl * 64 + c8 + j] - b[t * 64 + c8 + j]);
                    u32x4 v; v.x = pk2(o[0], o[1]); v.y = pk2(o[2], o[3]); v.z = pk2(o[4], o[5]); v.w = pk2(o[6], o[7]);
                    *(LAS u32x4*)(ktd + d * 64 * 72 + t * 72 + c8) = v;
                }
                if (tid < 128) { const int d = tid >> 6, c = tid & 63; DEC[(size_t)(ch * 2 + d) * 256 + h * 64 + c] = __expf(bc[d * 4096 + (d == 0 ? 63 : 0) * 64 + c]); }
            }
            __syncthreads();
            {
                const int d = w >> 2, dkt = w & 3;
                const LAS bf16_t* kd = ktd + d * 64 * 72;
                bf16x8 kb[2];
#pragma unroll
                for (int ks = 0; ks < 2; ++ks) kb[ks] = frag_tr(kd, 72, ks * 32, dkt * 16, lane);
                float* Ud = U + ((size_t)(ch * 2 + d) * 4 + h) * 8192;
#pragma unroll
                for (int dvt = 0; dvt < 8; ++dvt) {
                    f32x4 acc = {0.f, 0.f, 0.f, 0.f};
#pragma unroll
                    for (int ks = 0; ks < 2; ++ks) acc = mfma16(frag_tr(vt, 136, ks * 32, dvt * 16, lane), kb[ks], acc);
                    *(f32x4*)(Ud + (dkt * 16 + (lane & 15)) * 128 + dvt * 16 + 4 * (lane >> 4)) = acc;
                }
            }
            __syncthreads();
        } else {
            const int t2 = task - NGLA, ch = t2 >> 2, cq = t2 & 3, r0 = ch * 64;
            const int seg_lo = ch < NCHL ? r0 : NLAT + ((r0 - NLAT) >> 8) * 256, seg_hi = ch < NCHL ? r0 + 64 : seg_lo + 256;
            LAS bf16_t* xin = (LAS bf16_t*)lds;
            LAS bf16_t* xb = xin + 67 * 136;
            LAS float* lat = (LAS float*)(xb + 64 * 136);
            LAS bf16_t* git = (LAS bf16_t*)(lat + 2 * 64 * 128);
            for (int i = tid; i < 67 * 16; i += NTHREADS) {
                const int row = i >> 4, chunk = i & 15, r = r0 - 2 + row;
                u32x4 v = {0u, 0u, 0u, 0u};
                if (r >= seg_lo && r < seg_hi) v = *(const u32x4*)(P + (size_t)r * ABIN + PC_RGX + cq * 128 + chunk * 8);
                *(LAS u32x4*)(xin + row * 136 + chunk * 8) = v;
            }
            __syncthreads();
            {
                const int t = tid >> 3, c16 = (tid & 7) * 16;
                float o[16];
#pragma unroll
                for (int j = 0; j < 16; ++j) o[j] = p->rg_conv_b[cq * 128 + c16 + j];
#pragma unroll
                for (int tap = 0; tap < 4; ++tap)
#pragma unroll
                    for (int j = 0; j < 16; ++j) o[j] += p->rg_conv_w[tap * 512 + cq * 128 + c16 + j] * bf2f(xin[(t + tap) * 136 + c16 + j]);
#pragma unroll
                for (int j = 0; j < 16; j += 8) {
                    u32x4 v; v.x = pk2(o[j], o[j + 1]); v.y = pk2(o[j + 2], o[j + 3]); v.z = pk2(o[j + 4], o[j + 5]); v.w = pk2(o[j + 6], o[j + 7]);
                    *(LAS u32x4*)(xb + t * 136 + c16 + j) = v;
                }
            }
            __syncthreads();
            {
                const int blk = w & 1, d = (w >> 1) & 1, mat = w >> 2, n = cq * 2 + blk;
                const float* W = (mat ? p->rg_wi : p->rg_wr) + (size_t)(d * 8 + n) * 4096;
                const float* bias = (mat ? p->rg_bi : p->rg_br) + d * 512 + n * 64;
                bf16x8 wf[4][2];
#pragma unroll
                for (int ot = 0; ot < 4; ++ot)
#pragma unroll
                    for (int ks = 0; ks < 2; ++ks) {
                        const float* src = W + (size_t)(ks * 32 + 8 * (lane >> 4)) * 64 + ot * 16 + (lane & 15);
                        float f[8];
#pragma unroll
                        for (int j = 0; j < 8; ++j) f[j] = src[j * 64];
                        u32x4 v; v.x = pk2n(f[0], f[1]); v.y = pk2n(f[2], f[3]); v.z = pk2n(f[4], f[5]); v.w = pk2n(f[6], f[7]);
                        wf[ot][ks] = __builtin_bit_cast(bf16x8, v);
                    }
#pragma unroll
                for (int tt = 0; tt < 4; ++tt) {
                    bf16x8 xf[2];
#pragma unroll
                    for (int ks = 0; ks < 2; ++ks) xf[ks] = frag_row(xb, 136, tt * 16, blk * 64 + ks * 32, lane);
#pragma unroll
                    for (int ot = 0; ot < 4; ++ot) {
                        f32x4 acc = {0.f, 0.f, 0.f, 0.f};
#pragma unroll
                        for (int ks = 0; ks < 2; ++ks) acc = mfma16(wf[ot][ks], xf[ks], acc);
                        const int t = tt * 16 + (lane & 15), o = ot * 16 + 4 * (lane >> 4), c = blk * 64 + o;
                        const f32x4 bv = *(const f32x4*)(bias + o);
                        if (mat == 0) {
                            const f32x4 lam = *(const f32x4*)(p->rg_lambda + d * 512 + n * 64 + o);
                            f32x4 la;
#pragma unroll
                            for (int j = 0; j < 4; ++j) la[j] = -8.f * softplusf_(-lam[j]) * sigmoidf_(acc[j] + bv[j]);
                            *(LAS f32x4*)(lat + (d * 64 + t) * 128 + c) = la;
                        } else {
                            float gi[4];
#pragma unroll
                            for (int j = 0; j < 4; ++j) gi[j] = sigmoidf_(acc[j] + bv[j]) * bf2f(xb[t * 136 + c + j]);
                            u32x2 v; v.x = pk2(gi[0], gi[1]); v.y = pk2(gi[2], gi[3]);
                            *(LAS u32x2*)(git + (d * 64 + t) * 128 + c) = v;
                        }
                    }
                }
            }
            __syncthreads();
            if (tid < 256) {
                const int d = tid >> 7, c = tid & 127, gc = cq * 128 + c;
                float hacc = 0.f, ssum = 0.f;
                for (int s = 0; s < 64; ++s) {
                    const int t = d == 0 ? s : 63 - s;
                    const float la = lat[(d * 64 + t) * 128 + c];
                    const float u = sqrtf(-expm1f(2.f * la)) * bf2f(git[(d * 64 + t) * 128 + c]);
                    hacc = __expf(la) * hacc + u; ssum += la;
                    LA[((size_t)(r0 + t) * 2 + d) * 512 + gc] = la;
                    UU[((size_t)(r0 + t) * 2 + d) * 512 + gc] = f2bf(u);
                }
                AGGA[(size_t)(ch * 2 + d) * 512 + gc] = __expf(ssum);
                AGGH[(size_t)(ch * 2 + d) * 512 + gc] = hacc;
            }
            __syncthreads();
        }
    }
}

DI int scan_chunk(int b, int d, int st) {
    if (st < 4) return NCHL + b * 4 + (d == 0 ? st : 3 - st);
    const int j = st - 4;
    return b * 128 + (d == 0 ? j : 127 - j);
}

DI void phase_scan0(PP p) {
    float* U = (float*)(p->ws + OFF_ARENA + A_U);
    const float* DEC = (const float*)(p->ws + OFF_ARENA + A_DEC);
    const float* AGGA = (const float*)(p->ws + OFF_ARENA + A_AGGA);
    float* AGGH = (float*)(p->ws + OFF_ARENA + A_AGGH);
    const int gid = get_bid() * NTHREADS + get_tid(), nthr = gridDim.x * NTHREADS;
    for (int idx = gid; idx < 65536 + 4096; idx += nthr) {
        if (idx < 65536) {
            const int dv4 = idx & 31, dk = (idx >> 5) & 63, h = (idx >> 11) & 3, d = (idx >> 13) & 1, b = idx >> 14;
            f32x4 S = {0.f, 0.f, 0.f, 0.f};
            for (int st = 0; st < 132; st += 4) {
                f32x4 u[4]; float dc[4]; float* ptr[4];
#pragma unroll
                for (int q = 0; q < 4; ++q) {
                    const int cid = scan_chunk(b, d, st + q);
                    ptr[q] = U + ((size_t)(cid * 2 + d) * 4 + h) * 8192 + dk * 128 + dv4 * 4;
                    u[q] = *(const f32x4*)ptr[q];
                    dc[q] = DEC[(size_t)(cid * 2 + d) * 256 + h * 64 + dk];
                }
#pragma unroll
                for (int q = 0; q < 4; ++q) { *(f32x4*)ptr[q] = S; S = S * dc[q] + u[q]; }
            }
        } else {
            const int i2 = idx - 65536, c = i2 & 511, d = (i2 >> 9) & 1, b = i2 >> 10;
            float hs = 0.f;
            for (int st = 0; st < 132; st += 4) {
                float a[4], hh[4]; float* ptr[4];
#pragma unroll
                for (int q = 0; q < 4; ++q) {
                    const int cid = scan_chunk(b, d, st + q);
                    ptr[q] = AGGH + (size_t)(cid * 2 + d) * 512 + c;
                    hh[q] = *ptr[q]; a[q] = AGGA[(size_t)(cid * 2 + d) * 512 + c];
                }
#pragma unroll
                for (int q = 0; q < 4; ++q) { *ptr[q] = hs; hs = a[q] * hs + hh[q]; }
            }
        }
    }
}

DI void phase_g3(PP p, lds_t lds) {
    const int tid = get_tid(), lane = tid & 63, w = tid >> 6;
    const bf16_t* P = (const bf16_t*)(p->ws + OFF_ARENA + A_P);
    const float* U = (const float*)(p->ws + OFF_ARENA + A_U);
    const float* LA = (const float*)(p->ws + OFF_ARENA + A_LA);
    const bf16_t* UU = (const bf16_t*)(p->ws + OFF_ARENA + A_UU);
    const float* HST = (const float*)(p->ws + OFF_ARENA + A_AGGH);
    bf16_t* act = (bf16_t*)(p->ws + OFF_ACT);
    constexpr int NGLA = NCH * 4;
    for (int task = get_bid(); task < NGLA + NCH; task += gridDim.x) {
        if (task < NGLA) {
            const int ch = task >> 2, h = task & 3, r0 = ch * 64;
            LAS float* lrt = (LAS float*)lds;
            LAS float* wat = lrt + 2048;
            LAS float* bat = wat + 2048;
            LAS float* bc = bat + 128;
            LAS bf16_t* qt = (LAS bf16_t*)(bc + 4096);
            LAS bf16_t* kt = qt + 64 * 72;
            LAS bf16_t* qtd = kt + 64 * 72;
            LAS bf16_t* ktd = qtd + 64 * 72;
            LAS bf16_t* at = ktd + 64 * 72;
            LAS bf16_t* vt = at + 64 * 72;
            LAS bf16_t* St = vt + 64 * 136;
            LAS float* ot = (LAS float*)(St + 64 * 136);
            gla_load_decay_inputs(p, P, r0, h, lrt, wat, bat);
            { const int row = tid >> 3, chunk = tid & 7;
              *(LAS u32x4*)(qt + row * 72 + chunk * 8) = *(const u32x4*)(P + (size_t)(r0 + row) * ABIN + PC_Q + h * 64 + chunk * 8);
              *(LAS u32x4*)(kt + row * 72 + chunk * 8) = *(const u32x4*)(P + (size_t)(r0 + row) * ABIN + PC_K + h * 64 + chunk * 8); }
#pragma unroll
            for (int q = 0; q < 2; ++q) { const int i = tid + 512 * q, row = i >> 4, chunk = i & 15; *(LAS u32x4*)(vt + row * 136 + chunk * 8) = *(const u32x4*)(P + (size_t)(r0 + row) * ABIN + PC_V + h * 128 + chunk * 8); }
            __syncthreads();
            f32x4 oacc[4];
#pragma unroll
            for (int i = 0; i < 4; ++i) oacc[i] = (f32x4){0.f, 0.f, 0.f, 0.f};
            const int ott = w & 3, odv0 = (w >> 2) * 4;
            for (int d = 0; d < 2; ++d) {
                gla_bcum(bc, lrt + d * 1024, wat + d * 1024, bat + d * 64, d);
                {
                    const int t = tid >> 3, c8 = (tid & 7) * 8;
                    float qo[8], ko[8];
#pragma unroll
                    for (int j = 0; j < 8; ++j) { const float e = __expf(bc[t * 64 + c8 + j]); qo[j] = bf2f(qt[t * 72 + c8 + j]) * 0.125f * e; ko[j] = bf2f(kt[t * 72 + c8 + j]) / e; }
                    u32x4 v; v.x = pk2(qo[0], qo[1]); v.y = pk2(qo[2], qo[3]); v.z = pk2(qo[4], qo[5]); v.w = pk2(qo[6], qo[7]);
                    *(LAS u32x4*)(qtd + t * 72 + c8) = v;
                    v.x = pk2(ko[0], ko[1]); v.y = pk2(ko[2], ko[3]); v.z = pk2(ko[4], ko[5]); v.w = pk2(ko[6], ko[7]);
                    *(LAS u32x4*)(ktd + t * 72 + c8) = v;
                    const int dk = tid >> 3, dv16 = (tid & 7) * 16;
                    const float* src = U + ((size_t)(ch * 2 + d) * 4 + h) * 8192 + dk * 128 + dv16;
                    const f32x4 s0 = *(const f32x4*)src, s1 = *(const f32x4*)(src + 4), s2 = *(const f32x4*)(src + 8), s3 = *(const f32x4*)(src + 12);
                    v.x = pk2(s0[0], s0[1]); v.y = pk2(s0[2], s0[3]); v.z = pk2(s1[0], s1[1]); v.w = pk2(s1[2], s1[3]);
                    *(LAS u32x4*)(St + dk * 136 + dv16) = v;
                    v.x = pk2(s2[0], s2[1]); v.y = pk2(s2[2], s2[3]); v.z = pk2(s3[0], s3[1]); v.w = pk2(s3[2], s3[3]);
                    *(LAS u32x4*)(St + dk * 136 + dv16 + 8) = v;
                }
                __syncthreads();
                {
                    const int tt = w >> 1;
#pragma unroll
                    for (int e = 0; e < 2; ++e) {
                        const int st = (w & 1) * 2 + e;
                        f32x4 acc = {0.f, 0.f, 0.f, 0.f};
#pragma unroll
                        for (int ks = 0; ks < 2; ++ks) acc = mfma16(frag_row(ktd, 72, st * 16, ks * 32, lane), frag_row(qtd, 72, tt * 16, ks * 32, lane), acc);
                        const int t = tt * 16 + (lane & 15), s0 = st * 16 + 4 * (lane >> 4);
                        float a[4];
#pragma unroll
                        for (int j = 0; j < 4; ++j) { const int s = s0 + j; a[j] = (d == 0 ? s <= t : s >= t) ? acc[j] : 0.f; }
                        u32x2 v; v.x = pk2(a[0], a[1]); v.y = pk2(a[2], a[3]);
                        *(LAS u32x2*)(at + t * 72 + s0) = v;
                    }
                }
                __syncthreads();
                {
                    bf16x8 af[2], qf[2];
#pragma unroll
                    for (int ks = 0; ks < 2; ++ks) { af[ks] = frag_row(at, 72, ott * 16, ks * 32, lane); qf[ks] = frag_row(qtd, 72, ott * 16, ks * 32, lane); }
#pragma unroll
                    for (int i = 0; i < 4; ++i) {
                        const int dvt = odv0 + i;
#pragma unroll
                        for (int ks = 0; ks < 2; ++ks) {
                            oacc[i] = mfma16(frag_tr(vt, 136, ks * 32, dvt * 16, lane), af[ks], oacc[i]);
                            oacc[i] = mfma16(frag_tr(St, 136, ks * 32, dvt * 16, lane), qf[ks], oacc[i]);
                        }
                    }
                }
                __syncthreads();
            }
#pragma unroll
            for (int i = 0; i < 4; ++i) *(LAS f32x4*)(ot + (ott * 16 + (lane & 15)) * 132 + (odv0 + i) * 16 + 4 * (lane >> 4)) = oacc[i];
            __syncthreads();
            {
                const int t = tid >> 3, dv16 = (tid & 7) * 16;
                float o[16]; float ss = 0.f;
#pragma unroll
                for (int j = 0; j < 16; ++j) { o[j] = ot[t * 132 + dv16 + j]; ss += o[j] * o[j]; }
                ss += __shfl_xor(ss, 1); ss += __shfl_xor(ss, 2); ss += __shfl_xor(ss, 4);
                const float rs = rsqrtf(ss * (1.f / 128.f) + EPS);
                const bf16_t* gp = P + (size_t)(r0 + t) * ABIN + PC_G + h * 128 + dv16;
                const u32x4 g0 = *(const u32x4*)gp, g1 = *(const u32x4*)(gp + 8);
                const unsigned gw[8] = {g0.x, g0.y, g0.z, g0.w, g1.x, g1.y, g1.z, g1.w};
                float r[16];
#pragma unroll
                for (int j = 0; j < 8; ++j) {
                    r[2 * j] = o[2 * j] * rs * p->gla_norm_g[h * 128 + dv16 + 2 * j] * siluf_(lo_bf(gw[j]));
                    r[2 * j + 1] = o[2 * j + 1] * rs * p->gla_norm_g[h * 128 + dv16 + 2 * j + 1] * siluf_(hi_bf(gw[j]));
                }
                bf16_t* dst = act + (size_t)(r0 + t) * 1024 + h * 128 + dv16;
                u32x4 v; v.x = pk2(r[0], r[1]); v.y = pk2(r[2], r[3]); v.z = pk2(r[4], r[5]); v.w = pk2(r[6], r[7]);
                *(u32x4*)dst = v;
                v.x = pk2(r[8], r[9]); v.y = pk2(r[10], r[11]); v.z = pk2(r[12], r[13]); v.w = pk2(r[14], r[15]);
                *(u32x4*)(dst + 8) = v;
            }
            __syncthreads();
        } else {
            const int ch = task - NGLA, r0 = ch * 64, c = tid;
            LAS float* hf = (LAS float*)lds;
            float hs = HST[(size_t)(ch * 2 + 0) * 512 + c];
            for (int t = 0; t < 64; ++t) {
                const size_t o = ((size_t)(r0 + t) * 2 + 0) * 512 + c;
                hs = __expf(LA[o]) * hs + bf2f(UU[o]);
                hf[t * 512 + c] = hs;
            }
            hs = HST[(size_t)(ch * 2 + 1) * 512 + c];
            for (int t = 63; t >= 0; --t) {
                const size_t o = ((size_t)(r0 + t) * 2 + 1) * 512 + c;
                hs = __expf(LA[o]) * hs + bf2f(UU[o]);
                const float g = bf2f(P[(size_t)(r0 + t) * ABIN + PC_RGG + c]);
                act[(size_t)(r0 + t) * 1024 + 512 + c] = f2bf((hf[t * 512 + c] + hs) * gelu_tanh(g));
            }
            __syncthreads();
        }
    }
}


DI void phase_outproj0(PP p, lds_t lds) {
    const bf16_t* act = (const bf16_t*)(p->ws + OFF_ACT);
    float* X = (float*)(p->ws + OFF_ARENA + A_X);
    constexpr int NM = NTOK / 256, NN = 4;
    for (int u = get_bid(); u < NM * NN; u += gridDim.x) {
        const int pn = u / NM, pm = u % NM;
        const int set = row_set(pm * 256);
        const float* g1 = mods_ptr(p, 0, set, 2);
        const float* xin = pm * 256 < NLAT ? p->x + (size_t)pm * 256 * 1024 : p->ctx + (size_t)(pm * 256 - NLAT) * 1024;
        gemm_unit<256>(lds, 1024, 1024,
            [&](int r) { return act + (size_t)(pm * 256 + r) * 1024; },
            [&](int j) -> const float* { return p->ab_w_out + pn * 256 + j; },
            [&](const f32x4 (&acc)[8][4], int wr, int wc, int lane) {
                epi_each<4>(acc, wr, wc, lane, [&](int r, int c, f32x4 v) {
                    const int col = pn * 256 + c;
                    const f32x4 xi = *(const f32x4*)(xin + (size_t)r * 1024 + col), g = *(const f32x4*)(g1 + col);
                    *(f32x4*)(X + (size_t)(pm * 256 + r) * 1024 + col) = xi + g * v;
                });
            });
    }
}

struct MoeBufs { float* PT; float* PE; int* ROWID; int* ROWTOK; bf16_t* HDN; bf16_t* Y; int rpe; int nrows; };
DI MoeBufs moe_bufs(PP p, int layer) {
    MoeBufs m;
    char* a = p->ws + OFF_ARENA;
    if (layer == 0) { m.PT = (float*)(a + A_PT); m.PE = (float*)(a + A_PE); m.ROWID = (int*)(a + A_ROWID); m.ROWTOK = (int*)(a + A_ROWTOK); m.HDN = (bf16_t*)(a + A_HDN); m.Y = (bf16_t*)(a + A_Y); m.rpe = 4352; m.nrows = NTOK; }
    else { m.PT = (float*)(a + A_HB); m.PE = (float*)(a + A_HB + (size_t)NTOK * 64); m.ROWID = (int*)(a + A_HB + (size_t)NTOK * 128); m.ROWTOK = (int*)(a + A_HB + (size_t)NTOK * 192); m.HDN = (bf16_t*)(a + A_XM); m.Y = (bf16_t*)(a + A_XC); m.rpe = 4096; m.nrows = NLAT; }
    return m;
}

DI void phase_router(PP p, lds_t lds, int layer) {
    const int tid = get_tid(), lane = tid & 63;
    const MoeBufs m = moe_bufs(p, layer);
    const float* X = (const float*)(p->ws + OFF_ARENA + A_X);
    bf16_t* act = (bf16_t*)(p->ws + OFF_ACT);
    LAS float* rwT = (LAS float*)lds;
    for (int i = tid; i < 16384; i += NTHREADS) { const int k = i >> 4, e = i & 15; rwT[e * 1024 + k] = p->router_w[(size_t)layer * 16384 + i]; }
    __syncthreads();
    const int gw = get_bid() * 8 + (tid >> 6), nw = gridDim.x * 8;
    for (int r = gw; r < m.nrows; r += nw) {
        f32x4 v[4];
        row_load_f32(X + (size_t)r * 1024, v, lane);
        const float rs = rsqrtf(row_sumsq(v) * (1.f / 1024.f) + EPS);
        const int set = row_set(r);
        row_modulate(v, rs, p->norm2_g + layer * 1024, mods_ptr(p, layer, set, 4), mods_ptr(p, layer, set, 3), lane);
        row_store_bf16(act + (size_t)r * 1024, v, lane);
        float lg[16];
#pragma unroll
        for (int e = 0; e < 16; ++e) {
            float a = 0.f;
#pragma unroll
            for (int i = 0; i < 4; ++i) { const f32x4 wv = *(const LAS f32x4*)(rwT + e * 1024 + 4 * lane + 256 * i); a += v[i][0] * wv[0] + v[i][1] * wv[1] + v[i][2] * wv[2] + v[i][3] * wv[3]; }
            lg[e] = wave_sum(a);
            asm volatile("" ::: "memory");
        }
        float mx = lg[0];
#pragma unroll
        for (int e = 1; e < 16; ++e) mx = fmaxf(mx, lg[e]);
        float sum = 0.f;
#pragma unroll
        for (int e = 0; e < 16; ++e) { lg[e] = __expf(lg[e] - mx); sum += lg[e]; }
        const float inv = 1.f / sum;
        float mine = 0.f;
#pragma unroll
        for (int e = 0; e < 16; ++e) if (lane == e) mine = lg[e] * inv;
        if (lane < 16) {
            m.PT[(size_t)r * 16 + lane] = mine;
            if (r < NLAT) m.PE[((size_t)(r >> 13) * 16 + lane) * 8192 + (r & 8191)] = mine;
            else { const int rc = r - NLAT; m.PE[(size_t)NBATCH * 16 * 8192 + ((size_t)(rc >> 8) * 16 + lane) * 256 + (rc & 255)] = mine; }
        }
    }
}

DI int block_excl_scan(int v, LAS int* tmp, int* total) {
    const int tid = get_tid(), lane = tid & 63, w = tid >> 6;
    int inc = v;
#pragma unroll
    for (int o = 1; o < 64; o <<= 1) { const int t = __shfl_up(inc, o); if (lane >= o) inc += t; }
    __syncthreads();
    if (lane == 63) tmp[w] = inc;
    __syncthreads();
    int base = 0, tot = 0;
#pragma unroll
    for (int i = 0; i < 8; ++i) { const int t = tmp[i]; if (i < w) base += t; tot += t; }
    *total = tot;
    return base + inc - v;
}

DI void phase_topk(PP p, lds_t lds, int layer) {
    const int tid = get_tid();
    const MoeBufs m = moe_bufs(p, layer);
    LAS unsigned* keys = (LAS unsigned*)lds;
    LAS int* hist = (LAS int*)(keys + 8192);
    LAS int* tmp = hist + 256;
    LAS int* sel = tmp + 16;
    const int ntask = layer == 0 ? 128 : 64;
    for (int task = get_bid(); task < ntask; task += gridDim.x) {
        const bool isctx = task >= 64;
        const int b = (task & 63) >> 4, e = task & 15;
        const int n = isctx ? 256 : 8192, cap = isctx ? 32 : 1024;
        const float* src = isctx ? m.PE + (size_t)NBATCH * 16 * 8192 + ((size_t)b * 16 + e) * 256 : m.PE + ((size_t)b * 16 + e) * 8192;
        for (int i = tid; i < n; i += NTHREADS) keys[i] = __float_as_uint(src[i]);
        __syncthreads();
        unsigned prefix = 0u, mask = 0u; int kk = cap;
        for (int pass = 3; pass >= 0; --pass) {
            const int shift = pass * 8;
            if (tid < 256) hist[tid] = 0;
            __syncthreads();
            for (int i = tid; i < n; i += NTHREADS) { const unsigned k = keys[i]; if ((k & mask) == prefix) __hip_atomic_fetch_add((int*)(hist + ((k >> shift) & 255)), 1, __ATOMIC_RELAXED, __HIP_MEMORY_SCOPE_WORKGROUP); }
            __syncthreads();
            if (tid < 256) {
                int above = 0;
                for (int j = tid + 1; j < 256; ++j) above += hist[j];
                const int mineh = hist[tid];
                if (above < kk && kk <= above + mineh) { sel[0] = tid; sel[1] = above; }
            }
            __syncthreads();
            prefix |= (unsigned)sel[0] << shift; mask |= 0xffu << shift; kk -= sel[1];
            __syncthreads();
        }
        const unsigned T = prefix; const int need_eq = kk;
        const int ipt = n / NTHREADS > 0 ? n / NTHREADS : 1;
        const int i0 = tid * ipt;
        int cgt = 0, ceq = 0;
        if (i0 < n) for (int j = 0; j < ipt; ++j) { const unsigned k = keys[i0 + j]; cgt += k > T; ceq += k == T; }
        int tot;
        const int egt = block_excl_scan(cgt, tmp, &tot);
        const int eeq = block_excl_scan(ceq, tmp, &tot);
        const int slot0 = e * m.rpe + (isctx ? 4096 + b * 32 : b * 1024);
        const int row0 = isctx ? NLAT + b * 256 : b * 8192;
        if (i0 < n) {
            int ngt = egt, neq = eeq;
            for (int j = 0; j < ipt; ++j) {
                const unsigned k = keys[i0 + j];
                int slot = -1;
                if (k > T) { slot = slot0 + ngt + (neq < need_eq ? neq : need_eq); ++ngt; }
                else if (k == T) { if (neq < need_eq) slot = slot0 + ngt + neq; ++neq; }
                m.ROWID[(size_t)(row0 + i0 + j) * 16 + e] = slot;
                if (slot >= 0) m.ROWTOK[slot] = row0 + i0 + j;
            }
        }
        if (isctx && b == 0 && layer == 0) for (int i = tid; i < 128; i += NTHREADS) m.ROWTOK[e * m.rpe + 4224 + i] = -1;
        __syncthreads();
    }
}

DI void phase_moe_up(PP p, lds_t lds, int layer) {
    const MoeBufs m = moe_bufs(p, layer);
    const bf16_t* act = (const bf16_t*)(p->ws + OFF_ACT);
    const int nmt = layer == 0 ? 17 : 16;
    const int nunits = 16 * nmt * 8;
    for (int u = get_bid(); u < nunits; u += gridDim.x) {
        const int e = u / (nmt * 8), rem = u % (nmt * 8), nt = rem / nmt, mt = rem % nmt;
        const float* Wg = p->exp_w_gate + ((size_t)layer * 16 + e) * 1048576;
        const float* Wu = p->exp_w_up + ((size_t)layer * 16 + e) * 1048576;
        const int* rt = m.ROWTOK + e * m.rpe + mt * 256;
        bf16_t* H = m.HDN + ((size_t)e * m.rpe + mt * 256) * 1024 + nt * 128;
        gemm_unit<256>(lds, 1024, 1024,
            [&](int r) -> const bf16_t* { const int tok = rt[r]; return tok >= 0 ? act + (size_t)tok * 1024 : nullptr; },
            [&](int j) -> const float* { const int wcq = j >> 6, within = j & 63; const int hc = nt * 128 + wcq * 32 + (within & 31); return (within < 32 ? Wg : Wu) + hc; },
            [&](const f32x4 (&acc)[8][4], int wr, int wc, int lane) {
#pragma unroll
                for (int mi = 0; mi < 8; ++mi)
#pragma unroll
                    for (int ni = 0; ni < 2; ++ni) {
                        const f32x4 g = acc[mi][ni], uu = acc[mi][ni + 2];
                        f32x4 h;
#pragma unroll
                        for (int j = 0; j < 4; ++j) h[j] = siluf_(g[j]) * uu[j];
                        store_bf16x4(H + (size_t)(wr * 128 + mi * 16 + (lane & 15)) * 1024 + wc * 32 + ni * 16 + 4 * (lane >> 4), h);
                    }
            });
    }
}

DI void phase_moe_down(PP p, lds_t lds, int layer) {
    const MoeBufs m = moe_bufs(p, layer);
    const int nmt = layer == 0 ? 17 : 16;
    const int nunits = 16 * nmt * 4;
    for (int u = get_bid(); u < nunits; u += gridDim.x) {
        const int e = u / (nmt * 4), rem = u % (nmt * 4), nt = rem / nmt, mt = rem % nmt;
        const float* Wd = p->exp_w_down + ((size_t)layer * 16 + e) * 1048576;
        const bf16_t* H = m.HDN + ((size_t)e * m.rpe + mt * 256) * 1024;
        bf16_t* Y = m.Y + ((size_t)e * m.rpe + mt * 256) * 1024 + nt * 256;
        gemm_unit<256>(lds, 1024, 1024,
            [&](int r) { return H + (size_t)r * 1024; },
            [&](int j) -> const float* { return Wd + nt * 256 + j; },
            [&](const f32x4 (&acc)[8][4], int wr, int wc, int lane) {
                epi_each<4>(acc, wr, wc, lane, [&](int r, int c, f32x4 v) { store_bf16x4(Y + (size_t)r * 1024 + c, v); });
            });
    }
}

DI void phase_combine(PP p, int layer) {
    const int tid = get_tid(), lane = tid & 63;
    const MoeBufs m = moe_bufs(p, layer);
    float* X = (float*)(p->ws + OFF_ARENA + A_X);
    bf16_t* act = (bf16_t*)(p->ws + OFF_ACT);
    const int gw = get_bid() * 8 + (tid >> 6), nw = gridDim.x * 8;
    for (int r = gw; r < m.nrows; r += nw) {
        f32x4 v[4], a[4];
        row_load_f32(X + (size_t)r * 1024, v, lane);
#pragma unroll
        for (int i = 0; i < 4; ++i) a[i] = (f32x4){0.f, 0.f, 0.f, 0.f};
        for (int e = 0; e < 16; ++e) {
            const int rid = m.ROWID[(size_t)r * 16 + e];
            if (rid >= 0) {
                const float pe = m.PT[(size_t)r * 16 + e];
                const bf16_t* y = m.Y + (size_t)rid * 1024;
#pragma unroll
                for (int i = 0; i < 4; ++i) { const u32x2 yy = *(const u32x2*)(y + 4 * lane + 256 * i); a[i][0] += pe * lo_bf(yy.x); a[i][1] += pe * hi_bf(yy.x); a[i][2] += pe * lo_bf(yy.y); a[i][3] += pe * hi_bf(yy.y); }
            }
        }
        const int set = row_set(r);
        const float* g2 = mods_ptr(p, layer, set, 5);
#pragma unroll
        for (int i = 0; i < 4; ++i) { const f32x4 g = *(const f32x4*)(g2 + 4 * lane + 256 * i); v[i] = v[i] + g * a[i]; }
        const float rs = rsqrtf(row_sumsq(v) * (1.f / 1024.f) + EPS);
        if (layer == 0) {
#pragma unroll
            for (int i = 0; i < 4; ++i) *(f32x4*)(X + (size_t)r * 1024 + 4 * lane + 256 * i) = v[i];
            row_modulate(v, rs, p->norm1_g + 1024, mods_ptr(p, 1, set, 1), mods_ptr(p, 1, set, 0), lane);
            row_store_bf16(act + (size_t)r * 1024, v, lane);
        } else {
#pragma unroll
            for (int i = 0; i < 4; ++i) { const f32x4 g = *(const f32x4*)(p->final_g + 4 * lane + 256 * i); *(f32x4*)(p->out + (size_t)r * 1024 + 4 * lane + 256 * i) = v[i] * rs * g; }
        }
    }
}


DI void phase_upproj(PP p, lds_t lds, int half) {
    const bf16_t* act = (const bf16_t*)(p->ws + OFF_ACT);
    bf16_t* O = (bf16_t*)(p->ws + OFF_ARENA + A_XM);
    const int NM = half == 0 ? NTOK / 256 : NLAT / 256, NN = 8;
    for (int u = get_bid(); u < NM * NN; u += gridDim.x) {
        const int pn = u / NM, pm = u % NM;
        gemm_unit<256>(lds, 1024, 4096,
            [&](int r) { return act + (size_t)(pm * 256 + r) * 1024; },
            [&](int j) -> const float* { return p->m_w_up + half * 2048 + pn * 256 + j; },
            [&](const f32x4 (&acc)[8][4], int wr, int wc, int lane) {
                epi_each<4>(acc, wr, wc, lane, [&](int r, int c, f32x4 v) { store_bf16x4(O + (size_t)(pm * 256 + r) * 2048 + pn * 256 + c, v); });
            });
    }
}

DI void phase_mfeat(PP p, lds_t lds) {
    const int tid = get_tid(), lane = tid & 63, w = tid >> 6;
    bf16_t* XM = (bf16_t*)(p->ws + OFF_ARENA + A_XM);
    bf16_t* XC = (bf16_t*)(p->ws + OFF_ARENA + A_XC);
    bf16_t* CTXV = (bf16_t*)(p->ws + OFF_ACT + ACT_CTXV);
    bf16_t* RAWS = (bf16_t*)(p->ws + OFF_ACT + ACT_RAWS);
    float* GP = (float*)(p->ws + OFF_ACT + ACT_GP);
    const bf16_t* GC = (const bf16_t*)(p->ws + OFF_GCAT);
    const float* MM = (const float*)(p->ws + OFF_MMAT);
    LAS bf16_t* xin = (LAS bf16_t*)lds;
    LAS bf16_t* xct = xin + 67 * 136;
    LAS bf16_t* qpt = xct + 64 * 136;
    LAS bf16_t* gxc = qpt + 64 * 136;
    LAS bf16_t* gxm = gxc + 128 * 16;
    LAS float* mq = (LAS float*)(gxm + 128 * 16);
    LAS float* wvq = mq + 512;
    LAS float* cw = wvq + 512;
    LAS float* gred = cw + 640;
    for (int task = get_bid(); task < NCH * 4; task += gridDim.x) {
        const int ch = task >> 2, h = task & 3, r0 = ch * 64;
        const int seg_lo = ch < NCHL ? r0 : NLAT + ((r0 - NLAT) >> 8) * 256, seg_hi = ch < NCHL ? r0 + 64 : seg_lo + 256;
        f32x4 rs_acc[2] = {{0.f, 0.f, 0.f, 0.f}, {0.f, 0.f, 0.f, 0.f}};
        f32x4 g_acc = {0.f, 0.f, 0.f, 0.f};
        for (int q4 = 0; q4 < 4; ++q4) {
            const int col0 = h * 512 + q4 * 128;
            for (int i = tid; i < 67 * 16; i += NTHREADS) {
                const int row = i >> 4, chunk = i & 15, r = r0 - 2 + row;
                u32x4 v = {0u, 0u, 0u, 0u};
                if (r >= seg_lo && r < seg_hi) v = *(const u32x4*)(XM + (size_t)r * 2048 + col0 + chunk * 8);
                *(LAS u32x4*)(xin + row * 136 + chunk * 8) = v;
            }
            if (tid < 256) *(LAS u32x4*)(gxc + tid * 8) = *(const u32x4*)(GC + (size_t)col0 * 16 + tid * 8);
            else *(LAS u32x4*)(gxm + (tid - 256) * 8) = *(const u32x4*)(GC + (size_t)(2048 + col0) * 16 + (tid - 256) * 8);
            mq[tid] = bf2f(f2bf(MM[(size_t)(col0 >> 2) * 16 + tid]));
            wvq[tid] = p->m_wv[(size_t)(col0 >> 2) * 16 + tid];
            for (int i = tid; i < 640; i += NTHREADS) cw[i] = i < 512 ? p->m_conv_w[(size_t)(i >> 7) * 2048 + col0 + (i & 127)] : p->m_conv_b[col0 + i - 512];
            __syncthreads();
            {
                const int t = tid >> 3, c16 = (tid & 7) * 16;
                float xc[16], xm[16];
#pragma unroll
                for (int j = 0; j < 16; ++j) { xc[j] = cw[512 + c16 + j]; xm[j] = bf2f(xin[(t + 2) * 136 + c16 + j]); }
#pragma unroll
                for (int tap = 0; tap < 4; ++tap)
#pragma unroll
                    for (int j = 0; j < 16; ++j) xc[j] += cw[tap * 128 + c16 + j] * bf2f(xin[(t + tap) * 136 + c16 + j]);
                unsigned xcp[8];
#pragma unroll
                for (int j = 0; j < 8; ++j) { xcp[j] = pk2(siluf_(xc[2 * j]), siluf_(xc[2 * j + 1])); xc[2 * j] = lo_bf(xcp[j]); xc[2 * j + 1] = hi_bf(xcp[j]); }
                float vv[16], qp[16];
#pragma unroll
                for (int n = 0; n < 4; ++n) {
                    const int nb = (c16 >> 2) + n;
#pragma unroll
                    for (int o = 0; o < 4; ++o) {
                        float a = 0.f, b = 0.f;
#pragma unroll
                        for (int i = 0; i < 4; ++i) { a += xm[4 * n + i] * wvq[nb * 16 + i * 4 + o]; b += xc[4 * n + i] * mq[nb * 16 + i * 4 + o]; }
                        vv[4 * n + o] = a; qp[4 * n + o] = b;
                    }
                }
                u32x4 v0, v1;
                v0.x = xcp[0]; v0.y = xcp[1]; v0.z = xcp[2]; v0.w = xcp[3]; v1.x = xcp[4]; v1.y = xcp[5]; v1.z = xcp[6]; v1.w = xcp[7];
                *(LAS u32x4*)(xct + t * 136 + c16) = v0; *(LAS u32x4*)(xct + t * 136 + c16 + 8) = v1;
                bf16_t* xcg = XC + (size_t)(r0 + t) * 2048 + col0 + c16;
                *(u32x4*)xcg = v0; *(u32x4*)(xcg + 8) = v1;
                v0.x = pk2(qp[0], qp[1]); v0.y = pk2(qp[2], qp[3]); v0.z = pk2(qp[4], qp[5]); v0.w = pk2(qp[6], qp[7]);
                v1.x = pk2(qp[8], qp[9]); v1.y = pk2(qp[10], qp[11]); v1.z = pk2(qp[12], qp[13]); v1.w = pk2(qp[14], qp[15]);
                *(LAS u32x4*)(qpt + t * 136 + c16) = v0; *(LAS u32x4*)(qpt + t * 136 + c16 + 8) = v1;
                v0.x = pk2(vv[0], vv[1]); v0.y = pk2(vv[2], vv[3]); v0.z = pk2(vv[4], vv[5]); v0.w = pk2(vv[6], vv[7]);
                v1.x = pk2(vv[8], vv[9]); v1.y = pk2(vv[10], vv[11]); v1.z = pk2(vv[12], vv[13]); v1.w = pk2(vv[14], vv[15]);
                bf16_t* vg = ch < NCHL ? XM + (size_t)(r0 + t) * 2048 + col0 + c16 : CTXV + (size_t)(r0 + t - NLAT) * 2048 + col0 + c16;
                *(u32x4*)vg = v0; *(u32x4*)(vg + 8) = v1;
            }
            __syncthreads();
            {
                const int tt = w >> 1;
#pragma unroll
                for (int e = 0; e < 2; ++e) {
                    const int st = (w & 1) * 2 + e;
#pragma unroll
                    for (int ks = 0; ks < 4; ++ks) rs_acc[e] = mfma16(frag_row(xct, 136, st * 16, ks * 32, lane), frag_row(qpt, 136, tt * 16, ks * 32, lane), rs_acc[e]);
                }
                const int gt = w & 3, src = w >> 2;
                const LAS bf16_t* gm = src ? gxm : gxc;
                const LAS bf16_t* ft = src ? xin + 2 * 136 : xct;
#pragma unroll
                for (int ks = 0; ks < 4; ++ks) g_acc = mfma16(frag_tr(gm, 16, ks * 32, 0, lane), frag_row(ft, 136, gt * 16, ks * 32, lane), g_acc);
            }
            __syncthreads();
        }
        {
            const int tt = w >> 1;
#pragma unroll
            for (int e = 0; e < 2; ++e) {
                const int st = (w & 1) * 2 + e;
                store_bf16x4(RAWS + ((size_t)task * 64 + tt * 16 + (lane & 15)) * 64 + st * 16 + 4 * (lane >> 4), rs_acc[e]);
            }
            const int gt = w & 3, src = w >> 2;
            *(LAS f32x4*)(gred + (src * 64 + gt * 16 + (lane & 15)) * 16 + 4 * (lane >> 4)) = g_acc;
        }
        __syncthreads();
        if (tid < 256) {
            const int t = tid >> 2, q = tid & 3;
            const f32x4 a = *(const LAS f32x4*)(gred + t * 16 + q * 4), b = *(const LAS f32x4*)(gred + (64 + t) * 16 + q * 4);
            *(f32x4*)(GP + ((size_t)(r0 + t) * 4 + h) * 16 + q * 4) = a + b;
        }
        __syncthreads();
    }
}

constexpr int MS_KLD = 1056, MS_QLD = 1040;
DI void phase_mscan(PP p, lds_t lds) {
    const int tid = get_tid(), lane = tid & 63, w = tid >> 6, bid = get_bid();
    if (bid >= 256) return;
    const int grp = bid & 31, sl = bid >> 5, b = grp >> 3, h = (grp >> 1) & 3, d = grp & 1;
    const bf16_t* XC = (const bf16_t*)(p->ws + OFF_ARENA + A_XC);
    const bf16_t* V = (const bf16_t*)(p->ws + OFF_ARENA + A_XM);
    const bf16_t* CTXV = (const bf16_t*)(p->ws + OFF_ACT + ACT_CTXV);
    const bf16_t* RAWS = (const bf16_t*)(p->ws + OFF_ACT + ACT_RAWS);
    const float* GP = (const float*)(p->ws + OFF_ACT + ACT_GP);
    bf16_t* H = d == 0 ? (bf16_t*)p->out : (bf16_t*)(p->ws + OFF_ARENA + A_HB);
    #define MS_REGIONS(L) \
    lds_t xct = (L); \
    lds_t qpt = (L) + 64 * MS_KLD; \
    LAS bf16_t* vt = (LAS bf16_t*)((L) + 64 * MS_KLD + 64 * MS_QLD); \
    LAS bf16_t* St = vt + 4096; \
    LAS bf16_t* vwt = St + 4096; \
    LAS float* sc_b = (LAS float*)(vwt + 4096); \
    LAS float* sc_m = sc_b + 64; LAS float* sc_li = sc_m + 64; LAS float* sc_w = sc_li + 64; LAS float* sc_di = sc_w + 64; LAS float* sc_dn = sc_di + 64; \
    LAS float* sc_misc = sc_dn + 64; \
    LAS float* qn = sc_misc + 8; \
    LAS float* nvec = qn + 64; \
    LAS float* red = (LAS float*)qpt; \
    LAS bf16_t* otile = (LAS bf16_t*)(qpt + 16384); \
    LAS float* npart = (LAS float*)(qpt + 24576); \
    ;
    static_assert(64 * MS_KLD + 64 * MS_QLD + 3 * 8192 + (6 * 64 + 8 + 64 + 512) * 4 <= LDS_BYTES, "mscan lds");
    const int c16 = tid & 63;
    bf16x2_t Mp[2][4][2];
#pragma unroll
    for (int n = 0; n < 2; ++n) {
        const float* mm = (const float*)(p->ws + OFF_MMAT) + (size_t)(h * 128 + 2 * c16 + n) * 16;
#pragma unroll
        for (int o = 0; o < 4; ++o) { Mp[n][o][0] = __builtin_bit_cast(bf16x2_t, pk2(mm[o], mm[4 + o])); Mp[n][o][1] = __builtin_bit_cast(bf16x2_t, pk2(mm[8 + o], mm[12 + o])); }
    }
    const float bias_i = p->m_b_gates[d * 8 + h], bias_f = p->m_b_gates[d * 8 + 4 + h];
    f32x4 C[16];
#pragma unroll
    for (int i = 0; i < 16; ++i) C[i] = (f32x4){0.f, 0.f, 0.f, 0.f};
    { MS_REGIONS(lds) nvec[tid] = 0.f; (void)xct; (void)qpt; (void)vt; (void)St; (void)vwt; (void)sc_b; (void)red; (void)otile; (void)npart; (void)qn; }
    float m_prev = 0.f;
    u32x4 xcr[8], vr, rr; float gli = 0.f, gf = 0.f;
    auto prefetch = [&](int st) {
        int tp = get_tid();
        const int tid = tp, lane = tid & 63, w = tid >> 6;
        const int cid = scan_chunk(b, d, st), r0 = cid * 64;
        const bf16_t* xp = XC + (size_t)(r0 + (tid >> 6)) * 2048 + h * 512 + (tid & 63) * 8;
#pragma unroll
        for (int i = 0; i < 8; ++i) xcr[i] = *(const u32x4*)(xp + (size_t)i * 8 * 2048);
        { const int s_ = tid >> 3, chunk = tid & 7;
          vr = cid < NCHL ? *(const u32x4*)(V + (size_t)(r0 + s_) * 2048 + h * 512 + sl * 64 + chunk * 8) : *(const u32x4*)(CTXV + (size_t)(r0 + s_ - NLAT) * 2048 + h * 512 + sl * 64 + chunk * 8);
          rr = *(const u32x4*)(RAWS + ((size_t)(cid * 4 + h) * 64 + s_) * 64 + chunk * 8); }
        if (w == 0) {
            const int t = d ? 63 - lane : lane;
            const float* gp = GP + (size_t)(r0 + t) * 64;
            gli = gp[d * 8 + h] + gp[16 + d * 8 + h] + gp[32 + d * 8 + h] + gp[48 + d * 8 + h] + bias_i;
            gf = gp[d * 8 + 4 + h] + gp[16 + d * 8 + 4 + h] + gp[32 + d * 8 + 4 + h] + gp[48 + d * 8 + 4 + h] + bias_f;
        }
    };
    prefetch(0);
    for (int st = 0; st < 132; ++st) {
        const int cid = scan_chunk(b, d, st);
        const bool emit = cid < NCHL;
        int tl = tid, zoff = 0;
        asm volatile("" : "+v"(tl), "+v"(zoff));
        const int tid = tl, lane = tid & 63, w = tid >> 6, cg = w & 3, kh = w >> 2, g4 = lane >> 4, l15 = lane & 15, c16 = tid & 63, srow0 = tid >> 6;
        MS_REGIONS(lds + zoff)
        __syncthreads();
        {
            lds_t xw_ = xct + srow0 * MS_KLD + c16 * 16;
            lds_t qw_ = qpt + srow0 * MS_QLD + c16 * 16;
#pragma unroll
            for (int i = 0; i < 8; ++i) {
                const unsigned xw[4] = {xcr[i].x, xcr[i].y, xcr[i].z, xcr[i].w};
                float q[8];
#pragma unroll
                for (int n = 0; n < 2; ++n)
#pragma unroll
                    for (int o = 0; o < 4; ++o)
                        q[4 * n + o] = __builtin_amdgcn_fdot2_f32_bf16(__builtin_bit_cast(bf16x2_t, xw[2 * n + 1]), Mp[n][o][1], __builtin_amdgcn_fdot2_f32_bf16(__builtin_bit_cast(bf16x2_t, xw[2 * n]), Mp[n][o][0], 0.f, false), false);
                u32x4 qv; qv.x = pk2(q[0], q[1]); qv.y = pk2(q[2], q[3]); qv.z = pk2(q[4], q[5]); qv.w = pk2(q[6], q[7]);
                *(LAS u32x4*)(xw_ + i * 8 * MS_KLD) = xcr[i];
                *(LAS u32x4*)(qw_ + i * 8 * MS_QLD) = qv;
            }
        }
        { const int s_ = tid >> 3, chunk = tid & 7;
          *(LAS u32x4*)(vt + s_ * 64 + chunk * 8) = vr;
          *(LAS u32x4*)(St + s_ * 64 + chunk * 8) = rr; }
        if (w == 0) {
            const float lf = log_sigmoidf_(gf);
            float bb = lf;
#pragma unroll
            for (int o = 1; o < 64; o <<= 1) { const float t_ = __shfl_up(bb, o); if (lane >= o) bb += t_; }
            float pm = gli - bb;
#pragma unroll
            for (int o = 1; o < 64; o <<= 1) { const float t_ = __shfl_up(pm, o); if (lane >= o) pm = fmaxf(pm, t_); }
            const float my_m = bb + fmaxf(m_prev, pm);
            const float m_new = __shfl(my_m, 63);
            const float b_last = __shfl(bb, 63);
            const int t = d ? 63 - lane : lane;
            sc_b[t] = bb; sc_m[t] = my_m; sc_li[t] = gli; sc_w[t] = __expf(b_last - bb + gli - m_new); sc_di[t] = __expf(bb + m_prev - my_m);
            qn[lane] = 0.f;
            if (lane == 0) sc_misc[0] = __expf(b_last + m_prev - m_new);
            m_prev = m_new;
        }
        __syncthreads();
        if (emit) {
            const int t = tid & 63, part = tid >> 6;
            float a = 0.f;
            lds_t qr = qpt + t * MS_QLD + part * 128;
            const LAS float* nn = nvec + part * 64;
#pragma unroll
            for (int i = 0; i < 8; ++i) {
                const u32x4 qq = *(const LAS u32x4*)(qr + i * 16);
                const f32x4 n0 = *(const LAS f32x4*)(nn + 8 * i), n1 = *(const LAS f32x4*)(nn + 8 * i + 4);
                a += lo_bf(qq.x) * n0[0] + hi_bf(qq.x) * n0[1] + lo_bf(qq.y) * n0[2] + hi_bf(qq.y) * n0[3] + lo_bf(qq.z) * n1[0] + hi_bf(qq.z) * n1[1] + lo_bf(qq.w) * n1[2] + hi_bf(qq.w) * n1[3];
                if (i & 1) __builtin_amdgcn_sched_barrier(0);
            }
            __hip_atomic_fetch_add((float*)(qn + t), a, __ATOMIC_RELAXED, __HIP_MEMORY_SCOPE_WORKGROUP);
        }
        __syncthreads();
        {
            const int t = tid >> 3, s8 = (tid & 7) * 8;
            if (emit) {
                const u32x4 rw = *(const LAS u32x4*)(St + t * 64 + s8);
                const unsigned rwv[4] = {rw.x, rw.y, rw.z, rw.w};
                const float bt_ = sc_b[t], mt_ = sc_m[t];
                float sv[8]; float rsum = 0.f;
#pragma unroll
                for (int j = 0; j < 8; ++j) {
                    const int s_ = s8 + j;
                    const float raw = (j & 1) ? hi_bf(rwv[j >> 1]) : lo_bf(rwv[j >> 1]);
                    const bool keep = d == 0 ? s_ <= t : s_ >= t;
                    sv[j] = keep ? raw * __expf(bt_ - sc_b[s_] + sc_li[s_] - mt_) : 0.f;
                    rsum += sv[j];
                }
                u32x4 o; o.x = pk2(sv[0], sv[1]); o.y = pk2(sv[2], sv[3]); o.z = pk2(sv[4], sv[5]); o.w = pk2(sv[6], sv[7]);
                *(LAS u32x4*)(St + t * 64 + s8) = o;
                rsum += __shfl_xor(rsum, 1); rsum += __shfl_xor(rsum, 2); rsum += __shfl_xor(rsum, 4);
                if ((tid & 7) == 0) sc_dn[t] = fmaxf(fabsf(sc_di[t] * qn[t] + rsum), __expf(-mt_));
            }
            {
                const u32x4 vv = *(const LAS u32x4*)(vt + t * 64 + s8);
                const float ww = sc_w[t];
                u32x4 o; o.x = pk2(lo_bf(vv.x) * ww, hi_bf(vv.x) * ww); o.y = pk2(lo_bf(vv.y) * ww, hi_bf(vv.y) * ww); o.z = pk2(lo_bf(vv.z) * ww, hi_bf(vv.z) * ww); o.w = pk2(lo_bf(vv.w) * ww, hi_bf(vv.w) * ww);
                *(LAS u32x4*)(vwt + t * 64 + s8) = o;
            }
        }
        __syncthreads();
        f32x4 acc2[4];
#pragma unroll
        for (int tt = 0; tt < 4; ++tt) acc2[tt] = (f32x4){0.f, 0.f, 0.f, 0.f};
        if (emit) {
            lds_t qa = qpt + l15 * MS_QLD + (kh * 256 + 4 * g4) * 2;
#pragma unroll
            for (int m = 0; m < 8; ++m) {
                u32x4 cb; cb.x = pk2(C[2 * m][0], C[2 * m][1]); cb.y = pk2(C[2 * m][2], C[2 * m][3]); cb.z = pk2(C[2 * m + 1][0], C[2 * m + 1][1]); cb.w = pk2(C[2 * m + 1][2], C[2 * m + 1][3]);
                const bf16x8 cf = __builtin_bit_cast(bf16x8, cb);
#pragma unroll
                for (int tt = 0; tt < 4; ++tt) {
                    const u32x2 a0 = *(const LAS u32x2*)(qa + tt * 16 * MS_QLD + m * 64);
                    const u32x2 a1 = *(const LAS u32x2*)(qa + tt * 16 * MS_QLD + m * 64 + 32);
                    u32x4 av; av.x = a0.x; av.y = a0.y; av.z = a1.x; av.w = a1.y;
                    acc2[tt] = mfma16(__builtin_bit_cast(bf16x8, av), cf, acc2[tt]);
                }
                __builtin_amdgcn_sched_barrier(0);
            }
#pragma unroll
            for (int tt = 0; tt < 4; ++tt) {
                const f32x4 dd = *(const LAS f32x4*)(sc_di + tt * 16 + 4 * g4);
                acc2[tt] = acc2[tt] * dd;
                acc2[tt] = mfma16(frag_row(St, 64, tt * 16, kh * 32, lane), frag_tr(vt, 64, kh * 32, cg * 16, lane), acc2[tt]);
            }
        }
        if (st + 1 < 132) prefetch(st + 1);
        {
            const float gd = sc_misc[0];
            bf16x8 vb[2];
#pragma unroll
            for (int ks = 0; ks < 2; ++ks) vb[ks] = frag_tr(vwt, 64, ks * 32, cg * 16, lane);
            lds_t ka = xct + (8 * g4 + (l15 >> 2)) * MS_KLD + (kh * 256 + 4 * (l15 & 3)) * 2;
#pragma unroll
            for (int i = 0; i < 16; ++i) {
                C[i] = C[i] * gd;
#pragma unroll
                for (int ks = 0; ks < 2; ++ks) {
                    const s16x4 lo = __builtin_amdgcn_ds_read_tr16_b64_v4i16((LAS s16x4*)(ka + ks * 32 * MS_KLD + i * 32));
                    const s16x4 hi = __builtin_amdgcn_ds_read_tr16_b64_v4i16((LAS s16x4*)(ka + ks * 32 * MS_KLD + 4 * MS_KLD + i * 32));
                    C[i] = mfma16(__builtin_shufflevector(lo, hi, 0, 1, 2, 3, 4, 5, 6, 7), vb[ks], C[i]);
                }
                if (i & 1) __builtin_amdgcn_sched_barrier(0);
            }
        }
        __syncthreads();
        {
            const int kp = tid & 255, sh = tid >> 8;
            float a0 = 0.f, a1 = 0.f;
            lds_t xr = xct + sh * 32 * MS_KLD + kp * 4;
#pragma unroll 8
            for (int s_ = 0; s_ < 32; ++s_) {
                const unsigned xx = *(const LAS unsigned*)(xr + s_ * MS_KLD);
                const float ww = sc_w[sh * 32 + s_];
                a0 += ww * lo_bf(xx); a1 += ww * hi_bf(xx);
            }
            npart[sh * 512 + 2 * kp] = a0; npart[sh * 512 + 2 * kp + 1] = a1;
        }
        if (emit && kh == 1) {
#pragma unroll
            for (int tt = 0; tt < 4; ++tt) *(LAS f32x4*)(red + ((cg * 4 + tt) * 64 + lane) * 4) = acc2[tt];
        }
        __syncthreads();
        nvec[tid] = sc_misc[0] * nvec[tid] + npart[tid] + npart[512 + tid];
        if (emit && kh == 0) {
#pragma unroll
            for (int tt = 0; tt < 4; ++tt) {
                const f32x4 o = acc2[tt] + *(const LAS f32x4*)(red + ((cg * 4 + tt) * 64 + lane) * 4);
                const f32x4 dn = *(const LAS f32x4*)(sc_dn + tt * 16 + 4 * g4);
#pragma unroll
                for (int r = 0; r < 4; ++r) otile[(tt * 16 + 4 * g4 + r) * 64 + cg * 16 + l15] = f2bf(o[r] / dn[r]);
            }
        }
        __syncthreads();
        if (emit) {
            const int t = tid >> 3, chunk = tid & 7;
            *(u32x4*)(H + (size_t)(cid * 64 + t) * 2048 + h * 512 + sl * 64 + chunk * 8) = *(const LAS u32x4*)(otile + t * 64 + chunk * 8);
        }
    }
}

DI void phase_merge(PP p) {
    const int tid = get_tid(), lane = tid & 63;
    const bf16_t* HF = (const bf16_t*)p->out;
    bf16_t* HB = (bf16_t*)(p->ws + OFF_ARENA + A_HB);
    const bf16_t* XC = (const bf16_t*)(p->ws + OFF_ARENA + A_XC);
    const bf16_t* Z = (const bf16_t*)(p->ws + OFF_ARENA + A_XM);
    const int gw = get_bid() * 8 + (tid >> 6), nw = gridDim.x * 8;
    for (int r = gw; r < NLAT; r += nw) {
#pragma unroll
        for (int hh = 0; hh < 4; ++hh) {
            const size_t o = (size_t)r * 2048 + hh * 512 + lane * 8;
            const u32x4 a = *(const u32x4*)(HF + o), b = *(const u32x4*)(HB + o), xq = *(const u32x4*)(XC + o), zq = *(const u32x4*)(Z + o);
            const unsigned aw[4] = {a.x, a.y, a.z, a.w}, bw[4] = {b.x, b.y, b.z, b.w}, xw[4] = {xq.x, xq.y, xq.z, xq.w}, zw[4] = {zq.x, zq.y, zq.z, zq.w};
            float hv[8]; float sum = 0.f;
#pragma unroll
            for (int j = 0; j < 4; ++j) { hv[2 * j] = lo_bf(aw[j]) + lo_bf(bw[j]); hv[2 * j + 1] = hi_bf(aw[j]) + hi_bf(bw[j]); sum += hv[2 * j] + hv[2 * j + 1]; }
            const float mean = wave_sum(sum) * (1.f / 512.f);
            float sq = 0.f;
#pragma unroll
            for (int j = 0; j < 8; ++j) { hv[j] -= mean; sq += hv[j] * hv[j]; }
            const float rs = rsqrtf(wave_sum(sq) * (1.f / 512.f) + EPS);
            float ov[8];
#pragma unroll
            for (int j = 0; j < 8; ++j) {
                const int c = hh * 512 + lane * 8 + j;
                const float xcv = (j & 1) ? hi_bf(xw[j >> 1]) : lo_bf(xw[j >> 1]);
                const float zv = (j & 1) ? hi_bf(zw[j >> 1]) : lo_bf(zw[j >> 1]);
                ov[j] = (hv[j] * rs * p->m_norm_g[c] + p->m_skip[c] * xcv) * siluf_(zv);
            }
            u32x4 v; v.x = pk2(ov[0], ov[1]); v.y = pk2(ov[2], ov[3]); v.z = pk2(ov[4], ov[5]); v.w = pk2(ov[6], ov[7]);
            *(u32x4*)(HB + o) = v;
        }
    }
}

DI void phase_downproj(PP p, lds_t lds) {
    const bf16_t* A = (const bf16_t*)(p->ws + OFF_ARENA + A_HB);
    float* X = (float*)(p->ws + OFF_ARENA + A_X);
    constexpr int NM = NLAT / 256, NN = 4;
    for (int u = get_bid(); u < NM * NN; u += gridDim.x) {
        const int pn = u / NM, pm = u % NM;
        const float* g1 = mods_ptr(p, 1, pm >> 5, 2);
        gemm_unit<256>(lds, 2048, 1024,
            [&](int r) { return A + (size_t)(pm * 256 + r) * 2048; },
            [&](int j) -> const float* { return p->m_w_down + pn * 256 + j; },
            [&](const f32x4 (&acc)[8][4], int wr, int wc, int lane) {
                epi_each<4>(acc, wr, wc, lane, [&](int r, int c, f32x4 v) {
                    const int col = pn * 256 + c;
                    float* xp = X + (size_t)(pm * 256 + r) * 1024 + col;
                    const f32x4 g = *(const f32x4*)(g1 + col);
                    *(f32x4*)xp = *(const f32x4*)xp + g * v;
                });
            });
    }
}

DI void phase_dbg_final(PP p, int mode) {
    const int tid = get_tid(), lane = tid & 63;
    const int gw = get_bid() * 8 + (tid >> 6), nw = gridDim.x * 8;
    if (mode == 4) {
        const int* rid = (const int*)(p->ws + OFF_ARENA + A_ROWID);
        for (int r = gw; r < NLAT; r += nw)
            for (int c = lane; c < 1024; c += 64) p->out[(size_t)r * 1024 + c] = (float)rid[(size_t)r * 16 + (c & 15)];
        return;
    }
    if (mode == 7) {
        const bf16_t* y = (const bf16_t*)(p->ws + OFF_ARENA + A_Y);
        for (int r = gw; r < NLAT; r += nw)
            for (int c = lane; c < 1024; c += 64) { const float v = bf2f(y[(size_t)r * 1024 + c]); p->out[(size_t)r * 1024 + c] = (v == v && fabsf(v) < 1e30f) ? 0.f : 1000.f; }
        return;
    }
    if (mode >= 2) {
        const bf16_t* src = mode == 2 ? (const bf16_t*)(p->ws + OFF_ARENA + A_P) : mode == 5 ? (const bf16_t*)(p->ws + OFF_ARENA + A_HDN) : mode == 6 ? (const bf16_t*)(p->ws + OFF_ARENA + A_Y) : (const bf16_t*)(p->ws + OFF_ACT);
        const int ld = mode == 2 ? ABIN : 1024;
        for (int r = gw; r < NLAT; r += nw)
            for (int c = lane; c < 1024; c += 64) p->out[(size_t)r * 1024 + c] = bf2f(src[(size_t)r * ld + (mode == 2 ? c + DBG_COL0 : c)]);
        return;
    }
    const float* X = mode ? (const float*)(p->ws + OFF_ARENA + A_X) : p->x;
    for (int r = gw; r < NLAT; r += nw) {
        f32x4 v[4];
        row_load_f32(X + (size_t)r * 1024, v, lane);
        const float rs = rsqrtf(row_sumsq(v) * (1.f / 1024.f) + EPS);
#pragma unroll
        for (int i = 0; i < 4; ++i) { const f32x4 g = *(const f32x4*)(p->final_g + 4 * lane + 256 * i); *(f32x4*)(p->out + (size_t)r * 1024 + 4 * lane + 256 * i) = v[i] * rs * g; }
    }
}

DI void grid_barrier(cg::grid_group& grid) {
    asm volatile("s_waitcnt vmcnt(0) lgkmcnt(0)" ::: "memory");
    grid.sync();
    __builtin_amdgcn_fence(__ATOMIC_ACQUIRE, "agent");
    asm volatile("s_waitcnt vmcnt(0)" ::: "memory");
}
#define RUN_PHASE(K, CALL) if (ph_lo <= (K) && (K) < ph_hi && ((K) <= DBG_STOP)) { PP p = kp; asm volatile("" : "+s"(p)); CALL; if ((K) + 1 < ph_hi) grid_barrier(grid); }
__global__ void __launch_bounds__(NTHREADS) mega(Params p_in) {
    extern __shared__ __attribute__((aligned(16))) unsigned char lds_raw[];
    lds_t lds = (lds_t)lds_raw;
    cg::grid_group grid = cg::this_grid();
    PP kp = (PP)__builtin_amdgcn_kernarg_segment_ptr();
    const int ph_lo = kp->ph_lo, ph_hi = kp->ph_hi;
    RUN_PHASE(0, phase_mods(p, lds))
    RUN_PHASE(1, phase_norm(p, 0, NTOK, [&](int r) { return r < NLAT ? p->x + (size_t)r * 1024 : p->ctx + (size_t)(r - NLAT) * 1024; }))
    RUN_PHASE(2, phase_inproj(p, lds))
    RUN_PHASE(3, phase_g1(p, lds))
    RUN_PHASE(4, phase_scan0(p))
    RUN_PHASE(5, phase_g3(p, lds))
    RUN_PHASE(6, phase_outproj0(p, lds))
    RUN_PHASE(7, phase_router(p, lds, 0))
    RUN_PHASE(8, phase_topk(p, lds, 0))
    RUN_PHASE(9, phase_moe_up(p, lds, 0))
    RUN_PHASE(10, phase_moe_down(p, lds, 0))
    RUN_PHASE(11, phase_combine(p, 0))
    RUN_PHASE(12, phase_upproj(p, lds, 0))
    RUN_PHASE(13, phase_mfeat(p, lds))
    RUN_PHASE(14, phase_mscan(p, lds))
    RUN_PHASE(15, phase_norm(p, 1, NLAT, [&](int r) { return (const float*)(p->ws + OFF_ARENA + A_X) + (size_t)r * 1024; }))
    RUN_PHASE(16, phase_upproj(p, lds, 1))
    RUN_PHASE(17, phase_merge(p))
    RUN_PHASE(18, phase_downproj(p, lds))
    RUN_PHASE(19, phase_router(p, lds, 1))
    RUN_PHASE(20, phase_topk(p, lds, 1))
    RUN_PHASE(21, phase_moe_up(p, lds, 1))
    RUN_PHASE(22, phase_moe_down(p, lds, 1))
    RUN_PHASE(23, phase_combine(p, 1))
    if (DBG_STOP < 23 && DBG_STOP + 1 < ph_hi) { PP p = kp; asm volatile("" : "+s"(p)); phase_dbg_final(p, DBG_MODE); }
}

extern "C" void kernel_launch(void* const* d_in, const int* in_sizes, int n_in, void* d_out, int out_size, void* d_ws, size_t ws_size, hipStream_t stream) {
    static int grid = 0;
    if (grid == 0) {
        int dev = 0, cus = 0, per_cu = 0;
        hipGetDevice(&dev);
        hipDeviceGetAttribute(&cus, hipDeviceAttributeMultiprocessorCount, dev);
        hipFuncSetAttribute((const void*)mega, hipFuncAttributeMaxDynamicSharedMemorySize, LDS_BYTES);
        hipOccupancyMaxActiveBlocksPerMultiprocessor(&per_cu, (const void*)mega, NTHREADS, LDS_BYTES);
        if (per_cu < 1) { fprintf(stderr, "occupancy query says %d blocks/CU\n", per_cu); per_cu = 1; }
        grid = cus;
        if (ws_size < WS_NEED) { fprintf(stderr, "workspace too small: %zu < %zu\n", ws_size, (size_t)WS_NEED); grid = -1; }
    }
    if (grid < 0) return;
    Params hp{};
    const float** pp = (const float**)&hp;
    for (int i = 0; i < 36; ++i) pp[i] = (const float*)d_in[i];
    hp.out = (float*)d_out; hp.ws = (char*)d_ws; hp.ph_lo = 0; hp.ph_hi = DBG_STOP < 23 ? DBG_STOP + 2 : 24;
    void* args[] = {&hp};
    hipError_t e = hipLaunchCooperativeKernel((const void*)mega, dim3(grid), dim3(NTHREADS), args, LDS_BYTES, stream);
    if (e != hipSuccess) fprintf(stderr, "cooperative launch failed: %s\n", hipGetErrorString(e));
}
```

```cpp
#include <hip/hip_runtime.h>
#include <hip/hip_cooperative_groups.h>
#include <cstdio>
#include <cstdint>
namespace cg = cooperative_groups;

#define LAS __attribute__((address_space(3)))
#define DI __device__ __forceinline__
typedef unsigned short bf16_t;
typedef short bf16x8 __attribute__((ext_vector_type(8)));
typedef short s16x4 __attribute__((ext_vector_type(4)));
typedef float f32x4 __attribute__((ext_vector_type(4)));
typedef float f32x2 __attribute__((ext_vector_type(2)));
typedef unsigned u32x4 __attribute__((ext_vector_type(4)));
typedef unsigned u32x2 __attribute__((ext_vector_type(2)));
typedef LAS char* lds_t;

constexpr int D = 1024, NBATCH = 4, SEQ = 8192, CTXL = 256;
constexpr int NLAT = NBATCH * SEQ;
constexpr int NCTX = NBATCH * CTXL;
constexpr int NTOK = NLAT + NCTX;
constexpr int NCH = NTOK / 64;
constexpr int NCHL = NLAT / 64;
constexpr int ABIN = 2592;
constexpr int PC_Q = 0, PC_K = 256, PC_V = 512, PC_G = 1024, PC_LRF = 1536, PC_LRB = 1552, PC_RGG = 1568, PC_RGX = 2080;
constexpr float EPS = 1e-6f;
constexpr int NTHREADS = 512;
constexpr int LDS_BYTES = 160 * 1024;
#define DBG_MODE 1
#ifndef DUP_MASK
#define DUP_MASK 0
#endif
#ifndef EXTRA_BARRIERS
#define EXTRA_BARRIERS 0
#endif
#define DBG_STOP 23
#define DBG_COL0 0

constexpr size_t OFF_MODS = 0;
constexpr size_t OFF_GCAT = 245760;
constexpr size_t OFF_MMAT = 376832;
constexpr size_t OFF_BAR = 409600;
constexpr size_t OFF_ACT = 1u << 20;
constexpr size_t ACT_BYTES = (size_t)NTOK * 1024 * 2;
constexpr size_t OFF_ARENA = OFF_ACT + ACT_BYTES;
constexpr size_t A_P = 0;
constexpr size_t A_U = A_P + (size_t)NTOK * ABIN * 2;
constexpr size_t A_LA = A_U + (size_t)NCH * 2 * 4 * 8192 * 4;
constexpr size_t A_UU = A_LA + (size_t)NTOK * 2 * 512 * 4;
constexpr size_t A_DEC = A_UU + (size_t)NTOK * 2 * 512 * 2;
constexpr size_t A_AGGA = A_DEC + (size_t)NCH * 2 * 256 * 4;
constexpr size_t A_AGGH = A_AGGA + (size_t)NCH * 2 * 512 * 4;
constexpr size_t A_L0_END = A_AGGH + (size_t)NCH * 2 * 512 * 4;
constexpr size_t A_X = 0;
constexpr size_t A_PT = A_X + (size_t)NTOK * 1024 * 4;
constexpr size_t A_PE = A_PT + (size_t)NTOK * 16 * 4;
constexpr size_t A_ROWID = A_PE + (size_t)NTOK * 16 * 4;
constexpr size_t A_ROWTOK = A_ROWID + (size_t)NTOK * 16 * 4;
constexpr size_t A_HDN = A_ROWTOK + (size_t)16 * 4352 * 4;
constexpr size_t A_Y = A_HDN + (size_t)16 * 4352 * 1024 * 2;
constexpr size_t A_MOE0_END = A_Y + (size_t)16 * 4352 * 1024 * 2;
constexpr size_t A_XM = A_X + (size_t)NTOK * 1024 * 4;
constexpr size_t A_XC = A_XM + (size_t)NTOK * 2048 * 2;
constexpr size_t A_HB = A_XC + (size_t)NTOK * 2048 * 2;
constexpr size_t A_L1_END = A_HB + (size_t)NLAT * 2048 * 2;
constexpr size_t ACT_RAWS = 0;
constexpr size_t ACT_GP = ACT_RAWS + (size_t)NCH * 4 * 4096 * 2;
constexpr size_t ACT_CTXV = ACT_GP + (size_t)NTOK * 64 * 4;
constexpr size_t WS_NEED = OFF_ARENA + (A_L1_END > A_L0_END ? A_L1_END : A_L0_END);
static_assert(A_MOE0_END < A_L1_END, "arena");
static_assert(ACT_CTXV + (size_t)NCTX * 2048 * 2 <= ACT_BYTES, "act region");

struct Params {
    const float *x, *c, *ctx, *c_ctx, *mod_w, *mod_b, *norm1_g, *norm2_g, *ab_w_in, *gla_wa2, *gla_ba, *gla_norm_g;
    const float *rg_conv_w, *rg_conv_b, *rg_wr, *rg_br, *rg_wi, *rg_bi, *rg_lambda, *ab_w_out, *m_w_up, *m_conv_w, *m_conv_b;
    const float *m_wq, *m_wk, *m_wv, *m_w_gates, *m_b_gates, *m_skip, *m_norm_g, *m_w_down, *router_w, *exp_w_gate, *exp_w_up, *exp_w_down, *final_g;
    float* out;
    char* ws;
    int ph_lo, ph_hi;
};

typedef const Params __attribute__((address_space(4)))* PP;

DI int get_tid() { int t = threadIdx.x; asm volatile("" : "+v"(t)); return t; }
DI int get_bid() { int b = blockIdx.x; asm volatile("" : "+s"(b)); return b; }
DI float bf2f(bf16_t h) { return __uint_as_float((unsigned)h << 16); }
DI bf16_t f2bf(float x) { unsigned u = __float_as_uint(x); u += 0x7fffu + ((u >> 16) & 1u); return (bf16_t)(u >> 16); }
typedef __bf16 bf16x2_t __attribute__((ext_vector_type(2)));
DI unsigned pk2n(float lo, float hi) { const f32x2 v = {lo, hi}; return __builtin_bit_cast(unsigned, __builtin_convertvector(v, bf16x2_t)); }
DI unsigned pk2(float lo, float hi) { return pk2n(lo, hi); }
DI float lo_bf(unsigned u) { return __uint_as_float(u << 16); }
DI float hi_bf(unsigned u) { return __uint_as_float(u & 0xffff0000u); }
DI float sigmoidf_(float x) { return 1.f / (1.f + __expf(-x)); }
DI float siluf_(float x) { return x / (1.f + __expf(-x)); }
DI float log_sigmoidf_(float z) { return fminf(z, 0.f) - log1pf(__expf(-fabsf(z))); }
DI float softplusf_(float z) { return fmaxf(z, 0.f) + log1pf(__expf(-fabsf(z))); }
DI float gelu_tanh(float x) { const float u = 0.7978845608028654f * (x + 0.044715f * x * x * x); return 0.5f * x * (1.f + tanhf(u)); }
DI float wave_sum(float v) {
#pragma unroll
    for (int o = 32; o > 0; o >>= 1) v += __shfl_xor(v, o);
    return v;
}
DI f32x4 mfma16(bf16x8 a, bf16x8 b, f32x4 c) { return __builtin_amdgcn_mfma_f32_16x16x32_bf16(a, b, c, 0, 0, 0); }

DI bf16x8 frag_row(const LAS bf16_t* tile, int ld, int r0, int k0, int lane) {
    return *(const LAS bf16x8*)(tile + (r0 + (lane & 15)) * ld + k0 + 8 * (lane >> 4));
}
DI bf16x8 frag_tr(const LAS bf16_t* tile, int ld, int k0, int c0, int lane) {
    const int g = lane >> 4, i = lane & 15, q = i >> 2, p = i & 3;
    const LAS bf16_t* base = tile + (k0 + 8 * g + q) * ld + c0 + 4 * p;
    const s16x4 lo = __builtin_amdgcn_ds_read_tr16_b64_v4i16((LAS s16x4*)base);
    const s16x4 hi = __builtin_amdgcn_ds_read_tr16_b64_v4i16((LAS s16x4*)(base + 4 * ld));
    return __builtin_shufflevector(lo, hi, 0, 1, 2, 3, 4, 5, 6, 7);
}
DI const float* mods_ptr(PP p, int layer, int s, int which) { return (const float*)(p->ws + OFF_MODS) + ((size_t)(layer * 5 + s) * 6 + which) * 1024; }
DI int row_set(int r) { return r < NLAT ? (r >> 13) : 4; }

template <int BN, class ARow, class BCol, class Epi>
DI void gemm_unit(lds_t lds, int K, int ldb, ARow arow, BCol bcol, Epi epi) {
    constexpr int BK = 32;
    constexpr int NT = BN / 64;
    constexpr int LDA = BK + 8, LDB = BN + 16;
    constexpr int A_BYTES = 256 * LDA * 2, B_BYTES = BK * LDB * 2;
    static_assert(2 * A_BYTES + 2 * B_BYTES <= LDS_BYTES, "gemm lds");
    const int tid = get_tid(), lane = tid & 63, w = tid >> 6, wr = w >> 2, wc = w & 3;
    constexpr int ACH = BK / 8, ARP = NTHREADS / ACH, AP = 256 / ARP;
    const int achunk = tid % ACH, arow0 = tid / ACH;
    const bf16_t* ap[AP];
#pragma unroll
    for (int q = 0; q < AP; ++q) ap[q] = arow(arow0 + ARP * q);
    constexpr int CG = BN / 8, KR = NTHREADS / CG, BP = BK / KR;
    const int bc8 = tid % CG, bk0 = tid / CG;
    const float* bp = bcol(bc8 * 8);
    u32x4 areg[AP];
    f32x4 breg[BP][2];
    auto gload = [&](int kt) {
        const int k0 = kt * BK;
#pragma unroll
        for (int q = 0; q < AP; ++q) areg[q] = ap[q] ? *(const u32x4*)(ap[q] + k0 + achunk * 8) : (u32x4){0u, 0u, 0u, 0u};
#pragma unroll
        for (int q = 0; q < BP; ++q) {
            if (bp) { const float* s = bp + (size_t)(k0 + bk0 + KR * q) * ldb; breg[q][0] = *(const f32x4*)s; breg[q][1] = *(const f32x4*)(s + 4); }
            else { breg[q][0] = (f32x4){0.f, 0.f, 0.f, 0.f}; breg[q][1] = breg[q][0]; }
        }
    };
    auto lstore = [&](int buf) {
        LAS bf16_t* As = (LAS bf16_t*)(lds + buf * A_BYTES);
        LAS bf16_t* Bs = (LAS bf16_t*)(lds + 2 * A_BYTES + buf * B_BYTES);
#pragma unroll
        for (int q = 0; q < AP; ++q) *(LAS u32x4*)(As + (arow0 + ARP * q) * LDA + achunk * 8) = areg[q];
#pragma unroll
        for (int q = 0; q < BP; ++q) {
            u32x4 v; v.x = pk2(breg[q][0][0], breg[q][0][1]); v.y = pk2(breg[q][0][2], breg[q][0][3]); v.z = pk2(breg[q][1][0], breg[q][1][1]); v.w = pk2(breg[q][1][2], breg[q][1][3]);
            *(LAS u32x4*)(Bs + (bk0 + KR * q) * LDB + bc8 * 8) = v;
        }
    };
    f32x4 acc[8][NT];
#pragma unroll
    for (int mi = 0; mi < 8; ++mi)
#pragma unroll
        for (int ni = 0; ni < NT; ++ni) acc[mi][ni] = (f32x4){0.f, 0.f, 0.f, 0.f};
    const int nk = K / BK;
    gload(0);
    for (int kt = 0; kt < nk; ++kt) {
        lstore(kt & 1);
        __syncthreads();
        if (kt + 1 < nk) gload(kt + 1);
        const LAS bf16_t* As = (const LAS bf16_t*)(lds + (kt & 1) * A_BYTES);
        const LAS bf16_t* Bs = (const LAS bf16_t*)(lds + 2 * A_BYTES + (kt & 1) * B_BYTES);
#pragma unroll
        for (int ks = 0; ks < BK / 32; ++ks) {
            bf16x8 wb[NT];
#pragma unroll
            for (int ni = 0; ni < NT; ++ni) wb[ni] = frag_tr(Bs, LDB, ks * 32, wc * (BN / 4) + ni * 16, lane);
#pragma unroll
            for (int mi = 0; mi < 8; ++mi) {
                const bf16x8 xa = frag_row(As, LDA, wr * 128 + mi * 16, ks * 32, lane);
#pragma unroll
                for (int ni = 0; ni < NT; ++ni) acc[mi][ni] = mfma16(wb[ni], xa, acc[mi][ni]);
            }
        }
    }
    epi(acc, wr, wc, lane);
    __syncthreads();
}

template <int NT, class F>
DI void epi_each(const f32x4 (&acc)[8][NT], int wr, int wc, int lane, F f) {
#pragma unroll
    for (int mi = 0; mi < 8; ++mi)
#pragma unroll
        for (int ni = 0; ni < NT; ++ni) f(wr * 128 + mi * 16 + (lane & 15), wc * (NT * 16) + ni * 16 + 4 * (lane >> 4), acc[mi][ni]);
}
DI void store_bf16x4(bf16_t* dst, f32x4 v) { u32x2 o; o.x = pk2(v[0], v[1]); o.y = pk2(v[2], v[3]); *(u32x2*)dst = o; }

DI void row_load_f32(const float* src, f32x4 (&v)[4], int lane) {
#pragma unroll
    for (int i = 0; i < 4; ++i) v[i] = *(const f32x4*)(src + 4 * lane + 256 * i);
}
DI float row_sumsq(const f32x4 (&v)[4]) {
    float s = 0.f;
#pragma unroll
    for (int i = 0; i < 4; ++i) s += v[i][0] * v[i][0] + v[i][1] * v[i][1] + v[i][2] * v[i][2] + v[i][3] * v[i][3];
    return wave_sum(s);
}
DI void row_modulate(f32x4 (&v)[4], float rs, const float* g, const float* sc, const float* sh, int lane) {
#pragma unroll
    for (int i = 0; i < 4; ++i) {
        const int c = 4 * lane + 256 * i;
        const f32x4 gg = *(const f32x4*)(g + c), ss = *(const f32x4*)(sc + c), hh = *(const f32x4*)(sh + c);
#pragma unroll
        for (int j = 0; j < 4; ++j) v[i][j] = v[i][j] * rs * gg[j] * (1.f + ss[j]) + hh[j];
    }
}
DI void row_store_bf16(bf16_t* dst, const f32x4 (&v)[4], int lane) {
#pragma unroll
    for (int i = 0; i < 4; ++i) store_bf16x4(dst + 4 * lane + 256 * i, v[i]);
}

DI void phase_mods(PP p, lds_t lds) {
    const int tid = get_tid();
    LAS float* sil = (LAS float*)lds;
    LAS float* red = sil + 5 * 1024;
    for (int u = get_bid(); u < 192 + 32; u += gridDim.x) {
        if (u < 192) {
            const int layer = u / 96, c0 = (u % 96) * 64;
            for (int i = tid; i < 5 * 1024; i += NTHREADS) { const int s = i >> 10, k = i & 1023; const float cv = s < 4 ? p->c[s * 1024 + k] : p->c_ctx[k]; sil[i] = siluf_(cv); }
            __syncthreads();
            const int col = tid & 63, kp = tid >> 6;
            float a[5] = {0.f, 0.f, 0.f, 0.f, 0.f};
            const float* wp = p->mod_w + (size_t)layer * 1024 * 6144 + c0 + col;
            for (int k = kp * 128; k < kp * 128 + 128; ++k) {
                const float wv = wp[(size_t)k * 6144];
#pragma unroll
                for (int s = 0; s < 5; ++s) a[s] += sil[s * 1024 + k] * wv;
            }
#pragma unroll
            for (int s = 0; s < 5; ++s) red[(kp * 5 + s) * 64 + col] = a[s];
            __syncthreads();
            if (tid < 320) {
                const int s = tid >> 6, cc = tid & 63;
                float t = p->mod_b[layer * 6144 + c0 + cc];
#pragma unroll
                for (int k = 0; k < 8; ++k) t += red[(k * 5 + s) * 64 + cc];
                ((float*)(p->ws + OFF_MODS))[(size_t)(layer * 5 + s) * 6144 + c0 + cc] = t;
            }
            __syncthreads();
        } else {
            const int f0 = (u - 192) * 64;
            const int fl = tid >> 3, dgp = (tid & 7) * 2, f = f0 + fl, n = f >> 2, i = f & 3;
            bf16_t* gxc = (bf16_t*)(p->ws + OFF_GCAT);
            bf16_t* gxm = gxc + 2048 * 16;
#pragma unroll
            for (int e = 0; e < 2; ++e) {
                const int dg = dgp + e, d = dg >> 3, g = dg & 7;
                const float* wg = p->m_w_gates + (size_t)d * 6144 * 8;
                float a = 0.f, b = 0.f;
#pragma unroll
                for (int o = 0; o < 4; ++o) {
                    a += p->m_wq[n * 16 + i * 4 + o] * wg[(size_t)(4 * n + o) * 8 + g];
                    a += p->m_wk[n * 16 + i * 4 + o] * wg[(size_t)(2048 + 4 * n + o) * 8 + g] * 0.04419417382415922f;
                    b += p->m_wv[n * 16 + i * 4 + o] * wg[(size_t)(4096 + 4 * n + o) * 8 + g];
                }
                gxc[f * 16 + dg] = f2bf(a); gxm[f * 16 + dg] = f2bf(b);
            }
            if (tid < 256) {
                const int nn = (f0 >> 2) + (tid >> 4), e = tid & 15, ii = e >> 2, jj = e & 3;
                float a = 0.f;
#pragma unroll
                for (int o = 0; o < 4; ++o) a += p->m_wq[nn * 16 + ii * 4 + o] * p->m_wk[nn * 16 + jj * 4 + o];
                ((float*)(p->ws + OFF_MMAT))[nn * 16 + e] = a * 0.04419417382415922f;
            }
        }
    }
}

template <class Src>
DI void phase_norm(PP p, int layer, int nrows, Src src) {
    const int lane = get_tid() & 63, gw = get_bid() * 8 + (get_tid() >> 6), nw = gridDim.x * 8;
    bf16_t* act = (bf16_t*)(p->ws + OFF_ACT);
    for (int r = gw; r < nrows; r += nw) {
        f32x4 v[4];
        row_load_f32(src(r), v, lane);
        const float rs = rsqrtf(row_sumsq(v) * (1.f / 1024.f) + EPS);
        const int s = row_set(r);
        row_modulate(v, rs, p->norm1_g + layer * 1024, mods_ptr(p, layer, s, 1), mods_ptr(p, layer, s, 0), lane);
        row_store_bf16(act + (size_t)r * 1024, v, lane);
    }
}

DI void phase_inproj(PP p, lds_t lds) {
    const bf16_t* act = (const bf16_t*)(p->ws + OFF_ACT);
    bf16_t* P = (bf16_t*)(p->ws + OFF_ARENA + A_P);
    constexpr int NM = NTOK / 256, NN = 11;
    for (int u = get_bid(); u < NM * NN; u += gridDim.x) {
        const int pn = u / NM, pm = u % NM;
        gemm_unit<256>(lds, 1024, ABIN,
            [&](int r) { return act + (size_t)(pm * 256 + r) * 1024; },
            [&](int j) -> const float* { const int c = pn * 256 + j; return c < ABIN ? p->ab_w_in + c : nullptr; },
            [&](const f32x4 (&acc)[8][4], int wr, int wc, int lane) {
                epi_each<4>(acc, wr, wc, lane, [&](int r, int c, f32x4 v) { const int col = pn * 256 + c; if (col < ABIN) store_bf16x4(P + (size_t)(pm * 256 + r) * ABIN + col, v); });
            });
    }
}


DI void gla_bcum(LAS float* bc, const LAS float* lrt, const LAS float* wat, const LAS float* bat, int d) {
    const int tid = get_tid();
    {
        const int c = tid & 63, tq = tid >> 6;
        float wcol[16];
#pragma unroll
        for (int r = 0; r < 16; ++r) wcol[r] = wat[r * 64 + c];
        const float bias = bat[c];
        for (int t = tq * 8; t < tq * 8 + 8; ++t) {
            float z = bias;
#pragma unroll
            for (int r = 0; r < 16; ++r) z += lrt[t * 16 + r] * wcol[r];
            bc[t * 64 + c] = log_sigmoidf_(z) * (1.f / 16.f);
        }
    }
    __syncthreads();
    if (tid < 64) {
        float run = 0.f;
        if (d == 0) { for (int t = 0; t < 64; ++t) { run += bc[t * 64 + tid]; bc[t * 64 + tid] = run; } }
        else { for (int t = 63; t >= 0; --t) { run += bc[t * 64 + tid]; bc[t * 64 + tid] = run; } }
    }
    __syncthreads();
}
DI void gla_load_decay_inputs(PP p, const bf16_t* P, int r0, int h, LAS float* lrt, LAS float* wat, LAS float* bat) {
    const int tid = get_tid();
    if (tid < 256) {
        const int d = tid >> 7, t = (tid >> 1) & 63, half = tid & 1;
        const u32x4 v = *(const u32x4*)(P + (size_t)(r0 + t) * ABIN + PC_LRF + d * 16 + half * 8);
        LAS float* o = lrt + (d * 64 + t) * 16 + half * 8;
        o[0] = lo_bf(v.x); o[1] = hi_bf(v.x); o[2] = lo_bf(v.y); o[3] = hi_bf(v.y); o[4] = lo_bf(v.z); o[5] = hi_bf(v.z); o[6] = lo_bf(v.w); o[7] = hi_bf(v.w);
    }
    {
        const int i = tid * 4, d = i >> 10, r = (i >> 6) & 15, c = i & 63;
        *(LAS f32x4*)(wat + i) = *(const f32x4*)(p->gla_wa2 + (size_t)(d * 16 + r) * 256 + h * 64 + c);
    }
    if (tid < 128) bat[tid] = p->gla_ba[(tid >> 6) * 256 + h * 64 + (tid & 63)];
}

DI void phase_g1(PP p, lds_t lds) {
    const int tid = get_tid(), lane = tid & 63, w = tid >> 6;
    const bf16_t* P = (const bf16_t*)(p->ws + OFF_ARENA + A_P);
    float* U = (float*)(p->ws + OFF_ARENA + A_U);
    float* DEC = (float*)(p->ws + OFF_ARENA + A_DEC);
    float* LA = (float*)(p->ws + OFF_ARENA + A_LA);
    bf16_t* UU = (bf16_t*)(p->ws + OFF_ARENA + A_UU);
    float* AGGA = (float*)(p->ws + OFF_ARENA + A_AGGA);
    float* AGGH = (float*)(p->ws + OFF_ARENA + A_AGGH);
    constexpr int NGLA = NCH * 4, NLRU = NCH * 4;
    for (int task = get_bid(); task < NGLA + NLRU; task += gridDim.x) {
        if (task < NGLA) {
            const int ch = task >> 2, h = task & 3, r0 = ch * 64;
            LAS float* lrt = (LAS float*)lds;
            LAS float* wat = lrt + 2048;
            LAS float* bat = wat + 2048;
            LAS float* bc = bat + 128;
            LAS bf16_t* kt = (LAS bf16_t*)(bc + 8192);
            LAS bf16_t* ktd = kt + 64 * 72;
            LAS bf16_t* vt = ktd + 2 * 64 * 72;
            gla_load_decay_inputs(p, P, r0, h, lrt, wat, bat);
            { const int row = tid >> 3, chunk = tid & 7; *(LAS u32x4*)(kt + row * 72 + chunk * 8) = *(const u32x4*)(P + (size_t)(r0 + row) * ABIN + PC_K + h * 64 + chunk * 8); }
#pragma unroll
            for (int q = 0; q < 2; ++q) { const int i = tid + 512 * q, row = i >> 4, chunk = i & 15; *(LAS u32x4*)(vt + row * 136 + chunk * 8) = *(const u32x4*)(P + (size_t)(r0 + row) * ABIN + PC_V + h * 128 + chunk * 8); }
            __syncthreads();
            gla_bcum(bc, lrt, wat, bat, 0);
            gla_bcum(bc + 4096, lrt + 1024, wat + 1024, bat + 64, 1);
            {
                const int t = tid >> 3, c8 = (tid & 7) * 8;
#pragma unroll
                for (int d = 0; d < 2; ++d) {
                    const LAS float* b = bc + d * 4096;
                    const int tl = d == 0 ? 63 : 0;
                    float o[8];
#pragma unroll
                    for (int j = 0; j < 8; ++j) o[j] = bf2f(kt[t * 72 + c8 + j]) * __expf(b[tl * 64 + c8 + j] - b[t * 64 + c8 + j]);
                    u32x4 v; v.x = pk2(o[0], o[1]); v.y = pk2(o[2], o[3]); v.z = pk2(o[4], o[5]); v.w = pk2(o[6], o[7]);
                    *(LAS u32x4*)(ktd + d * 64 * 72 + t * 72 + c8) = v;
                }
                if (tid < 128) { const int d = tid >> 6, c = tid & 63; DEC[(size_t)(ch * 2 + d) * 256 + h * 64 + c] = __expf(bc[d * 4096 + (d == 0 ? 63 : 0) * 64 + c]); }
            }
            __syncthreads();
            {
                const int d = w >> 2, dkt = w & 3;
                const LAS bf16_t* kd = ktd + d * 64 * 72;
                bf16x8 kb[2];
#pragma unroll
                for (int ks = 0; ks < 2; ++ks) kb[ks] = frag_tr(kd, 72, ks * 32, dkt * 16, lane);
                float* Ud = U + ((size_t)(ch * 2 + d) * 4 + h) * 8192;
#pragma unroll
                for (int dvt = 0; dvt < 8; ++dvt) {
                    f32x4 acc = {0.f, 0.f, 0.f, 0.f};
#pragma unroll
                    for (int ks = 0; ks < 2; ++ks) acc = mfma16(frag_tr(vt, 136, ks * 32, dvt * 16, lane), kb[ks], acc);
                    *(f32x4*)(Ud + (dkt * 16 + (lane & 15)) * 128 + dvt * 16 + 4 * (lane >> 4)) = acc;
                }
            }
            __syncthreads();
        } else {
            const int t2 = task - NGLA, ch = t2 >> 2, cq = t2 & 3, r0 = ch * 64;
            const int seg_lo = ch < NCHL ? r0 : NLAT + ((r0 - NLAT) >> 8) * 256, seg_hi = ch < NCHL ? r0 + 64 : seg_lo + 256;
            LAS bf16_t* xin = (LAS bf16_t*)lds;
            LAS bf16_t* xb = xin + 67 * 136;
            LAS float* lat = (LAS float*)(xb + 64 * 136);
            LAS bf16_t* git = (LAS bf16_t*)(lat + 2 * 64 * 128);
            for (int i = tid; i < 67 * 16; i += NTHREADS) {
                const int row = i >> 4, chunk = i & 15, r = r0 - 2 + row;
                u32x4 v = {0u, 0u, 0u, 0u};
                if (r >= seg_lo && r < seg_hi) v = *(const u32x4*)(P + (size_t)r * ABIN + PC_RGX + cq * 128 + chunk * 8);
                *(LAS u32x4*)(xin + row * 136 + chunk * 8) = v;
            }
            __syncthreads();
            {
                const int t = tid >> 3, c16 = (tid & 7) * 16;
                float o[16];
#pragma unroll
                for (int j = 0; j < 16; ++j) o[j] = p->rg_conv_b[cq * 128 + c16 + j];
#pragma unroll
                for (int tap = 0; tap < 4; ++tap)
#pragma unroll
                    for (int j = 0; j < 16; ++j) o[j] += p->rg_conv_w[tap * 512 + cq * 128 + c16 + j] * bf2f(xin[(t + tap) * 136 + c16 + j]);
#pragma unroll
                for (int j = 0; j < 16; j += 8) {
                    u32x4 v; v.x = pk2(o[j], o[j + 1]); v.y = pk2(o[j + 2], o[j + 3]); v.z = pk2(o[j + 4], o[j + 5]); v.w = pk2(o[j + 6], o[j + 7]);
                    *(LAS u32x4*)(xb + t * 136 + c16 + j) = v;
                }
            }
            __syncthreads();
            {
                const int blk = w & 1, d = (w >> 1) & 1, mat = w >> 2, n = cq * 2 + blk;
                const float* W = (mat ? p->rg_wi : p->rg_wr) + (size_t)(d * 8 + n) * 4096;
                const float* bias = (mat ? p->rg_bi : p->rg_br) + d * 512 + n * 64;
                bf16x8 wf[4][2];
#pragma unroll
                for (int ot = 0; ot < 4; ++ot)
#pragma unroll
                    for (int ks = 0; ks < 2; ++ks) {
                        const float* src = W + (size_t)(ks * 32 + 8 * (lane >> 4)) * 64 + ot * 16 + (lane & 15);
                        float f[8];
#pragma unroll
                        for (int j = 0; j < 8; ++j) f[j] = src[j * 64];
                        u32x4 v; v.x = pk2n(f[0], f[1]); v.y = pk2n(f[2], f[3]); v.z = pk2n(f[4], f[5]); v.w = pk2n(f[6], f[7]);
                        wf[ot][ks] = __builtin_bit_cast(bf16x8, v);
                    }
#pragma unroll
                for (int tt = 0; tt < 4; ++tt) {
                    bf16x8 xf[2];
#pragma unroll
                    for (int ks = 0; ks < 2; ++ks) xf[ks] = frag_row(xb, 136, tt * 16, blk * 64 + ks * 32, lane);
#pragma unroll
                    for (int ot = 0; ot < 4; ++ot) {
                        f32x4 acc = {0.f, 0.f, 0.f, 0.f};
#pragma unroll
                        for (int ks = 0; ks < 2; ++ks) acc = mfma16(wf[ot][ks], xf[ks], acc);
                        const int t = tt * 16 + (lane & 15), o = ot * 16 + 4 * (lane >> 4), c = blk * 64 + o;
                        const f32x4 bv = *(const f32x4*)(bias + o);
                        if (mat == 0) {
                            const f32x4 lam = *(const f32x4*)(p->rg_lambda + d * 512 + n * 64 + o);
                            f32x4 la;
#pragma unroll
                            for (int j = 0; j < 4; ++j) la[j] = -8.f * softplusf_(-lam[j]) * sigmoidf_(acc[j] + bv[j]);
                            *(LAS f32x4*)(lat + (d * 64 + t) * 128 + c) = la;
                        } else {
                            float gi[4];
#pragma unroll
                            for (int j = 0; j < 4; ++j) gi[j] = sigmoidf_(acc[j] + bv[j]) * bf2f(xb[t * 136 + c + j]);
                            u32x2 v; v.x = pk2(gi[0], gi[1]); v.y = pk2(gi[2], gi[3]);
                            *(LAS u32x2*)(git + (d * 64 + t) * 128 + c) = v;
                        }
                    }
                }
            }
            __syncthreads();
            if (tid < 256) {
                const int d = tid >> 7, c = tid & 127, gc = cq * 128 + c;
                float hacc = 0.f, ssum = 0.f;
                for (int s = 0; s < 64; ++s) {
                    const int t = d == 0 ? s : 63 - s;
                    const float la = lat[(d * 64 + t) * 128 + c];
                    const float u = sqrtf(-expm1f(2.f * la)) * bf2f(git[(d * 64 + t) * 128 + c]);
                    hacc = __expf(la) * hacc + u; ssum += la;
                    LA[((size_t)(r0 + t) * 2 + d) * 512 + gc] = la;
                    UU[((size_t)(r0 + t) * 2 + d) * 512 + gc] = f2bf(u);
                }
                AGGA[(size_t)(ch * 2 + d) * 512 + gc] = __expf(ssum);
                AGGH[(size_t)(ch * 2 + d) * 512 + gc] = hacc;
            }
            __syncthreads();
        }
    }
}

DI int scan_chunk(int b, int d, int st) {
    if (st < 4) return NCHL + b * 4 + (d == 0 ? st : 3 - st);
    const int j = st - 4;
    return b * 128 + (d == 0 ? j : 127 - j);
}

DI void phase_scan0(PP p) {
    float* U = (float*)(p->ws + OFF_ARENA + A_U);
    const float* DEC = (const float*)(p->ws + OFF_ARENA + A_DEC);
    const float* AGGA = (const float*)(p->ws + OFF_ARENA + A_AGGA);
    float* AGGH = (float*)(p->ws + OFF_ARENA + A_AGGH);
    const int gid = get_bid() * NTHREADS + get_tid(), nthr = gridDim.x * NTHREADS;
    for (int idx = gid; idx < 65536 + 4096; idx += nthr) {
        if (idx < 65536) {
            const int dv4 = idx & 31, dk = (idx >> 5) & 63, h = (idx >> 11) & 3, d = (idx >> 13) & 1, b = idx >> 14;
            f32x4 S = {0.f, 0.f, 0.f, 0.f};
            for (int st = 0; st < 132; st += 4) {
                f32x4 u[4]; float dc[4]; float* ptr[4];
#pragma unroll
                for (int q = 0; q < 4; ++q) {
                    const int cid = scan_chunk(b, d, st + q);
                    ptr[q] = U + ((size_t)(cid * 2 + d) * 4 + h) * 8192 + dk * 128 + dv4 * 4;
                    u[q] = *(const f32x4*)ptr[q];
                    dc[q] = DEC[(size_t)(cid * 2 + d) * 256 + h * 64 + dk];
                }
#pragma unroll
                for (int q = 0; q < 4; ++q) { *(f32x4*)ptr[q] = S; S = S * dc[q] + u[q]; }
            }
        } else {
            const int i2 = idx - 65536, c = i2 & 511, d = (i2 >> 9) & 1, b = i2 >> 10;
            float hs = 0.f;
            for (int st = 0; st < 132; st += 4) {
                float a[4], hh[4]; float* ptr[4];
#pragma unroll
                for (int q = 0; q < 4; ++q) {
                    const int cid = scan_chunk(b, d, st + q);
                    ptr[q] = AGGH + (size_t)(cid * 2 + d) * 512 + c;
                    hh[q] = *ptr[q]; a[q] = AGGA[(size_t)(cid * 2 + d) * 512 + c];
                }
#pragma unroll
                for (int q = 0; q < 4; ++q) { *ptr[q] = hs; hs = a[q] * hs + hh[q]; }
            }
        }
    }
}

DI void phase_g3(PP p, lds_t lds) {
    const int tid = get_tid(), lane = tid & 63, w = tid >> 6;
    const bf16_t* P = (const bf16_t*)(p->ws + OFF_ARENA + A_P);
    const float* U = (const float*)(p->ws + OFF_ARENA + A_U);
    const float* LA = (const float*)(p->ws + OFF_ARENA + A_LA);
    const bf16_t* UU = (const bf16_t*)(p->ws + OFF_ARENA + A_UU);
    const float* HST = (const float*)(p->ws + OFF_ARENA + A_AGGH);
    bf16_t* act = (bf16_t*)(p->ws + OFF_ACT);
    constexpr int NGLA = NCH * 4;
    for (int task = get_bid(); task < NGLA + NCH; task += gridDim.x) {
        if (task < NGLA) {
            const int ch = task >> 2, h = task & 3, r0 = ch * 64;
            LAS float* lrt = (LAS float*)lds;
            LAS float* wat = lrt + 2048;
            LAS float* bat = wat + 2048;
            LAS float* bc = bat + 128;
            LAS bf16_t* qt = (LAS bf16_t*)(bc + 4096);
            LAS bf16_t* kt = qt + 64 * 72;
            LAS bf16_t* qtd = kt + 64 * 72;
            LAS bf16_t* ktd = qtd + 64 * 72;
            LAS bf16_t* at = ktd + 64 * 72;
            LAS bf16_t* vt = at + 64 * 72;
            LAS bf16_t* St = vt + 64 * 136;
            LAS float* ot = (LAS float*)(St + 64 * 136);
            gla_load_decay_inputs(p, P, r0, h, lrt, wat, bat);
            { const int row = tid >> 3, chunk = tid & 7;
              *(LAS u32x4*)(qt + row * 72 + chunk * 8) = *(const u32x4*)(P + (size_t)(r0 + row) * ABIN + PC_Q + h * 64 + chunk * 8);
              *(LAS u32x4*)(kt + row * 72 + chunk * 8) = *(const u32x4*)(P + (size_t)(r0 + row) * ABIN + PC_K + h * 64 + chunk * 8); }
#pragma unroll
            for (int q = 0; q < 2; ++q) { const int i = tid + 512 * q, row = i >> 4, chunk = i & 15; *(LAS u32x4*)(vt + row * 136 + chunk * 8) = *(const u32x4*)(P + (size_t)(r0 + row) * ABIN + PC_V + h * 128 + chunk * 8); }
            __syncthreads();
            f32x4 oacc[4];
#pragma unroll
            for (int i = 0; i < 4; ++i) oacc[i] = (f32x4){0.f, 0.f, 0.f, 0.f};
            const int ott = w & 3, odv0 = (w >> 2) * 4;
            for (int d = 0; d < 2; ++d) {
                gla_bcum(bc, lrt + d * 1024, wat + d * 1024, bat + d * 64, d);
                {
                    const int t = tid >> 3, c8 = (tid & 7) * 8;
                    float qo[8], ko[8];
#pragma unroll
                    for (int j = 0; j < 8; ++j) { const float e = __expf(bc[t * 64 + c8 + j]); qo[j] = bf2f(qt[t * 72 + c8 + j]) * 0.125f * e; ko[j] = bf2f(kt[t * 72 + c8 + j]) / e; }
                    u32x4 v; v.x = pk2(qo[0], qo[1]); v.y = pk2(qo[2], qo[3]); v.z = pk2(qo[4], qo[5]); v.w = pk2(qo[6], qo[7]);
                    *(LAS u32x4*)(qtd + t * 72 + c8) = v;
                    v.x = pk2(ko[0], ko[1]); v.y = pk2(ko[2], ko[3]); v.z = pk2(ko[4], ko[5]); v.w = pk2(ko[6], ko[7]);
                    *(LAS u32x4*)(ktd + t * 72 + c8) = v;
                    const int dk = tid >> 3, dv16 = (tid & 7) * 16;
                    const float* src = U + ((size_t)(ch * 2 + d) * 4 + h) * 8192 + dk * 128 + dv16;
                    const f32x4 s0 = *(const f32x4*)src, s1 = *(const f32x4*)(src + 4), s2 = *(const f32x4*)(src + 8), s3 = *(const f32x4*)(src + 12);
                    v.x = pk2(s0[0], s0[1]); v.y = pk2(s0[2], s0[3]); v.z = pk2(s1[0], s1[1]); v.w = pk2(s1[2], s1[3]);
                    *(LAS u32x4*)(St + dk * 136 + dv16) = v;
                    v.x = pk2(s2[0], s2[1]); v.y = pk2(s2[2], s2[3]); v.z = pk2(s3[0], s3[1]); v.w = pk2(s3[2], s3[3]);
                    *(LAS u32x4*)(St + dk * 136 + dv16 + 8) = v;
                }
                __syncthreads();
                {
                    const int tt = w >> 1;
#pragma unroll
                    for (int e = 0; e < 2; ++e) {
                        const int st = (w & 1) * 2 + e;
                        f32x4 acc = {0.f, 0.f, 0.f, 0.f};
#pragma unroll
                        for (int ks = 0; ks < 2; ++ks) acc = mfma16(frag_row(ktd, 72, st * 16, ks * 32, lane), frag_row(qtd, 72, tt * 16, ks * 32, lane), acc);
                        const int t = tt * 16 + (lane & 15), s0 = st * 16 + 4 * (lane >> 4);
                        float a[4];
#pragma unroll
                        for (int j = 0; j < 4; ++j) { const int s = s0 + j; a[j] = (d == 0 ? s <= t : s >= t) ? acc[j] : 0.f; }
                        u32x2 v; v.x = pk2(a[0], a[1]); v.y = pk2(a[2], a[3]);
                        *(LAS u32x2*)(at + t * 72 + s0) = v;
                    }
                }
                __syncthreads();
                {
                    bf16x8 af[2], qf[2];
#pragma unroll
                    for (int ks = 0; ks < 2; ++ks) { af[ks] = frag_row(at, 72, ott * 16, ks * 32, lane); qf[ks] = frag_row(qtd, 72, ott * 16, ks * 32, lane); }
#pragma unroll
                    for (int i = 0; i < 4; ++i) {
                        const int dvt = odv0 + i;
#pragma unroll
                        for (int ks = 0; ks < 2; ++ks) {
                            oacc[i] = mfma16(frag_tr(vt, 136, ks * 32, dvt * 16, lane), af[ks], oacc[i]);
                            oacc[i] = mfma16(frag_tr(St, 136, ks * 32, dvt * 16, lane), qf[ks], oacc[i]);
                        }
                    }
                }
                __syncthreads();
            }
#pragma unroll
            for (int i = 0; i < 4; ++i) *(LAS f32x4*)(ot + (ott * 16 + (lane & 15)) * 132 + (odv0 + i) * 16 + 4 * (lane >> 4)) = oacc[i];
            __syncthreads();
            {
                const int t = tid >> 3, dv16 = (tid & 7) * 16;
                float o[16]; float ss = 0.f;
#pragma unroll
                for (int j = 0; j < 16; ++j) { o[j] = ot[t * 132 + dv16 + j]; ss += o[j] * o[j]; }
                ss += __shfl_xor(ss, 1); ss += __shfl_xor(ss, 2); ss += __shfl_xor(ss, 4);
                const float rs = rsqrtf(ss * (1.f / 128.f) + EPS);
                const bf16_t* gp = P + (size_t)(r0 + t) * ABIN + PC_G + h * 128 + dv16;
                const u32x4 g0 = *(const u32x4*)gp, g1 = *(const u32x4*)(gp + 8);
                const unsigned gw[8] = {g0.x, g0.y, g0.z, g0.w, g1.x, g1.y, g1.z, g1.w};
                float r[16];
#pragma unroll
                for (int j = 0; j < 8; ++j) {
                    r[2 * j] = o[2 * j] * rs * p->gla_norm_g[h * 128 + dv16 + 2 * j] * siluf_(lo_bf(gw[j]));
                    r[2 * j + 1] = o[2 * j + 1] * rs * p->gla_norm_g[h * 128 + dv16 + 2 * j + 1] * siluf_(hi_bf(gw[j]));
                }
                bf16_t* dst = act + (size_t)(r0 + t) * 1024 + h * 128 + dv16;
                u32x4 v; v.x = pk2(r[0], r[1]); v.y = pk2(r[2], r[3]); v.z = pk2(r[4], r[5]); v.w = pk2(r[6], r[7]);
                *(u32x4*)dst = v;
                v.x = pk2(r[8], r[9]); v.y = pk2(r[10], r[11]); v.z = pk2(r[12], r[13]); v.w = pk2(r[14], r[15]);
                *(u32x4*)(dst + 8) = v;
            }
            __syncthreads();
        } else {
            const int ch = task - NGLA, r0 = ch * 64, c = tid;
            LAS float* hf = (LAS float*)lds;
            float hs = HST[(size_t)(ch * 2 + 0) * 512 + c];
            for (int t = 0; t < 64; ++t) {
                const size_t o = ((size_t)(r0 + t) * 2 + 0) * 512 + c;
                hs = __expf(LA[o]) * hs + bf2f(UU[o]);
                hf[t * 512 + c] = hs;
            }
            hs = HST[(size_t)(ch * 2 + 1) * 512 + c];
            for (int t = 63; t >= 0; --t) {
                const size_t o = ((size_t)(r0 + t) * 2 + 1) * 512 + c;
                hs = __expf(LA[o]) * hs + bf2f(UU[o]);
                const float g = bf2f(P[(size_t)(r0 + t) * ABIN + PC_RGG + c]);
                act[(size_t)(r0 + t) * 1024 + 512 + c] = f2bf((hf[t * 512 + c] + hs) * gelu_tanh(g));
            }
            __syncthreads();
        }
    }
}


DI void phase_outproj0(PP p, lds_t lds) {
    const bf16_t* act = (const bf16_t*)(p->ws + OFF_ACT);
    float* X = (float*)(p->ws + OFF_ARENA + A_X);
    constexpr int NM = NTOK / 256, NN = 4;
    for (int u = get_bid(); u < NM * NN; u += gridDim.x) {
        const int pn = u / NM, pm = u % NM;
        const int set = row_set(pm * 256);
        const float* g1 = mods_ptr(p, 0, set, 2);
        const float* xin = pm * 256 < NLAT ? p->x + (size_t)pm * 256 * 1024 : p->ctx + (size_t)(pm * 256 - NLAT) * 1024;
        gemm_unit<256>(lds, 1024, 1024,
            [&](int r) { return act + (size_t)(pm * 256 + r) * 1024; },
            [&](int j) -> const float* { return p->ab_w_out + pn * 256 + j; },
            [&](const f32x4 (&acc)[8][4], int wr, int wc, int lane) {
                epi_each<4>(acc, wr, wc, lane, [&](int r, int c, f32x4 v) {
                    const int col = pn * 256 + c;
                    const f32x4 xi = *(const f32x4*)(xin + (size_t)r * 1024 + col), g = *(const f32x4*)(g1 + col);
                    *(f32x4*)(X + (size_t)(pm * 256 + r) * 1024 + col) = xi + g * v;
                });
            });
    }
}

struct MoeBufs { float* PT; float* PE; int* ROWID; int* ROWTOK; bf16_t* HDN; bf16_t* Y; int rpe; int nrows; };
DI MoeBufs moe_bufs(PP p, int layer) {
    MoeBufs m;
    char* a = p->ws + OFF_ARENA;
    if (layer == 0) { m.PT = (float*)(a + A_PT); m.PE = (float*)(a + A_PE); m.ROWID = (int*)(a + A_ROWID); m.ROWTOK = (int*)(a + A_ROWTOK); m.HDN = (bf16_t*)(a + A_HDN); m.Y = (bf16_t*)(a + A_Y); m.rpe = 4352; m.nrows = NTOK; }
    else { m.PT = (float*)(a + A_HB); m.PE = (float*)(a + A_HB + (size_t)NTOK * 64); m.ROWID = (int*)(a + A_HB + (size_t)NTOK * 128); m.ROWTOK = (int*)(a + A_HB + (size_t)NTOK * 192); m.HDN = (bf16_t*)(a + A_XM); m.Y = (bf16_t*)(a + A_XC); m.rpe = 4096; m.nrows = NLAT; }
    return m;
}

DI void phase_router(PP p, lds_t lds, int layer) {
    const int tid = get_tid(), lane = tid & 63;
    const MoeBufs m = moe_bufs(p, layer);
    const float* X = (const float*)(p->ws + OFF_ARENA + A_X);
    bf16_t* act = (bf16_t*)(p->ws + OFF_ACT);
    LAS float* rwT = (LAS float*)lds;
    for (int i = tid; i < 16384; i += NTHREADS) { const int k = i >> 4, e = i & 15; rwT[e * 1024 + k] = p->router_w[(size_t)layer * 16384 + i]; }
    __syncthreads();
    const int gw = get_bid() * 8 + (tid >> 6), nw = gridDim.x * 8;
    for (int r = gw; r < m.nrows; r += nw) {
        f32x4 v[4];
        row_load_f32(X + (size_t)r * 1024, v, lane);
        const float rs = rsqrtf(row_sumsq(v) * (1.f / 1024.f) + EPS);
        const int set = row_set(r);
        row_modulate(v, rs, p->norm2_g + layer * 1024, mods_ptr(p, layer, set, 4), mods_ptr(p, layer, set, 3), lane);
        row_store_bf16(act + (size_t)r * 1024, v, lane);
        float lg[16];
#pragma unroll
        for (int e = 0; e < 16; ++e) {
            float a = 0.f;
#pragma unroll
            for (int i = 0; i < 4; ++i) { const f32x4 wv = *(const LAS f32x4*)(rwT + e * 1024 + 4 * lane + 256 * i); a += v[i][0] * wv[0] + v[i][1] * wv[1] + v[i][2] * wv[2] + v[i][3] * wv[3]; }
            lg[e] = wave_sum(a);
            asm volatile("" ::: "memory");
        }
        float mx = lg[0];
#pragma unroll
        for (int e = 1; e < 16; ++e) mx = fmaxf(mx, lg[e]);
        float sum = 0.f;
#pragma unroll
        for (int e = 0; e < 16; ++e) { lg[e] = __expf(lg[e] - mx); sum += lg[e]; }
        const float inv = 1.f / sum;
        float mine = 0.f;
#pragma unroll
        for (int e = 0; e < 16; ++e) if (lane == e) mine = lg[e] * inv;
        if (lane < 16) {
            m.PT[(size_t)r * 16 + lane] = mine;
            if (r < NLAT) m.PE[((size_t)(r >> 13) * 16 + lane) * 8192 + (r & 8191)] = mine;
            else { const int rc = r - NLAT; m.PE[(size_t)NBATCH * 16 * 8192 + ((size_t)(rc >> 8) * 16 + lane) * 256 + (rc & 255)] = mine; }
        }
    }
}

DI int block_excl_scan(int v, LAS int* tmp, int* total) {
    const int tid = get_tid(), lane = tid & 63, w = tid >> 6;
    int inc = v;
#pragma unroll
    for (int o = 1; o < 64; o <<= 1) { const int t = __shfl_up(inc, o); if (lane >= o) inc += t; }
    __syncthreads();
    if (lane == 63) tmp[w] = inc;
    __syncthreads();
    int base = 0, tot = 0;
#pragma unroll
    for (int i = 0; i < 8; ++i) { const int t = tmp[i]; if (i < w) base += t; tot += t; }
    *total = tot;
    return base + inc - v;
}

DI void phase_topk(PP p, lds_t lds, int layer) {
    const int tid = get_tid();
    const MoeBufs m = moe_bufs(p, layer);
    LAS unsigned* keys = (LAS unsigned*)lds;
    LAS int* hist = (LAS int*)(keys + 8192);
    LAS int* tmp = hist + 256;
    LAS int* sel = tmp + 16;
    const int ntask = layer == 0 ? 128 : 64;
    for (int task = get_bid(); task < ntask; task += gridDim.x) {
        const bool isctx = task >= 64;
        const int b = (task & 63) >> 4, e = task & 15;
        const int n = isctx ? 256 : 8192, cap = isctx ? 32 : 1024;
        const float* src = isctx ? m.PE + (size_t)NBATCH * 16 * 8192 + ((size_t)b * 16 + e) * 256 : m.PE + ((size_t)b * 16 + e) * 8192;
        for (int i = tid; i < n; i += NTHREADS) keys[i] = __float_as_uint(src[i]);
        __syncthreads();
        unsigned prefix = 0u, mask = 0u; int kk = cap;
        for (int pass = 3; pass >= 0; --pass) {
            const int shift = pass * 8;
            if (tid < 256) hist[tid] = 0;
            __syncthreads();
            for (int i = tid; i < n; i += NTHREADS) { const unsigned k = keys[i]; if ((k & mask) == prefix) __hip_atomic_fetch_add((int*)(hist + ((k >> shift) & 255)), 1, __ATOMIC_RELAXED, __HIP_MEMORY_SCOPE_WORKGROUP); }
            __syncthreads();
            if (tid < 256) {
                int above = 0;
                for (int j = tid + 1; j < 256; ++j) above += hist[j];
                const int mineh = hist[tid];
                if (above < kk && kk <= above + mineh) { sel[0] = tid; sel[1] = above; }
            }
            __syncthreads();
            prefix |= (unsigned)sel[0] << shift; mask |= 0xffu << shift; kk -= sel[1];
            __syncthreads();
        }
        const unsigned T = prefix; const int need_eq = kk;
        const int ipt = n / NTHREADS > 0 ? n / NTHREADS : 1;
        const int i0 = tid * ipt;
        int cgt = 0, ceq = 0;
        if (i0 < n) for (int j = 0; j < ipt; ++j) { const unsigned k = keys[i0 + j]; cgt += k > T; ceq += k == T; }
        int tot;
        const int egt = block_excl_scan(cgt, tmp, &tot);
        const int eeq = block_excl_scan(ceq, tmp, &tot);
        const int slot0 = e * m.rpe + (isctx ? 4096 + b * 32 : b * 1024);
        const int row0 = isctx ? NLAT + b * 256 : b * 8192;
        if (i0 < n) {
            int ngt = egt, neq = eeq;
            for (int j = 0; j < ipt; ++j) {
                const unsigned k = keys[i0 + j];
                int slot = -1;
                if (k > T) { slot = slot0 + ngt + (neq < need_eq ? neq : need_eq); ++ngt; }
                else if (k == T) { if (neq < need_eq) slot = slot0 + ngt + neq; ++neq; }
                m.ROWID[(size_t)(row0 + i0 + j) * 16 + e] = slot;
                if (slot >= 0) m.ROWTOK[slot] = row0 + i0 + j;
            }
        }
        if (isctx && b == 0 && layer == 0) for (int i = tid; i < 128; i += NTHREADS) m.ROWTOK[e * m.rpe + 4224 + i] = -1;
        __syncthreads();
    }
}

DI void phase_moe_up(PP p, lds_t lds, int layer) {
    const MoeBufs m = moe_bufs(p, layer);
    const bf16_t* act = (const bf16_t*)(p->ws + OFF_ACT);
    const int nmt = layer == 0 ? 17 : 16;
    const int nunits = 16 * nmt * 8;
    for (int u = get_bid(); u < nunits; u += gridDim.x) {
        const int e = u / (nmt * 8), rem = u % (nmt * 8), nt = rem / nmt, mt = rem % nmt;
        const float* Wg = p->exp_w_gate + ((size_t)layer * 16 + e) * 1048576;
        const float* Wu = p->exp_w_up + ((size_t)layer * 16 + e) * 1048576;
        const int* rt = m.ROWTOK + e * m.rpe + mt * 256;
        bf16_t* H = m.HDN + ((size_t)e * m.rpe + mt * 256) * 1024 + nt * 128;
        gemm_unit<256>(lds, 1024, 1024,
            [&](int r) -> const bf16_t* { const int tok = rt[r]; return tok >= 0 ? act + (size_t)tok * 1024 : nullptr; },
            [&](int j) -> const float* { const int wcq = j >> 6, within = j & 63; const int hc = nt * 128 + wcq * 32 + (within & 31); return (within < 32 ? Wg : Wu) + hc; },
            [&](const f32x4 (&acc)[8][4], int wr, int wc, int lane) {
#pragma unroll
                for (int mi = 0; mi < 8; ++mi)
#pragma unroll
                    for (int ni = 0; ni < 2; ++ni) {
                        const f32x4 g = acc[mi][ni], uu = acc[mi][ni + 2];
                        f32x4 h;
#pragma unroll
                        for (int j = 0; j < 4; ++j) h[j] = siluf_(g[j]) * uu[j];
                        store_bf16x4(H + (size_t)(wr * 128 + mi * 16 + (lane & 15)) * 1024 + wc * 32 + ni * 16 + 4 * (lane >> 4), h);
                    }
            });
    }
}

DI void phase_moe_down(PP p, lds_t lds, int layer) {
    const MoeBufs m = moe_bufs(p, layer);
    const int nmt = layer == 0 ? 17 : 16;
    const int nunits = 16 * nmt * 4;
    for (int u = get_bid(); u < nunits; u += gridDim.x) {
        const int e = u / (nmt * 4), rem = u % (nmt * 4), nt = rem / nmt, mt = rem % nmt;
        const float* Wd = p->exp_w_down + ((size_t)layer * 16 + e) * 1048576;
        const bf16_t* H = m.HDN + ((size_t)e * m.rpe + mt * 256) * 1024;
        bf16_t* Y = m.Y + ((size_t)e * m.rpe + mt * 256) * 1024 + nt * 256;
        gemm_unit<256>(lds, 1024, 1024,
            [&](int r) { return H + (size_t)r * 1024; },
            [&](int j) -> const float* { return Wd + nt * 256 + j; },
            [&](const f32x4 (&acc)[8][4], int wr, int wc, int lane) {
                epi_each<4>(acc, wr, wc, lane, [&](int r, int c, f32x4 v) { store_bf16x4(Y + (size_t)r * 1024 + c, v); });
            });
    }
}

DI void phase_combine(PP p, int layer) {
    const int tid = get_tid(), lane = tid & 63;
    const MoeBufs m = moe_bufs(p, layer);
    float* X = (float*)(p->ws + OFF_ARENA + A_X);
    bf16_t* act = (bf16_t*)(p->ws + OFF_ACT);
    const int gw = get_bid() * 8 + (tid >> 6), nw = gridDim.x * 8;
    for (int r = gw; r < m.nrows; r += nw) {
        f32x4 v[4], a[4];
        row_load_f32(X + (size_t)r * 1024, v, lane);
#pragma unroll
        for (int i = 0; i < 4; ++i) a[i] = (f32x4){0.f, 0.f, 0.f, 0.f};
        for (int e = 0; e < 16; ++e) {
            const int rid = m.ROWID[(size_t)r * 16 + e];
            if (rid >= 0) {
                const float pe = m.PT[(size_t)r * 16 + e];
                const bf16_t* y = m.Y + (size_t)rid * 1024;
#pragma unroll
                for (int i = 0; i < 4; ++i) { const u32x2 yy = *(const u32x2*)(y + 4 * lane + 256 * i); a[i][0] += pe * lo_bf(yy.x); a[i][1] += pe * hi_bf(yy.x); a[i][2] += pe * lo_bf(yy.y); a[i][3] += pe * hi_bf(yy.y); }
            }
        }
        const int set = row_set(r);
        const float* g2 = mods_ptr(p, layer, set, 5);
#pragma unroll
        for (int i = 0; i < 4; ++i) { const f32x4 g = *(const f32x4*)(g2 + 4 * lane + 256 * i); v[i] = v[i] + g * a[i]; }
        const float rs = rsqrtf(row_sumsq(v) * (1.f / 1024.f) + EPS);
        if (layer == 0) {
#pragma unroll
            for (int i = 0; i < 4; ++i) *(f32x4*)(X + (size_t)r * 1024 + 4 * lane + 256 * i) = v[i];
            row_modulate(v, rs, p->norm1_g + 1024, mods_ptr(p, 1, set, 1), mods_ptr(p, 1, set, 0), lane);
            row_store_bf16(act + (size_t)r * 1024, v, lane);
        } else {
#pragma unroll
            for (int i = 0; i < 4; ++i) { const f32x4 g = *(const f32x4*)(p->final_g + 4 * lane + 256 * i); *(f32x4*)(p->out + (size_t)r * 1024 + 4 * lane + 256 * i) = v[i] * rs * g; }
        }
    }
}


DI void phase_upproj(PP p, lds_t lds, int half) {
    const bf16_t* act = (const bf16_t*)(p->ws + OFF_ACT);
    bf16_t* O = (bf16_t*)(p->ws + OFF_ARENA + A_XM);
    const int NM = half == 0 ? NTOK / 256 : NLAT / 256, NN = 8;
    for (int u = get_bid(); u < NM * NN; u += gridDim.x) {
        const int pn = u / NM, pm = u % NM;
        gemm_unit<256>(lds, 1024, 4096,
            [&](int r) { return act + (size_t)(pm * 256 + r) * 1024; },
            [&](int j) -> const float* { return p->m_w_up + half * 2048 + pn * 256 + j; },
            [&](const f32x4 (&acc)[8][4], int wr, int wc, int lane) {
                epi_each<4>(acc, wr, wc, lane, [&](int r, int c, f32x4 v) { store_bf16x4(O + (size_t)(pm * 256 + r) * 2048 + pn * 256 + c, v); });
            });
    }
}

DI void phase_mfeat(PP p, lds_t lds) {
    const int tid = get_tid(), lane = tid & 63, w = tid >> 6;
    bf16_t* XM = (bf16_t*)(p->ws + OFF_ARENA + A_XM);
    bf16_t* XC = (bf16_t*)(p->ws + OFF_ARENA + A_XC);
    bf16_t* CTXV = (bf16_t*)(p->ws + OFF_ACT + ACT_CTXV);
    bf16_t* RAWS = (bf16_t*)(p->ws + OFF_ACT + ACT_RAWS);
    float* GP = (float*)(p->ws + OFF_ACT + ACT_GP);
    const bf16_t* GC = (const bf16_t*)(p->ws + OFF_GCAT);
    const float* MM = (const float*)(p->ws + OFF_MMAT);
    LAS bf16_t* xin = (LAS bf16_t*)lds;
    LAS bf16_t* xct = xin + 67 * 136;
    LAS bf16_t* qpt = xct + 64 * 136;
    LAS bf16_t* gxc = qpt + 64 * 136;
    LAS bf16_t* gxm = gxc + 128 * 16;
    LAS float* mq = (LAS float*)(gxm + 128 * 16);
    LAS float* wvq = mq + 512;
    LAS float* cw = wvq + 512;
    LAS float* gred = cw + 640;
    for (int task = get_bid(); task < NCH * 4; task += gridDim.x) {
        const int ch = task >> 2, h = task & 3, r0 = ch * 64;
        const int seg_lo = ch < NCHL ? r0 : NLAT + ((r0 - NLAT) >> 8) * 256, seg_hi = ch < NCHL ? r0 + 64 : seg_lo + 256;
        f32x4 rs_acc[2] = {{0.f, 0.f, 0.f, 0.f}, {0.f, 0.f, 0.f, 0.f}};
        f32x4 g_acc = {0.f, 0.f, 0.f, 0.f};
        for (int q4 = 0; q4 < 4; ++q4) {
            const int col0 = h * 512 + q4 * 128;
            for (int i = tid; i < 67 * 16; i += NTHREADS) {
                const int row = i >> 4, chunk = i & 15, r = r0 - 2 + row;
                u32x4 v = {0u, 0u, 0u, 0u};
                if (r >= seg_lo && r < seg_hi) v = *(const u32x4*)(XM + (size_t)r * 2048 + col0 + chunk * 8);
                *(LAS u32x4*)(xin + row * 136 + chunk * 8) = v;
            }
            if (tid < 256) *(LAS u32x4*)(gxc + tid * 8) = *(const u32x4*)(GC + (size_t)col0 * 16 + tid * 8);
            else *(LAS u32x4*)(gxm + (tid - 256) * 8) = *(const u32x4*)(GC + (size_t)(2048 + col0) * 16 + (tid - 256) * 8);
            mq[tid] = bf2f(f2bf(MM[(size_t)(col0 >> 2) * 16 + tid]));
            wvq[tid] = p->m_wv[(size_t)(col0 >> 2) * 16 + tid];
            for (int i = tid; i < 640; i += NTHREADS) cw[i] = i < 512 ? p->m_conv_w[(size_t)(i >> 7) * 2048 + col0 + (i & 127)] : p->m_conv_b[col0 + i - 512];
            __syncthreads();
            {
                const int t = tid >> 3, c16 = (tid & 7) * 16;
                float xc[16], xm[16];
#pragma unroll
                for (int j = 0; j < 16; ++j) { xc[j] = cw[512 + c16 + j]; xm[j] = bf2f(xin[(t + 2) * 136 + c16 + j]); }
#pragma unroll
                for (int tap = 0; tap < 4; ++tap)
#pragma unroll
                    for (int j = 0; j < 16; ++j) xc[j] += cw[tap * 128 + c16 + j] * bf2f(xin[(t + tap) * 136 + c16 + j]);
                unsigned xcp[8];
#pragma unroll
                for (int j = 0; j < 8; ++j) { xcp[j] = pk2(siluf_(xc[2 * j]), siluf_(xc[2 * j + 1])); xc[2 * j] = lo_bf(xcp[j]); xc[2 * j + 1] = hi_bf(xcp[j]); }
                float vv[16], qp[16];
#pragma unroll
                for (int n = 0; n < 4; ++n) {
                    const int nb = (c16 >> 2) + n;
#pragma unroll
                    for (int o = 0; o < 4; ++o) {
                        float a = 0.f, b = 0.f;
#pragma unroll
                        for (int i = 0; i < 4; ++i) { a += xm[4 * n + i] * wvq[nb * 16 + i * 4 + o]; b += xc[4 * n + i] * mq[nb * 16 + i * 4 + o]; }
                        vv[4 * n + o] = a; qp[4 * n + o] = b;
                    }
                }
                u32x4 v0, v1;
                v0.x = xcp[0]; v0.y = xcp[1]; v0.z = xcp[2]; v0.w = xcp[3]; v1.x = xcp[4]; v1.y = xcp[5]; v1.z = xcp[6]; v1.w = xcp[7];
                *(LAS u32x4*)(xct + t * 136 + c16) = v0; *(LAS u32x4*)(xct + t * 136 + c16 + 8) = v1;
                bf16_t* xcg = XC + (size_t)(r0 + t) * 2048 + col0 + c16;
                *(u32x4*)xcg = v0; *(u32x4*)(xcg + 8) = v1;
                v0.x = pk2(qp[0], qp[1]); v0.y = pk2(qp[2], qp[3]); v0.z = pk2(qp[4], qp[5]); v0.w = pk2(qp[6], qp[7]);
                v1.x = pk2(qp[8], qp[9]); v1.y = pk2(qp[10], qp[11]); v1.z = pk2(qp[12], qp[13]); v1.w = pk2(qp[14], qp[15]);
                *(LAS u32x4*)(qpt + t * 136 + c16) = v0; *(LAS u32x4*)(qpt + t * 136 + c16 + 8) = v1;
                v0.x = pk2(vv[0], vv[1]); v0.y = pk2(vv[2], vv[3]); v0.z = pk2(vv[4], vv[5]); v0.w = pk2(vv[6], vv[7]);
                v1.x = pk2(vv[8], vv[9]); v1.y = pk2(vv[10], vv[11]); v1.z = pk2(vv[12], vv[13]); v1.w = pk2(vv[14], vv[15]);
                bf16_t* vg = ch < NCHL ? XM + (size_t)(r0 + t) * 2048 + col0 + c16 : CTXV + (size_t)(r0 + t - NLAT) * 2048 + col0 + c16;
                *(u32x4*)vg = v0; *(u32x4*)(vg + 8) = v1;
            }
            __syncthreads();
            {
                const int tt = w >> 1;
#pragma unroll
                for (int e = 0; e < 2; ++e) {
                    const int st = (w & 1) * 2 + e;
#pragma unroll
                    for (int ks = 0; ks < 4; ++ks) rs_acc[e] = mfma16(frag_row(xct, 136, st * 16, ks * 32, lane), frag_row(qpt, 136, tt * 16, ks * 32, lane), rs_acc[e]);
                }
                const int gt = w & 3, src = w >> 2;
                const LAS bf16_t* gm = src ? gxm : gxc;
                const LAS bf16_t* ft = src ? xin + 2 * 136 : xct;
#pragma unroll
                for (int ks = 0; ks < 4; ++ks) g_acc = mfma16(frag_tr(gm, 16, ks * 32, 0, lane), frag_row(ft, 136, gt * 16, ks * 32, lane), g_acc);
            }
            __syncthreads();
        }
        {
            const int tt = w >> 1;
#pragma unroll
            for (int e = 0; e < 2; ++e) {
                const int st = (w & 1) * 2 + e;
                store_bf16x4(RAWS + ((size_t)task * 64 + tt * 16 + (lane & 15)) * 64 + st * 16 + 4 * (lane >> 4), rs_acc[e]);
            }
            const int gt = w & 3, src = w >> 2;
            *(LAS f32x4*)(gred + (src * 64 + gt * 16 + (lane & 15)) * 16 + 4 * (lane >> 4)) = g_acc;
        }
        __syncthreads();
        if (tid < 256) {
            const int t = tid >> 2, q = tid & 3;
            const f32x4 a = *(const LAS f32x4*)(gred + t * 16 + q * 4), b = *(const LAS f32x4*)(gred + (64 + t) * 16 + q * 4);
            *(f32x4*)(GP + ((size_t)(r0 + t) * 4 + h) * 16 + q * 4) = a + b;
        }
        __syncthreads();
    }
}

constexpr int MS_KLD = 1056, MS_QLD = 1040;
DI void phase_mscan(PP p, lds_t lds) {
    const int tid = get_tid(), lane = tid & 63, w = tid >> 6, bid = get_bid();
    if (bid >= 256) return;
    const int grp = bid & 31, sl = bid >> 5, b = grp >> 3, h = (grp >> 1) & 3, d = grp & 1;
    const bf16_t* XC = (const bf16_t*)(p->ws + OFF_ARENA + A_XC);
    const bf16_t* V = (const bf16_t*)(p->ws + OFF_ARENA + A_XM);
    const bf16_t* CTXV = (const bf16_t*)(p->ws + OFF_ACT + ACT_CTXV);
    const bf16_t* RAWS = (const bf16_t*)(p->ws + OFF_ACT + ACT_RAWS);
    const float* GP = (const float*)(p->ws + OFF_ACT + ACT_GP);
    bf16_t* H = d == 0 ? (bf16_t*)p->out : (bf16_t*)(p->ws + OFF_ARENA + A_HB);
    #define MS_REGIONS(L) \
    lds_t xct = (L); \
    lds_t qpt = (L) + 64 * MS_KLD; \
    LAS bf16_t* vt = (LAS bf16_t*)((L) + 64 * MS_KLD + 64 * MS_QLD); \
    LAS bf16_t* St = vt + 4096; \
    LAS bf16_t* vwt = St + 4096; \
    LAS float* sc_b = (LAS float*)(vwt + 4096); \
    LAS float* sc_m = sc_b + 64; LAS float* sc_li = sc_m + 64; LAS float* sc_w = sc_li + 64; LAS float* sc_di = sc_w + 64; LAS float* sc_dn = sc_di + 64; \
    LAS float* sc_misc = sc_dn + 64; \
    LAS float* qn = sc_misc + 8; \
    LAS float* nvec = qn + 64; \
    LAS float* red = (LAS float*)qpt; \
    LAS bf16_t* otile = (LAS bf16_t*)(qpt + 16384); \
    LAS float* npart = (LAS float*)(qpt + 24576); \
    ;
    static_assert(64 * MS_KLD + 64 * MS_QLD + 3 * 8192 + (6 * 64 + 8 + 64 + 512) * 4 <= LDS_BYTES, "mscan lds");
    const int c16 = tid & 63;
    bf16x2_t Mp[2][4][2];
#pragma unroll
    for (int n = 0; n < 2; ++n) {
        const float* mm = (const float*)(p->ws + OFF_MMAT) + (size_t)(h * 128 + 2 * c16 + n) * 16;
#pragma unroll
        for (int o = 0; o < 4; ++o) { Mp[n][o][0] = __builtin_bit_cast(bf16x2_t, pk2(mm[o], mm[4 + o])); Mp[n][o][1] = __builtin_bit_cast(bf16x2_t, pk2(mm[8 + o], mm[12 + o])); }
    }
    const float bias_i = p->m_b_gates[d * 8 + h], bias_f = p->m_b_gates[d * 8 + 4 + h];
    f32x4 C[16];
#pragma unroll
    for (int i = 0; i < 16; ++i) C[i] = (f32x4){0.f, 0.f, 0.f, 0.f};
    { MS_REGIONS(lds) nvec[tid] = 0.f; (void)xct; (void)qpt; (void)vt; (void)St; (void)vwt; (void)sc_b; (void)red; (void)otile; (void)npart; (void)qn; }
    float m_prev = 0.f;
    u32x4 xcr[8], vr, rr; float gli = 0.f, gf = 0.f;
    auto prefetch = [&](int st) {
        int tp = get_tid();
        const int tid = tp, lane = tid & 63, w = tid >> 6;
        const int cid = scan_chunk(b, d, st), r0 = cid * 64;
        const bf16_t* xp = XC + (size_t)(r0 + (tid >> 6)) * 2048 + h * 512 + (tid & 63) * 8;
#pragma unroll
        for (int i = 0; i < 8; ++i) xcr[i] = *(const u32x4*)(xp + (size_t)i * 8 * 2048);
        { const int s_ = tid >> 3, chunk = tid & 7;
          vr = cid < NCHL ? *(const u32x4*)(V + (size_t)(r0 + s_) * 2048 + h * 512 + sl * 64 + chunk * 8) : *(const u32x4*)(CTXV + (size_t)(r0 + s_ - NLAT) * 2048 + h * 512 + sl * 64 + chunk * 8);
          rr = *(const u32x4*)(RAWS + ((size_t)(cid * 4 + h) * 64 + s_) * 64 + chunk * 8); }
        if (w == 0) {
            const int t = d ? 63 - lane : lane;
            const float* gp = GP + (size_t)(r0 + t) * 64;
            gli = gp[d * 8 + h] + gp[16 + d * 8 + h] + gp[32 + d * 8 + h] + gp[48 + d * 8 + h] + bias_i;
            gf = gp[d * 8 + 4 + h] + gp[16 + d * 8 + 4 + h] + gp[32 + d * 8 + 4 + h] + gp[48 + d * 8 + 4 + h] + bias_f;
        }
    };
    prefetch(0);
    for (int st = 0; st < 132; ++st) {
        const int cid = scan_chunk(b, d, st);
        const bool emit = cid < NCHL;
        int tl = tid, zoff = 0;
        asm volatile("" : "+v"(tl), "+v"(zoff));
        const int tid = tl, lane = tid & 63, w = tid >> 6, cg = w & 3, kh = w >> 2, g4 = lane >> 4, l15 = lane & 15, c16 = tid & 63, srow0 = tid >> 6;
        MS_REGIONS(lds + zoff)
        __syncthreads();
        {
            lds_t xw_ = xct + srow0 * MS_KLD + c16 * 16;
            lds_t qw_ = qpt + srow0 * MS_QLD + c16 * 16;
#pragma unroll
            for (int i = 0; i < 8; ++i) {
                const unsigned xw[4] = {xcr[i].x, xcr[i].y, xcr[i].z, xcr[i].w};
                float q[8];
#pragma unroll
                for (int n = 0; n < 2; ++n)
#pragma unroll
                    for (int o = 0; o < 4; ++o)
                        q[4 * n + o] = __builtin_amdgcn_fdot2_f32_bf16(__builtin_bit_cast(bf16x2_t, xw[2 * n + 1]), Mp[n][o][1], __builtin_amdgcn_fdot2_f32_bf16(__builtin_bit_cast(bf16x2_t, xw[2 * n]), Mp[n][o][0], 0.f, false), false);
                u32x4 qv; qv.x = pk2(q[0], q[1]); qv.y = pk2(q[2], q[3]); qv.z = pk2(q[4], q[5]); qv.w = pk2(q[6], q[7]);
                *(LAS u32x4*)(xw_ + i * 8 * MS_KLD) = xcr[i];
                *(LAS u32x4*)(qw_ + i * 8 * MS_QLD) = qv;
            }
        }
        { const int s_ = tid >> 3, chunk = tid & 7;
          *(LAS u32x4*)(vt + s_ * 64 + chunk * 8) = vr;
          *(LAS u32x4*)(St + s_ * 64 + chunk * 8) = rr; }
        if (w == 0) {
            const float lf = log_sigmoidf_(gf);
            float bb = lf;
#pragma unroll
            for (int o = 1; o < 64; o <<= 1) { const float t_ = __shfl_up(bb, o); if (lane >= o) bb += t_; }
            float pm = gli - bb;
#pragma unroll
            for (int o = 1; o < 64; o <<= 1) { const float t_ = __shfl_up(pm, o); if (lane >= o) pm = fmaxf(pm, t_); }
            const float my_m = bb + fmaxf(m_prev, pm);
            const float m_new = __shfl(my_m, 63);
            const float b_last = __shfl(bb, 63);
            const int t = d ? 63 - lane : lane;
            sc_b[t] = bb; sc_m[t] = my_m; sc_li[t] = gli; sc_w[t] = __expf(b_last - bb + gli - m_new); sc_di[t] = __expf(bb + m_prev - my_m);
            qn[lane] = 0.f;
            if (lane == 0) sc_misc[0] = __expf(b_last + m_prev - m_new);
            m_prev = m_new;
        }
        __syncthreads();
        if (emit) {
            const int t = tid & 63, part = tid >> 6;
            float a = 0.f;
            lds_t qr = qpt + t * MS_QLD + part * 128;
            const LAS float* nn = nvec + part * 64;
#pragma unroll
            for (int i = 0; i < 8; ++i) {
                const u32x4 qq = *(const LAS u32x4*)(qr + i * 16);
                const f32x4 n0 = *(const LAS f32x4*)(nn + 8 * i), n1 = *(const LAS f32x4*)(nn + 8 * i + 4);
                a += lo_bf(qq.x) * n0[0] + hi_bf(qq.x) * n0[1] + lo_bf(qq.y) * n0[2] + hi_bf(qq.y) * n0[3] + lo_bf(qq.z) * n1[0] + hi_bf(qq.z) * n1[1] + lo_bf(qq.w) * n1[2] + hi_bf(qq.w) * n1[3];
                if (i & 1) __builtin_amdgcn_sched_barrier(0);
            }
            __hip_atomic_fetch_add((float*)(qn + t), a, __ATOMIC_RELAXED, __HIP_MEMORY_SCOPE_WORKGROUP);
        }
        __syncthreads();
        {
            const int t = tid >> 3, s8 = (tid & 7) * 8;
            if (emit) {
                const u32x4 rw = *(const LAS u32x4*)(St + t * 64 + s8);
                const unsigned rwv[4] = {rw.x, rw.y, rw.z, rw.w};
                const float bt_ = sc_b[t], mt_ = sc_m[t];
                float sv[8]; float rsum = 0.f;
#pragma unroll
                for (int j = 0; j < 8; ++j) {
                    const int s_ = s8 + j;
                    const float raw = (j & 1) ? hi_bf(rwv[j >> 1]) : lo_bf(rwv[j >> 1]);
                    const bool keep = d == 0 ? s_ <= t : s_ >= t;
                    sv[j] = keep ? raw * __expf(bt_ - sc_b[s_] + sc_li[s_] - mt_) : 0.f;
                    rsum += sv[j];
                }
                u32x4 o; o.x = pk2(sv[0], sv[1]); o.y = pk2(sv[2], sv[3]); o.z = pk2(sv[4], sv[5]); o.w = pk2(sv[6], sv[7]);
                *(LAS u32x4*)(St + t * 64 + s8) = o;
                rsum += __shfl_xor(rsum, 1); rsum += __shfl_xor(rsum, 2); rsum += __shfl_xor(rsum, 4);
                if ((tid & 7) == 0) sc_dn[t] = fmaxf(fabsf(sc_di[t] * qn[t] + rsum), __expf(-mt_));
            }
            {
                const u32x4 vv = *(const LAS u32x4*)(vt + t * 64 + s8);
                const float ww = sc_w[t];
                u32x4 o; o.x = pk2(lo_bf(vv.x) * ww, hi_bf(vv.x) * ww); o.y = pk2(lo_bf(vv.y) * ww, hi_bf(vv.y) * ww); o.z = pk2(lo_bf(vv.z) * ww, hi_bf(vv.z) * ww); o.w = pk2(lo_bf(vv.w) * ww, hi_bf(vv.w) * ww);
                *(LAS u32x4*)(vwt + t * 64 + s8) = o;
            }
        }
        __syncthreads();
        f32x4 acc2[4];
#pragma unroll
        for (int tt = 0; tt < 4; ++tt) acc2[tt] = (f32x4){0.f, 0.f, 0.f, 0.f};
        if (emit) {
            lds_t qa = qpt + l15 * MS_QLD + (kh * 256 + 4 * g4) * 2;
#pragma unroll
            for (int m = 0; m < 8; ++m) {
                u32x4 cb; cb.x = pk2(C[2 * m][0], C[2 * m][1]); cb.y = pk2(C[2 * m][2], C[2 * m][3]); cb.z = pk2(C[2 * m + 1][0], C[2 * m + 1][1]); cb.w = pk2(C[2 * m + 1][2], C[2 * m + 1][3]);
                const bf16x8 cf = __builtin_bit_cast(bf16x8, cb);
#pragma unroll
                for (int tt = 0; tt < 4; ++tt) {
                    const u32x2 a0 = *(const LAS u32x2*)(qa + tt * 16 * MS_QLD + m * 64);
                    const u32x2 a1 = *(const LAS u32x2*)(qa + tt * 16 * MS_QLD + m * 64 + 32);
                    u32x4 av; av.x = a0.x; av.y = a0.y; av.z = a1.x; av.w = a1.y;
                    acc2[tt] = mfma16(__builtin_bit_cast(bf16x8, av), cf, acc2[tt]);
                }
                __builtin_amdgcn_sched_barrier(0);
            }
#pragma unroll
            for (int tt = 0; tt < 4; ++tt) {
                const f32x4 dd = *(const LAS f32x4*)(sc_di + tt * 16 + 4 * g4);
                acc2[tt] = acc2[tt] * dd;
                acc2[tt] = mfma16(frag_row(St, 64, tt * 16, kh * 32, lane), frag_tr(vt, 64, kh * 32, cg * 16, lane), acc2[tt]);
            }
        }
        if (st + 1 < 132) prefetch(st + 1);
        {
            const float gd = sc_misc[0];
            bf16x8 vb[2];
#pragma unroll
            for (int ks = 0; ks < 2; ++ks) vb[ks] = frag_tr(vwt, 64, ks * 32, cg * 16, lane);
            lds_t ka = xct + (8 * g4 + (l15 >> 2)) * MS_KLD + (kh * 256 + 4 * (l15 & 3)) * 2;
#pragma unroll
            for (int i = 0; i < 16; ++i) {
                C[i] = C[i] * gd;
#pragma unroll
                for (int ks = 0; ks < 2; ++ks) {
                    const s16x4 lo = __builtin_amdgcn_ds_read_tr16_b64_v4i16((LAS s16x4*)(ka + ks * 32 * MS_KLD + i * 32));
                    const s16x4 hi = __builtin_amdgcn_ds_read_tr16_b64_v4i16((LAS s16x4*)(ka + ks * 32 * MS_KLD + 4 * MS_KLD + i * 32));
                    C[i] = mfma16(__builtin_shufflevector(lo, hi, 0, 1, 2, 3, 4, 5, 6, 7), vb[ks], C[i]);
                }
                if (i & 1) __builtin_amdgcn_sched_barrier(0);
            }
        }
        __syncthreads();
        {
            const int kp = tid & 255, sh = tid >> 8;
            float a0 = 0.f, a1 = 0.f;
            lds_t xr = xct + sh * 32 * MS_KLD + kp * 4;
#pragma unroll 8
            for (int s_ = 0; s_ < 32; ++s_) {
                const unsigned xx = *(const LAS unsigned*)(xr + s_ * MS_KLD);
                const float ww = sc_w[sh * 32 + s_];
                a0 += ww * lo_bf(xx); a1 += ww * hi_bf(xx);
            }
            npart[sh * 512 + 2 * kp] = a0; npart[sh * 512 + 2 * kp + 1] = a1;
        }
        if (emit && kh == 1) {
#pragma unroll
            for (int tt = 0; tt < 4; ++tt) *(LAS f32x4*)(red + ((cg * 4 + tt) * 64 + lane) * 4) = acc2[tt];
        }
        __syncthreads();
        nvec[tid] = sc_misc[0] * nvec[tid] + npart[tid] + npart[512 + tid];
        if (emit && kh == 0) {
#pragma unroll
            for (int tt = 0; tt < 4; ++tt) {
                const f32x4 o = acc2[tt] + *(const LAS f32x4*)(red + ((cg * 4 + tt) * 64 + lane) * 4);
                const f32x4 dn = *(const LAS f32x4*)(sc_dn + tt * 16 + 4 * g4);
#pragma unroll
                for (int r = 0; r < 4; ++r) otile[(tt * 16 + 4 * g4 + r) * 64 + cg * 16 + l15] = f2bf(o[r] / dn[r]);
            }
        }
        __syncthreads();
        if (emit) {
            const int t = tid >> 3, chunk = tid & 7;
            *(u32x4*)(H + (size_t)(cid * 64 + t) * 2048 + h * 512 + sl * 64 + chunk * 8) = *(const LAS u32x4*)(otile + t * 64 + chunk * 8);
        }
    }
}

DI void phase_merge(PP p) {
    const int tid = get_tid(), lane = tid & 63;
    const bf16_t* HF = (const bf16_t*)p->out;
    bf16_t* HB = (bf16_t*)(p->ws + OFF_ARENA + A_HB);
    const bf16_t* XC = (const bf16_t*)(p->ws + OFF_ARENA + A_XC);
    const bf16_t* Z = (const bf16_t*)(p->ws + OFF_ARENA + A_XM);
    const int gw = get_bid() * 8 + (tid >> 6), nw = gridDim.x * 8;
    for (int r = gw; r < NLAT; r += nw) {
#pragma unroll
        for (int hh = 0; hh < 4; ++hh) {
            const size_t o = (size_t)r * 2048 + hh * 512 + lane * 8;
            const u32x4 a = *(const u32x4*)(HF + o), b = *(const u32x4*)(HB + o), xq = *(const u32x4*)(XC + o), zq = *(const u32x4*)(Z + o);
            const unsigned aw[4] = {a.x, a.y, a.z, a.w}, bw[4] = {b.x, b.y, b.z, b.w}, xw[4] = {xq.x, xq.y, xq.z, xq.w}, zw[4] = {zq.x, zq.y, zq.z, zq.w};
            float hv[8]; float sum = 0.f;
#pragma unroll
            for (int j = 0; j < 4; ++j) { hv[2 * j] = lo_bf(aw[j]) + lo_bf(bw[j]); hv[2 * j + 1] = hi_bf(aw[j]) + hi_bf(bw[j]); sum += hv[2 * j] + hv[2 * j + 1]; }
            const float mean = wave_sum(sum) * (1.f / 512.f);
            float sq = 0.f;
#pragma unroll
            for (int j = 0; j < 8; ++j) { hv[j] -= mean; sq += hv[j] * hv[j]; }
            const float rs = rsqrtf(wave_sum(sq) * (1.f / 512.f) + EPS);
            float ov[8];
#pragma unroll
            for (int j = 0; j < 8; ++j) {
                const int c = hh * 512 + lane * 8 + j;
                const float xcv = (j & 1) ? hi_bf(xw[j >> 1]) : lo_bf(xw[j >> 1]);
                const float zv = (j & 1) ? hi_bf(zw[j >> 1]) : lo_bf(zw[j >> 1]);
                ov[j] = (hv[j] * rs * p->m_norm_g[c] + p->m_skip[c] * xcv) * siluf_(zv);
            }
            u32x4 v; v.x = pk2(ov[0], ov[1]); v.y = pk2(ov[2], ov[3]); v.z = pk2(ov[4], ov[5]); v.w = pk2(ov[6], ov[7]);
            *(u32x4*)(HB + o) = v;
        }
    }
}

DI void phase_downproj(PP p, lds_t lds) {
    const bf16_t* A = (const bf16_t*)(p->ws + OFF_ARENA + A_HB);
    float* X = (float*)(p->ws + OFF_ARENA + A_X);
    constexpr int NM = NLAT / 256, NN = 4;
    for (int u = get_bid(); u < NM * NN; u += gridDim.x) {
        const int pn = u / NM, pm = u % NM;
        const float* g1 = mods_ptr(p, 1, pm >> 5, 2);
        gemm_unit<256>(lds, 2048, 1024,
            [&](int r) { return A + (size_t)(pm * 256 + r) * 2048; },
            [&](int j) -> const float* { return p->m_w_down + pn * 256 + j; },
            [&](const f32x4 (&acc)[8][4], int wr, int wc, int lane) {
                epi_each<4>(acc, wr, wc, lane, [&](int r, int c, f32x4 v) {
                    const int col = pn * 256 + c;
                    float* xp = X + (size_t)(pm * 256 + r) * 1024 + col;
                    const f32x4 g = *(const f32x4*)(g1 + col);
                    *(f32x4*)xp = *(const f32x4*)xp + g * v;
                });
            });
    }
}

DI void phase_dbg_final(PP p, int mode) {
    const int tid = get_tid(), lane = tid & 63;
    const int gw = get_bid() * 8 + (tid >> 6), nw = gridDim.x * 8;
    if (mode == 4) {
        const int* rid = (const int*)(p->ws + OFF_ARENA + A_ROWID);
        for (int r = gw; r < NLAT; r += nw)
            for (int c = lane; c < 1024; c += 64) p->out[(size_t)r * 1024 + c] = (float)rid[(size_t)r * 16 + (c & 15)];
        return;
    }
    if (mode == 7) {
        const bf16_t* y = (const bf16_t*)(p->ws + OFF_ARENA + A_Y);
        for (int r = gw; r < NLAT; r += nw)
            for (int c = lane; c < 1024; c += 64) { const float v = bf2f(y[(size_t)r * 1024 + c]); p->out[(size_t)r * 1024 + c] = (v == v && fabsf(v) < 1e30f) ? 0.f : 1000.f; }
        return;
    }
    if (mode >= 2) {
        const bf16_t* src = mode == 2 ? (const bf16_t*)(p->ws + OFF_ARENA + A_P) : mode == 5 ? (const bf16_t*)(p->ws + OFF_ARENA + A_HDN) : mode == 6 ? (const bf16_t*)(p->ws + OFF_ARENA + A_Y) : (const bf16_t*)(p->ws + OFF_ACT);
        const int ld = mode == 2 ? ABIN : 1024;
        for (int r = gw; r < NLAT; r += nw)
            for (int c = lane; c < 1024; c += 64) p->out[(size_t)r * 1024 + c] = bf2f(src[(size_t)r * ld + (mode == 2 ? c + DBG_COL0 : c)]);
        return;
    }
    const float* X = mode ? (const float*)(p->ws + OFF_ARENA + A_X) : p->x;
    for (int r = gw; r < NLAT; r += nw) {
        f32x4 v[4];
        row_load_f32(X + (size_t)r * 1024, v, lane);
        const float rs = rsqrtf(row_sumsq(v) * (1.f / 1024.f) + EPS);
#pragma unroll
        for (int i = 0; i < 4; ++i) { const f32x4 g = *(const f32x4*)(p->final_g + 4 * lane + 256 * i); *(f32x4*)(p->out + (size_t)r * 1024 + 4 * lane + 256 * i) = v[i] * rs * g; }
    }
}

DI void grid_barrier(cg::grid_group& grid, PP p, unsigned& nbar) {
    asm volatile("s_waitcnt vmcnt(0) lgkmcnt(0)" ::: "memory");
    unsigned* ctr = (unsigned*)(p->ws + OFF_BAR);
    if (nbar == 0) {
        if (blockIdx.x == 0 && threadIdx.x == 0) __hip_atomic_store(ctr, 0u, __ATOMIC_RELAXED, __HIP_MEMORY_SCOPE_AGENT);
        asm volatile("s_waitcnt vmcnt(0)" ::: "memory");
        grid.sync();
        __builtin_amdgcn_fence(__ATOMIC_ACQUIRE, "agent");
        asm volatile("s_waitcnt vmcnt(0)" ::: "memory");
    } else {
        __syncthreads();
        if (threadIdx.x == 0) {
            __builtin_amdgcn_fence(__ATOMIC_RELEASE, "agent");
            asm volatile("s_waitcnt vmcnt(0)" ::: "memory");
            __hip_atomic_fetch_add(ctr, 1u, __ATOMIC_RELAXED, __HIP_MEMORY_SCOPE_AGENT);
            const unsigned target = nbar * gridDim.x;
            while (__hip_atomic_load(ctr, __ATOMIC_RELAXED, __HIP_MEMORY_SCOPE_AGENT) < target) __builtin_amdgcn_s_sleep(1);
            __builtin_amdgcn_fence(__ATOMIC_ACQUIRE, "agent");
            asm volatile("s_waitcnt vmcnt(0)" ::: "memory");
        }
        __syncthreads();
    }
    ++nbar;
}
#define RUN_PHASE(K, CALL) if (ph_lo <= (K) && (K) < ph_hi && ((K) <= DBG_STOP)) { PP p = kp; asm volatile("" : "+s"(p)); CALL; if ((DUP_MASK >> (K)) & 1) { grid_barrier(grid, p, nbar); asm volatile("" : "+s"(p)); CALL; } if ((K) + 1 < ph_hi) { grid_barrier(grid, p, nbar); if (EXTRA_BARRIERS) grid_barrier(grid, p, nbar); } }
__global__ void __launch_bounds__(NTHREADS) mega(Params p_in) {
    extern __shared__ __attribute__((aligned(16))) unsigned char lds_raw[];
    lds_t lds = (lds_t)lds_raw;
    cg::grid_group grid = cg::this_grid();
    PP kp = (PP)__builtin_amdgcn_kernarg_segment_ptr();
    const int ph_lo = kp->ph_lo, ph_hi = kp->ph_hi;
    unsigned nbar = 0;
    RUN_PHASE(0, phase_mods(p, lds))
    RUN_PHASE(1, phase_norm(p, 0, NTOK, [&](int r) { return r < NLAT ? p->x + (size_t)r * 1024 : p->ctx + (size_t)(r - NLAT) * 1024; }))
    RUN_PHASE(2, phase_inproj(p, lds))
    RUN_PHASE(3, phase_g1(p, lds))
    RUN_PHASE(4, phase_scan0(p))
    RUN_PHASE(5, phase_g3(p, lds))
    RUN_PHASE(6, phase_outproj0(p, lds))
    RUN_PHASE(7, phase_router(p, lds, 0))
    RUN_PHASE(8, phase_topk(p, lds, 0))
    RUN_PHASE(9, phase_moe_up(p, lds, 0))
    RUN_PHASE(10, phase_moe_down(p, lds, 0))
    RUN_PHASE(11, phase_combine(p, 0))
    RUN_PHASE(12, phase_upproj(p, lds, 0))
    RUN_PHASE(13, phase_mfeat(p, lds))
    RUN_PHASE(14, phase_mscan(p, lds))
    RUN_PHASE(15, phase_norm(p, 1, NLAT, [&](int r) { return (const float*)(p->ws + OFF_ARENA + A_X) + (size_t)r * 1024; }))
    RUN_PHASE(16, phase_upproj(p, lds, 1))
    RUN_PHASE(17, phase_merge(p))
    RUN_PHASE(18, phase_downproj(p, lds))
    RUN_PHASE(19, phase_router(p, lds, 1))
    RUN_PHASE(20, phase_topk(p, lds, 1))
    RUN_PHASE(21, phase_moe_up(p, lds, 1))
    RUN_PHASE(22, phase_moe_down(p, lds, 1))
    RUN_PHASE(23, phase_combine(p, 1))
    if (DBG_STOP < 23 && DBG_STOP + 1 < ph_hi) { PP p = kp; asm volatile("" : "+s"(p)); phase_dbg_final(p, DBG_MODE); }
}

extern "C" void kernel_launch(void* const* d_in, const int* in_sizes, int n_in, void* d_out, int out_size, void* d_ws, size_t ws_size, hipStream_t stream) {
    static int grid = 0;
    if (grid == 0) {
        int dev = 0, cus = 0, per_cu = 0;
        hipGetDevice(&dev);
        hipDeviceGetAttribute(&cus, hipDeviceAttributeMultiprocessorCount, dev);
        hipFuncSetAttribute((const void*)mega, hipFuncAttributeMaxDynamicSharedMemorySize, LDS_BYTES);
        hipOccupancyMaxActiveBlocksPerMultiprocessor(&per_cu, (const void*)mega, NTHREADS, LDS_BYTES);
        if (per_cu < 1) { fprintf(stderr, "occupancy query says %d blocks/CU\n", per_cu); per_cu = 1; }
        grid = cus;
        if (ws_size < WS_NEED) { fprintf(stderr, "workspace too small: %zu < %zu\n", ws_size, (size_t)WS_NEED); grid = -1; }
    }
    if (grid < 0) return;
    Params hp{};
    const float** pp = (const float**)&hp;
    for (int i = 0; i < 36; ++i) pp[i] = (const float*)d_in[i];
    hp.out = (float*)d_out; hp.ws = (char*)d_ws; hp.ph_lo = 0; hp.ph_hi = DBG_STOP < 23 ? DBG_STOP + 2 : 24;
    void* args[] = {&hp};
    hipError_t e = hipLaunchCooperativeKernel((const void*)mega, dim3(grid), dim3(NTHREADS), args, LDS_BYTES, stream);
    if (e != hipSuccess) fprintf(stderr, "cooperative launch failed: %s\n", hipGetErrorString(e));
}
```

```cpp
#include <hip/hip_runtime.h>
#include <hip/hip_cooperative_groups.h>
#include <cstdio>
#include <cstdint>
namespace cg = cooperative_groups;

#define LAS __attribute__((address_space(3)))
#define DI __device__ __forceinline__
typedef unsigned short bf16_t;
typedef short bf16x8 __attribute__((ext_vector_type(8)));
typedef short s16x4 __attribute__((ext_vector_type(4)));
typedef float f32x4 __attribute__((ext_vector_type(4)));
typedef float f32x2 __attribute__((ext_vector_type(2)));
typedef unsigned u32x4 __attribute__((ext_vector_type(4)));
typedef unsigned u32x2 __attribute__((ext_vector_type(2)));
typedef LAS char* lds_t;

constexpr int D = 1024, NBATCH = 4, SEQ = 8192, CTXL = 256;
constexpr int NLAT = NBATCH * SEQ;
constexpr int NCTX = NBATCH * CTXL;
constexpr int NTOK = NLAT + NCTX;
constexpr int NCH = NTOK / 64;
constexpr int NCHL = NLAT / 64;
constexpr int ABIN = 2592;
constexpr int PC_Q = 0, PC_K = 256, PC_V = 512, PC_G = 1024, PC_LRF = 1536, PC_LRB = 1552, PC_RGG = 1568, PC_RGX = 2080;
constexpr float EPS = 1e-6f;
constexpr int NTHREADS = 512;
constexpr int LDS_BYTES = 160 * 1024;
#define DBG_MODE 1
#ifndef DUP_MASK
#define DUP_MASK 0
#endif
#ifndef EXTRA_BARRIERS
#define EXTRA_BARRIERS 0
#endif
#define DBG_STOP 23
#define DBG_COL0 0

constexpr size_t OFF_MODS = 0;
constexpr size_t OFF_GCAT = 245760;
constexpr size_t OFF_MMAT = 376832;
constexpr size_t OFF_BAR = 409600;
constexpr size_t OFF_ACT = 1u << 20;
constexpr size_t ACT_BYTES = (size_t)NTOK * 1024 * 2;
constexpr size_t OFF_ARENA = OFF_ACT + ACT_BYTES;
constexpr size_t A_P = 0;
constexpr size_t A_U = A_P + (size_t)NTOK * ABIN * 2;
constexpr size_t A_LA = A_U + (size_t)NCH * 2 * 4 * 8192 * 4;
constexpr size_t A_UU = A_LA + (size_t)NTOK * 2 * 512 * 4;
constexpr size_t A_DEC = A_UU + (size_t)NTOK * 2 * 512 * 2;
constexpr size_t A_AGGA = A_DEC + (size_t)NCH * 2 * 256 * 4;
constexpr size_t A_AGGH = A_AGGA + (size_t)NCH * 2 * 512 * 4;
constexpr size_t A_L0_END = A_AGGH + (size_t)NCH * 2 * 512 * 4;
constexpr size_t A_X = 0;
constexpr size_t A_PT = A_X + (size_t)NTOK * 1024 * 4;
constexpr size_t A_PE = A_PT + (size_t)NTOK * 16 * 4;
constexpr size_t A_ROWID = A_PE + (size_t)NTOK * 16 * 4;
constexpr size_t A_ROWTOK = A_ROWID + (size_t)NTOK * 16 * 4;
constexpr size_t A_HDN = A_ROWTOK + (size_t)16 * 4352 * 4;
constexpr size_t A_Y = A_HDN + (size_t)16 * 4352 * 1024 * 2;
constexpr size_t A_MOE0_END = A_Y + (size_t)16 * 4352 * 1024 * 2;
constexpr size_t A_XM = A_X + (size_t)NTOK * 1024 * 4;
constexpr size_t A_XC = A_XM + (size_t)NTOK * 2048 * 2;
constexpr size_t A_HB = A_XC + (size_t)NTOK * 2048 * 2;
constexpr size_t A_L1_END = A_HB + (size_t)NLAT * 2048 * 2;
constexpr size_t ACT_RAWS = 0;
constexpr size_t ACT_GP = ACT_RAWS + (size_t)NCH * 4 * 4096 * 2;
constexpr size_t ACT_CTXV = ACT_GP + (size_t)NTOK * 64 * 4;
constexpr size_t WS_NEED = OFF_ARENA + (A_L1_END > A_L0_END ? A_L1_END : A_L0_END);
static_assert(A_MOE0_END < A_L1_END, "arena");
static_assert(ACT_CTXV + (size_t)NCTX * 2048 * 2 <= ACT_BYTES, "act region");

struct Params {
    const float *x, *c, *ctx, *c_ctx, *mod_w, *mod_b, *norm1_g, *norm2_g, *ab_w_in, *gla_wa2, *gla_ba, *gla_norm_g;
    const float *rg_conv_w, *rg_conv_b, *rg_wr, *rg_br, *rg_wi, *rg_bi, *rg_lambda, *ab_w_out, *m_w_up, *m_conv_w, *m_conv_b;
    const float *m_wq, *m_wk, *m_wv, *m_w_gates, *m_b_gates, *m_skip, *m_norm_g, *m_w_down, *router_w, *exp_w_gate, *exp_w_up, *exp_w_down, *final_g;
    float* out;
    char* ws;
    int ph_lo, ph_hi;
};

typedef const Params __attribute__((address_space(4)))* PP;

DI int get_tid() { int t = threadIdx.x; asm volatile("" : "+v"(t)); return t; }
DI int get_bid() { int b = blockIdx.x; asm volatile("" : "+s"(b)); return b; }
DI float bf2f(bf16_t h) { return __uint_as_float((unsigned)h << 16); }
DI bf16_t f2bf(float x) { unsigned u = __float_as_uint(x); u += 0x7fffu + ((u >> 16) & 1u); return (bf16_t)(u >> 16); }
typedef __bf16 bf16x2_t __attribute__((ext_vector_type(2)));
DI unsigned pk2n(float lo, float hi) { const f32x2 v = {lo, hi}; return __builtin_bit_cast(unsigned, __builtin_convertvector(v, bf16x2_t)); }
DI unsigned pk2(float lo, float hi) { return pk2n(lo, hi); }
DI float lo_bf(unsigned u) { return __uint_as_float(u << 16); }
DI float hi_bf(unsigned u) { return __uint_as_float(u & 0xffff0000u); }
DI float sigmoidf_(float x) { return 1.f / (1.f + __expf(-x)); }
DI float siluf_(float x) { return x / (1.f + __expf(-x)); }
DI float log_sigmoidf_(float z) { return fminf(z, 0.f) - log1pf(__expf(-fabsf(z))); }
DI float softplusf_(float z) { return fmaxf(z, 0.f) + log1pf(__expf(-fabsf(z))); }
DI float gelu_tanh(float x) { const float u = 0.7978845608028654f * (x + 0.044715f * x * x * x); return 0.5f * x * (1.f + tanhf(u)); }
DI float wave_sum(float v) {
#pragma unroll
    for (int o = 32; o > 0; o >>= 1) v += __shfl_xor(v, o);
    return v;
}
DI f32x4 mfma16(bf16x8 a, bf16x8 b, f32x4 c) { return __builtin_amdgcn_mfma_f32_16x16x32_bf16(a, b, c, 0, 0, 0); }

DI bf16x8 frag_row(const LAS bf16_t* tile, int ld, int r0, int k0, int lane) {
    return *(const LAS bf16x8*)(tile + (r0 + (lane & 15)) * ld + k0 + 8 * (lane >> 4));
}
DI bf16x8 frag_tr(const LAS bf16_t* tile, int ld, int k0, int c0, int lane) {
    const int g = lane >> 4, i = lane & 15, q = i >> 2, p = i & 3;
    const LAS bf16_t* base = tile + (k0 + 8 * g + q) * ld + c0 + 4 * p;
    const s16x4 lo = __builtin_amdgcn_ds_read_tr16_b64_v4i16((LAS s16x4*)base);
    const s16x4 hi = __builtin_amdgcn_ds_read_tr16_b64_v4i16((LAS s16x4*)(base + 4 * ld));
    return __builtin_shufflevector(lo, hi, 0, 1, 2, 3, 4, 5, 6, 7);
}
DI const float* mods_ptr(PP p, int layer, int s, int which) { return (const float*)(p->ws + OFF_MODS) + ((size_t)(layer * 5 + s) * 6 + which) * 1024; }
DI int row_set(int r) { return r < NLAT ? (r >> 13) : 4; }

template <int BN, class ARow, class BCol, class Epi>
DI void gemm_unit(lds_t lds, int K, int ldb, ARow arow, BCol bcol, Epi epi) {
    constexpr int BK = 32;
    constexpr int NT = BN / 64;
    constexpr int LDA = BK + 8, LDB = BN + 16;
    constexpr int A_BYTES = 256 * LDA * 2, B_BYTES = BK * LDB * 2;
    static_assert(2 * A_BYTES + 2 * B_BYTES <= LDS_BYTES, "gemm lds");
    const int tid = get_tid(), lane = tid & 63, w = tid >> 6, wr = w >> 2, wc = w & 3;
    constexpr int ACH = BK / 8, ARP = NTHREADS / ACH, AP = 256 / ARP;
    const int achunk = tid % ACH, arow0 = tid / ACH;
    const bf16_t* ap[AP];
#pragma unroll
    for (int q = 0; q < AP; ++q) ap[q] = arow(arow0 + ARP * q);
    constexpr int CG = BN / 8, KR = NTHREADS / CG, BP = BK / KR;
    const int bc8 = tid % CG, bk0 = tid / CG;
    const float* bp = bcol(bc8 * 8);
    u32x4 areg[AP];
    f32x4 breg[BP][2];
    auto gload = [&](int kt) {
        const int k0 = kt * BK;
#pragma unroll
        for (int q = 0; q < AP; ++q) areg[q] = ap[q] ? *(const u32x4*)(ap[q] + k0 + achunk * 8) : (u32x4){0u, 0u, 0u, 0u};
#pragma unroll
        for (int q = 0; q < BP; ++q) {
            if (bp) { const float* s = bp + (size_t)(k0 + bk0 + KR * q) * ldb; breg[q][0] = *(const f32x4*)s; breg[q][1] = *(const f32x4*)(s + 4); }
            else { breg[q][0] = (f32x4){0.f, 0.f, 0.f, 0.f}; breg[q][1] = breg[q][0]; }
        }
    };
    auto lstore = [&](int buf) {
        LAS bf16_t* As = (LAS bf16_t*)(lds + buf * A_BYTES);
        LAS bf16_t* Bs = (LAS bf16_t*)(lds + 2 * A_BYTES + buf * B_BYTES);
#pragma unroll
        for (int q = 0; q < AP; ++q) *(LAS u32x4*)(As + (arow0 + ARP * q) * LDA + achunk * 8) = areg[q];
#pragma unroll
        for (int q = 0; q < BP; ++q) {
            u32x4 v; v.x = pk2(breg[q][0][0], breg[q][0][1]); v.y = pk2(breg[q][0][2], breg[q][0][3]); v.z = pk2(breg[q][1][0], breg[q][1][1]); v.w = pk2(breg[q][1][2], breg[q][1][3]);
            *(LAS u32x4*)(Bs + (bk0 + KR * q) * LDB + bc8 * 8) = v;
        }
    };
    f32x4 acc[8][NT];
#pragma unroll
    for (int mi = 0; mi < 8; ++mi)
#pragma unroll
        for (int ni = 0; ni < NT; ++ni) acc[mi][ni] = (f32x4){0.f, 0.f, 0.f, 0.f};
    const int nk = K / BK;
    gload(0);
    for (int kt = 0; kt < nk; ++kt) {
        lstore(kt & 1);
        __syncthreads();
        if (kt + 1 < nk) gload(kt + 1);
        const LAS bf16_t* As = (const LAS bf16_t*)(lds + (kt & 1) * A_BYTES);
        const LAS bf16_t* Bs = (const LAS bf16_t*)(lds + 2 * A_BYTES + (kt & 1) * B_BYTES);
#pragma unroll
        for (int ks = 0; ks < BK / 32; ++ks) {
            bf16x8 wb[NT];
#pragma unroll
            for (int ni = 0; ni < NT; ++ni) wb[ni] = frag_tr(Bs, LDB, ks * 32, wc * (BN / 4) + ni * 16, lane);
#pragma unroll
            for (int mi = 0; mi < 8; ++mi) {
                const bf16x8 xa = frag_row(As, LDA, wr * 128 + mi * 16, ks * 32, lane);
#pragma unroll
                for (int ni = 0; ni < NT; ++ni) acc[mi][ni] = mfma16(wb[ni], xa, acc[mi][ni]);
            }
        }
    }
    epi(acc, wr, wc, lane);
    __syncthreads();
}

template <int NT, class F>
DI void epi_each(const f32x4 (&acc)[8][NT], int wr, int wc, int lane, F f) {
#pragma unroll
    for (int mi = 0; mi < 8; ++mi)
#pragma unroll
        for (int ni = 0; ni < NT; ++ni) f(wr * 128 + mi * 16 + (lane & 15), wc * (NT * 16) + ni * 16 + 4 * (lane >> 4), acc[mi][ni]);
}
DI void store_bf16x4(bf16_t* dst, f32x4 v) { u32x2 o; o.x = pk2(v[0], v[1]); o.y = pk2(v[2], v[3]); *(u32x2*)dst = o; }

DI void row_load_f32(const float* src, f32x4 (&v)[4], int lane) {
#pragma unroll
    for (int i = 0; i < 4; ++i) v[i] = *(const f32x4*)(src + 4 * lane + 256 * i);
}
DI float row_sumsq(const f32x4 (&v)[4]) {
    float s = 0.f;
#pragma unroll
    for (int i = 0; i < 4; ++i) s += v[i][0] * v[i][0] + v[i][1] * v[i][1] + v[i][2] * v[i][2] + v[i][3] * v[i][3];
    return wave_sum(s);
}
DI void row_modulate(f32x4 (&v)[4], float rs, const float* g, const float* sc, const float* sh, int lane) {
#pragma unroll
    for (int i = 0; i < 4; ++i) {
        const int c = 4 * lane + 256 * i;
        const f32x4 gg = *(const f32x4*)(g + c), ss = *(const f32x4*)(sc + c), hh = *(const f32x4*)(sh + c);
#pragma unroll
        for (int j = 0; j < 4; ++j) v[i][j] = v[i][j] * rs * gg[j] * (1.f + ss[j]) + hh[j];
    }
}
DI void row_store_bf16(bf16_t* dst, const f32x4 (&v)[4], int lane) {
#pragma unroll
    for (int i = 0; i < 4; ++i) store_bf16x4(dst + 4 * lane + 256 * i, v[i]);
}

DI void phase_mods(PP p, lds_t lds) {
    const int tid = get_tid();
    LAS float* sil = (LAS float*)lds;
    LAS float* red = sil + 5 * 1024;
    for (int u = get_bid(); u < 192 + 32; u += gridDim.x) {
        if (u < 192) {
            const int layer = u / 96, c0 = (u % 96) * 64;
            for (int i = tid; i < 5 * 1024; i += NTHREADS) { const int s = i >> 10, k = i & 1023; const float cv = s < 4 ? p->c[s * 1024 + k] : p->c_ctx[k]; sil[i] = siluf_(cv); }
            __syncthreads();
            const int col = tid & 63, kp = tid >> 6;
            float a[5] = {0.f, 0.f, 0.f, 0.f, 0.f};
            const float* wp = p->mod_w + (size_t)layer * 1024 * 6144 + c0 + col;
            for (int k = kp * 128; k < kp * 128 + 128; ++k) {
                const float wv = wp[(size_t)k * 6144];
#pragma unroll
                for (int s = 0; s < 5; ++s) a[s] += sil[s * 1024 + k] * wv;
            }
#pragma unroll
            for (int s = 0; s < 5; ++s) red[(kp * 5 + s) * 64 + col] = a[s];
            __syncthreads();
            if (tid < 320) {
                const int s = tid >> 6, cc = tid & 63;
                float t = p->mod_b[layer * 6144 + c0 + cc];
#pragma unroll
                for (int k = 0; k < 8; ++k) t += red[(k * 5 + s) * 64 + cc];
                ((float*)(p->ws + OFF_MODS))[(size_t)(layer * 5 + s) * 6144 + c0 + cc] = t;
            }
            __syncthreads();
        } else {
            const int f0 = (u - 192) * 64;
            const int fl = tid >> 3, dgp = (tid & 7) * 2, f = f0 + fl, n = f >> 2, i = f & 3;
            bf16_t* gxc = (bf16_t*)(p->ws + OFF_GCAT);
            bf16_t* gxm = gxc + 2048 * 16;
#pragma unroll
            for (int e = 0; e < 2; ++e) {
                const int dg = dgp + e, d = dg >> 3, g = dg & 7;
                const float* wg = p->m_w_gates + (size_t)d * 6144 * 8;
                float a = 0.f, b = 0.f;
#pragma unroll
                for (int o = 0; o < 4; ++o) {
                    a += p->m_wq[n * 16 + i * 4 + o] * wg[(size_t)(4 * n + o) * 8 + g];
                    a += p->m_wk[n * 16 + i * 4 + o] * wg[(size_t)(2048 + 4 * n + o) * 8 + g] * 0.04419417382415922f;
                    b += p->m_wv[n * 16 + i * 4 + o] * wg[(size_t)(4096 + 4 * n + o) * 8 + g];
                }
                gxc[f * 16 + dg] = f2bf(a); gxm[f * 16 + dg] = f2bf(b);
            }
            if (tid < 256) {
                const int nn = (f0 >> 2) + (tid >> 4), e = tid & 15, ii = e >> 2, jj = e & 3;
                float a = 0.f;
#pragma unroll
                for (int o = 0; o < 4; ++o) a += p->m_wq[nn * 16 + ii * 4 + o] * p->m_wk[nn * 16 + jj * 4 + o];
                ((float*)(p->ws + OFF_MMAT))[nn * 16 + e] = a * 0.04419417382415922f;
            }
        }
    }
}

template <class Src>
DI void phase_norm(PP p, int layer, int nrows, Src src) {
    const int lane = get_tid() & 63, gw = get_bid() * 8 + (get_tid() >> 6), nw = gridDim.x * 8;
    bf16_t* act = (bf16_t*)(p->ws + OFF_ACT);
    for (int r = gw; r < nrows; r += nw) {
        f32x4 v[4];
        row_load_f32(src(r), v, lane);
        const float rs = rsqrtf(row_sumsq(v) * (1.f / 1024.f) + EPS);
        const int s = row_set(r);
        row_modulate(v, rs, p->norm1_g + layer * 1024, mods_ptr(p, layer, s, 1), mods_ptr(p, layer, s, 0), lane);
        row_store_bf16(act + (size_t)r * 1024, v, lane);
    }
}

DI void phase_inproj(PP p, lds_t lds) {
    const bf16_t* act = (const bf16_t*)(p->ws + OFF_ACT);
    bf16_t* P = (bf16_t*)(p->ws + OFF_ARENA + A_P);
    constexpr int NM = NTOK / 256, NN = 11;
    for (int u = get_bid(); u < NM * NN; u += gridDim.x) {
        const int pn = u / NM, pm = u % NM;
        gemm_unit<256>(lds, 1024, ABIN,
            [&](int r) { return act + (size_t)(pm * 256 + r) * 1024; },
            [&](int j) -> const float* { const int c = pn * 256 + j; return c < ABIN ? p->ab_w_in + c : nullptr; },
            [&](const f32x4 (&acc)[8][4], int wr, int wc, int lane) {
                epi_each<4>(acc, wr, wc, lane, [&](int r, int c, f32x4 v) { const int col = pn * 256 + c; if (col < ABIN) store_bf16x4(P + (size_t)(pm * 256 + r) * ABIN + col, v); });
            });
    }
}


DI void gla_bcum(LAS float* bc, const LAS float* lrt, const LAS float* wat, const LAS float* bat, int d, LAS float* seg_tot) {
    const int tid = get_tid();
    {
        const int c = tid & 63, tq = tid >> 6;
        float wcol[16];
#pragma unroll
        for (int r = 0; r < 16; ++r) wcol[r] = wat[r * 64 + c];
        const float bias = bat[c];
        for (int t = tq * 8; t < tq * 8 + 8; ++t) {
            float z = bias;
#pragma unroll
            for (int r = 0; r < 16; ++r) z += lrt[t * 16 + r] * wcol[r];
            bc[t * 64 + c] = log_sigmoidf_(z) * (1.f / 16.f);
        }
    }
    __syncthreads();
    {
        const int c = tid & 63, seg = tid >> 6;
        float v[8]; float run = 0.f;
#pragma unroll
        for (int j = 0; j < 8; ++j) { const int pp = seg * 8 + j, t = d == 0 ? pp : 63 - pp; run += bc[t * 64 + c]; v[j] = run; }
        LAS float* tot = seg_tot + seg * 64 + c;
        *tot = run;
        __syncthreads();
        float off = 0.f;
#pragma unroll
        for (int k = 0; k < 7; ++k) off += (k < seg) ? seg_tot[k * 64 + c] : 0.f;
#pragma unroll
        for (int j = 0; j < 8; ++j) { const int pp = seg * 8 + j, t = d == 0 ? pp : 63 - pp; bc[t * 64 + c] = v[j] + off; }
    }
    __syncthreads();
}
DI void gla_load_decay_inputs(PP p, const bf16_t* P, int r0, int h, LAS float* lrt, LAS float* wat, LAS float* bat) {
    const int tid = get_tid();
    if (tid < 256) {
        const int d = tid >> 7, t = (tid >> 1) & 63, half = tid & 1;
        const u32x4 v = *(const u32x4*)(P + (size_t)(r0 + t) * ABIN + PC_LRF + d * 16 + half * 8);
        LAS float* o = lrt + (d * 64 + t) * 16 + half * 8;
        o[0] = lo_bf(v.x); o[1] = hi_bf(v.x); o[2] = lo_bf(v.y); o[3] = hi_bf(v.y); o[4] = lo_bf(v.z); o[5] = hi_bf(v.z); o[6] = lo_bf(v.w); o[7] = hi_bf(v.w);
    }
    {
        const int i = tid * 4, d = i >> 10, r = (i >> 6) & 15, c = i & 63;
        *(LAS f32x4*)(wat + i) = *(const f32x4*)(p->gla_wa2 + (size_t)(d * 16 + r) * 256 + h * 64 + c);
    }
    if (tid < 128) bat[tid] = p->gla_ba[(tid >> 6) * 256 + h * 64 + (tid & 63)];
}

DI void phase_g1(PP p, lds_t lds) {
    const int tid = get_tid(), lane = tid & 63, w = tid >> 6;
    const bf16_t* P = (const bf16_t*)(p->ws + OFF_ARENA + A_P);
    float* U = (float*)(p->ws + OFF_ARENA + A_U);
    float* DEC = (float*)(p->ws + OFF_ARENA + A_DEC);
    float* LA = (float*)(p->ws + OFF_ARENA + A_LA);
    bf16_t* UU = (bf16_t*)(p->ws + OFF_ARENA + A_UU);
    float* AGGA = (float*)(p->ws + OFF_ARENA + A_AGGA);
    float* AGGH = (float*)(p->ws + OFF_ARENA + A_AGGH);
    constexpr int NGLA = NCH * 4, NLRU = NCH * 4;
    for (int task = get_bid(); task < NGLA + NLRU; task += gridDim.x) {
        if (task < NGLA) {
            const int ch = task >> 2, h = task & 3, r0 = ch * 64;
            LAS float* lrt = (LAS float*)lds;
            LAS float* wat = lrt + 2048;
            LAS float* bat = wat + 2048;
            LAS float* bc = bat + 128;
            LAS bf16_t* kt = (LAS bf16_t*)(bc + 8192);
            LAS bf16_t* ktd = kt + 64 * 72;
            LAS bf16_t* vt = ktd + 2 * 64 * 72;
            gla_load_decay_inputs(p, P, r0, h, lrt, wat, bat);
            { const int row = tid >> 3, chunk = tid & 7; *(LAS u32x4*)(kt + row * 72 + chunk * 8) = *(const u32x4*)(P + (size_t)(r0 + row) * ABIN + PC_K + h * 64 + chunk * 8); }
#pragma unroll
            for (int q = 0; q < 2; ++q) { const int i = tid + 512 * q, row = i >> 4, chunk = i & 15; *(LAS u32x4*)(vt + row * 136 + chunk * 8) = *(const u32x4*)(P + (size_t)(r0 + row) * ABIN + PC_V + h * 128 + chunk * 8); }
            __syncthreads();
            gla_bcum(bc, lrt, wat, bat, 0, (LAS float*)(vt + 64 * 136));
            gla_bcum(bc + 4096, lrt + 1024, wat + 1024, bat + 64, 1, (LAS float*)(vt + 64 * 136));
            {
                const int t = tid >> 3, c8 = (tid & 7) * 8;
#pragma unroll
                for (int d = 0; d < 2; ++d) {
                    const LAS float* b = bc + d * 4096;
                    const int tl = d == 0 ? 63 : 0;
                    float o[8];
#pragma unroll
                    for (int j = 0; j < 8; ++j) o[j] = bf2f(kt[t * 72 + c8 + j]) * __expf(b[tl * 64 + c8 + j] - b[t * 64 + c8 + j]);
                    u32x4 v; v.x = pk2(o[0], o[1]); v.y = pk2(o[2], o[3]); v.z = pk2(o[4], o[5]); v.w = pk2(o[6], o[7]);
                    *(LAS u32x4*)(ktd + d * 64 * 72 + t * 72 + c8) = v;
                }
                if (tid < 128) { const int d = tid >> 6, c = tid & 63; DEC[(size_t)(ch * 2 + d) * 256 + h * 64 + c] = __expf(bc[d * 4096 + (d == 0 ? 63 : 0) * 64 + c]); }
            }
            __syncthreads();
            {
                const int d = w >> 2, dkt = w & 3;
                const LAS bf16_t* kd = ktd + d * 64 * 72;
                bf16x8 kb[2];
#pragma unroll
                for (int ks = 0; ks < 2; ++ks) kb[ks] = frag_tr(kd, 72, ks * 32, dkt * 16, lane);
                float* Ud = U + ((size_t)(ch * 2 + d) * 4 + h) * 8192;
#pragma unroll
                for (int dvt = 0; dvt < 8; ++dvt) {
                    f32x4 acc = {0.f, 0.f, 0.f, 0.f};
#pragma unroll
                    for (int ks = 0; ks < 2; ++ks) acc = mfma16(frag_tr(vt, 136, ks * 32, dvt * 16, lane), kb[ks], acc);
                    *(f32x4*)(Ud + (dkt * 16 + (lane & 15)) * 128 + dvt * 16 + 4 * (lane >> 4)) = acc;
                }
            }
            __syncthreads();
        } else {
            const int t2 = task - NGLA, ch = t2 >> 2, cq = t2 & 3, r0 = ch * 64;
            const int seg_lo = ch < NCHL ? r0 : NLAT + ((r0 - NLAT) >> 8) * 256, seg_hi = ch < NCHL ? r0 + 64 : seg_lo + 256;
            LAS bf16_t* xin = (LAS bf16_t*)lds;
            LAS bf16_t* xb = xin + 67 * 136;
            LAS float* lat = (LAS float*)(xb + 64 * 136);
            LAS bf16_t* git = (LAS bf16_t*)(lat + 2 * 64 * 128);
            for (int i = tid; i < 67 * 16; i += NTHREADS) {
                const int row = i >> 4, chunk = i & 15, r = r0 - 2 + row;
                u32x4 v = {0u, 0u, 0u, 0u};
                if (r >= seg_lo && r < seg_hi) v = *(const u32x4*)(P + (size_t)r * ABIN + PC_RGX + cq * 128 + chunk * 8);
                *(LAS u32x4*)(xin + row * 136 + chunk * 8) = v;
            }
            __syncthreads();
            {
                const int t = tid >> 3, c16 = (tid & 7) * 16;
                float o[16];
#pragma unroll
                for (int j = 0; j < 16; ++j) o[j] = p->rg_conv_b[cq * 128 + c16 + j];
#pragma unroll
                for (int tap = 0; tap < 4; ++tap)
#pragma unroll
                    for (int j = 0; j < 16; ++j) o[j] += p->rg_conv_w[tap * 512 + cq * 128 + c16 + j] * bf2f(xin[(t + tap) * 136 + c16 + j]);
#pragma unroll
                for (int j = 0; j < 16; j += 8) {
                    u32x4 v; v.x = pk2(o[j], o[j + 1]); v.y = pk2(o[j + 2], o[j + 3]); v.z = pk2(o[j + 4], o[j + 5]); v.w = pk2(o[j + 6], o[j + 7]);
                    *(LAS u32x4*)(xb + t * 136 + c16 + j) = v;
                }
            }
            __syncthreads();
            {
                const int blk = w & 1, d = (w >> 1) & 1, mat = w >> 2, n = cq * 2 + blk;
                const float* W = (mat ? p->rg_wi : p->rg_wr) + (size_t)(d * 8 + n) * 4096;
                const float* bias = (mat ? p->rg_bi : p->rg_br) + d * 512 + n * 64;
                bf16x8 wf[4][2];
#pragma unroll
                for (int ot = 0; ot < 4; ++ot)
#pragma unroll
                    for (int ks = 0; ks < 2; ++ks) {
                        const float* src = W + (size_t)(ks * 32 + 8 * (lane >> 4)) * 64 + ot * 16 + (lane & 15);
                        float f[8];
#pragma unroll
                        for (int j = 0; j < 8; ++j) f[j] = src[j * 64];
                        u32x4 v; v.x = pk2n(f[0], f[1]); v.y = pk2n(f[2], f[3]); v.z = pk2n(f[4], f[5]); v.w = pk2n(f[6], f[7]);
                        wf[ot][ks] = __builtin_bit_cast(bf16x8, v);
                    }
#pragma unroll
                for (int tt = 0; tt < 4; ++tt) {
                    bf16x8 xf[2];
#pragma unroll
                    for (int ks = 0; ks < 2; ++ks) xf[ks] = frag_row(xb, 136, tt * 16, blk * 64 + ks * 32, lane);
#pragma unroll
                    for (int ot = 0; ot < 4; ++ot) {
                        f32x4 acc = {0.f, 0.f, 0.f, 0.f};
#pragma unroll
                        for (int ks = 0; ks < 2; ++ks) acc = mfma16(wf[ot][ks], xf[ks], acc);
                        const int t = tt * 16 + (lane & 15), o = ot * 16 + 4 * (lane >> 4), c = blk * 64 + o;
                        const f32x4 bv = *(const f32x4*)(bias + o);
                        if (mat == 0) {
                            const f32x4 lam = *(const f32x4*)(p->rg_lambda + d * 512 + n * 64 + o);
                            f32x4 la;
#pragma unroll
                            for (int j = 0; j < 4; ++j) la[j] = -8.f * softplusf_(-lam[j]) * sigmoidf_(acc[j] + bv[j]);
                            *(LAS f32x4*)(lat + (d * 64 + t) * 128 + c) = la;
                        } else {
                            float gi[4];
#pragma unroll
                            for (int j = 0; j < 4; ++j) gi[j] = sigmoidf_(acc[j] + bv[j]) * bf2f(xb[t * 136 + c + j]);
                            u32x2 v; v.x = pk2(gi[0], gi[1]); v.y = pk2(gi[2], gi[3]);
                            *(LAS u32x2*)(git + (d * 64 + t) * 128 + c) = v;
                        }
                    }
                }
            }
            __syncthreads();
            {
                const int c4 = (tid & 31) * 4, rest = tid >> 5, d = rest >> 3, t0 = (rest & 7) * 8, gc = cq * 128 + c4;
#pragma unroll
                for (int j = 0; j < 8; ++j) {
                    const int t = t0 + j;
                    const f32x4 la = *(const LAS f32x4*)(lat + (d * 64 + t) * 128 + c4);
                    const u32x2 gg = *(const LAS u32x2*)(git + (d * 64 + t) * 128 + c4);
                    f32x4 av; float u[4];
                    const float gi[4] = {lo_bf(gg.x), hi_bf(gg.x), lo_bf(gg.y), hi_bf(gg.y)};
#pragma unroll
                    for (int e = 0; e < 4; ++e) { av[e] = __expf(la[e]); u[e] = sqrtf(-expm1f(2.f * la[e])) * gi[e]; }
                    u32x2 uo; uo.x = pk2(u[0], u[1]); uo.y = pk2(u[2], u[3]);
                    *(f32x4*)(LA + ((size_t)(r0 + t) * 2 + d) * 512 + gc) = la;
                    *(u32x2*)(UU + ((size_t)(r0 + t) * 2 + d) * 512 + gc) = uo;
                    *(LAS f32x4*)(lat + (d * 64 + t) * 128 + c4) = av;
                    *(LAS u32x2*)(git + (d * 64 + t) * 128 + c4) = uo;
                }
            }
            __syncthreads();
            {
                const int half = tid >> 8, d = (tid >> 7) & 1, c = tid & 127, gc = cq * 128 + c;
                float hacc = 0.f, aprod = 1.f;
#pragma unroll 8
                for (int s_ = 0; s_ < 32; ++s_) {
                    const int pp = half * 32 + s_, t = d == 0 ? pp : 63 - pp;
                    const float a = lat[(d * 64 + t) * 128 + c], u = bf2f(git[(d * 64 + t) * 128 + c]);
                    hacc = a * hacc + u; aprod *= a;
                }
                LAS float* comb = (LAS float*)xin;
                comb[(half * 256 + d * 128 + c) * 2] = aprod; comb[(half * 256 + d * 128 + c) * 2 + 1] = hacc;
                __syncthreads();
                if (half == 0) {
                    const float a1 = comb[(256 + d * 128 + c) * 2], h1 = comb[(256 + d * 128 + c) * 2 + 1];
                    AGGA[(size_t)(ch * 2 + d) * 512 + gc] = aprod * a1;
                    AGGH[(size_t)(ch * 2 + d) * 512 + gc] = a1 * hacc + h1;
                }
            }
            __syncthreads();
        }
    }
}

DI int scan_chunk(int b, int d, int st) {
    if (st < 4) return NCHL + b * 4 + (d == 0 ? st : 3 - st);
    const int j = st - 4;
    return b * 128 + (d == 0 ? j : 127 - j);
}

DI void phase_scan0(PP p) {
    float* U = (float*)(p->ws + OFF_ARENA + A_U);
    const float* DEC = (const float*)(p->ws + OFF_ARENA + A_DEC);
    const float* AGGA = (const float*)(p->ws + OFF_ARENA + A_AGGA);
    float* AGGH = (float*)(p->ws + OFF_ARENA + A_AGGH);
    const int gid = get_bid() * NTHREADS + get_tid(), nthr = gridDim.x * NTHREADS;
    for (int idx = gid; idx < 65536 + 4096; idx += nthr) {
        if (idx < 65536) {
            const int dv4 = idx & 31, dk = (idx >> 5) & 63, h = (idx >> 11) & 3, d = (idx >> 13) & 1, b = idx >> 14;
            f32x4 S = {0.f, 0.f, 0.f, 0.f};
            for (int st = 0; st < 132; st += 4) {
                f32x4 u[4]; float dc[4]; float* ptr[4];
#pragma unroll
                for (int q = 0; q < 4; ++q) {
                    const int cid = scan_chunk(b, d, st + q);
                    ptr[q] = U + ((size_t)(cid * 2 + d) * 4 + h) * 8192 + dk * 128 + dv4 * 4;
                    u[q] = *(const f32x4*)ptr[q];
                    dc[q] = DEC[(size_t)(cid * 2 + d) * 256 + h * 64 + dk];
                }
#pragma unroll
                for (int q = 0; q < 4; ++q) { *(f32x4*)ptr[q] = S; S = S * dc[q] + u[q]; }
            }
        } else {
            const int i2 = idx - 65536, c = i2 & 511, d = (i2 >> 9) & 1, b = i2 >> 10;
            float hs = 0.f;
            for (int st = 0; st < 132; st += 4) {
                float a[4], hh[4]; float* ptr[4];
#pragma unroll
                for (int q = 0; q < 4; ++q) {
                    const int cid = scan_chunk(b, d, st + q);
                    ptr[q] = AGGH + (size_t)(cid * 2 + d) * 512 + c;
                    hh[q] = *ptr[q]; a[q] = AGGA[(size_t)(cid * 2 + d) * 512 + c];
                }
#pragma unroll
                for (int q = 0; q < 4; ++q) { *ptr[q] = hs; hs = a[q] * hs + hh[q]; }
            }
        }
    }
}

DI void phase_g3(PP p, lds_t lds) {
    const int tid = get_tid(), lane = tid & 63, w = tid >> 6;
    const bf16_t* P = (const bf16_t*)(p->ws + OFF_ARENA + A_P);
    const float* U = (const float*)(p->ws + OFF_ARENA + A_U);
    const float* LA = (const float*)(p->ws + OFF_ARENA + A_LA);
    const bf16_t* UU = (const bf16_t*)(p->ws + OFF_ARENA + A_UU);
    const float* HST = (const float*)(p->ws + OFF_ARENA + A_AGGH);
    bf16_t* act = (bf16_t*)(p->ws + OFF_ACT);
    constexpr int NGLA = NCH * 4;
    for (int task = get_bid(); task < NGLA + NCH; task += gridDim.x) {
        if (task < NGLA) {
            const int ch = task >> 2, h = task & 3, r0 = ch * 64;
            LAS float* lrt = (LAS float*)lds;
            LAS float* wat = lrt + 2048;
            LAS float* bat = wat + 2048;
            LAS float* bc = bat + 128;
            LAS bf16_t* qt = (LAS bf16_t*)(bc + 4096);
            LAS bf16_t* kt = qt + 64 * 72;
            LAS bf16_t* qtd = kt + 64 * 72;
            LAS bf16_t* ktd = qtd + 64 * 72;
            LAS bf16_t* at = ktd + 64 * 72;
            LAS bf16_t* vt = at + 64 * 72;
            LAS bf16_t* St = vt + 64 * 136;
            LAS float* ot = (LAS float*)(St + 64 * 136);
            gla_load_decay_inputs(p, P, r0, h, lrt, wat, bat);
            { const int row = tid >> 3, chunk = tid & 7;
              *(LAS u32x4*)(qt + row * 72 + chunk * 8) = *(const u32x4*)(P + (size_t)(r0 + row) * ABIN + PC_Q + h * 64 + chunk * 8);
              *(LAS u32x4*)(kt + row * 72 + chunk * 8) = *(const u32x4*)(P + (size_t)(r0 + row) * ABIN + PC_K + h * 64 + chunk * 8); }
#pragma unroll
            for (int q = 0; q < 2; ++q) { const int i = tid + 512 * q, row = i >> 4, chunk = i & 15; *(LAS u32x4*)(vt + row * 136 + chunk * 8) = *(const u32x4*)(P + (size_t)(r0 + row) * ABIN + PC_V + h * 128 + chunk * 8); }
            __syncthreads();
            f32x4 oacc[4];
#pragma unroll
            for (int i = 0; i < 4; ++i) oacc[i] = (f32x4){0.f, 0.f, 0.f, 0.f};
            const int ott = w & 3, odv0 = (w >> 2) * 4;
            for (int d = 0; d < 2; ++d) {
                gla_bcum(bc, lrt + d * 1024, wat + d * 1024, bat + d * 64, d, ot);
                {
                    const int t = tid >> 3, c8 = (tid & 7) * 8;
                    float qo[8], ko[8];
#pragma unroll
                    for (int j = 0; j < 8; ++j) { const float e = __expf(bc[t * 64 + c8 + j]); qo[j] = bf2f(qt[t * 72 + c8 + j]) * 0.125f * e; ko[j] = bf2f(kt[t * 72 + c8 + j]) / e; }
                    u32x4 v; v.x = pk2(qo[0], qo[1]); v.y = pk2(qo[2], qo[3]); v.z = pk2(qo[4], qo[5]); v.w = pk2(qo[6], qo[7]);
                    *(LAS u32x4*)(qtd + t * 72 + c8) = v;
                    v.x = pk2(ko[0], ko[1]); v.y = pk2(ko[2], ko[3]); v.z = pk2(ko[4], ko[5]); v.w = pk2(ko[6], ko[7]);
                    *(LAS u32x4*)(ktd + t * 72 + c8) = v;
                    const int dk = tid >> 3, dv16 = (tid & 7) * 16;
                    const float* src = U + ((size_t)(ch * 2 + d) * 4 + h) * 8192 + dk * 128 + dv16;
                    const f32x4 s0 = *(const f32x4*)src, s1 = *(const f32x4*)(src + 4), s2 = *(const f32x4*)(src + 8), s3 = *(const f32x4*)(src + 12);
                    v.x = pk2(s0[0], s0[1]); v.y = pk2(s0[2], s0[3]); v.z = pk2(s1[0], s1[1]); v.w = pk2(s1[2], s1[3]);
                    *(LAS u32x4*)(St + dk * 136 + dv16) = v;
                    v.x = pk2(s2[0], s2[1]); v.y = pk2(s2[2], s2[3]); v.z = pk2(s3[0], s3[1]); v.w = pk2(s3[2], s3[3]);
                    *(LAS u32x4*)(St + dk * 136 + dv16 + 8) = v;
                }
                __syncthreads();
                {
                    const int tt = w >> 1;
#pragma unroll
                    for (int e = 0; e < 2; ++e) {
                        const int st = (w & 1) * 2 + e;
                        f32x4 acc = {0.f, 0.f, 0.f, 0.f};
#pragma unroll
                        for (int ks = 0; ks < 2; ++ks) acc = mfma16(frag_row(ktd, 72, st * 16, ks * 32, lane), frag_row(qtd, 72, tt * 16, ks * 32, lane), acc);
                        const int t = tt * 16 + (lane & 15), s0 = st * 16 + 4 * (lane >> 4);
                        float a[4];
#pragma unroll
                        for (int j = 0; j < 4; ++j) { const int s = s0 + j; a[j] = (d == 0 ? s <= t : s >= t) ? acc[j] : 0.f; }
                        u32x2 v; v.x = pk2(a[0], a[1]); v.y = pk2(a[2], a[3]);
                        *(LAS u32x2*)(at + t * 72 + s0) = v;
                    }
                }
                __syncthreads();
                {
                    bf16x8 af[2], qf[2];
#pragma unroll
                    for (int ks = 0; ks < 2; ++ks) { af[ks] = frag_row(at, 72, ott * 16, ks * 32, lane); qf[ks] = frag_row(qtd, 72, ott * 16, ks * 32, lane); }
#pragma unroll
                    for (int i = 0; i < 4; ++i) {
                        const int dvt = odv0 + i;
#pragma unroll
                        for (int ks = 0; ks < 2; ++ks) {
                            oacc[i] = mfma16(frag_tr(vt, 136, ks * 32, dvt * 16, lane), af[ks], oacc[i]);
                            oacc[i] = mfma16(frag_tr(St, 136, ks * 32, dvt * 16, lane), qf[ks], oacc[i]);
                        }
                    }
                }
                __syncthreads();
            }
#pragma unroll
            for (int i = 0; i < 4; ++i) *(LAS f32x4*)(ot + (ott * 16 + (lane & 15)) * 132 + (odv0 + i) * 16 + 4 * (lane >> 4)) = oacc[i];
            __syncthreads();
            {
                const int t = tid >> 3, dv16 = (tid & 7) * 16;
                float o[16]; float ss = 0.f;
#pragma unroll
                for (int j = 0; j < 16; ++j) { o[j] = ot[t * 132 + dv16 + j]; ss += o[j] * o[j]; }
                ss += __shfl_xor(ss, 1); ss += __shfl_xor(ss, 2); ss += __shfl_xor(ss, 4);
                const float rs = rsqrtf(ss * (1.f / 128.f) + EPS);
                const bf16_t* gp = P + (size_t)(r0 + t) * ABIN + PC_G + h * 128 + dv16;
                const u32x4 g0 = *(const u32x4*)gp, g1 = *(const u32x4*)(gp + 8);
                const unsigned gw[8] = {g0.x, g0.y, g0.z, g0.w, g1.x, g1.y, g1.z, g1.w};
                float r[16];
#pragma unroll
                for (int j = 0; j < 8; ++j) {
                    r[2 * j] = o[2 * j] * rs * p->gla_norm_g[h * 128 + dv16 + 2 * j] * siluf_(lo_bf(gw[j]));
                    r[2 * j + 1] = o[2 * j + 1] * rs * p->gla_norm_g[h * 128 + dv16 + 2 * j + 1] * siluf_(hi_bf(gw[j]));
                }
                bf16_t* dst = act + (size_t)(r0 + t) * 1024 + h * 128 + dv16;
                u32x4 v; v.x = pk2(r[0], r[1]); v.y = pk2(r[2], r[3]); v.z = pk2(r[4], r[5]); v.w = pk2(r[6], r[7]);
                *(u32x4*)dst = v;
                v.x = pk2(r[8], r[9]); v.y = pk2(r[10], r[11]); v.z = pk2(r[12], r[13]); v.w = pk2(r[14], r[15]);
                *(u32x4*)(dst + 8) = v;
            }
            __syncthreads();
        } else {
            const int ch = task - NGLA, r0 = ch * 64, c = tid;
            LAS float* hf = (LAS float*)lds;
            float hs = HST[(size_t)(ch * 2 + 0) * 512 + c];
            for (int tb = 0; tb < 64; tb += 16) {
                float la[16]; bf16_t uu[16];
#pragma unroll
                for (int j = 0; j < 16; ++j) { const size_t o = ((size_t)(r0 + tb + j) * 2 + 0) * 512 + c; la[j] = LA[o]; uu[j] = UU[o]; }
#pragma unroll
                for (int j = 0; j < 16; ++j) { hs = __expf(la[j]) * hs + bf2f(uu[j]); hf[(tb + j) * 512 + c] = hs; }
            }
            hs = HST[(size_t)(ch * 2 + 1) * 512 + c];
            for (int tb = 48; tb >= 0; tb -= 16) {
                float la[16]; bf16_t uu[16], gg[16];
#pragma unroll
                for (int j = 0; j < 16; ++j) { const size_t o = ((size_t)(r0 + tb + j) * 2 + 1) * 512 + c; la[j] = LA[o]; uu[j] = UU[o]; gg[j] = P[(size_t)(r0 + tb + j) * ABIN + PC_RGG + c]; }
#pragma unroll
                for (int j = 15; j >= 0; --j) {
                    hs = __expf(la[j]) * hs + bf2f(uu[j]);
                    act[(size_t)(r0 + tb + j) * 1024 + 512 + c] = f2bf((hf[(tb + j) * 512 + c] + hs) * gelu_tanh(bf2f(gg[j])));
                }
            }
            __syncthreads();
        }
    }
}


DI void phase_outproj0(PP p, lds_t lds) {
    const bf16_t* act = (const bf16_t*)(p->ws + OFF_ACT);
    float* X = (float*)(p->ws + OFF_ARENA + A_X);
    constexpr int NM = NTOK / 256, NN = 4;
    for (int u = get_bid(); u < NM * NN; u += gridDim.x) {
        const int pn = u / NM, pm = u % NM;
        const int set = row_set(pm * 256);
        const float* g1 = mods_ptr(p, 0, set, 2);
        const float* xin = pm * 256 < NLAT ? p->x + (size_t)pm * 256 * 1024 : p->ctx + (size_t)(pm * 256 - NLAT) * 1024;
        gemm_unit<256>(lds, 1024, 1024,
            [&](int r) { return act + (size_t)(pm * 256 + r) * 1024; },
            [&](int j) -> const float* { return p->ab_w_out + pn * 256 + j; },
            [&](const f32x4 (&acc)[8][4], int wr, int wc, int lane) {
                epi_each<4>(acc, wr, wc, lane, [&](int r, int c, f32x4 v) {
                    const int col = pn * 256 + c;
                    const f32x4 xi = *(const f32x4*)(xin + (size_t)r * 1024 + col), g = *(const f32x4*)(g1 + col);
                    *(f32x4*)(X + (size_t)(pm * 256 + r) * 1024 + col) = xi + g * v;
                });
            });
    }
}

struct MoeBufs { float* PT; float* PE; int* ROWID; int* ROWTOK; bf16_t* HDN; bf16_t* Y; int rpe; int nrows; };
DI MoeBufs moe_bufs(PP p, int layer) {
    MoeBufs m;
    char* a = p->ws + OFF_ARENA;
    if (layer == 0) { m.PT = (float*)(a + A_PT); m.PE = (float*)(a + A_PE); m.ROWID = (int*)(a + A_ROWID); m.ROWTOK = (int*)(a + A_ROWTOK); m.HDN = (bf16_t*)(a + A_HDN); m.Y = (bf16_t*)(a + A_Y); m.rpe = 4352; m.nrows = NTOK; }
    else { m.PT = (float*)(a + A_HB); m.PE = (float*)(a + A_HB + (size_t)NTOK * 64); m.ROWID = (int*)(a + A_HB + (size_t)NTOK * 128); m.ROWTOK = (int*)(a + A_HB + (size_t)NTOK * 192); m.HDN = (bf16_t*)(a + A_XM); m.Y = (bf16_t*)(a + A_XC); m.rpe = 4096; m.nrows = NLAT; }
    return m;
}

DI void phase_router(PP p, lds_t lds, int layer) {
    const int tid = get_tid(), lane = tid & 63;
    const MoeBufs m = moe_bufs(p, layer);
    const float* X = (const float*)(p->ws + OFF_ARENA + A_X);
    bf16_t* act = (bf16_t*)(p->ws + OFF_ACT);
    LAS float* rwT = (LAS float*)lds;
    for (int i = tid; i < 16384; i += NTHREADS) { const int k = i >> 4, e = i & 15; rwT[e * 1024 + k] = p->router_w[(size_t)layer * 16384 + i]; }
    __syncthreads();
    const int gw = get_bid() * 8 + (tid >> 6), nw = gridDim.x * 8;
    for (int r = gw; r < m.nrows; r += nw) {
        f32x4 v[4];
        row_load_f32(X + (size_t)r * 1024, v, lane);
        const float rs = rsqrtf(row_sumsq(v) * (1.f / 1024.f) + EPS);
        const int set = row_set(r);
        row_modulate(v, rs, p->norm2_g + layer * 1024, mods_ptr(p, layer, set, 4), mods_ptr(p, layer, set, 3), lane);
        row_store_bf16(act + (size_t)r * 1024, v, lane);
        float lg[16];
#pragma unroll
        for (int e = 0; e < 16; ++e) {
            float a = 0.f;
#pragma unroll
            for (int i = 0; i < 4; ++i) { const f32x4 wv = *(const LAS f32x4*)(rwT + e * 1024 + 4 * lane + 256 * i); a += v[i][0] * wv[0] + v[i][1] * wv[1] + v[i][2] * wv[2] + v[i][3] * wv[3]; }
            lg[e] = wave_sum(a);
            asm volatile("" ::: "memory");
        }
        float mx = lg[0];
#pragma unroll
        for (int e = 1; e < 16; ++e) mx = fmaxf(mx, lg[e]);
        float sum = 0.f;
#pragma unroll
        for (int e = 0; e < 16; ++e) { lg[e] = __expf(lg[e] - mx); sum += lg[e]; }
        const float inv = 1.f / sum;
        float mine = 0.f;
#pragma unroll
        for (int e = 0; e < 16; ++e) if (lane == e) mine = lg[e] * inv;
        if (lane < 16) {
            m.PT[(size_t)r * 16 + lane] = mine;
            if (r < NLAT) m.PE[((size_t)(r >> 13) * 16 + lane) * 8192 + (r & 8191)] = mine;
            else { const int rc = r - NLAT; m.PE[(size_t)NBATCH * 16 * 8192 + ((size_t)(rc >> 8) * 16 + lane) * 256 + (rc & 255)] = mine; }
        }
    }
}

DI int block_excl_scan(int v, LAS int* tmp, int* total) {
    const int tid = get_tid(), lane = tid & 63, w = tid >> 6;
    int inc = v;
#pragma unroll
    for (int o = 1; o < 64; o <<= 1) { const int t = __shfl_up(inc, o); if (lane >= o) inc += t; }
    __syncthreads();
    if (lane == 63) tmp[w] = inc;
    __syncthreads();
    int base = 0, tot = 0;
#pragma unroll
    for (int i = 0; i < 8; ++i) { const int t = tmp[i]; if (i < w) base += t; tot += t; }
    *total = tot;
    return base + inc - v;
}

DI void phase_topk(PP p, lds_t lds, int layer) {
    const int tid = get_tid();
    const MoeBufs m = moe_bufs(p, layer);
    LAS unsigned* keys = (LAS unsigned*)lds;
    LAS int* hist = (LAS int*)(keys + 8192);
    LAS int* tmp = hist + 256;
    LAS int* sel = tmp + 16;
    const int ntask = layer == 0 ? 128 : 64;
    for (int task = get_bid(); task < ntask; task += gridDim.x) {
        const bool isctx = task >= 64;
        const int b = (task & 63) >> 4, e = task & 15;
        const int n = isctx ? 256 : 8192, cap = isctx ? 32 : 1024;
        const float* src = isctx ? m.PE + (size_t)NBATCH * 16 * 8192 + ((size_t)b * 16 + e) * 256 : m.PE + ((size_t)b * 16 + e) * 8192;
        for (int i = tid; i < n; i += NTHREADS) keys[i] = __float_as_uint(src[i]);
        __syncthreads();
        unsigned prefix = 0u, mask = 0u; int kk = cap;
        for (int pass = 3; pass >= 0; --pass) {
            const int shift = pass * 8;
            if (tid < 256) hist[tid] = 0;
            __syncthreads();
            for (int i = tid; i < n; i += NTHREADS) { const unsigned k = keys[i]; if ((k & mask) == prefix) __hip_atomic_fetch_add((int*)(hist + ((k >> shift) & 255)), 1, __ATOMIC_RELAXED, __HIP_MEMORY_SCOPE_WORKGROUP); }
            __syncthreads();
            if (tid < 256) {
                int above = 0;
                for (int j = tid + 1; j < 256; ++j) above += hist[j];
                const int mineh = hist[tid];
                if (above < kk && kk <= above + mineh) { sel[0] = tid; sel[1] = above; }
            }
            __syncthreads();
            prefix |= (unsigned)sel[0] << shift; mask |= 0xffu << shift; kk -= sel[1];
            __syncthreads();
        }
        const unsigned T = prefix; const int need_eq = kk;
        const int ipt = n / NTHREADS > 0 ? n / NTHREADS : 1;
        const int i0 = tid * ipt;
        int cgt = 0, ceq = 0;
        if (i0 < n) for (int j = 0; j < ipt; ++j) { const unsigned k = keys[i0 + j]; cgt += k > T; ceq += k == T; }
        int tot;
        const int egt = block_excl_scan(cgt, tmp, &tot);
        const int eeq = block_excl_scan(ceq, tmp, &tot);
        const int slot0 = e * m.rpe + (isctx ? 4096 + b * 32 : b * 1024);
        const int row0 = isctx ? NLAT + b * 256 : b * 8192;
        if (i0 < n) {
            int ngt = egt, neq = eeq;
            for (int j = 0; j < ipt; ++j) {
                const unsigned k = keys[i0 + j];
                int slot = -1;
                if (k > T) { slot = slot0 + ngt + (neq < need_eq ? neq : need_eq); ++ngt; }
                else if (k == T) { if (neq < need_eq) slot = slot0 + ngt + neq; ++neq; }
                m.ROWID[(size_t)(row0 + i0 + j) * 16 + e] = slot;
                if (slot >= 0) m.ROWTOK[slot] = row0 + i0 + j;
            }
        }
        if (isctx && b == 0 && layer == 0) for (int i = tid; i < 128; i += NTHREADS) m.ROWTOK[e * m.rpe + 4224 + i] = -1;
        __syncthreads();
    }
}

DI void phase_moe_up(PP p, lds_t lds, int layer) {
    const MoeBufs m = moe_bufs(p, layer);
    const bf16_t* act = (const bf16_t*)(p->ws + OFF_ACT);
    const int nmt = layer == 0 ? 17 : 16;
    const int nunits = 16 * nmt * 8;
    for (int u = get_bid(); u < nunits; u += gridDim.x) {
        const int e = u / (nmt * 8), rem = u % (nmt * 8), nt = rem / nmt, mt = rem % nmt;
        const float* Wg = p->exp_w_gate + ((size_t)layer * 16 + e) * 1048576;
        const float* Wu = p->exp_w_up + ((size_t)layer * 16 + e) * 1048576;
        const int* rt = m.ROWTOK + e * m.rpe + mt * 256;
        bf16_t* H = m.HDN + ((size_t)e * m.rpe + mt * 256) * 1024 + nt * 128;
        gemm_unit<256>(lds, 1024, 1024,
            [&](int r) -> const bf16_t* { const int tok = rt[r]; return tok >= 0 ? act + (size_t)tok * 1024 : nullptr; },
            [&](int j) -> const float* { const int wcq = j >> 6, within = j & 63; const int hc = nt * 128 + wcq * 32 + (within & 31); return (within < 32 ? Wg : Wu) + hc; },
            [&](const f32x4 (&acc)[8][4], int wr, int wc, int lane) {
#pragma unroll
                for (int mi = 0; mi < 8; ++mi)
#pragma unroll
                    for (int ni = 0; ni < 2; ++ni) {
                        const f32x4 g = acc[mi][ni], uu = acc[mi][ni + 2];
                        f32x4 h;
#pragma unroll
                        for (int j = 0; j < 4; ++j) h[j] = siluf_(g[j]) * uu[j];
                        store_bf16x4(H + (size_t)(wr * 128 + mi * 16 + (lane & 15)) * 1024 + wc * 32 + ni * 16 + 4 * (lane >> 4), h);
                    }
            });
    }
}

DI void phase_moe_down(PP p, lds_t lds, int layer) {
    const MoeBufs m = moe_bufs(p, layer);
    const int nmt = layer == 0 ? 17 : 16;
    const int nunits = 16 * nmt * 4;
    for (int u = get_bid(); u < nunits; u += gridDim.x) {
        const int e = u / (nmt * 4), rem = u % (nmt * 4), nt = rem / nmt, mt = rem % nmt;
        const float* Wd = p->exp_w_down + ((size_t)layer * 16 + e) * 1048576;
        const bf16_t* H = m.HDN + ((size_t)e * m.rpe + mt * 256) * 1024;
        bf16_t* Y = m.Y + ((size_t)e * m.rpe + mt * 256) * 1024 + nt * 256;
        gemm_unit<256>(lds, 1024, 1024,
            [&](int r) { return H + (size_t)r * 1024; },
            [&](int j) -> const float* { return Wd + nt * 256 + j; },
            [&](const f32x4 (&acc)[8][4], int wr, int wc, int lane) {
                epi_each<4>(acc, wr, wc, lane, [&](int r, int c, f32x4 v) { store_bf16x4(Y + (size_t)r * 1024 + c, v); });
            });
    }
}

DI void phase_combine(PP p, int layer) {
    const int tid = get_tid(), lane = tid & 63;
    const MoeBufs m = moe_bufs(p, layer);
    float* X = (float*)(p->ws + OFF_ARENA + A_X);
    bf16_t* act = (bf16_t*)(p->ws + OFF_ACT);
    const int gw = get_bid() * 8 + (tid >> 6), nw = gridDim.x * 8;
    for (int r = gw; r < m.nrows; r += nw) {
        f32x4 v[4], a[4];
        row_load_f32(X + (size_t)r * 1024, v, lane);
#pragma unroll
        for (int i = 0; i < 4; ++i) a[i] = (f32x4){0.f, 0.f, 0.f, 0.f};
        for (int e = 0; e < 16; ++e) {
            const int rid = m.ROWID[(size_t)r * 16 + e];
            if (rid >= 0) {
                const float pe = m.PT[(size_t)r * 16 + e];
                const bf16_t* y = m.Y + (size_t)rid * 1024;
#pragma unroll
                for (int i = 0; i < 4; ++i) { const u32x2 yy = *(const u32x2*)(y + 4 * lane + 256 * i); a[i][0] += pe * lo_bf(yy.x); a[i][1] += pe * hi_bf(yy.x); a[i][2] += pe * lo_bf(yy.y); a[i][3] += pe * hi_bf(yy.y); }
            }
        }
        const int set = row_set(r);
        const float* g2 = mods_ptr(p, layer, set, 5);
#pragma unroll
        for (int i = 0; i < 4; ++i) { const f32x4 g = *(const f32x4*)(g2 + 4 * lane + 256 * i); v[i] = v[i] + g * a[i]; }
        const float rs = rsqrtf(row_sumsq(v) * (1.f / 1024.f) + EPS);
        if (layer == 0) {
#pragma unroll
            for (int i = 0; i < 4; ++i) *(f32x4*)(X + (size_t)r * 1024 + 4 * lane + 256 * i) = v[i];
            row_modulate(v, rs, p->norm1_g + 1024, mods_ptr(p, 1, set, 1), mods_ptr(p, 1, set, 0), lane);
            row_store_bf16(act + (size_t)r * 1024, v, lane);
        } else {
#pragma unroll
            for (int i = 0; i < 4; ++i) { const f32x4 g = *(const f32x4*)(p->final_g + 4 * lane + 256 * i); *(f32x4*)(p->out + (size_t)r * 1024 + 4 * lane + 256 * i) = v[i] * rs * g; }
        }
    }
}


DI void phase_upproj(PP p, lds_t lds, int half) {
    const bf16_t* act = (const bf16_t*)(p->ws + OFF_ACT);
    bf16_t* O = (bf16_t*)(p->ws + OFF_ARENA + A_XM);
    const int NM = half == 0 ? NTOK / 256 : NLAT / 256, NN = 8;
    for (int u = get_bid(); u < NM * NN; u += gridDim.x) {
        const int pn = u / NM, pm = u % NM;
        gemm_unit<256>(lds, 1024, 4096,
            [&](int r) { return act + (size_t)(pm * 256 + r) * 1024; },
            [&](int j) -> const float* { return p->m_w_up + half * 2048 + pn * 256 + j; },
            [&](const f32x4 (&acc)[8][4], int wr, int wc, int lane) {
                epi_each<4>(acc, wr, wc, lane, [&](int r, int c, f32x4 v) { store_bf16x4(O + (size_t)(pm * 256 + r) * 2048 + pn * 256 + c, v); });
            });
    }
}

DI void phase_mfeat(PP p, lds_t lds) {
    const int tid = get_tid(), lane = tid & 63, w = tid >> 6;
    bf16_t* XM = (bf16_t*)(p->ws + OFF_ARENA + A_XM);
    bf16_t* XC = (bf16_t*)(p->ws + OFF_ARENA + A_XC);
    bf16_t* CTXV = (bf16_t*)(p->ws + OFF_ACT + ACT_CTXV);
    bf16_t* RAWS = (bf16_t*)(p->ws + OFF_ACT + ACT_RAWS);
    float* GP = (float*)(p->ws + OFF_ACT + ACT_GP);
    const bf16_t* GC = (const bf16_t*)(p->ws + OFF_GCAT);
    const float* MM = (const float*)(p->ws + OFF_MMAT);
    LAS bf16_t* xin = (LAS bf16_t*)lds;
    LAS bf16_t* xct = xin + 67 * 136;
    LAS bf16_t* qpt = xct + 64 * 136;
    LAS bf16_t* gxc = qpt + 64 * 136;
    LAS bf16_t* gxm = gxc + 128 * 16;
    LAS float* mq = (LAS float*)(gxm + 128 * 16);
    LAS float* wvq = mq + 512;
    LAS float* cw = wvq + 512;
    LAS float* gred = cw + 640;
    for (int task = get_bid(); task < NCH * 4; task += gridDim.x) {
        const int ch = task >> 2, h = task & 3, r0 = ch * 64;
        const int seg_lo = ch < NCHL ? r0 : NLAT + ((r0 - NLAT) >> 8) * 256, seg_hi = ch < NCHL ? r0 + 64 : seg_lo + 256;
        f32x4 rs_acc[2] = {{0.f, 0.f, 0.f, 0.f}, {0.f, 0.f, 0.f, 0.f}};
        f32x4 g_acc = {0.f, 0.f, 0.f, 0.f};
        for (int q4 = 0; q4 < 4; ++q4) {
            const int col0 = h * 512 + q4 * 128;
            for (int i = tid; i < 67 * 16; i += NTHREADS) {
                const int row = i >> 4, chunk = i & 15, r = r0 - 2 + row;
                u32x4 v = {0u, 0u, 0u, 0u};
                if (r >= seg_lo && r < seg_hi) v = *(const u32x4*)(XM + (size_t)r * 2048 + col0 + chunk * 8);
                *(LAS u32x4*)(xin + row * 136 + chunk * 8) = v;
            }
            if (tid < 256) *(LAS u32x4*)(gxc + tid * 8) = *(const u32x4*)(GC + (size_t)col0 * 16 + tid * 8);
            else *(LAS u32x4*)(gxm + (tid - 256) * 8) = *(const u32x4*)(GC + (size_t)(2048 + col0) * 16 + (tid - 256) * 8);
            mq[tid] = bf2f(f2bf(MM[(size_t)(col0 >> 2) * 16 + tid]));
            wvq[tid] = p->m_wv[(size_t)(col0 >> 2) * 16 + tid];
            for (int i = tid; i < 640; i += NTHREADS) cw[i] = i < 512 ? p->m_conv_w[(size_t)(i >> 7) * 2048 + col0 + (i & 127)] : p->m_conv_b[col0 + i - 512];
            __syncthreads();
            {
                const int t = tid >> 3, c16 = (tid & 7) * 16;
                float xc[16], xm[16];
#pragma unroll
                for (int j = 0; j < 16; ++j) { xc[j] = cw[512 + c16 + j]; xm[j] = bf2f(xin[(t + 2) * 136 + c16 + j]); }
#pragma unroll
                for (int tap = 0; tap < 4; ++tap)
#pragma unroll
                    for (int j = 0; j < 16; ++j) xc[j] += cw[tap * 128 + c16 + j] * bf2f(xin[(t + tap) * 136 + c16 + j]);
                unsigned xcp[8];
#pragma unroll
                for (int j = 0; j < 8; ++j) { xcp[j] = pk2(siluf_(xc[2 * j]), siluf_(xc[2 * j + 1])); xc[2 * j] = lo_bf(xcp[j]); xc[2 * j + 1] = hi_bf(xcp[j]); }
                float vv[16], qp[16];
#pragma unroll
                for (int n = 0; n < 4; ++n) {
                    const int nb = (c16 >> 2) + n;
#pragma unroll
                    for (int o = 0; o < 4; ++o) {
                        float a = 0.f, b = 0.f;
#pragma unroll
                        for (int i = 0; i < 4; ++i) { a += xm[4 * n + i] * wvq[nb * 16 + i * 4 + o]; b += xc[4 * n + i] * mq[nb * 16 + i * 4 + o]; }
                        vv[4 * n + o] = a; qp[4 * n + o] = b;
                    }
                }
                u32x4 v0, v1;
                v0.x = xcp[0]; v0.y = xcp[1]; v0.z = xcp[2]; v0.w = xcp[3]; v1.x = xcp[4]; v1.y = xcp[5]; v1.z = xcp[6]; v1.w = xcp[7];
                *(LAS u32x4*)(xct + t * 136 + c16) = v0; *(LAS u32x4*)(xct + t * 136 + c16 + 8) = v1;
                bf16_t* xcg = XC + (size_t)(r0 + t) * 2048 + col0 + c16;
                *(u32x4*)xcg = v0; *(u32x4*)(xcg + 8) = v1;
                v0.x = pk2(qp[0], qp[1]); v0.y = pk2(qp[2], qp[3]); v0.z = pk2(qp[4], qp[5]); v0.w = pk2(qp[6], qp[7]);
                v1.x = pk2(qp[8], qp[9]); v1.y = pk2(qp[10], qp[11]); v1.z = pk2(qp[12], qp[13]); v1.w = pk2(qp[14], qp[15]);
                *(LAS u32x4*)(qpt + t * 136 + c16) = v0; *(LAS u32x4*)(qpt + t * 136 + c16 + 8) = v1;
                v0.x = pk2(vv[0], vv[1]); v0.y = pk2(vv[2], vv[3]); v0.z = pk2(vv[4], vv[5]); v0.w = pk2(vv[6], vv[7]);
                v1.x = pk2(vv[8], vv[9]); v1.y = pk2(vv[10], vv[11]); v1.z = pk2(vv[12], vv[13]); v1.w = pk2(vv[14], vv[15]);
                bf16_t* vg = ch < NCHL ? XM + (size_t)(r0 + t) * 2048 + col0 + c16 : CTXV + (size_t)(r0 + t - NLAT) * 2048 + col0 + c16;
                *(u32x4*)vg = v0; *(u32x4*)(vg + 8) = v1;
            }
            __syncthreads();
            {
                const int tt = w >> 1;
#pragma unroll
                for (int e = 0; e < 2; ++e) {
                    const int st = (w & 1) * 2 + e;
#pragma unroll
                    for (int ks = 0; ks < 4; ++ks) rs_acc[e] = mfma16(frag_row(xct, 136, st * 16, ks * 32, lane), frag_row(qpt, 136, tt * 16, ks * 32, lane), rs_acc[e]);
                }
                const int gt = w & 3, src = w >> 2;
                const LAS bf16_t* gm = src ? gxm : gxc;
                const LAS bf16_t* ft = src ? xin + 2 * 136 : xct;
#pragma unroll
                for (int ks = 0; ks < 4; ++ks) g_acc = mfma16(frag_tr(gm, 16, ks * 32, 0, lane), frag_row(ft, 136, gt * 16, ks * 32, lane), g_acc);
            }
            __syncthreads();
        }
        {
            const int tt = w >> 1;
#pragma unroll
            for (int e = 0; e < 2; ++e) {
                const int st = (w & 1) * 2 + e;
                store_bf16x4(RAWS + ((size_t)task * 64 + tt * 16 + (lane & 15)) * 64 + st * 16 + 4 * (lane >> 4), rs_acc[e]);
            }
            const int gt = w & 3, src = w >> 2;
            *(LAS f32x4*)(gred + (src * 64 + gt * 16 + (lane & 15)) * 16 + 4 * (lane >> 4)) = g_acc;
        }
        __syncthreads();
        if (tid < 256) {
            const int t = tid >> 2, q = tid & 3;
            const f32x4 a = *(const LAS f32x4*)(gred + t * 16 + q * 4), b = *(const LAS f32x4*)(gred + (64 + t) * 16 + q * 4);
            *(f32x4*)(GP + ((size_t)(r0 + t) * 4 + h) * 16 + q * 4) = a + b;
        }
        __syncthreads();
    }
}

constexpr int MS_KLD = 1056, MS_QLD = 1040;
constexpr size_t ACT_MSC = 32u << 20;
static_assert(ACT_MSC >= ACT_CTXV + (size_t)NCTX * 2048 * 2 && ACT_MSC + (size_t)256 * 132 * 192 * 4 <= ACT_BYTES, "msc scratch");
#define MS_REGIONS(L) \
    lds_t xct = (L);                                                         \
    lds_t qpt = (L) + 64 * MS_KLD;                                           \
    LAS bf16_t* vt = (LAS bf16_t*)((L) + 64 * MS_KLD + 64 * MS_QLD);         \
    LAS bf16_t* St = vt + 4096;                                              \
    LAS bf16_t* vwt = St + 4096;                                             \
    LAS float* sc_b = (LAS float*)(vwt + 4096); \
    LAS float* sc_m = sc_b + 64; LAS float* sc_li = sc_m + 64; LAS float* sc_w = sc_li + 64; LAS float* sc_di = sc_w + 64; LAS float* sc_rs = sc_di + 64; \
    LAS float* sc_misc = sc_rs + 64;                                         \
    LAS float* qn = sc_misc + 8;                                             \
    LAS float* nvec = qn + 64;                                               \
    LAS float* red = (LAS float*)qpt;
DI void phase_mscan(PP p, lds_t lds) {
    const int tid = get_tid(), lane = tid & 63, w = tid >> 6, bid = get_bid();
    if (bid >= 256) return;
    const int grp = bid & 31, sl = bid >> 5, b = grp >> 3, h = (grp >> 1) & 3, d = grp & 1;
    const bf16_t* XC = (const bf16_t*)(p->ws + OFF_ARENA + A_XC);
    const bf16_t* V = (const bf16_t*)(p->ws + OFF_ARENA + A_XM);
    const bf16_t* CTXV = (const bf16_t*)(p->ws + OFF_ACT + ACT_CTXV);
    const bf16_t* RAWS = (const bf16_t*)(p->ws + OFF_ACT + ACT_RAWS);
    const float* GP = (const float*)(p->ws + OFF_ACT + ACT_GP);
    float* MSC = (float*)(p->ws + OFF_ACT + ACT_MSC) + (size_t)bid * 132 * 192;
    bf16_t* H = d == 0 ? (bf16_t*)p->out : (bf16_t*)(p->ws + OFF_ARENA + A_HB);
    static_assert(64 * MS_KLD + 64 * MS_QLD + 3 * 8192 + (6 * 64 + 8 + 64 + 512) * 4 <= LDS_BYTES, "mscan lds");
    {
        const float bias_i = p->m_b_gates[d * 8 + h], bias_f = p->m_b_gates[d * 8 + 4 + h];
        for (int st = w; st < 132; st += 8) {
            const int cid = scan_chunk(b, d, st), t = d ? 63 - lane : lane;
            const float* gp = GP + (size_t)(cid * 64 + t) * 64;
            const float gli = gp[d * 8 + h] + gp[16 + d * 8 + h] + gp[32 + d * 8 + h] + gp[48 + d * 8 + h] + bias_i;
            const float gf = gp[d * 8 + 4 + h] + gp[16 + d * 8 + 4 + h] + gp[32 + d * 8 + 4 + h] + gp[48 + d * 8 + 4 + h] + bias_f;
            float bb = log_sigmoidf_(gf);
#pragma unroll
            for (int o = 1; o < 64; o <<= 1) { const float t_ = __shfl_up(bb, o); if (lane >= o) bb += t_; }
            float pm = gli - bb;
#pragma unroll
            for (int o = 1; o < 64; o <<= 1) { const float t_ = __shfl_up(pm, o); if (lane >= o) pm = fmaxf(pm, t_); }
            float* dst = MSC + (size_t)st * 192;
            dst[lane] = bb; dst[64 + lane] = gli; dst[128 + lane] = pm;
        }
    }
    const int c16o = tid & 63;
    bf16x2_t Mp[2][4][2];
#pragma unroll
    for (int n = 0; n < 2; ++n) {
        const float* mm = (const float*)(p->ws + OFF_MMAT) + (size_t)(h * 128 + 2 * c16o + n) * 16;
#pragma unroll
        for (int o = 0; o < 4; ++o) { Mp[n][o][0] = __builtin_bit_cast(bf16x2_t, pk2(mm[o], mm[4 + o])); Mp[n][o][1] = __builtin_bit_cast(bf16x2_t, pk2(mm[8 + o], mm[12 + o])); }
    }
    f32x4 C[16];
#pragma unroll
    for (int i = 0; i < 16; ++i) C[i] = (f32x4){0.f, 0.f, 0.f, 0.f};
    { MS_REGIONS(lds) nvec[tid] = 0.f; (void)xct; (void)vt; (void)sc_b; (void)red; }
    float m_prev = 0.f;
    u32x4 xcr[8], vr, rr; float g_b = 0.f, g_li = 0.f, g_pm = 0.f;
    asm volatile("s_waitcnt vmcnt(0)" ::: "memory");
    __syncthreads();
    auto prefetch = [&](int st) {
        int tp = get_tid();
        const int tid = tp, lane = tid & 63, w = tid >> 6;
        const int cid = scan_chunk(b, d, st), r0 = cid * 64;
        const bf16_t* xp = XC + (size_t)(r0 + (tid >> 6)) * 2048 + h * 512 + (tid & 63) * 8;
#pragma unroll
        for (int i = 0; i < 8; ++i) xcr[i] = *(const u32x4*)(xp + (size_t)i * 8 * 2048);
        { const int s_ = tid >> 3, chunk = tid & 7;
          vr = cid < NCHL ? *(const u32x4*)(V + (size_t)(r0 + s_) * 2048 + h * 512 + sl * 64 + chunk * 8) : *(const u32x4*)(CTXV + (size_t)(r0 + s_ - NLAT) * 2048 + h * 512 + sl * 64 + chunk * 8);
          rr = *(const u32x4*)(RAWS + ((size_t)(cid * 4 + h) * 64 + s_) * 64 + chunk * 8); }
        if (w == 0) { const float* src = MSC + (size_t)st * 192; g_b = src[lane]; g_li = src[64 + lane]; g_pm = src[128 + lane]; }
    };
    prefetch(0);
    for (int st = 0; st < 132; ++st) {
        const int cid = scan_chunk(b, d, st);
        const bool emit = cid < NCHL;
        int tl = tid, zoff = 0;
        asm volatile("" : "+v"(tl), "+v"(zoff));
        const int tid = tl, lane = tid & 63, w = tid >> 6, cg = w & 3, kh = w >> 2, g4 = lane >> 4, l15 = lane & 15, c16 = tid & 63, srow0 = tid >> 6;
        MS_REGIONS(lds + zoff)
        __syncthreads();
        {
            lds_t xw_ = xct + srow0 * MS_KLD + c16 * 16;
            lds_t qw_ = qpt + srow0 * MS_QLD + c16 * 16;
#pragma unroll
            for (int i = 0; i < 8; ++i) {
                const unsigned xw[4] = {xcr[i].x, xcr[i].y, xcr[i].z, xcr[i].w};
                float q[8];
#pragma unroll
                for (int n = 0; n < 2; ++n)
#pragma unroll
                    for (int o = 0; o < 4; ++o)
                        q[4 * n + o] = __builtin_amdgcn_fdot2_f32_bf16(__builtin_bit_cast(bf16x2_t, xw[2 * n + 1]), Mp[n][o][1], __builtin_amdgcn_fdot2_f32_bf16(__builtin_bit_cast(bf16x2_t, xw[2 * n]), Mp[n][o][0], 0.f, false), false);
                u32x4 qv; qv.x = pk2(q[0], q[1]); qv.y = pk2(q[2], q[3]); qv.z = pk2(q[4], q[5]); qv.w = pk2(q[6], q[7]);
                *(LAS u32x4*)(xw_ + i * 8 * MS_KLD) = xcr[i];
                *(LAS u32x4*)(qw_ + i * 8 * MS_QLD) = qv;
            }
        }
        { const int s_ = tid >> 3, chunk = tid & 7;
          *(LAS u32x4*)(vt + s_ * 64 + chunk * 8) = vr;
          *(LAS u32x4*)(St + s_ * 64 + chunk * 8) = rr; }
        if (w == 0) {
            const float my_m = g_b + fmaxf(m_prev, g_pm);
            const float m_new = __shfl(my_m, 63), b_last = __shfl(g_b, 63);
            const int t = d ? 63 - lane : lane;
            sc_b[t] = g_b; sc_m[t] = my_m; sc_li[t] = g_li - g_b; sc_w[t] = __expf(b_last - g_b + g_li - m_new); sc_di[t] = __expf(g_b + m_prev - my_m);
            qn[lane] = 0.f;
            if (lane == 0) sc_misc[0] = __expf(b_last + m_prev - m_new);
            m_prev = m_new;
        }
        __syncthreads();
        if (emit) {
            const int t = tid & 63, part = tid >> 6;
            float a = 0.f;
            lds_t qr = qpt + t * MS_QLD + part * 128;
            const LAS float* nn = nvec + part * 64;
#pragma unroll
            for (int i = 0; i < 8; ++i) {
                const u32x4 qq = *(const LAS u32x4*)(qr + i * 16);
                const f32x4 n0 = *(const LAS f32x4*)(nn + 8 * i), n1 = *(const LAS f32x4*)(nn + 8 * i + 4);
                a += lo_bf(qq.x) * n0[0] + hi_bf(qq.x) * n0[1] + lo_bf(qq.y) * n0[2] + hi_bf(qq.y) * n0[3] + lo_bf(qq.z) * n1[0] + hi_bf(qq.z) * n1[1] + lo_bf(qq.w) * n1[2] + hi_bf(qq.w) * n1[3];
            }
            __hip_atomic_fetch_add((float*)(qn + t), a, __ATOMIC_RELAXED, __HIP_MEMORY_SCOPE_WORKGROUP);
        }
        {
            const int t = tid >> 3, s8 = (tid & 7) * 8;
            if (emit) {
                const u32x4 rw = *(const LAS u32x4*)(St + t * 64 + s8);
                const unsigned rwv[4] = {rw.x, rw.y, rw.z, rw.w};
                const float base = sc_b[t] - sc_m[t];
                const f32x4 e0 = *(const LAS f32x4*)(sc_li + s8), e1 = *(const LAS f32x4*)(sc_li + s8 + 4);
                float sv[8]; float rsum = 0.f;
#pragma unroll
                for (int j = 0; j < 8; ++j) {
                    const int s_ = s8 + j;
                    const float raw = (j & 1) ? hi_bf(rwv[j >> 1]) : lo_bf(rwv[j >> 1]);
                    const bool keep = d == 0 ? s_ <= t : s_ >= t;
                    const float ex = __expf(base + (j < 4 ? e0[j & 3] : e1[j & 3]));
                    sv[j] = keep ? raw * ex : 0.f;
                    rsum += sv[j];
                }
                u32x4 o; o.x = pk2(sv[0], sv[1]); o.y = pk2(sv[2], sv[3]); o.z = pk2(sv[4], sv[5]); o.w = pk2(sv[6], sv[7]);
                *(LAS u32x4*)(St + t * 64 + s8) = o;
                rsum += __shfl_xor(rsum, 1); rsum += __shfl_xor(rsum, 2); rsum += __shfl_xor(rsum, 4);
                if ((tid & 7) == 0) sc_rs[t] = rsum;
            }
            {
                const u32x4 vv = *(const LAS u32x4*)(vt + t * 64 + s8);
                const float ww = sc_w[t];
                u32x4 o; o.x = pk2(lo_bf(vv.x) * ww, hi_bf(vv.x) * ww); o.y = pk2(lo_bf(vv.y) * ww, hi_bf(vv.y) * ww); o.z = pk2(lo_bf(vv.z) * ww, hi_bf(vv.z) * ww); o.w = pk2(lo_bf(vv.w) * ww, hi_bf(vv.w) * ww);
                *(LAS u32x4*)(vwt + t * 64 + s8) = o;
            }
        }
        __syncthreads();
        f32x4 acc2[4];
#pragma unroll
        for (int tt = 0; tt < 4; ++tt) acc2[tt] = (f32x4){0.f, 0.f, 0.f, 0.f};
        if (emit) {
            lds_t qa = qpt + l15 * MS_QLD + (kh * 256 + 4 * g4) * 2;
#pragma unroll
            for (int m = 0; m < 8; ++m) {
                u32x4 cb; cb.x = pk2(C[2 * m][0], C[2 * m][1]); cb.y = pk2(C[2 * m][2], C[2 * m][3]); cb.z = pk2(C[2 * m + 1][0], C[2 * m + 1][1]); cb.w = pk2(C[2 * m + 1][2], C[2 * m + 1][3]);
                const bf16x8 cf = __builtin_bit_cast(bf16x8, cb);
#pragma unroll
                for (int tt = 0; tt < 4; ++tt) {
                    const u32x2 a0 = *(const LAS u32x2*)(qa + tt * 16 * MS_QLD + m * 64);
                    const u32x2 a1 = *(const LAS u32x2*)(qa + tt * 16 * MS_QLD + m * 64 + 32);
                    u32x4 av; av.x = a0.x; av.y = a0.y; av.z = a1.x; av.w = a1.y;
                    acc2[tt] = mfma16(cf, __builtin_bit_cast(bf16x8, av), acc2[tt]);
                }
            }
            const bf16x8 vf = frag_tr(vt, 64, kh * 32, cg * 16, lane);
#pragma unroll
            for (int tt = 0; tt < 4; ++tt) {
                acc2[tt] = acc2[tt] * sc_di[tt * 16 + l15];
                acc2[tt] = mfma16(vf, frag_row(St, 64, tt * 16, kh * 32, lane), acc2[tt]);
            }
        }
        if (st + 1 < 132) prefetch(st + 1);
        {
            const float gd = sc_misc[0];
            bf16x8 vb[2];
#pragma unroll
            for (int ks = 0; ks < 2; ++ks) vb[ks] = frag_tr(vwt, 64, ks * 32, cg * 16, lane);
            lds_t ka = xct + (8 * g4 + (l15 >> 2)) * MS_KLD + (kh * 256 + 4 * (l15 & 3)) * 2;
#pragma unroll
            for (int i = 0; i < 16; ++i) {
                C[i] = C[i] * gd;
#pragma unroll
                for (int ks = 0; ks < 2; ++ks) {
                    const s16x4 lo = __builtin_amdgcn_ds_read_tr16_b64_v4i16((LAS s16x4*)(ka + ks * 32 * MS_KLD + i * 32));
                    const s16x4 hi = __builtin_amdgcn_ds_read_tr16_b64_v4i16((LAS s16x4*)(ka + ks * 32 * MS_KLD + 4 * MS_KLD + i * 32));
                    C[i] = mfma16(__builtin_shufflevector(lo, hi, 0, 1, 2, 3, 4, 5, 6, 7), vb[ks], C[i]);
                }
            }
            float a = 0.f;
            lds_t xr = xct + tid * 2;
#pragma unroll 16
            for (int s_ = 0; s_ < 64; ++s_) a += sc_w[s_] * bf2f(*(const LAS bf16_t*)(xr + s_ * MS_KLD));
            nvec[tid] = gd * nvec[tid] + a;
        }
        __syncthreads();
        if (emit && kh == 1) {
#pragma unroll
            for (int tt = 0; tt < 4; ++tt) *(LAS f32x4*)(red + ((cg * 4 + tt) * 64 + lane) * 4) = acc2[tt];
        }
        __syncthreads();
        if (emit && kh == 0) {
#pragma unroll
            for (int tt = 0; tt < 4; ++tt) {
                const int t = tt * 16 + l15;
                const f32x4 o = acc2[tt] + *(const LAS f32x4*)(red + ((cg * 4 + tt) * 64 + lane) * 4);
                const float dn = fmaxf(fabsf(sc_di[t] * qn[t] + sc_rs[t]), __expf(-sc_m[t]));
                store_bf16x4(H + (size_t)(cid * 64 + t) * 2048 + h * 512 + sl * 64 + cg * 16 + 4 * g4, o * (1.f / dn));
            }
        }
    }
}

DI void phase_merge(PP p) {
    const int tid = get_tid(), lane = tid & 63;
    const bf16_t* HF = (const bf16_t*)p->out;
    bf16_t* HB = (bf16_t*)(p->ws + OFF_ARENA + A_HB);
    const bf16_t* XC = (const bf16_t*)(p->ws + OFF_ARENA + A_XC);
    const bf16_t* Z = (const bf16_t*)(p->ws + OFF_ARENA + A_XM);
    const int gw = get_bid() * 8 + (tid >> 6), nw = gridDim.x * 8;
    for (int r = gw; r < NLAT; r += nw) {
#pragma unroll
        for (int hh = 0; hh < 4; ++hh) {
            const size_t o = (size_t)r * 2048 + hh * 512 + lane * 8;
            const u32x4 a = *(const u32x4*)(HF + o), b = *(const u32x4*)(HB + o), xq = *(const u32x4*)(XC + o), zq = *(const u32x4*)(Z + o);
            const unsigned aw[4] = {a.x, a.y, a.z, a.w}, bw[4] = {b.x, b.y, b.z, b.w}, xw[4] = {xq.x, xq.y, xq.z, xq.w}, zw[4] = {zq.x, zq.y, zq.z, zq.w};
            float hv[8]; float sum = 0.f;
#pragma unroll
            for (int j = 0; j < 4; ++j) { hv[2 * j] = lo_bf(aw[j]) + lo_bf(bw[j]); hv[2 * j + 1] = hi_bf(aw[j]) + hi_bf(bw[j]); sum += hv[2 * j] + hv[2 * j + 1]; }
            const float mean = wave_sum(sum) * (1.f / 512.f);
            float sq = 0.f;
#pragma unroll
            for (int j = 0; j < 8; ++j) { hv[j] -= mean; sq += hv[j] * hv[j]; }
            const float rs = rsqrtf(wave_sum(sq) * (1.f / 512.f) + EPS);
            float ov[8];
#pragma unroll
            for (int j = 0; j < 8; ++j) {
                const int c = hh * 512 + lane * 8 + j;
                const float xcv = (j & 1) ? hi_bf(xw[j >> 1]) : lo_bf(xw[j >> 1]);
                const float zv = (j & 1) ? hi_bf(zw[j >> 1]) : lo_bf(zw[j >> 1]);
                ov[j] = (hv[j] * rs * p->m_norm_g[c] + p->m_skip[c] * xcv) * siluf_(zv);
            }
            u32x4 v; v.x = pk2(ov[0], ov[1]); v.y = pk2(ov[2], ov[3]); v.z = pk2(ov[4], ov[5]); v.w = pk2(ov[6], ov[7]);
            *(u32x4*)(HB + o) = v;
        }
    }
}

DI void phase_downproj(PP p, lds_t lds) {
    const bf16_t* A = (const bf16_t*)(p->ws + OFF_ARENA + A_HB);
    float* X = (float*)(p->ws + OFF_ARENA + A_X);
    constexpr int NM = NLAT / 256, NN = 4;
    for (int u = get_bid(); u < NM * NN; u += gridDim.x) {
        const int pn = u / NM, pm = u % NM;
        const float* g1 = mods_ptr(p, 1, pm >> 5, 2);
        gemm_unit<256>(lds, 2048, 1024,
            [&](int r) { return A + (size_t)(pm * 256 + r) * 2048; },
            [&](int j) -> const float* { return p->m_w_down + pn * 256 + j; },
            [&](const f32x4 (&acc)[8][4], int wr, int wc, int lane) {
                epi_each<4>(acc, wr, wc, lane, [&](int r, int c, f32x4 v) {
                    const int col = pn * 256 + c;
                    float* xp = X + (size_t)(pm * 256 + r) * 1024 + col;
                    const f32x4 g = *(const f32x4*)(g1 + col);
                    *(f32x4*)xp = *(const f32x4*)xp + g * v;
                });
            });
    }
}

DI void phase_dbg_final(PP p, int mode) {
    const int tid = get_tid(), lane = tid & 63;
    const int gw = get_bid() * 8 + (tid >> 6), nw = gridDim.x * 8;
    if (mode == 4) {
        const int* rid = (const int*)(p->ws + OFF_ARENA + A_ROWID);
        for (int r = gw; r < NLAT; r += nw)
            for (int c = lane; c < 1024; c += 64) p->out[(size_t)r * 1024 + c] = (float)rid[(size_t)r * 16 + (c & 15)];
        return;
    }
    if (mode == 7) {
        const bf16_t* y = (const bf16_t*)(p->ws + OFF_ARENA + A_Y);
        for (int r = gw; r < NLAT; r += nw)
            for (int c = lane; c < 1024; c += 64) { const float v = bf2f(y[(size_t)r * 1024 + c]); p->out[(size_t)r * 1024 + c] = (v == v && fabsf(v) < 1e30f) ? 0.f : 1000.f; }
        return;
    }
    if (mode >= 2) {
        const bf16_t* src = mode == 2 ? (const bf16_t*)(p->ws + OFF_ARENA + A_P) : mode == 5 ? (const bf16_t*)(p->ws + OFF_ARENA + A_HDN) : mode == 6 ? (const bf16_t*)(p->ws + OFF_ARENA + A_Y) : (const bf16_t*)(p->ws + OFF_ACT);
        const int ld = mode == 2 ? ABIN : 1024;
        for (int r = gw; r < NLAT; r += nw)
            for (int c = lane; c < 1024; c += 64) p->out[(size_t)r * 1024 + c] = bf2f(src[(size_t)r * ld + (mode == 2 ? c + DBG_COL0 : c)]);
        return;
    }
    const float* X = mode ? (const float*)(p->ws + OFF_ARENA + A_X) : p->x;
    for (int r = gw; r < NLAT; r += nw) {
        f32x4 v[4];
        row_load_f32(X + (size_t)r * 1024, v, lane);
        const float rs = rsqrtf(row_sumsq(v) * (1.f / 1024.f) + EPS);
#pragma unroll
        for (int i = 0; i < 4; ++i) { const f32x4 g = *(const f32x4*)(p->final_g + 4 * lane + 256 * i); *(f32x4*)(p->out + (size_t)r * 1024 + 4 * lane + 256 * i) = v[i] * rs * g; }
    }
}

DI void grid_barrier(cg::grid_group& grid, PP p, unsigned& nbar) {
    asm volatile("s_waitcnt vmcnt(0) lgkmcnt(0)" ::: "memory");
    unsigned* ctr = (unsigned*)(p->ws + OFF_BAR);
    if (nbar == 0) {
        if (blockIdx.x == 0 && threadIdx.x == 0) __hip_atomic_store(ctr, 0u, __ATOMIC_RELAXED, __HIP_MEMORY_SCOPE_AGENT);
        asm volatile("s_waitcnt vmcnt(0)" ::: "memory");
        grid.sync();
        __builtin_amdgcn_fence(__ATOMIC_ACQUIRE, "agent");
        asm volatile("s_waitcnt vmcnt(0)" ::: "memory");
    } else {
        __syncthreads();
        if (threadIdx.x == 0) {
            __builtin_amdgcn_fence(__ATOMIC_RELEASE, "agent");
            asm volatile("s_waitcnt vmcnt(0)" ::: "memory");
            __hip_atomic_fetch_add(ctr, 1u, __ATOMIC_RELAXED, __HIP_MEMORY_SCOPE_AGENT);
            const unsigned target = nbar * gridDim.x;
            while (__hip_atomic_load(ctr, __ATOMIC_RELAXED, __HIP_MEMORY_SCOPE_AGENT) < target) __builtin_amdgcn_s_sleep(1);
            __builtin_amdgcn_fence(__ATOMIC_ACQUIRE, "agent");
            asm volatile("s_waitcnt vmcnt(0)" ::: "memory");
        }
        __syncthreads();
    }
    ++nbar;
}
#define RUN_PHASE(K, CALL) if (ph_lo <= (K) && (K) < ph_hi && ((K) <= DBG_STOP)) { PP p = kp; asm volatile("" : "+s"(p)); CALL; if ((DUP_MASK >> (K)) & 1) { grid_barrier(grid, p, nbar); asm volatile("" : "+s"(p)); CALL; } if ((K) + 1 < ph_hi) { grid_barrier(grid, p, nbar); if (EXTRA_BARRIERS) grid_barrier(grid, p, nbar); } }
__global__ void __launch_bounds__(NTHREADS) mega(Params p_in) {
    extern __shared__ __attribute__((aligned(16))) unsigned char lds_raw[];
    lds_t lds = (lds_t)lds_raw;
    cg::grid_group grid = cg::this_grid();
    PP kp = (PP)__builtin_amdgcn_kernarg_segment_ptr();
    const int ph_lo = kp->ph_lo, ph_hi = kp->ph_hi;
    unsigned nbar = 0;
    RUN_PHASE(0, phase_mods(p, lds))
    RUN_PHASE(1, phase_norm(p, 0, NTOK, [&](int r) { return r < NLAT ? p->x + (size_t)r * 1024 : p->ctx + (size_t)(r - NLAT) * 1024; }))
    RUN_PHASE(2, phase_inproj(p, lds))
    RUN_PHASE(3, phase_g1(p, lds))
    RUN_PHASE(4, phase_scan0(p))
    RUN_PHASE(5, phase_g3(p, lds))
    RUN_PHASE(6, phase_outproj0(p, lds))
    RUN_PHASE(7, phase_router(p, lds, 0))
    RUN_PHASE(8, phase_topk(p, lds, 0))
    RUN_PHASE(9, phase_moe_up(p, lds, 0))
    RUN_PHASE(10, phase_moe_down(p, lds, 0))
    RUN_PHASE(11, phase_combine(p, 0))
    RUN_PHASE(12, phase_upproj(p, lds, 0))
    RUN_PHASE(13, phase_mfeat(p, lds))
    RUN_PHASE(14, phase_mscan(p, lds))
    RUN_PHASE(15, phase_norm(p, 1, NLAT, [&](int r) { return (const float*)(p->ws + OFF_ARENA + A_X) + (size_t)r * 1024; }))
    RUN_PHASE(16, phase_upproj(p, lds, 1))
    RUN_PHASE(17, phase_merge(p))
    RUN_PHASE(18, phase_downproj(p, lds))
    RUN_PHASE(19, phase_router(p, lds, 1))
    RUN_PHASE(20, phase_topk(p, lds, 1))
    RUN_PHASE(21, phase_moe_up(p, lds, 1))
    RUN_PHASE(22, phase_moe_down(p, lds, 1))
    RUN_PHASE(23, phase_combine(p, 1))
    if (DBG_STOP < 23 && DBG_STOP + 1 < ph_hi) { PP p = kp; asm volatile("" : "+s"(p)); phase_dbg_final(p, DBG_MODE); }
}

extern "C" void kernel_launch(void* const* d_in, const int* in_sizes, int n_in, void* d_out, int out_size, void* d_ws, size_t ws_size, hipStream_t stream) {
    static int grid = 0;
    if (grid == 0) {
        int dev = 0, cus = 0, per_cu = 0;
        hipGetDevice(&dev);
        hipDeviceGetAttribute(&cus, hipDeviceAttributeMultiprocessorCount, dev);
        hipFuncSetAttribute((const void*)mega, hipFuncAttributeMaxDynamicSharedMemorySize, LDS_BYTES);
        hipOccupancyMaxActiveBlocksPerMultiprocessor(&per_cu, (const void*)mega, NTHREADS, LDS_BYTES);
        if (per_cu < 1) { fprintf(stderr, "occupancy query says %d blocks/CU\n", per_cu); per_cu = 1; }
        grid = cus;
        if (ws_size < WS_NEED) { fprintf(stderr, "workspace too small: %zu < %zu\n", ws_size, (size_t)WS_NEED); grid = -1; }
    }
    if (grid < 0) return;
    Params hp{};
    const float** pp = (const float**)&hp;
    for (int i = 0; i < 36; ++i) pp[i] = (const float*)d_in[i];
    hp.out = (float*)d_out; hp.ws = (char*)d_ws; hp.ph_lo = 0; hp.ph_hi = DBG_STOP < 23 ? DBG_STOP + 2 : 24;
    void* args[] = {&hp};
    hipError_t e = hipLaunchCooperativeKernel((const void*)mega, dim3(grid), dim3(NTHREADS), args, LDS_BYTES, stream);
    if (e != hipSuccess) fprintf(stderr, "cooperative launch failed: %s\n", hipGetErrorString(e));
}
```

```cpp
#include <hip/hip_runtime.h>
#include <hip/hip_cooperative_groups.h>
#include <cstdio>
#include <cstdint>
namespace cg = cooperative_groups;

#define LAS __attribute__((address_space(3)))
#define DI __device__ __forceinline__
typedef unsigned short bf16_t;
typedef short bf16x8 __attribute__((ext_vector_type(8)));
typedef short s16x4 __attribute__((ext_vector_type(4)));
typedef float f32x4 __attribute__((ext_vector_type(4)));
typedef float f32x2 __attribute__((ext_vector_type(2)));
typedef unsigned u32x4 __attribute__((ext_vector_type(4)));
typedef unsigned u32x2 __attribute__((ext_vector_type(2)));
typedef LAS char* lds_t;

constexpr int D = 1024, NBATCH = 4, SEQ = 8192, CTXL = 256;
constexpr int NLAT = NBATCH * SEQ;
constexpr int NCTX = NBATCH * CTXL;
constexpr int NTOK = NLAT + NCTX;
constexpr int NCH = NTOK / 64;
constexpr int NCHL = NLAT / 64;
constexpr int ABIN = 2592;
constexpr int PC_Q = 0, PC_K = 256, PC_V = 512, PC_G = 1024, PC_LRF = 1536, PC_LRB = 1552, PC_RGG = 1568, PC_RGX = 2080;
constexpr float EPS = 1e-6f;
constexpr int NTHREADS = 512;
constexpr int LDS_BYTES = 160 * 1024;
#define DBG_MODE 1
#ifndef DUP_MASK
#define DUP_MASK 0
#endif
#ifndef EXTRA_BARRIERS
#define EXTRA_BARRIERS 0
#endif
#define DBG_STOP 23
#define DBG_COL0 0

constexpr size_t OFF_MODS = 0;
constexpr size_t OFF_GCAT = 245760;
constexpr size_t OFF_MMAT = 376832;
constexpr size_t OFF_BAR = 409600;
constexpr size_t OFF_ACT = 1u << 20;
constexpr size_t ACT_BYTES = (size_t)NTOK * 1024 * 2;
constexpr size_t OFF_ARENA = OFF_ACT + ACT_BYTES;
constexpr size_t A_P = 0;
constexpr size_t A_U = A_P + (size_t)NTOK * ABIN * 2;
constexpr size_t A_LA = A_U + (size_t)NCH * 2 * 4 * 8192 * 4;
constexpr size_t A_UU = A_LA + (size_t)NTOK * 2 * 512 * 4;
constexpr size_t A_DEC = A_UU + (size_t)NTOK * 2 * 512 * 2;
constexpr size_t A_AGGA = A_DEC + (size_t)NCH * 2 * 256 * 4;
constexpr size_t A_AGGH = A_AGGA + (size_t)NCH * 2 * 512 * 4;
constexpr size_t A_L0_END = A_AGGH + (size_t)NCH * 2 * 512 * 4;
constexpr size_t A_X = 0;
constexpr size_t A_PT = A_X + (size_t)NTOK * 1024 * 4;
constexpr size_t A_PE = A_PT + (size_t)NTOK * 16 * 4;
constexpr size_t A_ROWID = A_PE + (size_t)NTOK * 16 * 4;
constexpr size_t A_ROWTOK = A_ROWID + (size_t)NTOK * 16 * 4;
constexpr size_t A_HDN = A_ROWTOK + (size_t)16 * 4352 * 4;
constexpr size_t A_Y = A_HDN + (size_t)16 * 4352 * 1024 * 2;
constexpr size_t A_MOE0_END = A_Y + (size_t)16 * 4352 * 1024 * 2;
constexpr size_t A_XM = A_X + (size_t)NTOK * 1024 * 4;
constexpr size_t A_XC = A_XM + (size_t)NTOK * 2048 * 2;
constexpr size_t A_HB = A_XC + (size_t)NTOK * 2048 * 2;
constexpr size_t A_L1_END = A_HB + (size_t)NLAT * 2048 * 2;
constexpr size_t ACT_RAWS = 0;
constexpr size_t ACT_GP = ACT_RAWS + (size_t)NCH * 4 * 4096 * 2;
constexpr size_t ACT_CTXV = ACT_GP + (size_t)NTOK * 64 * 4;
constexpr size_t WS_NEED = OFF_ARENA + (A_L1_END > A_L0_END ? A_L1_END : A_L0_END);
static_assert(A_MOE0_END < A_L1_END, "arena");
static_assert(ACT_CTXV + (size_t)NCTX * 2048 * 2 <= ACT_BYTES, "act region");

struct Params {
    const float *x, *c, *ctx, *c_ctx, *mod_w, *mod_b, *norm1_g, *norm2_g, *ab_w_in, *gla_wa2, *gla_ba, *gla_norm_g;
    const float *rg_conv_w, *rg_conv_b, *rg_wr, *rg_br, *rg_wi, *rg_bi, *rg_lambda, *ab_w_out, *m_w_up, *m_conv_w, *m_conv_b;
    const float *m_wq, *m_wk, *m_wv, *m_w_gates, *m_b_gates, *m_skip, *m_norm_g, *m_w_down, *router_w, *exp_w_gate, *exp_w_up, *exp_w_down, *final_g;
    float* out;
    char* ws;
    int ph_lo, ph_hi;
};

typedef const Params __attribute__((address_space(4)))* PP;

DI int get_tid() { int t = threadIdx.x; asm volatile("" : "+v"(t)); return t; }
DI int get_bid() { int b = blockIdx.x; asm volatile("" : "+s"(b)); return b; }
DI float bf2f(bf16_t h) { return __uint_as_float((unsigned)h << 16); }
DI bf16_t f2bf(float x) { unsigned u = __float_as_uint(x); u += 0x7fffu + ((u >> 16) & 1u); return (bf16_t)(u >> 16); }
typedef __bf16 bf16x2_t __attribute__((ext_vector_type(2)));
DI unsigned pk2n(float lo, float hi) { const f32x2 v = {lo, hi}; return __builtin_bit_cast(unsigned, __builtin_convertvector(v, bf16x2_t)); }
DI unsigned pk2(float lo, float hi) { return pk2n(lo, hi); }
DI float lo_bf(unsigned u) { return __uint_as_float(u << 16); }
DI float hi_bf(unsigned u) { return __uint_as_float(u & 0xffff0000u); }
DI float sigmoidf_(float x) { return 1.f / (1.f + __expf(-x)); }
DI float siluf_(float x) { return x / (1.f + __expf(-x)); }
DI float log_sigmoidf_(float z) { return fminf(z, 0.f) - log1pf(__expf(-fabsf(z))); }
DI float softplusf_(float z) { return fmaxf(z, 0.f) + log1pf(__expf(-fabsf(z))); }
DI float gelu_tanh(float x) { const float u = 0.7978845608028654f * (x + 0.044715f * x * x * x); return 0.5f * x * (1.f + tanhf(u)); }
DI float wave_sum(float v) {
#pragma unroll
    for (int o = 32; o > 0; o >>= 1) v += __shfl_xor(v, o);
    return v;
}
DI f32x4 mfma16(bf16x8 a, bf16x8 b, f32x4 c) { return __builtin_amdgcn_mfma_f32_16x16x32_bf16(a, b, c, 0, 0, 0); }

DI bf16x8 frag_row(const LAS bf16_t* tile, int ld, int r0, int k0, int lane) {
    return *(const LAS bf16x8*)(tile + (r0 + (lane & 15)) * ld + k0 + 8 * (lane >> 4));
}
DI bf16x8 frag_tr(const LAS bf16_t* tile, int ld, int k0, int c0, int lane) {
    const int g = lane >> 4, i = lane & 15, q = i >> 2, p = i & 3;
    const LAS bf16_t* base = tile + (k0 + 8 * g + q) * ld + c0 + 4 * p;
    const s16x4 lo = __builtin_amdgcn_ds_read_tr16_b64_v4i16((LAS s16x4*)base);
    const s16x4 hi = __builtin_amdgcn_ds_read_tr16_b64_v4i16((LAS s16x4*)(base + 4 * ld));
    return __builtin_shufflevector(lo, hi, 0, 1, 2, 3, 4, 5, 6, 7);
}
DI const float* mods_ptr(PP p, int layer, int s, int which) { return (const float*)(p->ws + OFF_MODS) + ((size_t)(layer * 5 + s) * 6 + which) * 1024; }
DI int row_set(int r) { return r < NLAT ? (r >> 13) : 4; }

template <int BN, class ARow, class BCol, class Epi>
DI void gemm_unit(lds_t lds, int K, int ldb, ARow arow, BCol bcol, Epi epi) {
    constexpr int BK = 32;
    constexpr int NT = BN / 64;
    constexpr int LDA = BK + 8, LDB = BN + 16;
    constexpr int A_BYTES = 256 * LDA * 2, B_BYTES = BK * LDB * 2;
    static_assert(2 * A_BYTES + 2 * B_BYTES <= LDS_BYTES, "gemm lds");
    const int tid = get_tid(), lane = tid & 63, w = tid >> 6, wr = w >> 2, wc = w & 3;
    constexpr int ACH = BK / 8, ARP = NTHREADS / ACH, AP = 256 / ARP;
    const int achunk = tid % ACH, arow0 = tid / ACH;
    const bf16_t* ap[AP];
#pragma unroll
    for (int q = 0; q < AP; ++q) ap[q] = arow(arow0 + ARP * q);
    constexpr int CG = BN / 8, KR = NTHREADS / CG, BP = BK / KR;
    const int bc8 = tid % CG, bk0 = tid / CG;
    const float* bp = bcol(bc8 * 8);
    u32x4 areg[AP];
    f32x4 breg[BP][2];
    auto gload = [&](int kt) {
        const int k0 = kt * BK;
#pragma unroll
        for (int q = 0; q < AP; ++q) areg[q] = ap[q] ? *(const u32x4*)(ap[q] + k0 + achunk * 8) : (u32x4){0u, 0u, 0u, 0u};
#pragma unroll
        for (int q = 0; q < BP; ++q) {
            if (bp) { const float* s = bp + (size_t)(k0 + bk0 + KR * q) * ldb; breg[q][0] = *(const f32x4*)s; breg[q][1] = *(const f32x4*)(s + 4); }
            else { breg[q][0] = (f32x4){0.f, 0.f, 0.f, 0.f}; breg[q][1] = breg[q][0]; }
        }
    };
    auto lstore = [&](int buf) {
        LAS bf16_t* As = (LAS bf16_t*)(lds + buf * A_BYTES);
        LAS bf16_t* Bs = (LAS bf16_t*)(lds + 2 * A_BYTES + buf * B_BYTES);
#pragma unroll
        for (int q = 0; q < AP; ++q) *(LAS u32x4*)(As + (arow0 + ARP * q) * LDA + achunk * 8) = areg[q];
#pragma unroll
        for (int q = 0; q < BP; ++q) {
            u32x4 v; v.x = pk2(breg[q][0][0], breg[q][0][1]); v.y = pk2(breg[q][0][2], breg[q][0][3]); v.z = pk2(breg[q][1][0], breg[q][1][1]); v.w = pk2(breg[q][1][2], breg[q][1][3]);
            *(LAS u32x4*)(Bs + (bk0 + KR * q) * LDB + bc8 * 8) = v;
        }
    };
    f32x4 acc[8][NT];
#pragma unroll
    for (int mi = 0; mi < 8; ++mi)
#pragma unroll
        for (int ni = 0; ni < NT; ++ni) acc[mi][ni] = (f32x4){0.f, 0.f, 0.f, 0.f};
    const int nk = K / BK;
    gload(0);
    for (int kt = 0; kt < nk; ++kt) {
        lstore(kt & 1);
        __syncthreads();
        if (kt + 1 < nk) gload(kt + 1);
        const LAS bf16_t* As = (const LAS bf16_t*)(lds + (kt & 1) * A_BYTES);
        const LAS bf16_t* Bs = (const LAS bf16_t*)(lds + 2 * A_BYTES + (kt & 1) * B_BYTES);
#pragma unroll
        for (int ks = 0; ks < BK / 32; ++ks) {
            bf16x8 wb[NT];
#pragma unroll
            for (int ni = 0; ni < NT; ++ni) wb[ni] = frag_tr(Bs, LDB, ks * 32, wc * (BN / 4) + ni * 16, lane);
#pragma unroll
            for (int mi = 0; mi < 8; ++mi) {
                const bf16x8 xa = frag_row(As, LDA, wr * 128 + mi * 16, ks * 32, lane);
#pragma unroll
                for (int ni = 0; ni < NT; ++ni) acc[mi][ni] = mfma16(wb[ni], xa, acc[mi][ni]);
            }
        }
    }
    epi(acc, wr, wc, lane);
    __syncthreads();
}

template <int NT, class F>
DI void epi_each(const f32x4 (&acc)[8][NT], int wr, int wc, int lane, F f) {
#pragma unroll
    for (int mi = 0; mi < 8; ++mi)
#pragma unroll
        for (int ni = 0; ni < NT; ++ni) f(wr * 128 + mi * 16 + (lane & 15), wc * (NT * 16) + ni * 16 + 4 * (lane >> 4), acc[mi][ni]);
}
DI void store_bf16x4(bf16_t* dst, f32x4 v) { u32x2 o; o.x = pk2(v[0], v[1]); o.y = pk2(v[2], v[3]); *(u32x2*)dst = o; }

DI void row_load_f32(const float* src, f32x4 (&v)[4], int lane) {
#pragma unroll
    for (int i = 0; i < 4; ++i) v[i] = *(const f32x4*)(src + 4 * lane + 256 * i);
}
DI float row_sumsq(const f32x4 (&v)[4]) {
    float s = 0.f;
#pragma unroll
    for (int i = 0; i < 4; ++i) s += v[i][0] * v[i][0] + v[i][1] * v[i][1] + v[i][2] * v[i][2] + v[i][3] * v[i][3];
    return wave_sum(s);
}
DI void row_modulate(f32x4 (&v)[4], float rs, const float* g, const float* sc, const float* sh, int lane) {
#pragma unroll
    for (int i = 0; i < 4; ++i) {
        const int c = 4 * lane + 256 * i;
        const f32x4 gg = *(const f32x4*)(g + c), ss = *(const f32x4*)(sc + c), hh = *(const f32x4*)(sh + c);
#pragma unroll
        for (int j = 0; j < 4; ++j) v[i][j] = v[i][j] * rs * gg[j] * (1.f + ss[j]) + hh[j];
    }
}
DI void row_store_bf16(bf16_t* dst, const f32x4 (&v)[4], int lane) {
#pragma unroll
    for (int i = 0; i < 4; ++i) store_bf16x4(dst + 4 * lane + 256 * i, v[i]);
}

DI void phase_mods(PP p, lds_t lds) {
    const int tid = get_tid();
    LAS float* sil = (LAS float*)lds;
    LAS float* red = sil + 5 * 1024;
    for (int u = get_bid(); u < 192 + 32; u += gridDim.x) {
        if (u < 192) {
            const int layer = u / 96, c0 = (u % 96) * 64;
            for (int i = tid; i < 5 * 1024; i += NTHREADS) { const int s = i >> 10, k = i & 1023; const float cv = s < 4 ? p->c[s * 1024 + k] : p->c_ctx[k]; sil[i] = siluf_(cv); }
            __syncthreads();
            const int col = tid & 63, kp = tid >> 6;
            float a[5] = {0.f, 0.f, 0.f, 0.f, 0.f};
            const float* wp = p->mod_w + (size_t)layer * 1024 * 6144 + c0 + col;
            for (int k = kp * 128; k < kp * 128 + 128; ++k) {
                const float wv = wp[(size_t)k * 6144];
#pragma unroll
                for (int s = 0; s < 5; ++s) a[s] += sil[s * 1024 + k] * wv;
            }
#pragma unroll
            for (int s = 0; s < 5; ++s) red[(kp * 5 + s) * 64 + col] = a[s];
            __syncthreads();
            if (tid < 320) {
                const int s = tid >> 6, cc = tid & 63;
                float t = p->mod_b[layer * 6144 + c0 + cc];
#pragma unroll
                for (int k = 0; k < 8; ++k) t += red[(k * 5 + s) * 64 + cc];
                ((float*)(p->ws + OFF_MODS))[(size_t)(layer * 5 + s) * 6144 + c0 + cc] = t;
            }
            __syncthreads();
        } else {
            const int f0 = (u - 192) * 64;
            const int fl = tid >> 3, dgp = (tid & 7) * 2, f = f0 + fl, n = f >> 2, i = f & 3;
            bf16_t* gxc = (bf16_t*)(p->ws + OFF_GCAT);
            bf16_t* gxm = gxc + 2048 * 16;
#pragma unroll
            for (int e = 0; e < 2; ++e) {
                const int dg = dgp + e, d = dg >> 3, g = dg & 7;
                const float* wg = p->m_w_gates + (size_t)d * 6144 * 8;
                float a = 0.f, b = 0.f;
#pragma unroll
                for (int o = 0; o < 4; ++o) {
                    a += p->m_wq[n * 16 + i * 4 + o] * wg[(size_t)(4 * n + o) * 8 + g];
                    a += p->m_wk[n * 16 + i * 4 + o] * wg[(size_t)(2048 + 4 * n + o) * 8 + g] * 0.04419417382415922f;
                    b += p->m_wv[n * 16 + i * 4 + o] * wg[(size_t)(4096 + 4 * n + o) * 8 + g];
                }
                gxc[f * 16 + dg] = f2bf(a); gxm[f * 16 + dg] = f2bf(b);
            }
            if (tid < 256) {
                const int nn = (f0 >> 2) + (tid >> 4), e = tid & 15, ii = e >> 2, jj = e & 3;
                float a = 0.f;
#pragma unroll
                for (int o = 0; o < 4; ++o) a += p->m_wq[nn * 16 + ii * 4 + o] * p->m_wk[nn * 16 + jj * 4 + o];
                ((float*)(p->ws + OFF_MMAT))[nn * 16 + e] = a * 0.04419417382415922f;
            }
        }
    }
}

template <class Src>
DI void phase_norm(PP p, int layer, int nrows, Src src) {
    const int lane = get_tid() & 63, gw = get_bid() * 8 + (get_tid() >> 6), nw = gridDim.x * 8;
    bf16_t* act = (bf16_t*)(p->ws + OFF_ACT);
    for (int r = gw; r < nrows; r += nw) {
        f32x4 v[4];
        row_load_f32(src(r), v, lane);
        const float rs = rsqrtf(row_sumsq(v) * (1.f / 1024.f) + EPS);
        const int s = row_set(r);
        row_modulate(v, rs, p->norm1_g + layer * 1024, mods_ptr(p, layer, s, 1), mods_ptr(p, layer, s, 0), lane);
        row_store_bf16(act + (size_t)r * 1024, v, lane);
    }
}

DI void phase_inproj(PP p, lds_t lds) {
    const bf16_t* act = (const bf16_t*)(p->ws + OFF_ACT);
    bf16_t* P = (bf16_t*)(p->ws + OFF_ARENA + A_P);
    constexpr int NM = NTOK / 256, NN = 11;
    for (int u = get_bid(); u < NM * NN; u += gridDim.x) {
        const int pn = u / NM, pm = u % NM;
        gemm_unit<256>(lds, 1024, ABIN,
            [&](int r) { return act + (size_t)(pm * 256 + r) * 1024; },
            [&](int j) -> const float* { const int c = pn * 256 + j; return c < ABIN ? p->ab_w_in + c : nullptr; },
            [&](const f32x4 (&acc)[8][4], int wr, int wc, int lane) {
                epi_each<4>(acc, wr, wc, lane, [&](int r, int c, f32x4 v) { const int col = pn * 256 + c; if (col < ABIN) store_bf16x4(P + (size_t)(pm * 256 + r) * ABIN + col, v); });
            });
    }
}


DI void gla_bcum(LAS float* bc, const LAS float* lrt, const LAS float* wat, const LAS float* bat, int d, LAS float* seg_tot) {
    const int tid = get_tid();
    {
        const int c = tid & 63, tq = tid >> 6;
        float wcol[16];
#pragma unroll
        for (int r = 0; r < 16; ++r) wcol[r] = wat[r * 64 + c];
        const float bias = bat[c];
        for (int t = tq * 8; t < tq * 8 + 8; ++t) {
            float z = bias;
#pragma unroll
            for (int r = 0; r < 16; ++r) z += lrt[t * 16 + r] * wcol[r];
            bc[t * 64 + c] = log_sigmoidf_(z) * (1.f / 16.f);
        }
    }
    __syncthreads();
    {
        const int c = tid & 63, seg = tid >> 6;
        float v[8]; float run = 0.f;
#pragma unroll
        for (int j = 0; j < 8; ++j) { const int pp = seg * 8 + j, t = d == 0 ? pp : 63 - pp; run += bc[t * 64 + c]; v[j] = run; }
        LAS float* tot = seg_tot + seg * 64 + c;
        *tot = run;
        __syncthreads();
        float off = 0.f;
#pragma unroll
        for (int k = 0; k < 7; ++k) off += (k < seg) ? seg_tot[k * 64 + c] : 0.f;
#pragma unroll
        for (int j = 0; j < 8; ++j) { const int pp = seg * 8 + j, t = d == 0 ? pp : 63 - pp; bc[t * 64 + c] = v[j] + off; }
    }
    __syncthreads();
}
DI void gla_load_decay_inputs(PP p, const bf16_t* P, int r0, int h, LAS float* lrt, LAS float* wat, LAS float* bat) {
    const int tid = get_tid();
    if (tid < 256) {
        const int d = tid >> 7, t = (tid >> 1) & 63, half = tid & 1;
        const u32x4 v = *(const u32x4*)(P + (size_t)(r0 + t) * ABIN + PC_LRF + d * 16 + half * 8);
        LAS float* o = lrt + (d * 64 + t) * 16 + half * 8;
        o[0] = lo_bf(v.x); o[1] = hi_bf(v.x); o[2] = lo_bf(v.y); o[3] = hi_bf(v.y); o[4] = lo_bf(v.z); o[5] = hi_bf(v.z); o[6] = lo_bf(v.w); o[7] = hi_bf(v.w);
    }
    {
        const int i = tid * 4, d = i >> 10, r = (i >> 6) & 15, c = i & 63;
        *(LAS f32x4*)(wat + i) = *(const f32x4*)(p->gla_wa2 + (size_t)(d * 16 + r) * 256 + h * 64 + c);
    }
    if (tid < 128) bat[tid] = p->gla_ba[(tid >> 6) * 256 + h * 64 + (tid & 63)];
}

DI void phase_g1(PP p, lds_t lds) {
    const int tid = get_tid(), lane = tid & 63, w = tid >> 6;
    const bf16_t* P = (const bf16_t*)(p->ws + OFF_ARENA + A_P);
    float* U = (float*)(p->ws + OFF_ARENA + A_U);
    float* DEC = (float*)(p->ws + OFF_ARENA + A_DEC);
    float* LA = (float*)(p->ws + OFF_ARENA + A_LA);
    bf16_t* UU = (bf16_t*)(p->ws + OFF_ARENA + A_UU);
    float* AGGA = (float*)(p->ws + OFF_ARENA + A_AGGA);
    float* AGGH = (float*)(p->ws + OFF_ARENA + A_AGGH);
    constexpr int NGLA = NCH * 4, NLRU = NCH * 4;
    for (int task = get_bid(); task < NGLA + NLRU; task += gridDim.x) {
        if (task < NGLA) {
            const int ch = task >> 2, h = task & 3, r0 = ch * 64;
            LAS float* lrt = (LAS float*)lds;
            LAS float* wat = lrt + 2048;
            LAS float* bat = wat + 2048;
            LAS float* bc = bat + 128;
            LAS bf16_t* kt = (LAS bf16_t*)(bc + 8192);
            LAS bf16_t* ktd = kt + 64 * 72;
            LAS bf16_t* vt = ktd + 2 * 64 * 72;
            gla_load_decay_inputs(p, P, r0, h, lrt, wat, bat);
            { const int row = tid >> 3, chunk = tid & 7; *(LAS u32x4*)(kt + row * 72 + chunk * 8) = *(const u32x4*)(P + (size_t)(r0 + row) * ABIN + PC_K + h * 64 + chunk * 8); }
#pragma unroll
            for (int q = 0; q < 2; ++q) { const int i = tid + 512 * q, row = i >> 4, chunk = i & 15; *(LAS u32x4*)(vt + row * 136 + chunk * 8) = *(const u32x4*)(P + (size_t)(r0 + row) * ABIN + PC_V + h * 128 + chunk * 8); }
            __syncthreads();
            gla_bcum(bc, lrt, wat, bat, 0, (LAS float*)(vt + 64 * 136));
            gla_bcum(bc + 4096, lrt + 1024, wat + 1024, bat + 64, 1, (LAS float*)(vt + 64 * 136));
            {
                const int t = tid >> 3, c8 = (tid & 7) * 8;
#pragma unroll
                for (int d = 0; d < 2; ++d) {
                    const LAS float* b = bc + d * 4096;
                    const int tl = d == 0 ? 63 : 0;
                    float o[8];
#pragma unroll
                    for (int j = 0; j < 8; ++j) o[j] = bf2f(kt[t * 72 + c8 + j]) * __expf(b[tl * 64 + c8 + j] - b[t * 64 + c8 + j]);
                    u32x4 v; v.x = pk2(o[0], o[1]); v.y = pk2(o[2], o[3]); v.z = pk2(o[4], o[5]); v.w = pk2(o[6], o[7]);
                    *(LAS u32x4*)(ktd + d * 64 * 72 + t * 72 + c8) = v;
                }
                if (tid < 128) { const int d = tid >> 6, c = tid & 63; DEC[(size_t)(ch * 2 + d) * 256 + h * 64 + c] = __expf(bc[d * 4096 + (d == 0 ? 63 : 0) * 64 + c]); }
            }
            __syncthreads();
            {
                const int d = w >> 2, dkt = w & 3;
                const LAS bf16_t* kd = ktd + d * 64 * 72;
                bf16x8 kb[2];
#pragma unroll
                for (int ks = 0; ks < 2; ++ks) kb[ks] = frag_tr(kd, 72, ks * 32, dkt * 16, lane);
                float* Ud = U + ((size_t)(ch * 2 + d) * 4 + h) * 8192;
#pragma unroll
                for (int dvt = 0; dvt < 8; ++dvt) {
                    f32x4 acc = {0.f, 0.f, 0.f, 0.f};
#pragma unroll
                    for (int ks = 0; ks < 2; ++ks) acc = mfma16(frag_tr(vt, 136, ks * 32, dvt * 16, lane), kb[ks], acc);
                    *(f32x4*)(Ud + (dkt * 16 + (lane & 15)) * 128 + dvt * 16 + 4 * (lane >> 4)) = acc;
                }
            }
            __syncthreads();
        } else {
            const int t2 = task - NGLA, ch = t2 >> 2, cq = t2 & 3, r0 = ch * 64;
            const int seg_lo = ch < NCHL ? r0 : NLAT + ((r0 - NLAT) >> 8) * 256, seg_hi = ch < NCHL ? r0 + 64 : seg_lo + 256;
            LAS bf16_t* xin = (LAS bf16_t*)lds;
            LAS bf16_t* xb = xin + 67 * 136;
            LAS float* lat = (LAS float*)(xb + 64 * 136);
            LAS bf16_t* git = (LAS bf16_t*)(lat + 2 * 64 * 128);
            for (int i = tid; i < 67 * 16; i += NTHREADS) {
                const int row = i >> 4, chunk = i & 15, r = r0 - 2 + row;
                u32x4 v = {0u, 0u, 0u, 0u};
                if (r >= seg_lo && r < seg_hi) v = *(const u32x4*)(P + (size_t)r * ABIN + PC_RGX + cq * 128 + chunk * 8);
                *(LAS u32x4*)(xin + row * 136 + chunk * 8) = v;
            }
            __syncthreads();
            {
                const int t = tid >> 3, c16 = (tid & 7) * 16;
                float o[16];
#pragma unroll
                for (int j = 0; j < 16; ++j) o[j] = p->rg_conv_b[cq * 128 + c16 + j];
#pragma unroll
                for (int tap = 0; tap < 4; ++tap)
#pragma unroll
                    for (int j = 0; j < 16; ++j) o[j] += p->rg_conv_w[tap * 512 + cq * 128 + c16 + j] * bf2f(xin[(t + tap) * 136 + c16 + j]);
#pragma unroll
                for (int j = 0; j < 16; j += 8) {
                    u32x4 v; v.x = pk2(o[j], o[j + 1]); v.y = pk2(o[j + 2], o[j + 3]); v.z = pk2(o[j + 4], o[j + 5]); v.w = pk2(o[j + 6], o[j + 7]);
                    *(LAS u32x4*)(xb + t * 136 + c16 + j) = v;
                }
            }
            __syncthreads();
            {
                const int blk = w & 1, d = (w >> 1) & 1, mat = w >> 2, n = cq * 2 + blk;
                const float* W = (mat ? p->rg_wi : p->rg_wr) + (size_t)(d * 8 + n) * 4096;
                const float* bias = (mat ? p->rg_bi : p->rg_br) + d * 512 + n * 64;
                bf16x8 wf[4][2];
#pragma unroll
                for (int ot = 0; ot < 4; ++ot)
#pragma unroll
                    for (int ks = 0; ks < 2; ++ks) {
                        const float* src = W + (size_t)(ks * 32 + 8 * (lane >> 4)) * 64 + ot * 16 + (lane & 15);
                        float f[8];
#pragma unroll
                        for (int j = 0; j < 8; ++j) f[j] = src[j * 64];
                        u32x4 v; v.x = pk2n(f[0], f[1]); v.y = pk2n(f[2], f[3]); v.z = pk2n(f[4], f[5]); v.w = pk2n(f[6], f[7]);
                        wf[ot][ks] = __builtin_bit_cast(bf16x8, v);
                    }
#pragma unroll
                for (int tt = 0; tt < 4; ++tt) {
                    bf16x8 xf[2];
#pragma unroll
                    for (int ks = 0; ks < 2; ++ks) xf[ks] = frag_row(xb, 136, tt * 16, blk * 64 + ks * 32, lane);
#pragma unroll
                    for (int ot = 0; ot < 4; ++ot) {
                        f32x4 acc = {0.f, 0.f, 0.f, 0.f};
#pragma unroll
                        for (int ks = 0; ks < 2; ++ks) acc = mfma16(wf[ot][ks], xf[ks], acc);
                        const int t = tt * 16 + (lane & 15), o = ot * 16 + 4 * (lane >> 4), c = blk * 64 + o;
                        const f32x4 bv = *(const f32x4*)(bias + o);
                        if (mat == 0) {
                            const f32x4 lam = *(const f32x4*)(p->rg_lambda + d * 512 + n * 64 + o);
                            f32x4 la;
#pragma unroll
                            for (int j = 0; j < 4; ++j) la[j] = -8.f * softplusf_(-lam[j]) * sigmoidf_(acc[j] + bv[j]);
                            *(LAS f32x4*)(lat + (d * 64 + t) * 128 + c) = la;
                        } else {
                            float gi[4];
#pragma unroll
                            for (int j = 0; j < 4; ++j) gi[j] = sigmoidf_(acc[j] + bv[j]) * bf2f(xb[t * 136 + c + j]);
                            u32x2 v; v.x = pk2(gi[0], gi[1]); v.y = pk2(gi[2], gi[3]);
                            *(LAS u32x2*)(git + (d * 64 + t) * 128 + c) = v;
                        }
                    }
                }
            }
            __syncthreads();
            {
                const int c4 = (tid & 31) * 4, rest = tid >> 5, d = rest >> 3, t0 = (rest & 7) * 8, gc = cq * 128 + c4;
#pragma unroll
                for (int j = 0; j < 8; ++j) {
                    const int t = t0 + j;
                    const f32x4 la = *(const LAS f32x4*)(lat + (d * 64 + t) * 128 + c4);
                    const u32x2 gg = *(const LAS u32x2*)(git + (d * 64 + t) * 128 + c4);
                    f32x4 av; float u[4];
                    const float gi[4] = {lo_bf(gg.x), hi_bf(gg.x), lo_bf(gg.y), hi_bf(gg.y)};
#pragma unroll
                    for (int e = 0; e < 4; ++e) { av[e] = __expf(la[e]); u[e] = sqrtf(-expm1f(2.f * la[e])) * gi[e]; }
                    u32x2 uo; uo.x = pk2(u[0], u[1]); uo.y = pk2(u[2], u[3]);
                    *(f32x4*)(LA + ((size_t)(r0 + t) * 2 + d) * 512 + gc) = la;
                    *(u32x2*)(UU + ((size_t)(r0 + t) * 2 + d) * 512 + gc) = uo;
                    *(LAS f32x4*)(lat + (d * 64 + t) * 128 + c4) = av;
                    *(LAS u32x2*)(git + (d * 64 + t) * 128 + c4) = uo;
                }
            }
            __syncthreads();
            {
                const int half = tid >> 8, d = (tid >> 7) & 1, c = tid & 127, gc = cq * 128 + c;
                float hacc = 0.f, aprod = 1.f;
#pragma unroll 8
                for (int s_ = 0; s_ < 32; ++s_) {
                    const int pp = half * 32 + s_, t = d == 0 ? pp : 63 - pp;
                    const float a = lat[(d * 64 + t) * 128 + c], u = bf2f(git[(d * 64 + t) * 128 + c]);
                    hacc = a * hacc + u; aprod *= a;
                }
                LAS float* comb = (LAS float*)xin;
                comb[(half * 256 + d * 128 + c) * 2] = aprod; comb[(half * 256 + d * 128 + c) * 2 + 1] = hacc;
                __syncthreads();
                if (half == 0) {
                    const float a1 = comb[(256 + d * 128 + c) * 2], h1 = comb[(256 + d * 128 + c) * 2 + 1];
                    AGGA[(size_t)(ch * 2 + d) * 512 + gc] = aprod * a1;
                    AGGH[(size_t)(ch * 2 + d) * 512 + gc] = a1 * hacc + h1;
                }
            }
            __syncthreads();
        }
    }
}

DI int scan_chunk(int b, int d, int st) {
    if (st < 4) return NCHL + b * 4 + (d == 0 ? st : 3 - st);
    const int j = st - 4;
    return b * 128 + (d == 0 ? j : 127 - j);
}

DI void phase_scan0(PP p) {
    float* U = (float*)(p->ws + OFF_ARENA + A_U);
    const float* DEC = (const float*)(p->ws + OFF_ARENA + A_DEC);
    const float* AGGA = (const float*)(p->ws + OFF_ARENA + A_AGGA);
    float* AGGH = (float*)(p->ws + OFF_ARENA + A_AGGH);
    const int gid = get_bid() * NTHREADS + get_tid(), nthr = gridDim.x * NTHREADS;
    for (int idx = gid; idx < 65536 + 4096; idx += nthr) {
        if (idx < 65536) {
            const int dv4 = idx & 31, dk = (idx >> 5) & 63, h = (idx >> 11) & 3, d = (idx >> 13) & 1, b = idx >> 14;
            f32x4 S = {0.f, 0.f, 0.f, 0.f};
            for (int st = 0; st < 132; st += 4) {
                f32x4 u[4]; float dc[4]; float* ptr[4];
#pragma unroll
                for (int q = 0; q < 4; ++q) {
                    const int cid = scan_chunk(b, d, st + q);
                    ptr[q] = U + ((size_t)(cid * 2 + d) * 4 + h) * 8192 + dk * 128 + dv4 * 4;
                    u[q] = *(const f32x4*)ptr[q];
                    dc[q] = DEC[(size_t)(cid * 2 + d) * 256 + h * 64 + dk];
                }
#pragma unroll
                for (int q = 0; q < 4; ++q) { *(f32x4*)ptr[q] = S; S = S * dc[q] + u[q]; }
            }
        } else {
            const int i2 = idx - 65536, c = i2 & 511, d = (i2 >> 9) & 1, b = i2 >> 10;
            float hs = 0.f;
            for (int st = 0; st < 132; st += 4) {
                float a[4], hh[4]; float* ptr[4];
#pragma unroll
                for (int q = 0; q < 4; ++q) {
                    const int cid = scan_chunk(b, d, st + q);
                    ptr[q] = AGGH + (size_t)(cid * 2 + d) * 512 + c;
                    hh[q] = *ptr[q]; a[q] = AGGA[(size_t)(cid * 2 + d) * 512 + c];
                }
#pragma unroll
                for (int q = 0; q < 4; ++q) { *ptr[q] = hs; hs = a[q] * hs + hh[q]; }
            }
        }
    }
}

DI void phase_g3(PP p, lds_t lds) {
    const int tid = get_tid(), lane = tid & 63, w = tid >> 6;
    const bf16_t* P = (const bf16_t*)(p->ws + OFF_ARENA + A_P);
    const float* U = (const float*)(p->ws + OFF_ARENA + A_U);
    const float* LA = (const float*)(p->ws + OFF_ARENA + A_LA);
    const bf16_t* UU = (const bf16_t*)(p->ws + OFF_ARENA + A_UU);
    const float* HST = (const float*)(p->ws + OFF_ARENA + A_AGGH);
    bf16_t* act = (bf16_t*)(p->ws + OFF_ACT);
    constexpr int NGLA = NCH * 4;
    for (int task = get_bid(); task < NGLA + NCH; task += gridDim.x) {
        if (task < NGLA) {
            const int ch = task >> 2, h = task & 3, r0 = ch * 64;
            LAS float* lrt = (LAS float*)lds;
            LAS float* wat = lrt + 2048;
            LAS float* bat = wat + 2048;
            LAS float* bc = bat + 128;
            LAS bf16_t* qt = (LAS bf16_t*)(bc + 4096);
            LAS bf16_t* kt = qt + 64 * 72;
            LAS bf16_t* qtd = kt + 64 * 72;
            LAS bf16_t* ktd = qtd + 64 * 72;
            LAS bf16_t* at = ktd + 64 * 72;
            LAS bf16_t* vt = at + 64 * 72;
            LAS bf16_t* St = vt + 64 * 136;
            LAS float* ot = (LAS float*)(St + 64 * 136);
            gla_load_decay_inputs(p, P, r0, h, lrt, wat, bat);
            { const int row = tid >> 3, chunk = tid & 7;
              *(LAS u32x4*)(qt + row * 72 + chunk * 8) = *(const u32x4*)(P + (size_t)(r0 + row) * ABIN + PC_Q + h * 64 + chunk * 8);
              *(LAS u32x4*)(kt + row * 72 + chunk * 8) = *(const u32x4*)(P + (size_t)(r0 + row) * ABIN + PC_K + h * 64 + chunk * 8); }
#pragma unroll
            for (int q = 0; q < 2; ++q) { const int i = tid + 512 * q, row = i >> 4, chunk = i & 15; *(LAS u32x4*)(vt + row * 136 + chunk * 8) = *(const u32x4*)(P + (size_t)(r0 + row) * ABIN + PC_V + h * 128 + chunk * 8); }
            __syncthreads();
            f32x4 oacc[4];
#pragma unroll
            for (int i = 0; i < 4; ++i) oacc[i] = (f32x4){0.f, 0.f, 0.f, 0.f};
            const int ott = w & 3, odv0 = (w >> 2) * 4;
            for (int d = 0; d < 2; ++d) {
                gla_bcum(bc, lrt + d * 1024, wat + d * 1024, bat + d * 64, d, ot);
                {
                    const int t = tid >> 3, c8 = (tid & 7) * 8;
                    float qo[8], ko[8];
#pragma unroll
                    for (int j = 0; j < 8; ++j) { const float e = __expf(bc[t * 64 + c8 + j]); qo[j] = bf2f(qt[t * 72 + c8 + j]) * 0.125f * e; ko[j] = bf2f(kt[t * 72 + c8 + j]) / e; }
                    u32x4 v; v.x = pk2(qo[0], qo[1]); v.y = pk2(qo[2], qo[3]); v.z = pk2(qo[4], qo[5]); v.w = pk2(qo[6], qo[7]);
                    *(LAS u32x4*)(qtd + t * 72 + c8) = v;
                    v.x = pk2(ko[0], ko[1]); v.y = pk2(ko[2], ko[3]); v.z = pk2(ko[4], ko[5]); v.w = pk2(ko[6], ko[7]);
                    *(LAS u32x4*)(ktd + t * 72 + c8) = v;
                    const int dk = tid >> 3, dv16 = (tid & 7) * 16;
                    const float* src = U + ((size_t)(ch * 2 + d) * 4 + h) * 8192 + dk * 128 + dv16;
                    const f32x4 s0 = *(const f32x4*)src, s1 = *(const f32x4*)(src + 4), s2 = *(const f32x4*)(src + 8), s3 = *(const f32x4*)(src + 12);
                    v.x = pk2(s0[0], s0[1]); v.y = pk2(s0[2], s0[3]); v.z = pk2(s1[0], s1[1]); v.w = pk2(s1[2], s1[3]);
                    *(LAS u32x4*)(St + dk * 136 + dv16) = v;
                    v.x = pk2(s2[0], s2[1]); v.y = pk2(s2[2], s2[3]); v.z = pk2(s3[0], s3[1]); v.w = pk2(s3[2], s3[3]);
                    *(LAS u32x4*)(St + dk * 136 + dv16 + 8) = v;
                }
                __syncthreads();
                {
                    const int tt = w >> 1;
#pragma unroll
                    for (int e = 0; e < 2; ++e) {
                        const int st = (w & 1) * 2 + e;
                        f32x4 acc = {0.f, 0.f, 0.f, 0.f};
#pragma unroll
                        for (int ks = 0; ks < 2; ++ks) acc = mfma16(frag_row(ktd, 72, st * 16, ks * 32, lane), frag_row(qtd, 72, tt * 16, ks * 32, lane), acc);
                        const int t = tt * 16 + (lane & 15), s0 = st * 16 + 4 * (lane >> 4);
                        float a[4];
#pragma unroll
                        for (int j = 0; j < 4; ++j) { const int s = s0 + j; a[j] = (d == 0 ? s <= t : s >= t) ? acc[j] : 0.f; }
                        u32x2 v; v.x = pk2(a[0], a[1]); v.y = pk2(a[2], a[3]);
                        *(LAS u32x2*)(at + t * 72 + s0) = v;
                    }
                }
                __syncthreads();
                {
                    bf16x8 af[2], qf[2];
#pragma unroll
                    for (int ks = 0; ks < 2; ++ks) { af[ks] = frag_row(at, 72, ott * 16, ks * 32, lane); qf[ks] = frag_row(qtd, 72, ott * 16, ks * 32, lane); }
#pragma unroll
                    for (int i = 0; i < 4; ++i) {
                        const int dvt = odv0 + i;
#pragma unroll
                        for (int ks = 0; ks < 2; ++ks) {
                            oacc[i] = mfma16(frag_tr(vt, 136, ks * 32, dvt * 16, lane), af[ks], oacc[i]);
                            oacc[i] = mfma16(frag_tr(St, 136, ks * 32, dvt * 16, lane), qf[ks], oacc[i]);
                        }
                    }
                }
                __syncthreads();
            }
#pragma unroll
            for (int i = 0; i < 4; ++i) *(LAS f32x4*)(ot + (ott * 16 + (lane & 15)) * 132 + (odv0 + i) * 16 + 4 * (lane >> 4)) = oacc[i];
            __syncthreads();
            {
                const int t = tid >> 3, dv16 = (tid & 7) * 16;
                float o[16]; float ss = 0.f;
#pragma unroll
                for (int j = 0; j < 16; ++j) { o[j] = ot[t * 132 + dv16 + j]; ss += o[j] * o[j]; }
                ss += __shfl_xor(ss, 1); ss += __shfl_xor(ss, 2); ss += __shfl_xor(ss, 4);
                const float rs = rsqrtf(ss * (1.f / 128.f) + EPS);
                const bf16_t* gp = P + (size_t)(r0 + t) * ABIN + PC_G + h * 128 + dv16;
                const u32x4 g0 = *(const u32x4*)gp, g1 = *(const u32x4*)(gp + 8);
                const unsigned gw[8] = {g0.x, g0.y, g0.z, g0.w, g1.x, g1.y, g1.z, g1.w};
                float r[16];
#pragma unroll
                for (int j = 0; j < 8; ++j) {
                    r[2 * j] = o[2 * j] * rs * p->gla_norm_g[h * 128 + dv16 + 2 * j] * siluf_(lo_bf(gw[j]));
                    r[2 * j + 1] = o[2 * j + 1] * rs * p->gla_norm_g[h * 128 + dv16 + 2 * j + 1] * siluf_(hi_bf(gw[j]));
                }
                bf16_t* dst = act + (size_t)(r0 + t) * 1024 + h * 128 + dv16;
                u32x4 v; v.x = pk2(r[0], r[1]); v.y = pk2(r[2], r[3]); v.z = pk2(r[4], r[5]); v.w = pk2(r[6], r[7]);
                *(u32x4*)dst = v;
                v.x = pk2(r[8], r[9]); v.y = pk2(r[10], r[11]); v.z = pk2(r[12], r[13]); v.w = pk2(r[14], r[15]);
                *(u32x4*)(dst + 8) = v;
            }
            __syncthreads();
        } else {
            const int ch = task - NGLA, r0 = ch * 64, c = tid;
            LAS float* hf = (LAS float*)lds;
            float hs = HST[(size_t)(ch * 2 + 0) * 512 + c];
            for (int tb = 0; tb < 64; tb += 16) {
                float la[16]; bf16_t uu[16];
#pragma unroll
                for (int j = 0; j < 16; ++j) { const size_t o = ((size_t)(r0 + tb + j) * 2 + 0) * 512 + c; la[j] = LA[o]; uu[j] = UU[o]; }
#pragma unroll
                for (int j = 0; j < 16; ++j) { hs = __expf(la[j]) * hs + bf2f(uu[j]); hf[(tb + j) * 512 + c] = hs; }
            }
            hs = HST[(size_t)(ch * 2 + 1) * 512 + c];
            for (int tb = 48; tb >= 0; tb -= 16) {
                float la[16]; bf16_t uu[16], gg[16];
#pragma unroll
                for (int j = 0; j < 16; ++j) { const size_t o = ((size_t)(r0 + tb + j) * 2 + 1) * 512 + c; la[j] = LA[o]; uu[j] = UU[o]; gg[j] = P[(size_t)(r0 + tb + j) * ABIN + PC_RGG + c]; }
#pragma unroll
                for (int j = 15; j >= 0; --j) {
                    hs = __expf(la[j]) * hs + bf2f(uu[j]);
                    act[(size_t)(r0 + tb + j) * 1024 + 512 + c] = f2bf((hf[(tb + j) * 512 + c] + hs) * gelu_tanh(bf2f(gg[j])));
                }
            }
            __syncthreads();
        }
    }
}


DI void phase_outproj0(PP p, lds_t lds) {
    const bf16_t* act = (const bf16_t*)(p->ws + OFF_ACT);
    float* X = (float*)(p->ws + OFF_ARENA + A_X);
    constexpr int NM = NTOK / 256, NN = 4;
    for (int u = get_bid(); u < NM * NN; u += gridDim.x) {
        const int pn = u / NM, pm = u % NM;
        const int set = row_set(pm * 256);
        const float* g1 = mods_ptr(p, 0, set, 2);
        const float* xin = pm * 256 < NLAT ? p->x + (size_t)pm * 256 * 1024 : p->ctx + (size_t)(pm * 256 - NLAT) * 1024;
        gemm_unit<256>(lds, 1024, 1024,
            [&](int r) { return act + (size_t)(pm * 256 + r) * 1024; },
            [&](int j) -> const float* { return p->ab_w_out + pn * 256 + j; },
            [&](const f32x4 (&acc)[8][4], int wr, int wc, int lane) {
                epi_each<4>(acc, wr, wc, lane, [&](int r, int c, f32x4 v) {
                    const int col = pn * 256 + c;
                    const f32x4 xi = *(const f32x4*)(xin + (size_t)r * 1024 + col), g = *(const f32x4*)(g1 + col);
                    *(f32x4*)(X + (size_t)(pm * 256 + r) * 1024 + col) = xi + g * v;
                });
            });
    }
}

struct MoeBufs { float* PT; float* PE; int* ROWID; int* ROWTOK; bf16_t* HDN; bf16_t* Y; int rpe; int nrows; };
DI MoeBufs moe_bufs(PP p, int layer) {
    MoeBufs m;
    char* a = p->ws + OFF_ARENA;
    if (layer == 0) { m.PT = (float*)(a + A_PT); m.PE = (float*)(a + A_PE); m.ROWID = (int*)(a + A_ROWID); m.ROWTOK = (int*)(a + A_ROWTOK); m.HDN = (bf16_t*)(a + A_HDN); m.Y = (bf16_t*)(a + A_Y); m.rpe = 4352; m.nrows = NTOK; }
    else { m.PT = (float*)(a + A_HB); m.PE = (float*)(a + A_HB + (size_t)NTOK * 64); m.ROWID = (int*)(a + A_HB + (size_t)NTOK * 128); m.ROWTOK = (int*)(a + A_HB + (size_t)NTOK * 192); m.HDN = (bf16_t*)(a + A_XM); m.Y = (bf16_t*)(a + A_XC); m.rpe = 4096; m.nrows = NLAT; }
    return m;
}

DI void phase_router(PP p, lds_t lds, int layer) {
    const int tid = get_tid(), lane = tid & 63;
    const MoeBufs m = moe_bufs(p, layer);
    const float* X = (const float*)(p->ws + OFF_ARENA + A_X);
    bf16_t* act = (bf16_t*)(p->ws + OFF_ACT);
    LAS float* rwT = (LAS float*)lds;
    for (int i = tid; i < 16384; i += NTHREADS) { const int k = i >> 4, e = i & 15; rwT[e * 1024 + k] = p->router_w[(size_t)layer * 16384 + i]; }
    __syncthreads();
    const int gw = get_bid() * 8 + (tid >> 6), nw = gridDim.x * 8;
    for (int r = gw; r < m.nrows; r += nw) {
        f32x4 v[4];
        row_load_f32(X + (size_t)r * 1024, v, lane);
        const float rs = rsqrtf(row_sumsq(v) * (1.f / 1024.f) + EPS);
        const int set = row_set(r);
        row_modulate(v, rs, p->norm2_g + layer * 1024, mods_ptr(p, layer, set, 4), mods_ptr(p, layer, set, 3), lane);
        row_store_bf16(act + (size_t)r * 1024, v, lane);
        float lg[16];
#pragma unroll
        for (int e = 0; e < 16; ++e) {
            float a = 0.f;
#pragma unroll
            for (int i = 0; i < 4; ++i) { const f32x4 wv = *(const LAS f32x4*)(rwT + e * 1024 + 4 * lane + 256 * i); a += v[i][0] * wv[0] + v[i][1] * wv[1] + v[i][2] * wv[2] + v[i][3] * wv[3]; }
            lg[e] = wave_sum(a);
            asm volatile("" ::: "memory");
        }
        float mx = lg[0];
#pragma unroll
        for (int e = 1; e < 16; ++e) mx = fmaxf(mx, lg[e]);
        float sum = 0.f;
#pragma unroll
        for (int e = 0; e < 16; ++e) { lg[e] = __expf(lg[e] - mx); sum += lg[e]; }
        const float inv = 1.f / sum;
        float mine = 0.f;
#pragma unroll
        for (int e = 0; e < 16; ++e) if (lane == e) mine = lg[e] * inv;
        if (lane < 16) {
            m.PT[(size_t)r * 16 + lane] = mine;
            if (r < NLAT) m.PE[((size_t)(r >> 13) * 16 + lane) * 8192 + (r & 8191)] = mine;
            else { const int rc = r - NLAT; m.PE[(size_t)NBATCH * 16 * 8192 + ((size_t)(rc >> 8) * 16 + lane) * 256 + (rc & 255)] = mine; }
        }
    }
}

DI int block_excl_scan(int v, LAS int* tmp, int* total) {
    const int tid = get_tid(), lane = tid & 63, w = tid >> 6;
    int inc = v;
#pragma unroll
    for (int o = 1; o < 64; o <<= 1) { const int t = __shfl_up(inc, o); if (lane >= o) inc += t; }
    __syncthreads();
    if (lane == 63) tmp[w] = inc;
    __syncthreads();
    int base = 0, tot = 0;
#pragma unroll
    for (int i = 0; i < 8; ++i) { const int t = tmp[i]; if (i < w) base += t; tot += t; }
    *total = tot;
    return base + inc - v;
}

DI void phase_topk(PP p, lds_t lds, int layer) {
    const int tid = get_tid();
    const MoeBufs m = moe_bufs(p, layer);
    LAS unsigned* keys = (LAS unsigned*)lds;
    LAS int* hist = (LAS int*)(keys + 8192);
    LAS int* tmp = hist + 256;
    LAS int* sel = tmp + 16;
    const int ntask = layer == 0 ? 128 : 64;
    for (int task = get_bid(); task < ntask; task += gridDim.x) {
        const bool isctx = task >= 64;
        const int b = (task & 63) >> 4, e = task & 15;
        const int n = isctx ? 256 : 8192, cap = isctx ? 32 : 1024;
        const float* src = isctx ? m.PE + (size_t)NBATCH * 16 * 8192 + ((size_t)b * 16 + e) * 256 : m.PE + ((size_t)b * 16 + e) * 8192;
        for (int i = tid; i < n; i += NTHREADS) keys[i] = __float_as_uint(src[i]);
        __syncthreads();
        unsigned prefix = 0u, mask = 0u; int kk = cap;
        for (int pass = 3; pass >= 0; --pass) {
            const int shift = pass * 8;
            if (tid < 256) hist[tid] = 0;
            __syncthreads();
            for (int i = tid; i < n; i += NTHREADS) { const unsigned k = keys[i]; if ((k & mask) == prefix) __hip_atomic_fetch_add((int*)(hist + ((k >> shift) & 255)), 1, __ATOMIC_RELAXED, __HIP_MEMORY_SCOPE_WORKGROUP); }
            __syncthreads();
            if (tid < 256) {
                int above = 0;
                for (int j = tid + 1; j < 256; ++j) above += hist[j];
                const int mineh = hist[tid];
                if (above < kk && kk <= above + mineh) { sel[0] = tid; sel[1] = above; }
            }
            __syncthreads();
            prefix |= (unsigned)sel[0] << shift; mask |= 0xffu << shift; kk -= sel[1];
            __syncthreads();
        }
        const unsigned T = prefix; const int need_eq = kk;
        const int ipt = n / NTHREADS > 0 ? n / NTHREADS : 1;
        const int i0 = tid * ipt;
        int cgt = 0, ceq = 0;
        if (i0 < n) for (int j = 0; j < ipt; ++j) { const unsigned k = keys[i0 + j]; cgt += k > T; ceq += k == T; }
        int tot;
        const int egt = block_excl_scan(cgt, tmp, &tot);
        const int eeq = block_excl_scan(ceq, tmp, &tot);
        const int slot0 = e * m.rpe + (isctx ? 4096 + b * 32 : b * 1024);
        const int row0 = isctx ? NLAT + b * 256 : b * 8192;
        if (i0 < n) {
            int ngt = egt, neq = eeq;
            for (int j = 0; j < ipt; ++j) {
                const unsigned k = keys[i0 + j];
                int slot = -1;
                if (k > T) { slot = slot0 + ngt + (neq < need_eq ? neq : need_eq); ++ngt; }
                else if (k == T) { if (neq < need_eq) slot = slot0 + ngt + neq; ++neq; }
                m.ROWID[(size_t)(row0 + i0 + j) * 16 + e] = slot;
                if (slot >= 0) m.ROWTOK[slot] = row0 + i0 + j;
            }
        }
        if (isctx && b == 0 && layer == 0) for (int i = tid; i < 128; i += NTHREADS) m.ROWTOK[e * m.rpe + 4224 + i] = -1;
        __syncthreads();
    }
}

DI void phase_moe_up(PP p, lds_t lds, int layer) {
    const MoeBufs m = moe_bufs(p, layer);
    const bf16_t* act = (const bf16_t*)(p->ws + OFF_ACT);
    const int nmt = layer == 0 ? 17 : 16;
    const int nunits = 16 * nmt * 8;
    for (int u = get_bid(); u < nunits; u += gridDim.x) {
        const int e = u / (nmt * 8), rem = u % (nmt * 8), nt = rem / nmt, mt = rem % nmt;
        const float* Wg = p->exp_w_gate + ((size_t)layer * 16 + e) * 1048576;
        const float* Wu = p->exp_w_up + ((size_t)layer * 16 + e) * 1048576;
        const int* rt = m.ROWTOK + e * m.rpe + mt * 256;
        bf16_t* H = m.HDN + ((size_t)e * m.rpe + mt * 256) * 1024 + nt * 128;
        gemm_unit<256>(lds, 1024, 1024,
            [&](int r) -> const bf16_t* { const int tok = rt[r]; return tok >= 0 ? act + (size_t)tok * 1024 : nullptr; },
            [&](int j) -> const float* { const int wcq = j >> 6, within = j & 63; const int hc = nt * 128 + wcq * 32 + (within & 31); return (within < 32 ? Wg : Wu) + hc; },
            [&](const f32x4 (&acc)[8][4], int wr, int wc, int lane) {
#pragma unroll
                for (int mi = 0; mi < 8; ++mi)
#pragma unroll
                    for (int ni = 0; ni < 2; ++ni) {
                        const f32x4 g = acc[mi][ni], uu = acc[mi][ni + 2];
                        f32x4 h;
#pragma unroll
                        for (int j = 0; j < 4; ++j) h[j] = siluf_(g[j]) * uu[j];
                        store_bf16x4(H + (size_t)(wr * 128 + mi * 16 + (lane & 15)) * 1024 + wc * 32 + ni * 16 + 4 * (lane >> 4), h);
                    }
            });
    }
}

DI void phase_moe_down(PP p, lds_t lds, int layer) {
    const MoeBufs m = moe_bufs(p, layer);
    const int nmt = layer == 0 ? 17 : 16;
    const int nunits = 16 * nmt * 4;
    for (int u = get_bid(); u < nunits; u += gridDim.x) {
        const int e = u / (nmt * 4), rem = u % (nmt * 4), nt = rem / nmt, mt = rem % nmt;
        const float* Wd = p->exp_w_down + ((size_t)layer * 16 + e) * 1048576;
        const bf16_t* H = m.HDN + ((size_t)e * m.rpe + mt * 256) * 1024;
        bf16_t* Y = m.Y + ((size_t)e * m.rpe + mt * 256) * 1024 + nt * 256;
        gemm_unit<256>(lds, 1024, 1024,
            [&](int r) { return H + (size_t)r * 1024; },
            [&](int j) -> const float* { return Wd + nt * 256 + j; },
            [&](const f32x4 (&acc)[8][4], int wr, int wc, int lane) {
                epi_each<4>(acc, wr, wc, lane, [&](int r, int c, f32x4 v) { store_bf16x4(Y + (size_t)r * 1024 + c, v); });
            });
    }
}

DI void phase_combine(PP p, int layer) {
    const int tid = get_tid(), lane = tid & 63;
    const MoeBufs m = moe_bufs(p, layer);
    float* X = (float*)(p->ws + OFF_ARENA + A_X);
    bf16_t* act = (bf16_t*)(p->ws + OFF_ACT);
    const int gw = get_bid() * 8 + (tid >> 6), nw = gridDim.x * 8;
    for (int r = gw; r < m.nrows; r += nw) {
        f32x4 v[4], a[4];
        row_load_f32(X + (size_t)r * 1024, v, lane);
#pragma unroll
        for (int i = 0; i < 4; ++i) a[i] = (f32x4){0.f, 0.f, 0.f, 0.f};
        for (int e = 0; e < 16; ++e) {
            const int rid = m.ROWID[(size_t)r * 16 + e];
            if (rid >= 0) {
                const float pe = m.PT[(size_t)r * 16 + e];
                const bf16_t* y = m.Y + (size_t)rid * 1024;
#pragma unroll
                for (int i = 0; i < 4; ++i) { const u32x2 yy = *(const u32x2*)(y + 4 * lane + 256 * i); a[i][0] += pe * lo_bf(yy.x); a[i][1] += pe * hi_bf(yy.x); a[i][2] += pe * lo_bf(yy.y); a[i][3] += pe * hi_bf(yy.y); }
            }
        }
        const int set = row_set(r);
        const float* g2 = mods_ptr(p, layer, set, 5);
#pragma unroll
        for (int i = 0; i < 4; ++i) { const f32x4 g = *(const f32x4*)(g2 + 4 * lane + 256 * i); v[i] = v[i] + g * a[i]; }
        const float rs = rsqrtf(row_sumsq(v) * (1.f / 1024.f) + EPS);
        if (layer == 0) {
#pragma unroll
            for (int i = 0; i < 4; ++i) *(f32x4*)(X + (size_t)r * 1024 + 4 * lane + 256 * i) = v[i];
            row_modulate(v, rs, p->norm1_g + 1024, mods_ptr(p, 1, set, 1), mods_ptr(p, 1, set, 0), lane);
            row_store_bf16(act + (size_t)r * 1024, v, lane);
        } else {
#pragma unroll
            for (int i = 0; i < 4; ++i) { const f32x4 g = *(const f32x4*)(p->final_g + 4 * lane + 256 * i); *(f32x4*)(p->out + (size_t)r * 1024 + 4 * lane + 256 * i) = v[i] * rs * g; }
        }
    }
}


DI void phase_upproj(PP p, lds_t lds, int half) {
    const bf16_t* act = (const bf16_t*)(p->ws + OFF_ACT);
    bf16_t* O = (bf16_t*)(p->ws + OFF_ARENA + A_XM);
    const int NM = half == 0 ? NTOK / 256 : NLAT / 256, NN = 8;
    for (int u = get_bid(); u < NM * NN; u += gridDim.x) {
        const int pn = u / NM, pm = u % NM;
        gemm_unit<256>(lds, 1024, 4096,
            [&](int r) { return act + (size_t)(pm * 256 + r) * 1024; },
            [&](int j) -> const float* { return p->m_w_up + half * 2048 + pn * 256 + j; },
            [&](const f32x4 (&acc)[8][4], int wr, int wc, int lane) {
                epi_each<4>(acc, wr, wc, lane, [&](int r, int c, f32x4 v) { store_bf16x4(O + (size_t)(pm * 256 + r) * 2048 + pn * 256 + c, v); });
            });
    }
}

DI void phase_mfeat(PP p, lds_t lds) {
    const int tid = get_tid(), lane = tid & 63, w = tid >> 6;
    bf16_t* XM = (bf16_t*)(p->ws + OFF_ARENA + A_XM);
    bf16_t* XC = (bf16_t*)(p->ws + OFF_ARENA + A_XC);
    bf16_t* CTXV = (bf16_t*)(p->ws + OFF_ACT + ACT_CTXV);
    bf16_t* RAWS = (bf16_t*)(p->ws + OFF_ACT + ACT_RAWS);
    float* GP = (float*)(p->ws + OFF_ACT + ACT_GP);
    const bf16_t* GC = (const bf16_t*)(p->ws + OFF_GCAT);
    const float* MM = (const float*)(p->ws + OFF_MMAT);
    LAS bf16_t* xin = (LAS bf16_t*)lds;
    LAS bf16_t* xct = xin + 67 * 136;
    LAS bf16_t* qpt = xct + 64 * 136;
    LAS bf16_t* gxc = qpt + 64 * 136;
    LAS bf16_t* gxm = gxc + 128 * 16;
    LAS float* mq = (LAS float*)(gxm + 128 * 16);
    LAS float* wvq = mq + 512;
    LAS float* cw = wvq + 512;
    LAS float* gred = cw + 640;
    for (int task = get_bid(); task < NCH * 4; task += gridDim.x) {
        const int ch = task >> 2, h = task & 3, r0 = ch * 64;
        const int seg_lo = ch < NCHL ? r0 : NLAT + ((r0 - NLAT) >> 8) * 256, seg_hi = ch < NCHL ? r0 + 64 : seg_lo + 256;
        f32x4 rs_acc[2] = {{0.f, 0.f, 0.f, 0.f}, {0.f, 0.f, 0.f, 0.f}};
        f32x4 g_acc = {0.f, 0.f, 0.f, 0.f};
        for (int q4 = 0; q4 < 4; ++q4) {
            const int col0 = h * 512 + q4 * 128;
            for (int i = tid; i < 67 * 16; i += NTHREADS) {
                const int row = i >> 4, chunk = i & 15, r = r0 - 2 + row;
                u32x4 v = {0u, 0u, 0u, 0u};
                if (r >= seg_lo && r < seg_hi) v = *(const u32x4*)(XM + (size_t)r * 2048 + col0 + chunk * 8);
                *(LAS u32x4*)(xin + row * 136 + chunk * 8) = v;
            }
            if (tid < 256) *(LAS u32x4*)(gxc + tid * 8) = *(const u32x4*)(GC + (size_t)col0 * 16 + tid * 8);
            else *(LAS u32x4*)(gxm + (tid - 256) * 8) = *(const u32x4*)(GC + (size_t)(2048 + col0) * 16 + (tid - 256) * 8);
            mq[tid] = bf2f(f2bf(MM[(size_t)(col0 >> 2) * 16 + tid]));
            wvq[tid] = p->m_wv[(size_t)(col0 >> 2) * 16 + tid];
            for (int i = tid; i < 640; i += NTHREADS) cw[i] = i < 512 ? p->m_conv_w[(size_t)(i >> 7) * 2048 + col0 + (i & 127)] : p->m_conv_b[col0 + i - 512];
            __syncthreads();
            {
                const int t = tid >> 3, c16 = (tid & 7) * 16;
                float xc[16], xm[16];
#pragma unroll
                for (int j = 0; j < 16; ++j) { xc[j] = cw[512 + c16 + j]; xm[j] = bf2f(xin[(t + 2) * 136 + c16 + j]); }
#pragma unroll
                for (int tap = 0; tap < 4; ++tap)
#pragma unroll
                    for (int j = 0; j < 16; ++j) xc[j] += cw[tap * 128 + c16 + j] * bf2f(xin[(t + tap) * 136 + c16 + j]);
                unsigned xcp[8];
#pragma unroll
                for (int j = 0; j < 8; ++j) { xcp[j] = pk2(siluf_(xc[2 * j]), siluf_(xc[2 * j + 1])); xc[2 * j] = lo_bf(xcp[j]); xc[2 * j + 1] = hi_bf(xcp[j]); }
                float vv[16], qp[16];
#pragma unroll
                for (int n = 0; n < 4; ++n) {
                    const int nb = (c16 >> 2) + n;
#pragma unroll
                    for (int o = 0; o < 4; ++o) {
                        float a = 0.f, b = 0.f;
#pragma unroll
                        for (int i = 0; i < 4; ++i) { a += xm[4 * n + i] * wvq[nb * 16 + i * 4 + o]; b += xc[4 * n + i] * mq[nb * 16 + i * 4 + o]; }
                        vv[4 * n + o] = a; qp[4 * n + o] = b;
                    }
                }
                u32x4 v0, v1;
                v0.x = xcp[0]; v0.y = xcp[1]; v0.z = xcp[2]; v0.w = xcp[3]; v1.x = xcp[4]; v1.y = xcp[5]; v1.z = xcp[6]; v1.w = xcp[7];
                *(LAS u32x4*)(xct + t * 136 + c16) = v0; *(LAS u32x4*)(xct + t * 136 + c16 + 8) = v1;
                bf16_t* xcg = XC + (size_t)(r0 + t) * 2048 + col0 + c16;
                *(u32x4*)xcg = v0; *(u32x4*)(xcg + 8) = v1;
                v0.x = pk2(qp[0], qp[1]); v0.y = pk2(qp[2], qp[3]); v0.z = pk2(qp[4], qp[5]); v0.w = pk2(qp[6], qp[7]);
                v1.x = pk2(qp[8], qp[9]); v1.y = pk2(qp[10], qp[11]); v1.z = pk2(qp[12], qp[13]); v1.w = pk2(qp[14], qp[15]);
                *(LAS u32x4*)(qpt + t * 136 + c16) = v0; *(LAS u32x4*)(qpt + t * 136 + c16 + 8) = v1;
                v0.x = pk2(vv[0], vv[1]); v0.y = pk2(vv[2], vv[3]); v0.z = pk2(vv[4], vv[5]); v0.w = pk2(vv[6], vv[7]);
                v1.x = pk2(vv[8], vv[9]); v1.y = pk2(vv[10], vv[11]); v1.z = pk2(vv[12], vv[13]); v1.w = pk2(vv[14], vv[15]);
                bf16_t* vg = ch < NCHL ? XM + (size_t)(r0 + t) * 2048 + col0 + c16 : CTXV + (size_t)(r0 + t - NLAT) * 2048 + col0 + c16;
                *(u32x4*)vg = v0; *(u32x4*)(vg + 8) = v1;
            }
            __syncthreads();
            {
                const int tt = w >> 1;
#pragma unroll
                for (int e = 0; e < 2; ++e) {
                    const int st = (w & 1) * 2 + e;
#pragma unroll
                    for (int ks = 0; ks < 4; ++ks) rs_acc[e] = mfma16(frag_row(xct, 136, st * 16, ks * 32, lane), frag_row(qpt, 136, tt * 16, ks * 32, lane), rs_acc[e]);
                }
                const int gt = w & 3, src = w >> 2;
                const LAS bf16_t* gm = src ? gxm : gxc;
                const LAS bf16_t* ft = src ? xin + 2 * 136 : xct;
#pragma unroll
                for (int ks = 0; ks < 4; ++ks) g_acc = mfma16(frag_tr(gm, 16, ks * 32, 0, lane), frag_row(ft, 136, gt * 16, ks * 32, lane), g_acc);
            }
            __syncthreads();
        }
        {
            const int tt = w >> 1;
#pragma unroll
            for (int e = 0; e < 2; ++e) {
                const int st = (w & 1) * 2 + e;
                store_bf16x4(RAWS + ((size_t)task * 64 + tt * 16 + (lane & 15)) * 64 + st * 16 + 4 * (lane >> 4), rs_acc[e]);
            }
            const int gt = w & 3, src = w >> 2;
            *(LAS f32x4*)(gred + (src * 64 + gt * 16 + (lane & 15)) * 16 + 4 * (lane >> 4)) = g_acc;
        }
        __syncthreads();
        if (tid < 256) {
            const int t = tid >> 2, q = tid & 3;
            const f32x4 a = *(const LAS f32x4*)(gred + t * 16 + q * 4), b = *(const LAS f32x4*)(gred + (64 + t) * 16 + q * 4);
            *(f32x4*)(GP + ((size_t)(r0 + t) * 4 + h) * 16 + q * 4) = a + b;
        }
        __syncthreads();
    }
}

constexpr int MS_KLD = 1056, MS_QLD = 1040;
constexpr size_t ACT_MSC = 32u << 20;
static_assert(ACT_MSC >= ACT_CTXV + (size_t)NCTX * 2048 * 2 && ACT_MSC + (size_t)256 * 132 * 192 * 4 <= ACT_BYTES, "msc scratch");
#define MS_REGIONS(L) \
    lds_t xct = (L);                                                         \
    lds_t qpt = (L) + 64 * MS_KLD;                                           \
    LAS bf16_t* vt = (LAS bf16_t*)((L) + 64 * MS_KLD + 64 * MS_QLD);         \
    LAS bf16_t* St = vt + 4096;                                              \
    LAS bf16_t* vwt = St + 4096;                                             \
    LAS float* sc_b = (LAS float*)(vwt + 4096); \
    LAS float* sc_m = sc_b + 64; LAS float* sc_li = sc_m + 64; LAS float* sc_w = sc_li + 64; LAS float* sc_di = sc_w + 64; LAS float* sc_rs = sc_di + 64; \
    LAS float* sc_misc = sc_rs + 64;                                         \
    LAS float* qn = sc_misc + 8;                                             \
    LAS float* nvec = qn + 64;                                               \
    LAS float* red = (LAS float*)qpt;
DI void phase_mscan(PP p, lds_t lds) {
    const int tid = get_tid(), lane = tid & 63, w = tid >> 6, bid = get_bid();
    if (bid >= 256) return;
    const int grp = bid & 31, sl = bid >> 5, b = grp >> 3, h = (grp >> 1) & 3, d = grp & 1;
    const bf16_t* XC = (const bf16_t*)(p->ws + OFF_ARENA + A_XC);
    const bf16_t* V = (const bf16_t*)(p->ws + OFF_ARENA + A_XM);
    const bf16_t* CTXV = (const bf16_t*)(p->ws + OFF_ACT + ACT_CTXV);
    const bf16_t* RAWS = (const bf16_t*)(p->ws + OFF_ACT + ACT_RAWS);
    const float* GP = (const float*)(p->ws + OFF_ACT + ACT_GP);
    float* MSC = (float*)(p->ws + OFF_ACT + ACT_MSC) + (size_t)bid * 132 * 192;
    bf16_t* H = d == 0 ? (bf16_t*)p->out : (bf16_t*)(p->ws + OFF_ARENA + A_HB);
    static_assert(64 * MS_KLD + 64 * MS_QLD + 3 * 8192 + (6 * 64 + 8 + 64 + 512) * 4 <= LDS_BYTES, "mscan lds");
    {
        const float bias_i = p->m_b_gates[d * 8 + h], bias_f = p->m_b_gates[d * 8 + 4 + h];
        for (int st = w; st < 132; st += 8) {
            const int cid = scan_chunk(b, d, st), t = d ? 63 - lane : lane;
            const float* gp = GP + (size_t)(cid * 64 + t) * 64;
            const float gli = gp[d * 8 + h] + gp[16 + d * 8 + h] + gp[32 + d * 8 + h] + gp[48 + d * 8 + h] + bias_i;
            const float gf = gp[d * 8 + 4 + h] + gp[16 + d * 8 + 4 + h] + gp[32 + d * 8 + 4 + h] + gp[48 + d * 8 + 4 + h] + bias_f;
            float bb = log_sigmoidf_(gf);
#pragma unroll
            for (int o = 1; o < 64; o <<= 1) { const float t_ = __shfl_up(bb, o); if (lane >= o) bb += t_; }
            float pm = gli - bb;
#pragma unroll
            for (int o = 1; o < 64; o <<= 1) { const float t_ = __shfl_up(pm, o); if (lane >= o) pm = fmaxf(pm, t_); }
            float* dst = MSC + (size_t)st * 192;
            dst[lane] = bb; dst[64 + lane] = gli; dst[128 + lane] = pm;
        }
    }
    const int c16o = tid & 63;
    bf16x2_t Mp[2][4][2];
#pragma unroll
    for (int n = 0; n < 2; ++n) {
        const float* mm = (const float*)(p->ws + OFF_MMAT) + (size_t)(h * 128 + 2 * c16o + n) * 16;
#pragma unroll
        for (int o = 0; o < 4; ++o) { Mp[n][o][0] = __builtin_bit_cast(bf16x2_t, pk2(mm[o], mm[4 + o])); Mp[n][o][1] = __builtin_bit_cast(bf16x2_t, pk2(mm[8 + o], mm[12 + o])); }
    }
    f32x4 C[16];
#pragma unroll
    for (int i = 0; i < 16; ++i) C[i] = (f32x4){0.f, 0.f, 0.f, 0.f};
    f32x4 Nacc[4];
#pragma unroll
    for (int i = 0; i < 4; ++i) Nacc[i] = (f32x4){0.f, 0.f, 0.f, 0.f};
    { MS_REGIONS(lds) nvec[tid] = 0.f; (void)xct; (void)vt; (void)sc_b; (void)red; }
    float m_prev = 0.f;
    u32x4 xcr[8], vr, rr; float g_b = 0.f, g_li = 0.f, g_pm = 0.f;
    asm volatile("s_waitcnt vmcnt(0)" ::: "memory");
    __syncthreads();
    auto prefetch = [&](int st) {
        int tp = get_tid();
        const int tid = tp, lane = tid & 63, w = tid >> 6;
        const int cid = scan_chunk(b, d, st), r0 = cid * 64;
        const bf16_t* xp = XC + (size_t)(r0 + (tid >> 6)) * 2048 + h * 512 + (tid & 63) * 8;
#pragma unroll
        for (int i = 0; i < 8; ++i) xcr[i] = *(const u32x4*)(xp + (size_t)i * 8 * 2048);
        { const int s_ = tid >> 3, chunk = tid & 7;
          vr = cid < NCHL ? *(const u32x4*)(V + (size_t)(r0 + s_) * 2048 + h * 512 + sl * 64 + chunk * 8) : *(const u32x4*)(CTXV + (size_t)(r0 + s_ - NLAT) * 2048 + h * 512 + sl * 64 + chunk * 8);
          rr = *(const u32x4*)(RAWS + ((size_t)(cid * 4 + h) * 64 + s_) * 64 + chunk * 8); }
        if (w == 0) { const float* src = MSC + (size_t)st * 192; g_b = src[lane]; g_li = src[64 + lane]; g_pm = src[128 + lane]; }
    };
    prefetch(0);
    for (int st = 0; st < 132; ++st) {
        const int cid = scan_chunk(b, d, st);
        const bool emit = cid < NCHL;
        int tl = tid, zoff = 0;
        asm volatile("" : "+v"(tl), "+v"(zoff));
        const int tid = tl, lane = tid & 63, w = tid >> 6, cg = w & 3, kh = w >> 2, g4 = lane >> 4, l15 = lane & 15, c16 = tid & 63, srow0 = tid >> 6;
        MS_REGIONS(lds + zoff)
        __syncthreads();
        {
            lds_t xw_ = xct + srow0 * MS_KLD + c16 * 16;
            lds_t qw_ = qpt + srow0 * MS_QLD + c16 * 16;
#pragma unroll
            for (int i = 0; i < 8; ++i) {
                const unsigned xw[4] = {xcr[i].x, xcr[i].y, xcr[i].z, xcr[i].w};
                float q[8];
#pragma unroll
                for (int n = 0; n < 2; ++n)
#pragma unroll
                    for (int o = 0; o < 4; ++o)
                        q[4 * n + o] = __builtin_amdgcn_fdot2_f32_bf16(__builtin_bit_cast(bf16x2_t, xw[2 * n + 1]), Mp[n][o][1], __builtin_amdgcn_fdot2_f32_bf16(__builtin_bit_cast(bf16x2_t, xw[2 * n]), Mp[n][o][0], 0.f, false), false);
                u32x4 qv; qv.x = pk2(q[0], q[1]); qv.y = pk2(q[2], q[3]); qv.z = pk2(q[4], q[5]); qv.w = pk2(q[6], q[7]);
                *(LAS u32x4*)(xw_ + i * 8 * MS_KLD) = xcr[i];
                *(LAS u32x4*)(qw_ + i * 8 * MS_QLD) = qv;
            }
        }
        { const int s_ = tid >> 3, chunk = tid & 7;
          *(LAS u32x4*)(vt + s_ * 64 + chunk * 8) = vr;
          *(LAS u32x4*)(St + s_ * 64 + chunk * 8) = rr; }
        if (w == 0) {
            const float my_m = g_b + fmaxf(m_prev, g_pm);
            const float m_new = __shfl(my_m, 63), b_last = __shfl(g_b, 63);
            const int t = d ? 63 - lane : lane;
            sc_b[t] = g_b; sc_m[t] = my_m; sc_li[t] = g_li - g_b; sc_w[t] = __expf(b_last - g_b + g_li - m_new); sc_di[t] = __expf(g_b + m_prev - my_m);
            qn[lane] = 0.f;
            if (lane == 0) sc_misc[0] = __expf(b_last + m_prev - m_new);
            m_prev = m_new;
        }
        __syncthreads();
        if (emit) {
            const int t = tid & 63, part = tid >> 6;
            float a = 0.f;
            lds_t qr = qpt + t * MS_QLD + part * 128;
            const LAS float* nn = nvec + part * 64;
#pragma unroll
            for (int i = 0; i < 8; ++i) {
                const u32x4 qq = *(const LAS u32x4*)(qr + i * 16);
                const f32x4 n0 = *(const LAS f32x4*)(nn + 8 * i), n1 = *(const LAS f32x4*)(nn + 8 * i + 4);
                a += lo_bf(qq.x) * n0[0] + hi_bf(qq.x) * n0[1] + lo_bf(qq.y) * n0[2] + hi_bf(qq.y) * n0[3] + lo_bf(qq.z) * n1[0] + hi_bf(qq.z) * n1[1] + lo_bf(qq.w) * n1[2] + hi_bf(qq.w) * n1[3];
            }
            __hip_atomic_fetch_add((float*)(qn + t), a, __ATOMIC_RELAXED, __HIP_MEMORY_SCOPE_WORKGROUP);
        }
        {
            const int t = tid >> 3, s8 = (tid & 7) * 8;
            if (emit) {
                const u32x4 rw = *(const LAS u32x4*)(St + t * 64 + s8);
                const unsigned rwv[4] = {rw.x, rw.y, rw.z, rw.w};
                const float base = sc_b[t] - sc_m[t];
                const f32x4 e0 = *(const LAS f32x4*)(sc_li + s8), e1 = *(const LAS f32x4*)(sc_li + s8 + 4);
                float sv[8]; float rsum = 0.f;
#pragma unroll
                for (int j = 0; j < 8; ++j) {
                    const int s_ = s8 + j;
                    const float raw = (j & 1) ? hi_bf(rwv[j >> 1]) : lo_bf(rwv[j >> 1]);
                    const bool keep = d == 0 ? s_ <= t : s_ >= t;
                    const float ex = __expf(base + (j < 4 ? e0[j & 3] : e1[j & 3]));
                    sv[j] = keep ? raw * ex : 0.f;
                    rsum += sv[j];
                }
                u32x4 o; o.x = pk2(sv[0], sv[1]); o.y = pk2(sv[2], sv[3]); o.z = pk2(sv[4], sv[5]); o.w = pk2(sv[6], sv[7]);
                *(LAS u32x4*)(St + t * 64 + s8) = o;
                rsum += __shfl_xor(rsum, 1); rsum += __shfl_xor(rsum, 2); rsum += __shfl_xor(rsum, 4);
                if ((tid & 7) == 0) sc_rs[t] = rsum;
            }
            {
                const u32x4 vv = *(const LAS u32x4*)(vt + t * 64 + s8);
                const float ww = sc_w[t];
                u32x4 o; o.x = pk2(lo_bf(vv.x) * ww, hi_bf(vv.x) * ww); o.y = pk2(lo_bf(vv.y) * ww, hi_bf(vv.y) * ww); o.z = pk2(lo_bf(vv.z) * ww, hi_bf(vv.z) * ww); o.w = pk2(lo_bf(vv.w) * ww, hi_bf(vv.w) * ww);
                *(LAS u32x4*)(vwt + t * 64 + s8) = o;
            }
        }
        __syncthreads();
        f32x4 acc2[4];
#pragma unroll
        for (int tt = 0; tt < 4; ++tt) acc2[tt] = (f32x4){0.f, 0.f, 0.f, 0.f};
        if (emit) {
            lds_t qa = qpt + l15 * MS_QLD + (kh * 256 + 4 * g4) * 2;
            u32x2 qb[2][4][2];
#pragma unroll
            for (int tt = 0; tt < 4; ++tt) { qb[0][tt][0] = *(const LAS u32x2*)(qa + tt * 16 * MS_QLD); qb[0][tt][1] = *(const LAS u32x2*)(qa + tt * 16 * MS_QLD + 32); }
#pragma unroll
            for (int m = 0; m < 8; ++m) {
                if (m + 1 < 8) {
#pragma unroll
                    for (int tt = 0; tt < 4; ++tt) { qb[(m + 1) & 1][tt][0] = *(const LAS u32x2*)(qa + tt * 16 * MS_QLD + (m + 1) * 64); qb[(m + 1) & 1][tt][1] = *(const LAS u32x2*)(qa + tt * 16 * MS_QLD + (m + 1) * 64 + 32); }
                }
                u32x4 cb; cb.x = pk2(C[2 * m][0], C[2 * m][1]); cb.y = pk2(C[2 * m][2], C[2 * m][3]); cb.z = pk2(C[2 * m + 1][0], C[2 * m + 1][1]); cb.w = pk2(C[2 * m + 1][2], C[2 * m + 1][3]);
                const bf16x8 cf = __builtin_bit_cast(bf16x8, cb);
#pragma unroll
                for (int tt = 0; tt < 4; ++tt) {
                    u32x4 av; av.x = qb[m & 1][tt][0].x; av.y = qb[m & 1][tt][0].y; av.z = qb[m & 1][tt][1].x; av.w = qb[m & 1][tt][1].y;
                    acc2[tt] = mfma16(cf, __builtin_bit_cast(bf16x8, av), acc2[tt]);
                }
            }
            const bf16x8 vf = frag_tr(vt, 64, kh * 32, cg * 16, lane);
#pragma unroll
            for (int tt = 0; tt < 4; ++tt) {
                acc2[tt] = acc2[tt] * sc_di[tt * 16 + l15];
                acc2[tt] = mfma16(vf, frag_row(St, 64, tt * 16, kh * 32, lane), acc2[tt]);
            }
        }
        if (st + 1 < 132) prefetch(st + 1);
        {
            const float gd = sc_misc[0];
            bf16x8 vb[2], wf[2];
#pragma unroll
            for (int ks = 0; ks < 2; ++ks) {
                vb[ks] = frag_tr(vwt, 64, ks * 32, cg * 16, lane);
                const f32x4 w0 = *(const LAS f32x4*)(sc_w + ks * 32 + 8 * g4), w1 = *(const LAS f32x4*)(sc_w + ks * 32 + 8 * g4 + 4);
                u32x4 wp; wp.x = pk2(w0[0], w0[1]); wp.y = pk2(w0[2], w0[3]); wp.z = pk2(w1[0], w1[1]); wp.w = pk2(w1[2], w1[3]);
                if (l15 != 0) wp = (u32x4){0u, 0u, 0u, 0u};
                wf[ks] = __builtin_bit_cast(bf16x8, wp);
            }
#pragma unroll
            for (int j = 0; j < 4; ++j) Nacc[j] = Nacc[j] * gd;
            lds_t ka = xct + (8 * g4 + (l15 >> 2)) * MS_KLD + (kh * 256 + 4 * (l15 & 3)) * 2;
            const int cg_s = __builtin_amdgcn_readfirstlane(cg);
            s16x4 kb[2][2][2];
#pragma unroll
            for (int ks = 0; ks < 2; ++ks) {
                kb[0][ks][0] = __builtin_amdgcn_ds_read_tr16_b64_v4i16((LAS s16x4*)(ka + ks * 32 * MS_KLD));
                kb[0][ks][1] = __builtin_amdgcn_ds_read_tr16_b64_v4i16((LAS s16x4*)(ka + ks * 32 * MS_KLD + 4 * MS_KLD));
            }
#pragma unroll
            for (int i = 0; i < 16; ++i) {
                if (i + 1 < 16) {
#pragma unroll
                    for (int ks = 0; ks < 2; ++ks) {
                        kb[(i + 1) & 1][ks][0] = __builtin_amdgcn_ds_read_tr16_b64_v4i16((LAS s16x4*)(ka + ks * 32 * MS_KLD + (i + 1) * 32));
                        kb[(i + 1) & 1][ks][1] = __builtin_amdgcn_ds_read_tr16_b64_v4i16((LAS s16x4*)(ka + ks * 32 * MS_KLD + 4 * MS_KLD + (i + 1) * 32));
                    }
                }
                C[i] = C[i] * gd;
                const bool own = ((i >> 1) & 3) == cg_s;
#pragma unroll
                for (int ks = 0; ks < 2; ++ks) {
                    const bf16x8 kf = __builtin_shufflevector(kb[i & 1][ks][0], kb[i & 1][ks][1], 0, 1, 2, 3, 4, 5, 6, 7);
                    C[i] = mfma16(kf, vb[ks], C[i]);
                    if (own) Nacc[(i >> 3) * 2 + (i & 1)] = mfma16(kf, wf[ks], Nacc[(i >> 3) * 2 + (i & 1)]);
                }
            }
            if (l15 == 0) {
#pragma unroll
                for (int j = 0; j < 4; ++j) *(LAS f32x4*)(nvec + kh * 256 + (2 * cg + (j & 1) + 8 * (j >> 1)) * 16 + 4 * g4) = Nacc[j];
            }
        }
        __syncthreads();
        if (emit && kh == 1) {
#pragma unroll
            for (int tt = 0; tt < 4; ++tt) *(LAS f32x4*)(red + ((cg * 4 + tt) * 64 + lane) * 4) = acc2[tt];
        }
        __syncthreads();
        if (emit && kh == 0) {
#pragma unroll
            for (int tt = 0; tt < 4; ++tt) {
                const int t = tt * 16 + l15;
                const f32x4 o = acc2[tt] + *(const LAS f32x4*)(red + ((cg * 4 + tt) * 64 + lane) * 4);
                const float dn = fmaxf(fabsf(sc_di[t] * qn[t] + sc_rs[t]), __expf(-sc_m[t]));
                store_bf16x4(H + (size_t)(cid * 64 + t) * 2048 + h * 512 + sl * 64 + cg * 16 + 4 * g4, o * (1.f / dn));
            }
        }
    }
}

DI void phase_merge(PP p) {
    const int tid = get_tid(), lane = tid & 63;
    const bf16_t* HF = (const bf16_t*)p->out;
    bf16_t* HB = (bf16_t*)(p->ws + OFF_ARENA + A_HB);
    const bf16_t* XC = (const bf16_t*)(p->ws + OFF_ARENA + A_XC);
    const bf16_t* Z = (const bf16_t*)(p->ws + OFF_ARENA + A_XM);
    const int gw = get_bid() * 8 + (tid >> 6), nw = gridDim.x * 8;
    for (int r = gw; r < NLAT; r += nw) {
#pragma unroll
        for (int hh = 0; hh < 4; ++hh) {
            const size_t o = (size_t)r * 2048 + hh * 512 + lane * 8;
            const u32x4 a = *(const u32x4*)(HF + o), b = *(const u32x4*)(HB + o), xq = *(const u32x4*)(XC + o), zq = *(const u32x4*)(Z + o);
            const unsigned aw[4] = {a.x, a.y, a.z, a.w}, bw[4] = {b.x, b.y, b.z, b.w}, xw[4] = {xq.x, xq.y, xq.z, xq.w}, zw[4] = {zq.x, zq.y, zq.z, zq.w};
            float hv[8]; float sum = 0.f;
#pragma unroll
            for (int j = 0; j < 4; ++j) { hv[2 * j] = lo_bf(aw[j]) + lo_bf(bw[j]); hv[2 * j + 1] = hi_bf(aw[j]) + hi_bf(bw[j]); sum += hv[2 * j] + hv[2 * j + 1]; }
            const float mean = wave_sum(sum) * (1.f / 512.f);
            float sq = 0.f;
#pragma unroll
            for (int j = 0; j < 8; ++j) { hv[j] -= mean; sq += hv[j] * hv[j]; }
            const float rs = rsqrtf(wave_sum(sq) * (1.f / 512.f) + EPS);
            float ov[8];
#pragma unroll
            for (int j = 0; j < 8; ++j) {
                const int c = hh * 512 + lane * 8 + j;
                const float xcv = (j & 1) ? hi_bf(xw[j >> 1]) : lo_bf(xw[j >> 1]);
                const float zv = (j & 1) ? hi_bf(zw[j >> 1]) : lo_bf(zw[j >> 1]);
                ov[j] = (hv[j] * rs * p->m_norm_g[c] + p->m_skip[c] * xcv) * siluf_(zv);
            }
            u32x4 v; v.x = pk2(ov[0], ov[1]); v.y = pk2(ov[2], ov[3]); v.z = pk2(ov[4], ov[5]); v.w = pk2(ov[6], ov[7]);
            *(u32x4*)(HB + o) = v;
        }
    }
}

DI void phase_downproj(PP p, lds_t lds) {
    const bf16_t* A = (const bf16_t*)(p->ws + OFF_ARENA + A_HB);
    float* X = (float*)(p->ws + OFF_ARENA + A_X);
    constexpr int NM = NLAT / 256, NN = 4;
    for (int u = get_bid(); u < NM * NN; u += gridDim.x) {
        const int pn = u / NM, pm = u % NM;
        const float* g1 = mods_ptr(p, 1, pm >> 5, 2);
        gemm_unit<256>(lds, 2048, 1024,
            [&](int r) { return A + (size_t)(pm * 256 + r) * 2048; },
            [&](int j) -> const float* { return p->m_w_down + pn * 256 + j; },
            [&](const f32x4 (&acc)[8][4], int wr, int wc, int lane) {
                epi_each<4>(acc, wr, wc, lane, [&](int r, int c, f32x4 v) {
                    const int col = pn * 256 + c;
                    float* xp = X + (size_t)(pm * 256 + r) * 1024 + col;
                    const f32x4 g = *(const f32x4*)(g1 + col);
                    *(f32x4*)xp = *(const f32x4*)xp + g * v;
                });
            });
    }
}

DI void phase_dbg_final(PP p, int mode) {
    const int tid = get_tid(), lane = tid & 63;
    const int gw = get_bid() * 8 + (tid >> 6), nw = gridDim.x * 8;
    if (mode == 4) {
        const int* rid = (const int*)(p->ws + OFF_ARENA + A_ROWID);
        for (int r = gw; r < NLAT; r += nw)
            for (int c = lane; c < 1024; c += 64) p->out[(size_t)r * 1024 + c] = (float)rid[(size_t)r * 16 + (c & 15)];
        return;
    }
    if (mode == 7) {
        const bf16_t* y = (const bf16_t*)(p->ws + OFF_ARENA + A_Y);
        for (int r = gw; r < NLAT; r += nw)
            for (int c = lane; c < 1024; c += 64) { const float v = bf2f(y[(size_t)r * 1024 + c]); p->out[(size_t)r * 1024 + c] = (v == v && fabsf(v) < 1e30f) ? 0.f : 1000.f; }
        return;
    }
    if (mode >= 2) {
        const bf16_t* src = mode == 2 ? (const bf16_t*)(p->ws + OFF_ARENA + A_P) : mode == 5 ? (const bf16_t*)(p->ws + OFF_ARENA + A_HDN) : mode == 6 ? (const bf16_t*)(p->ws + OFF_ARENA + A_Y) : (const bf16_t*)(p->ws + OFF_ACT);
        const int ld = mode == 2 ? ABIN : 1024;
        for (int r = gw; r < NLAT; r += nw)
            for (int c = lane; c < 1024; c += 64) p->out[(size_t)r * 1024 + c] = bf2f(src[(size_t)r * ld + (mode == 2 ? c + DBG_COL0 : c)]);
        return;
    }
    const float* X = mode ? (const float*)(p->ws + OFF_ARENA + A_X) : p->x;
    for (int r = gw; r < NLAT; r += nw) {
        f32x4 v[4];
        row_load_f32(X + (size_t)r * 1024, v, lane);
        const float rs = rsqrtf(row_sumsq(v) * (1.f / 1024.f) + EPS);
#pragma unroll
        for (int i = 0; i < 4; ++i) { const f32x4 g = *(const f32x4*)(p->final_g + 4 * lane + 256 * i); *(f32x4*)(p->out + (size_t)r * 1024 + 4 * lane + 256 * i) = v[i] * rs * g; }
    }
}

DI void grid_barrier(cg::grid_group& grid, PP p, unsigned& nbar) {
    asm volatile("s_waitcnt vmcnt(0) lgkmcnt(0)" ::: "memory");
    unsigned* ctr = (unsigned*)(p->ws + OFF_BAR);
    if (nbar == 0) {
        if (blockIdx.x == 0 && threadIdx.x == 0) __hip_atomic_store(ctr, 0u, __ATOMIC_RELAXED, __HIP_MEMORY_SCOPE_AGENT);
        asm volatile("s_waitcnt vmcnt(0)" ::: "memory");
        grid.sync();
        __builtin_amdgcn_fence(__ATOMIC_ACQUIRE, "agent");
        asm volatile("s_waitcnt vmcnt(0)" ::: "memory");
    } else {
        __syncthreads();
        if (threadIdx.x == 0) {
            __builtin_amdgcn_fence(__ATOMIC_RELEASE, "agent");
            asm volatile("s_waitcnt vmcnt(0)" ::: "memory");
            __hip_atomic_fetch_add(ctr, 1u, __ATOMIC_RELAXED, __HIP_MEMORY_SCOPE_AGENT);
            const unsigned target = nbar * gridDim.x;
            while (__hip_atomic_load(ctr, __ATOMIC_RELAXED, __HIP_MEMORY_SCOPE_AGENT) < target) __builtin_amdgcn_s_sleep(1);
            __builtin_amdgcn_fence(__ATOMIC_ACQUIRE, "agent");
            asm volatile("s_waitcnt vmcnt(0)" ::: "memory");
        }
        __syncthreads();
    }
    ++nbar;
}
#define RUN_PHASE(K, CALL) if (ph_lo <= (K) && (K) < ph_hi && ((K) <= DBG_STOP)) { PP p = kp; asm volatile("" : "+s"(p)); CALL; if ((DUP_MASK >> (K)) & 1) { grid_barrier(grid, p, nbar); asm volatile("" : "+s"(p)); CALL; } if ((K) + 1 < ph_hi) { grid_barrier(grid, p, nbar); if (EXTRA_BARRIERS) grid_barrier(grid, p, nbar); } }
__global__ void __launch_bounds__(NTHREADS) mega(Params p_in) {
    extern __shared__ __attribute__((aligned(16))) unsigned char lds_raw[];
    lds_t lds = (lds_t)lds_raw;
    cg::grid_group grid = cg::this_grid();
    PP kp = (PP)__builtin_amdgcn_kernarg_segment_ptr();
    const int ph_lo = kp->ph_lo, ph_hi = kp->ph_hi;
    unsigned nbar = 0;
    RUN_PHASE(0, phase_mods(p, lds))
    RUN_PHASE(1, phase_norm(p, 0, NTOK, [&](int r) { return r < NLAT ? p->x + (size_t)r * 1024 : p->ctx + (size_t)(r - NLAT) * 1024; }))
    RUN_PHASE(2, phase_inproj(p, lds))
    RUN_PHASE(3, phase_g1(p, lds))
    RUN_PHASE(4, phase_scan0(p))
    RUN_PHASE(5, phase_g3(p, lds))
    RUN_PHASE(6, phase_outproj0(p, lds))
    RUN_PHASE(7, phase_router(p, lds, 0))
    RUN_PHASE(8, phase_topk(p, lds, 0))
    RUN_PHASE(9, phase_moe_up(p, lds, 0))
    RUN_PHASE(10, phase_moe_down(p, lds, 0))
    RUN_PHASE(11, phase_combine(p, 0))
    RUN_PHASE(12, phase_upproj(p, lds, 0))
    RUN_PHASE(13, phase_mfeat(p, lds))
    RUN_PHASE(14, phase_mscan(p, lds))
    RUN_PHASE(15, phase_norm(p, 1, NLAT, [&](int r) { return (const float*)(p->ws + OFF_ARENA + A_X) + (size_t)r * 1024; }))
    RUN_PHASE(16, phase_upproj(p, lds, 1))
    RUN_PHASE(17, phase_merge(p))
    RUN_PHASE(18, phase_downproj(p, lds))
    RUN_PHASE(19, phase_router(p, lds, 1))
    RUN_PHASE(20, phase_topk(p, lds, 1))
    RUN_PHASE(21, phase_moe_up(p, lds, 1))
    RUN_PHASE(22, phase_moe_down(p, lds, 1))
    RUN_PHASE(23, phase_combine(p, 1))
    if (DBG_STOP < 23 && DBG_STOP + 1 < ph_hi) { PP p = kp; asm volatile("" : "+s"(p)); phase_dbg_final(p, DBG_MODE); }
}

extern "C" void kernel_launch(void* const* d_in, const int* in_sizes, int n_in, void* d_out, int out_size, void* d_ws, size_t ws_size, hipStream_t stream) {
    static int grid = 0;
    if (grid == 0) {
        int dev = 0, cus = 0, per_cu = 0;
        hipGetDevice(&dev);
        hipDeviceGetAttribute(&cus, hipDeviceAttributeMultiprocessorCount, dev);
        hipFuncSetAttribute((const void*)mega, hipFuncAttributeMaxDynamicSharedMemorySize, LDS_BYTES);
        hipOccupancyMaxActiveBlocksPerMultiprocessor(&per_cu, (const void*)mega, NTHREADS, LDS_BYTES);
        if (per_cu < 1) { fprintf(stderr, "occupancy query says %d blocks/CU\n", per_cu); per_cu = 1; }
        grid = cus;
        if (ws_size < WS_NEED) { fprintf(stderr, "workspace too small: %zu < %zu\n", ws_size, (size_t)WS_NEED); grid = -1; }
    }
    if (grid < 0) return;
    Params hp{};
    const float** pp = (const float**)&hp;
    for (int i = 0; i < 36; ++i) pp[i] = (const float*)d_in[i];
    hp.out = (float*)d_out; hp.ws = (char*)d_ws; hp.ph_lo = 0; hp.ph_hi = DBG_STOP < 23 ? DBG_STOP + 2 : 24;
    void* args[] = {&hp};
    hipError_t e = hipLaunchCooperativeKernel((const void*)mega, dim3(grid), dim3(NTHREADS), args, LDS_BYTES, stream);
    if (e != hipSuccess) fprintf(stderr, "cooperative launch failed: %s\n", hipGetErrorString(e));
}
```

```cpp
#include <hip/hip_runtime.h>
#include <hip/hip_cooperative_groups.h>
#include <cstdio>
#include <cstdint>
namespace cg = cooperative_groups;

#define LAS __attribute__((address_space(3)))
#define DI __device__ __forceinline__
typedef unsigned short bf16_t;
typedef short bf16x8 __attribute__((ext_vector_type(8)));
typedef short s16x4 __attribute__((ext_vector_type(4)));
typedef float f32x4 __attribute__((ext_vector_type(4)));
typedef float f32x2 __attribute__((ext_vector_type(2)));
typedef unsigned u32x4 __attribute__((ext_vector_type(4)));
typedef unsigned u32x2 __attribute__((ext_vector_type(2)));
typedef LAS char* lds_t;

constexpr int D = 1024, NBATCH = 4, SEQ = 8192, CTXL = 256;
constexpr int NLAT = NBATCH * SEQ;
constexpr int NCTX = NBATCH * CTXL;
constexpr int NTOK = NLAT + NCTX;
constexpr int NCH = NTOK / 64;
constexpr int NCHL = NLAT / 64;
constexpr int ABIN = 2592;
constexpr int PC_Q = 0, PC_K = 256, PC_V = 512, PC_G = 1024, PC_LRF = 1536, PC_LRB = 1552, PC_RGG = 1568, PC_RGX = 2080;
constexpr float EPS = 1e-6f;
constexpr int NTHREADS = 512;
constexpr int LDS_BYTES = 160 * 1024;
#define DBG_MODE 1
#ifndef DUP_MASK
#define DUP_MASK 0
#endif
#ifndef EXTRA_BARRIERS
#define EXTRA_BARRIERS 0
#endif
#define DBG_STOP 23
#define DBG_COL0 0

constexpr size_t OFF_MODS = 0;
constexpr size_t OFF_GCAT = 245760;
constexpr size_t OFF_MMAT = 376832;
constexpr size_t OFF_BAR = 409600;
constexpr size_t OFF_ACT = 1u << 20;
constexpr size_t ACT_BYTES = (size_t)NTOK * 1024 * 2;
constexpr size_t OFF_ARENA = OFF_ACT + ACT_BYTES;
constexpr size_t A_P = 0;
constexpr size_t A_U = A_P + (size_t)NTOK * ABIN * 2;
constexpr size_t A_LA = A_U + (size_t)NCH * 2 * 4 * 8192 * 4;
constexpr size_t A_UU = A_LA + (size_t)NTOK * 2 * 512 * 4;
constexpr size_t A_DEC = A_UU + (size_t)NTOK * 2 * 512 * 2;
constexpr size_t A_AGGA = A_DEC + (size_t)NCH * 2 * 256 * 4;
constexpr size_t A_AGGH = A_AGGA + (size_t)NCH * 2 * 512 * 4;
constexpr size_t A_L0_END = A_AGGH + (size_t)NCH * 2 * 512 * 4;
constexpr size_t A_X = 0;
constexpr size_t A_PT = A_X + (size_t)NTOK * 1024 * 4;
constexpr size_t A_PE = A_PT + (size_t)NTOK * 16 * 4;
constexpr size_t A_ROWID = A_PE + (size_t)NTOK * 16 * 4;
constexpr size_t A_ROWTOK = A_ROWID + (size_t)NTOK * 16 * 4;
constexpr size_t A_HDN = A_ROWTOK + (size_t)16 * 4352 * 4;
constexpr size_t A_Y = A_HDN + (size_t)16 * 4352 * 1024 * 2;
constexpr size_t A_MOE0_END = A_Y + (size_t)16 * 4352 * 1024 * 2;
constexpr size_t A_XM = A_X + (size_t)NTOK * 1024 * 4;
constexpr size_t A_XC = A_XM + (size_t)NTOK * 2048 * 2;
constexpr size_t A_HB = A_XC + (size_t)NTOK * 2048 * 2;
constexpr size_t A_L1_END = A_HB + (size_t)NLAT * 2048 * 2;
constexpr size_t ACT_RAWS = 0;
constexpr size_t ACT_GP = ACT_RAWS + (size_t)NCH * 4 * 4096 * 2;
constexpr size_t ACT_CTXV = ACT_GP + (size_t)NTOK * 64 * 4;
constexpr size_t WS_NEED = OFF_ARENA + (A_L1_END > A_L0_END ? A_L1_END : A_L0_END);
static_assert(A_MOE0_END < A_L1_END, "arena");
static_assert(ACT_CTXV + (size_t)NCTX * 2048 * 2 <= ACT_BYTES, "act region");

struct Params {
    const float *x, *c, *ctx, *c_ctx, *mod_w, *mod_b, *norm1_g, *norm2_g, *ab_w_in, *gla_wa2, *gla_ba, *gla_norm_g;
    const float *rg_conv_w, *rg_conv_b, *rg_wr, *rg_br, *rg_wi, *rg_bi, *rg_lambda, *ab_w_out, *m_w_up, *m_conv_w, *m_conv_b;
    const float *m_wq, *m_wk, *m_wv, *m_w_gates, *m_b_gates, *m_skip, *m_norm_g, *m_w_down, *router_w, *exp_w_gate, *exp_w_up, *exp_w_down, *final_g;
    float* out;
    char* ws;
    int ph_lo, ph_hi;
};

typedef const Params __attribute__((address_space(4)))* PP;

DI int get_tid() { int t = threadIdx.x; asm volatile("" : "+v"(t)); return t; }
DI int get_bid() { int b = blockIdx.x; asm volatile("" : "+s"(b)); return b; }
DI float bf2f(bf16_t h) { return __uint_as_float((unsigned)h << 16); }
DI bf16_t f2bf(float x) { unsigned u = __float_as_uint(x); u += 0x7fffu + ((u >> 16) & 1u); return (bf16_t)(u >> 16); }
typedef __bf16 bf16x2_t __attribute__((ext_vector_type(2)));
DI unsigned pk2n(float lo, float hi) { const f32x2 v = {lo, hi}; return __builtin_bit_cast(unsigned, __builtin_convertvector(v, bf16x2_t)); }
DI unsigned pk2(float lo, float hi) { return pk2n(lo, hi); }
DI float lo_bf(unsigned u) { return __uint_as_float(u << 16); }
DI float hi_bf(unsigned u) { return __uint_as_float(u & 0xffff0000u); }
DI float sigmoidf_(float x) { return 1.f / (1.f + __expf(-x)); }
DI float siluf_(float x) { return x / (1.f + __expf(-x)); }
DI float log_sigmoidf_(float z) { return fminf(z, 0.f) - log1pf(__expf(-fabsf(z))); }
DI float softplusf_(float z) { return fmaxf(z, 0.f) + log1pf(__expf(-fabsf(z))); }
DI float gelu_tanh(float x) { const float u = 0.7978845608028654f * (x + 0.044715f * x * x * x); return 0.5f * x * (1.f + tanhf(u)); }
DI float wave_sum(float v) {
#pragma unroll
    for (int o = 32; o > 0; o >>= 1) v += __shfl_xor(v, o);
    return v;
}
DI f32x4 mfma16(bf16x8 a, bf16x8 b, f32x4 c) { return __builtin_amdgcn_mfma_f32_16x16x32_bf16(a, b, c, 0, 0, 0); }

DI bf16x8 frag_row(const LAS bf16_t* tile, int ld, int r0, int k0, int lane) {
    return *(const LAS bf16x8*)(tile + (r0 + (lane & 15)) * ld + k0 + 8 * (lane >> 4));
}
DI bf16x8 frag_tr(const LAS bf16_t* tile, int ld, int k0, int c0, int lane) {
    const int g = lane >> 4, i = lane & 15, q = i >> 2, p = i & 3;
    const LAS bf16_t* base = tile + (k0 + 8 * g + q) * ld + c0 + 4 * p;
    const s16x4 lo = __builtin_amdgcn_ds_read_tr16_b64_v4i16((LAS s16x4*)base);
    const s16x4 hi = __builtin_amdgcn_ds_read_tr16_b64_v4i16((LAS s16x4*)(base + 4 * ld));
    return __builtin_shufflevector(lo, hi, 0, 1, 2, 3, 4, 5, 6, 7);
}
DI const float* mods_ptr(PP p, int layer, int s, int which) { return (const float*)(p->ws + OFF_MODS) + ((size_t)(layer * 5 + s) * 6 + which) * 1024; }
DI int row_set(int r) { return r < NLAT ? (r >> 13) : 4; }

template <int BN, int BK, class ARow, class BCol, class Epi>
DI void gemm_unit(lds_t lds, int K, int ldb, ARow arow, BCol bcol, Epi epi) {
    constexpr int NT = BN / 64;
    constexpr int LDA = BK + 8, LDB = BN + 16;
    constexpr int A_BYTES = 256 * LDA * 2, B_BYTES = BK * LDB * 2;
    static_assert(2 * A_BYTES + 2 * B_BYTES <= LDS_BYTES, "gemm lds");
    const int tid = get_tid(), lane = tid & 63, w = tid >> 6, wr = w >> 2, wc = w & 3;
    constexpr int ACH = BK / 8, ARP = NTHREADS / ACH, AP = 256 / ARP;
    const int achunk = tid % ACH, arow0 = tid / ACH;
    const bf16_t* ap[AP];
#pragma unroll
    for (int q = 0; q < AP; ++q) ap[q] = arow(arow0 + ARP * q);
    constexpr int CG = BN / 8, KR = NTHREADS / CG, BP = BK / KR;
    const int bc8 = tid % CG, bk0 = tid / CG;
    const float* bp = bcol(bc8 * 8);
    u32x4 areg[AP];
    f32x4 breg[BP][2];
    auto gload = [&](int kt) {
        const int k0 = kt * BK;
#pragma unroll
        for (int q = 0; q < AP; ++q) areg[q] = ap[q] ? *(const u32x4*)(ap[q] + k0 + achunk * 8) : (u32x4){0u, 0u, 0u, 0u};
#pragma unroll
        for (int q = 0; q < BP; ++q) {
            if (bp) { const float* s = bp + (size_t)(k0 + bk0 + KR * q) * ldb; breg[q][0] = *(const f32x4*)s; breg[q][1] = *(const f32x4*)(s + 4); }
            else { breg[q][0] = (f32x4){0.f, 0.f, 0.f, 0.f}; breg[q][1] = breg[q][0]; }
        }
    };
    auto lstore = [&](int buf) {
        LAS bf16_t* As = (LAS bf16_t*)(lds + buf * A_BYTES);
        LAS bf16_t* Bs = (LAS bf16_t*)(lds + 2 * A_BYTES + buf * B_BYTES);
#pragma unroll
        for (int q = 0; q < AP; ++q) *(LAS u32x4*)(As + (arow0 + ARP * q) * LDA + achunk * 8) = areg[q];
#pragma unroll
        for (int q = 0; q < BP; ++q) {
            u32x4 v; v.x = pk2(breg[q][0][0], breg[q][0][1]); v.y = pk2(breg[q][0][2], breg[q][0][3]); v.z = pk2(breg[q][1][0], breg[q][1][1]); v.w = pk2(breg[q][1][2], breg[q][1][3]);
            *(LAS u32x4*)(Bs + (bk0 + KR * q) * LDB + bc8 * 8) = v;
        }
    };
    f32x4 acc[8][NT];
#pragma unroll
    for (int mi = 0; mi < 8; ++mi)
#pragma unroll
        for (int ni = 0; ni < NT; ++ni) acc[mi][ni] = (f32x4){0.f, 0.f, 0.f, 0.f};
    const int nk = K / BK;
    gload(0);
    for (int kt = 0; kt < nk; ++kt) {
        lstore(kt & 1);
        __syncthreads();
        if (kt + 1 < nk) gload(kt + 1);
        const LAS bf16_t* As = (const LAS bf16_t*)(lds + (kt & 1) * A_BYTES);
        const LAS bf16_t* Bs = (const LAS bf16_t*)(lds + 2 * A_BYTES + (kt & 1) * B_BYTES);
#pragma unroll
        for (int ks = 0; ks < BK / 32; ++ks) {
            bf16x8 wb[NT];
#pragma unroll
            for (int ni = 0; ni < NT; ++ni) wb[ni] = frag_tr(Bs, LDB, ks * 32, wc * (BN / 4) + ni * 16, lane);
#pragma unroll
            for (int mi = 0; mi < 8; ++mi) {
                const bf16x8 xa = frag_row(As, LDA, wr * 128 + mi * 16, ks * 32, lane);
#pragma unroll
                for (int ni = 0; ni < NT; ++ni) acc[mi][ni] = mfma16(wb[ni], xa, acc[mi][ni]);
            }
        }
    }
    epi(acc, wr, wc, lane);
    __syncthreads();
}


template <class F>
DI void for_units_xcd(int NB, int NM, int NN, int TM, int TN, F f) {
    const int bid = get_bid();
    if (gridDim.x != 256) {
        for (int u = bid; u < NB * NM * NN; u += gridDim.x) f(u / (NM * NN), (u % (NM * NN)) % NM, (u % (NM * NN)) / NM);
        return;
    }
    const int xcd = bid & 7, slot = bid >> 3, tsz = TM * TN, per = 32 / tsz;
    const int nsm = (NM + TM - 1) / TM, nsn = (NN + TN - 1) / TN, ntot = NB * nsm * nsn;
    for (int j = 0;; ++j) {
        const int S = (j * 8 + xcd) * per + slot / tsz;
        if ((j * 8) * per >= ntot) break;
        if (S >= ntot) continue;
        const int within = slot % tsz, batch = S / (nsm * nsn), sl = S % (nsm * nsn);
        const int pm = (sl % nsm) * TM + within % TM, pn = (sl / nsm) * TN + within / TM;
        if (pm < NM && pn < NN) f(batch, pm, pn);
    }
}

template <int NT, class F>
DI void epi_each(const f32x4 (&acc)[8][NT], int wr, int wc, int lane, F f) {
#pragma unroll
    for (int mi = 0; mi < 8; ++mi)
#pragma unroll
        for (int ni = 0; ni < NT; ++ni) f(wr * 128 + mi * 16 + (lane & 15), wc * (NT * 16) + ni * 16 + 4 * (lane >> 4), acc[mi][ni]);
}
DI void store_bf16x4(bf16_t* dst, f32x4 v) { u32x2 o; o.x = pk2(v[0], v[1]); o.y = pk2(v[2], v[3]); *(u32x2*)dst = o; }

DI void row_load_f32(const float* src, f32x4 (&v)[4], int lane) {
#pragma unroll
    for (int i = 0; i < 4; ++i) v[i] = *(const f32x4*)(src + 4 * lane + 256 * i);
}
DI float row_sumsq(const f32x4 (&v)[4]) {
    float s = 0.f;
#pragma unroll
    for (int i = 0; i < 4; ++i) s += v[i][0] * v[i][0] + v[i][1] * v[i][1] + v[i][2] * v[i][2] + v[i][3] * v[i][3];
    return wave_sum(s);
}
DI void row_modulate(f32x4 (&v)[4], float rs, const float* g, const float* sc, const float* sh, int lane) {
#pragma unroll
    for (int i = 0; i < 4; ++i) {
        const int c = 4 * lane + 256 * i;
        const f32x4 gg = *(const f32x4*)(g + c), ss = *(const f32x4*)(sc + c), hh = *(const f32x4*)(sh + c);
#pragma unroll
        for (int j = 0; j < 4; ++j) v[i][j] = v[i][j] * rs * gg[j] * (1.f + ss[j]) + hh[j];
    }
}
DI void row_store_bf16(bf16_t* dst, const f32x4 (&v)[4], int lane) {
#pragma unroll
    for (int i = 0; i < 4; ++i) store_bf16x4(dst + 4 * lane + 256 * i, v[i]);
}

DI void phase_mods(PP p, lds_t lds) {
    const int tid = get_tid();
    LAS float* sil = (LAS float*)lds;
    LAS float* red = sil + 5 * 1024;
    for (int u = get_bid(); u < 192 + 32; u += gridDim.x) {
        if (u < 192) {
            const int layer = u / 96, c0 = (u % 96) * 64;
            for (int i = tid; i < 5 * 1024; i += NTHREADS) { const int s = i >> 10, k = i & 1023; const float cv = s < 4 ? p->c[s * 1024 + k] : p->c_ctx[k]; sil[i] = siluf_(cv); }
            __syncthreads();
            const int col = tid & 63, kp = tid >> 6;
            float a[5] = {0.f, 0.f, 0.f, 0.f, 0.f};
            const float* wp = p->mod_w + (size_t)layer * 1024 * 6144 + c0 + col;
            for (int k = kp * 128; k < kp * 128 + 128; ++k) {
                const float wv = wp[(size_t)k * 6144];
#pragma unroll
                for (int s = 0; s < 5; ++s) a[s] += sil[s * 1024 + k] * wv;
            }
#pragma unroll
            for (int s = 0; s < 5; ++s) red[(kp * 5 + s) * 64 + col] = a[s];
            __syncthreads();
            if (tid < 320) {
                const int s = tid >> 6, cc = tid & 63;
                float t = p->mod_b[layer * 6144 + c0 + cc];
#pragma unroll
                for (int k = 0; k < 8; ++k) t += red[(k * 5 + s) * 64 + cc];
                ((float*)(p->ws + OFF_MODS))[(size_t)(layer * 5 + s) * 6144 + c0 + cc] = t;
            }
            __syncthreads();
        } else {
            const int f0 = (u - 192) * 64;
            const int fl = tid >> 3, dgp = (tid & 7) * 2, f = f0 + fl, n = f >> 2, i = f & 3;
            bf16_t* gxc = (bf16_t*)(p->ws + OFF_GCAT);
            bf16_t* gxm = gxc + 2048 * 16;
#pragma unroll
            for (int e = 0; e < 2; ++e) {
                const int dg = dgp + e, d = dg >> 3, g = dg & 7;
                const float* wg = p->m_w_gates + (size_t)d * 6144 * 8;
                float a = 0.f, b = 0.f;
#pragma unroll
                for (int o = 0; o < 4; ++o) {
                    a += p->m_wq[n * 16 + i * 4 + o] * wg[(size_t)(4 * n + o) * 8 + g];
                    a += p->m_wk[n * 16 + i * 4 + o] * wg[(size_t)(2048 + 4 * n + o) * 8 + g] * 0.04419417382415922f;
                    b += p->m_wv[n * 16 + i * 4 + o] * wg[(size_t)(4096 + 4 * n + o) * 8 + g];
                }
                gxc[f * 16 + dg] = f2bf(a); gxm[f * 16 + dg] = f2bf(b);
            }
            if (tid < 256) {
                const int nn = (f0 >> 2) + (tid >> 4), e = tid & 15, ii = e >> 2, jj = e & 3;
                float a = 0.f;
#pragma unroll
                for (int o = 0; o < 4; ++o) a += p->m_wq[nn * 16 + ii * 4 + o] * p->m_wk[nn * 16 + jj * 4 + o];
                ((float*)(p->ws + OFF_MMAT))[nn * 16 + e] = a * 0.04419417382415922f;
            }
        }
    }
}

template <class Src>
DI void phase_norm(PP p, int layer, int nrows, Src src) {
    const int lane = get_tid() & 63, gw = get_bid() * 8 + (get_tid() >> 6), nw = gridDim.x * 8;
    bf16_t* act = (bf16_t*)(p->ws + OFF_ACT);
    for (int r = gw; r < nrows; r += nw) {
        f32x4 v[4];
        row_load_f32(src(r), v, lane);
        const float rs = rsqrtf(row_sumsq(v) * (1.f / 1024.f) + EPS);
        const int s = row_set(r);
        row_modulate(v, rs, p->norm1_g + layer * 1024, mods_ptr(p, layer, s, 1), mods_ptr(p, layer, s, 0), lane);
        row_store_bf16(act + (size_t)r * 1024, v, lane);
    }
}

DI void phase_inproj(PP p, lds_t lds) {
    const bf16_t* act = (const bf16_t*)(p->ws + OFF_ACT);
    bf16_t* P = (bf16_t*)(p->ws + OFF_ARENA + A_P);
    constexpr int NM = NTOK / 256, NN = 11;
    for (int u = get_bid(); u < NM * NN; u += gridDim.x) {
        const int pn = u / NM, pm = u % NM;
        gemm_unit<256, 32>(lds, 1024, ABIN,
            [&](int r) { return act + (size_t)(pm * 256 + r) * 1024; },
            [&](int j) -> const float* { const int c = pn * 256 + j; return c < ABIN ? p->ab_w_in + c : nullptr; },
            [&](const f32x4 (&acc)[8][4], int wr, int wc, int lane) {
                epi_each<4>(acc, wr, wc, lane, [&](int r, int c, f32x4 v) { const int col = pn * 256 + c; if (col < ABIN) store_bf16x4(P + (size_t)(pm * 256 + r) * ABIN + col, v); });
            });
    }
}


DI void gla_bcum(LAS float* bc, const LAS float* lrt, const LAS float* wat, const LAS float* bat, int d, LAS float* seg_tot) {
    const int tid = get_tid();
    {
        const int c = tid & 63, tq = tid >> 6;
        float wcol[16];
#pragma unroll
        for (int r = 0; r < 16; ++r) wcol[r] = wat[r * 64 + c];
        const float bias = bat[c];
        for (int t = tq * 8; t < tq * 8 + 8; ++t) {
            float z = bias;
#pragma unroll
            for (int r = 0; r < 16; ++r) z += lrt[t * 16 + r] * wcol[r];
            bc[t * 64 + c] = log_sigmoidf_(z) * (1.f / 16.f);
        }
    }
    __syncthreads();
    {
        const int c = tid & 63, seg = tid >> 6;
        float v[8]; float run = 0.f;
#pragma unroll
        for (int j = 0; j < 8; ++j) { const int pp = seg * 8 + j, t = d == 0 ? pp : 63 - pp; run += bc[t * 64 + c]; v[j] = run; }
        LAS float* tot = seg_tot + seg * 64 + c;
        *tot = run;
        __syncthreads();
        float off = 0.f;
#pragma unroll
        for (int k = 0; k < 7; ++k) off += (k < seg) ? seg_tot[k * 64 + c] : 0.f;
#pragma unroll
        for (int j = 0; j < 8; ++j) { const int pp = seg * 8 + j, t = d == 0 ? pp : 63 - pp; bc[t * 64 + c] = v[j] + off; }
    }
    __syncthreads();
}
DI void gla_load_decay_inputs(PP p, const bf16_t* P, int r0, int h, LAS float* lrt, LAS float* wat, LAS float* bat) {
    const int tid = get_tid();
    if (tid < 256) {
        const int d = tid >> 7, t = (tid >> 1) & 63, half = tid & 1;
        const u32x4 v = *(const u32x4*)(P + (size_t)(r0 + t) * ABIN + PC_LRF + d * 16 + half * 8);
        LAS float* o = lrt + (d * 64 + t) * 16 + half * 8;
        o[0] = lo_bf(v.x); o[1] = hi_bf(v.x); o[2] = lo_bf(v.y); o[3] = hi_bf(v.y); o[4] = lo_bf(v.z); o[5] = hi_bf(v.z); o[6] = lo_bf(v.w); o[7] = hi_bf(v.w);
    }
    {
        const int i = tid * 4, d = i >> 10, r = (i >> 6) & 15, c = i & 63;
        *(LAS f32x4*)(wat + i) = *(const f32x4*)(p->gla_wa2 + (size_t)(d * 16 + r) * 256 + h * 64 + c);
    }
    if (tid < 128) bat[tid] = p->gla_ba[(tid >> 6) * 256 + h * 64 + (tid & 63)];
}

DI void phase_g1(PP p, lds_t lds) {
    const int tid = get_tid(), lane = tid & 63, w = tid >> 6;
    const bf16_t* P = (const bf16_t*)(p->ws + OFF_ARENA + A_P);
    float* U = (float*)(p->ws + OFF_ARENA + A_U);
    float* DEC = (float*)(p->ws + OFF_ARENA + A_DEC);
    float* LA = (float*)(p->ws + OFF_ARENA + A_LA);
    bf16_t* UU = (bf16_t*)(p->ws + OFF_ARENA + A_UU);
    float* AGGA = (float*)(p->ws + OFF_ARENA + A_AGGA);
    float* AGGH = (float*)(p->ws + OFF_ARENA + A_AGGH);
    constexpr int NGLA = NCH * 4, NLRU = NCH * 4;
    for (int task = get_bid(); task < NGLA + NLRU; task += gridDim.x) {
        if (task < NGLA) {
            const int ch = task >> 2, h = task & 3, r0 = ch * 64;
            LAS float* lrt = (LAS float*)lds;
            LAS float* wat = lrt + 2048;
            LAS float* bat = wat + 2048;
            LAS float* bc = bat + 128;
            LAS bf16_t* kt = (LAS bf16_t*)(bc + 8192);
            LAS bf16_t* ktd = kt + 64 * 72;
            LAS bf16_t* vt = ktd + 2 * 64 * 72;
            gla_load_decay_inputs(p, P, r0, h, lrt, wat, bat);
            { const int row = tid >> 3, chunk = tid & 7; *(LAS u32x4*)(kt + row * 72 + chunk * 8) = *(const u32x4*)(P + (size_t)(r0 + row) * ABIN + PC_K + h * 64 + chunk * 8); }
#pragma unroll
            for (int q = 0; q < 2; ++q) { const int i = tid + 512 * q, row = i >> 4, chunk = i & 15; *(LAS u32x4*)(vt + row * 136 + chunk * 8) = *(const u32x4*)(P + (size_t)(r0 + row) * ABIN + PC_V + h * 128 + chunk * 8); }
            __syncthreads();
            gla_bcum(bc, lrt, wat, bat, 0, (LAS float*)(vt + 64 * 136));
            gla_bcum(bc + 4096, lrt + 1024, wat + 1024, bat + 64, 1, (LAS float*)(vt + 64 * 136));
            {
                const int t = tid >> 3, c8 = (tid & 7) * 8;
#pragma unroll
                for (int d = 0; d < 2; ++d) {
                    const LAS float* b = bc + d * 4096;
                    const int tl = d == 0 ? 63 : 0;
                    float o[8];
#pragma unroll
                    for (int j = 0; j < 8; ++j) o[j] = bf2f(kt[t * 72 + c8 + j]) * __expf(b[tl * 64 + c8 + j] - b[t * 64 + c8 + j]);
                    u32x4 v; v.x = pk2(o[0], o[1]); v.y = pk2(o[2], o[3]); v.z = pk2(o[4], o[5]); v.w = pk2(o[6], o[7]);
                    *(LAS u32x4*)(ktd + d * 64 * 72 + t * 72 + c8) = v;
                }
                if (tid < 128) { const int d = tid >> 6, c = tid & 63; DEC[(size_t)(ch * 2 + d) * 256 + h * 64 + c] = __expf(bc[d * 4096 + (d == 0 ? 63 : 0) * 64 + c]); }
            }
            __syncthreads();
            {
                const int d = w >> 2, dkt = w & 3;
                const LAS bf16_t* kd = ktd + d * 64 * 72;
                bf16x8 kb[2];
#pragma unroll
                for (int ks = 0; ks < 2; ++ks) kb[ks] = frag_tr(kd, 72, ks * 32, dkt * 16, lane);
                float* Ud = U + ((size_t)(ch * 2 + d) * 4 + h) * 8192;
#pragma unroll
                for (int dvt = 0; dvt < 8; ++dvt) {
                    f32x4 acc = {0.f, 0.f, 0.f, 0.f};
#pragma unroll
                    for (int ks = 0; ks < 2; ++ks) acc = mfma16(frag_tr(vt, 136, ks * 32, dvt * 16, lane), kb[ks], acc);
                    *(f32x4*)(Ud + (dkt * 16 + (lane & 15)) * 128 + dvt * 16 + 4 * (lane >> 4)) = acc;
                }
            }
            __syncthreads();
        } else {
            const int t2 = task - NGLA, ch = t2 >> 2, cq = t2 & 3, r0 = ch * 64;
            const int seg_lo = ch < NCHL ? r0 : NLAT + ((r0 - NLAT) >> 8) * 256, seg_hi = ch < NCHL ? r0 + 64 : seg_lo + 256;
            LAS bf16_t* xin = (LAS bf16_t*)lds;
            LAS bf16_t* xb = xin + 67 * 136;
            LAS float* lat = (LAS float*)(xb + 64 * 136);
            LAS bf16_t* git = (LAS bf16_t*)(lat + 2 * 64 * 128);
            for (int i = tid; i < 67 * 16; i += NTHREADS) {
                const int row = i >> 4, chunk = i & 15, r = r0 - 2 + row;
                u32x4 v = {0u, 0u, 0u, 0u};
                if (r >= seg_lo && r < seg_hi) v = *(const u32x4*)(P + (size_t)r * ABIN + PC_RGX + cq * 128 + chunk * 8);
                *(LAS u32x4*)(xin + row * 136 + chunk * 8) = v;
            }
            __syncthreads();
            {
                const int t = tid >> 3, c16 = (tid & 7) * 16;
                float o[16];
#pragma unroll
                for (int j = 0; j < 16; ++j) o[j] = p->rg_conv_b[cq * 128 + c16 + j];
#pragma unroll
                for (int tap = 0; tap < 4; ++tap)
#pragma unroll
                    for (int j = 0; j < 16; ++j) o[j] += p->rg_conv_w[tap * 512 + cq * 128 + c16 + j] * bf2f(xin[(t + tap) * 136 + c16 + j]);
#pragma unroll
                for (int j = 0; j < 16; j += 8) {
                    u32x4 v; v.x = pk2(o[j], o[j + 1]); v.y = pk2(o[j + 2], o[j + 3]); v.z = pk2(o[j + 4], o[j + 5]); v.w = pk2(o[j + 6], o[j + 7]);
                    *(LAS u32x4*)(xb + t * 136 + c16 + j) = v;
                }
            }
            __syncthreads();
            {
                const int blk = w & 1, d = (w >> 1) & 1, mat = w >> 2, n = cq * 2 + blk;
                const float* W = (mat ? p->rg_wi : p->rg_wr) + (size_t)(d * 8 + n) * 4096;
                const float* bias = (mat ? p->rg_bi : p->rg_br) + d * 512 + n * 64;
                bf16x8 wf[4][2];
#pragma unroll
                for (int ot = 0; ot < 4; ++ot)
#pragma unroll
                    for (int ks = 0; ks < 2; ++ks) {
                        const float* src = W + (size_t)(ks * 32 + 8 * (lane >> 4)) * 64 + ot * 16 + (lane & 15);
                        float f[8];
#pragma unroll
                        for (int j = 0; j < 8; ++j) f[j] = src[j * 64];
                        u32x4 v; v.x = pk2n(f[0], f[1]); v.y = pk2n(f[2], f[3]); v.z = pk2n(f[4], f[5]); v.w = pk2n(f[6], f[7]);
                        wf[ot][ks] = __builtin_bit_cast(bf16x8, v);
                    }
#pragma unroll
                for (int tt = 0; tt < 4; ++tt) {
                    bf16x8 xf[2];
#pragma unroll
                    for (int ks = 0; ks < 2; ++ks) xf[ks] = frag_row(xb, 136, tt * 16, blk * 64 + ks * 32, lane);
#pragma unroll
                    for (int ot = 0; ot < 4; ++ot) {
                        f32x4 acc = {0.f, 0.f, 0.f, 0.f};
#pragma unroll
                        for (int ks = 0; ks < 2; ++ks) acc = mfma16(wf[ot][ks], xf[ks], acc);
                        const int t = tt * 16 + (lane & 15), o = ot * 16 + 4 * (lane >> 4), c = blk * 64 + o;
                        const f32x4 bv = *(const f32x4*)(bias + o);
                        if (mat == 0) {
                            const f32x4 lam = *(const f32x4*)(p->rg_lambda + d * 512 + n * 64 + o);
                            f32x4 la;
#pragma unroll
                            for (int j = 0; j < 4; ++j) la[j] = -8.f * softplusf_(-lam[j]) * sigmoidf_(acc[j] + bv[j]);
                            *(LAS f32x4*)(lat + (d * 64 + t) * 128 + c) = la;
                        } else {
                            float gi[4];
#pragma unroll
                            for (int j = 0; j < 4; ++j) gi[j] = sigmoidf_(acc[j] + bv[j]) * bf2f(xb[t * 136 + c + j]);
                            u32x2 v; v.x = pk2(gi[0], gi[1]); v.y = pk2(gi[2], gi[3]);
                            *(LAS u32x2*)(git + (d * 64 + t) * 128 + c) = v;
                        }
                    }
                }
            }
            __syncthreads();
            {
                const int c4 = (tid & 31) * 4, rest = tid >> 5, d = rest >> 3, t0 = (rest & 7) * 8, gc = cq * 128 + c4;
#pragma unroll
                for (int j = 0; j < 8; ++j) {
                    const int t = t0 + j;
                    const f32x4 la = *(const LAS f32x4*)(lat + (d * 64 + t) * 128 + c4);
                    const u32x2 gg = *(const LAS u32x2*)(git + (d * 64 + t) * 128 + c4);
                    f32x4 av; float u[4];
                    const float gi[4] = {lo_bf(gg.x), hi_bf(gg.x), lo_bf(gg.y), hi_bf(gg.y)};
#pragma unroll
                    for (int e = 0; e < 4; ++e) { av[e] = __expf(la[e]); u[e] = sqrtf(-expm1f(2.f * la[e])) * gi[e]; }
                    u32x2 uo; uo.x = pk2(u[0], u[1]); uo.y = pk2(u[2], u[3]);
                    *(f32x4*)(LA + ((size_t)(r0 + t) * 2 + d) * 512 + gc) = la;
                    *(u32x2*)(UU + ((size_t)(r0 + t) * 2 + d) * 512 + gc) = uo;
                    *(LAS f32x4*)(lat + (d * 64 + t) * 128 + c4) = av;
                    *(LAS u32x2*)(git + (d * 64 + t) * 128 + c4) = uo;
                }
            }
            __syncthreads();
            {
                const int half = tid >> 8, d = (tid >> 7) & 1, c = tid & 127, gc = cq * 128 + c;
                float hacc = 0.f, aprod = 1.f;
#pragma unroll 8
                for (int s_ = 0; s_ < 32; ++s_) {
                    const int pp = half * 32 + s_, t = d == 0 ? pp : 63 - pp;
                    const float a = lat[(d * 64 + t) * 128 + c], u = bf2f(git[(d * 64 + t) * 128 + c]);
                    hacc = a * hacc + u; aprod *= a;
                }
                LAS float* comb = (LAS float*)xin;
                comb[(half * 256 + d * 128 + c) * 2] = aprod; comb[(half * 256 + d * 128 + c) * 2 + 1] = hacc;
                __syncthreads();
                if (half == 0) {
                    const float a1 = comb[(256 + d * 128 + c) * 2], h1 = comb[(256 + d * 128 + c) * 2 + 1];
                    AGGA[(size_t)(ch * 2 + d) * 512 + gc] = aprod * a1;
                    AGGH[(size_t)(ch * 2 + d) * 512 + gc] = a1 * hacc + h1;
                }
            }
            __syncthreads();
        }
    }
}

DI int scan_chunk(int b, int d, int st) {
    if (st < 4) return NCHL + b * 4 + (d == 0 ? st : 3 - st);
    const int j = st - 4;
    return b * 128 + (d == 0 ? j : 127 - j);
}

DI void phase_scan0(PP p) {
    float* U = (float*)(p->ws + OFF_ARENA + A_U);
    const float* DEC = (const float*)(p->ws + OFF_ARENA + A_DEC);
    const float* AGGA = (const float*)(p->ws + OFF_ARENA + A_AGGA);
    float* AGGH = (float*)(p->ws + OFF_ARENA + A_AGGH);
    const int gid = get_bid() * NTHREADS + get_tid(), nthr = gridDim.x * NTHREADS;
    for (int idx = gid; idx < 65536 + 4096; idx += nthr) {
        if (idx < 65536) {
            const int dv4 = idx & 31, dk = (idx >> 5) & 63, h = (idx >> 11) & 3, d = (idx >> 13) & 1, b = idx >> 14;
            f32x4 S = {0.f, 0.f, 0.f, 0.f};
            for (int st = 0; st < 132; st += 4) {
                f32x4 u[4]; float dc[4]; float* ptr[4];
#pragma unroll
                for (int q = 0; q < 4; ++q) {
                    const int cid = scan_chunk(b, d, st + q);
                    ptr[q] = U + ((size_t)(cid * 2 + d) * 4 + h) * 8192 + dk * 128 + dv4 * 4;
                    u[q] = *(const f32x4*)ptr[q];
                    dc[q] = DEC[(size_t)(cid * 2 + d) * 256 + h * 64 + dk];
                }
#pragma unroll
                for (int q = 0; q < 4; ++q) { *(f32x4*)ptr[q] = S; S = S * dc[q] + u[q]; }
            }
        } else {
            const int i2 = idx - 65536, c = i2 & 511, d = (i2 >> 9) & 1, b = i2 >> 10;
            float hs = 0.f;
            for (int st = 0; st < 132; st += 4) {
                float a[4], hh[4]; float* ptr[4];
#pragma unroll
                for (int q = 0; q < 4; ++q) {
                    const int cid = scan_chunk(b, d, st + q);
                    ptr[q] = AGGH + (size_t)(cid * 2 + d) * 512 + c;
                    hh[q] = *ptr[q]; a[q] = AGGA[(size_t)(cid * 2 + d) * 512 + c];
                }
#pragma unroll
                for (int q = 0; q < 4; ++q) { *ptr[q] = hs; hs = a[q] * hs + hh[q]; }
            }
        }
    }
}

DI void phase_g3(PP p, lds_t lds) {
    const int tid = get_tid(), lane = tid & 63, w = tid >> 6;
    const bf16_t* P = (const bf16_t*)(p->ws + OFF_ARENA + A_P);
    const float* U = (const float*)(p->ws + OFF_ARENA + A_U);
    const float* LA = (const float*)(p->ws + OFF_ARENA + A_LA);
    const bf16_t* UU = (const bf16_t*)(p->ws + OFF_ARENA + A_UU);
    const float* HST = (const float*)(p->ws + OFF_ARENA + A_AGGH);
    bf16_t* act = (bf16_t*)(p->ws + OFF_ACT);
    constexpr int NGLA = NCH * 4;
    for (int task = get_bid(); task < NGLA + NCH; task += gridDim.x) {
        if (task < NGLA) {
            const int ch = task >> 2, h = task & 3, r0 = ch * 64;
            LAS float* lrt = (LAS float*)lds;
            LAS float* wat = lrt + 2048;
            LAS float* bat = wat + 2048;
            LAS float* bc = bat + 128;
            LAS bf16_t* qt = (LAS bf16_t*)(bc + 4096);
            LAS bf16_t* kt = qt + 64 * 72;
            LAS bf16_t* qtd = kt + 64 * 72;
            LAS bf16_t* ktd = qtd + 64 * 72;
            LAS bf16_t* at = ktd + 64 * 72;
            LAS bf16_t* vt = at + 64 * 72;
            LAS bf16_t* St = vt + 64 * 136;
            LAS float* ot = (LAS float*)(St + 64 * 136);
            gla_load_decay_inputs(p, P, r0, h, lrt, wat, bat);
            { const int row = tid >> 3, chunk = tid & 7;
              *(LAS u32x4*)(qt + row * 72 + chunk * 8) = *(const u32x4*)(P + (size_t)(r0 + row) * ABIN + PC_Q + h * 64 + chunk * 8);
              *(LAS u32x4*)(kt + row * 72 + chunk * 8) = *(const u32x4*)(P + (size_t)(r0 + row) * ABIN + PC_K + h * 64 + chunk * 8); }
#pragma unroll
            for (int q = 0; q < 2; ++q) { const int i = tid + 512 * q, row = i >> 4, chunk = i & 15; *(LAS u32x4*)(vt + row * 136 + chunk * 8) = *(const u32x4*)(P + (size_t)(r0 + row) * ABIN + PC_V + h * 128 + chunk * 8); }
            __syncthreads();
            f32x4 oacc[4];
#pragma unroll
            for (int i = 0; i < 4; ++i) oacc[i] = (f32x4){0.f, 0.f, 0.f, 0.f};
            const int ott = w & 3, odv0 = (w >> 2) * 4;
            for (int d = 0; d < 2; ++d) {
                gla_bcum(bc, lrt + d * 1024, wat + d * 1024, bat + d * 64, d, ot);
                {
                    const int t = tid >> 3, c8 = (tid & 7) * 8;
                    float qo[8], ko[8];
#pragma unroll
                    for (int j = 0; j < 8; ++j) { const float e = __expf(bc[t * 64 + c8 + j]); qo[j] = bf2f(qt[t * 72 + c8 + j]) * 0.125f * e; ko[j] = bf2f(kt[t * 72 + c8 + j]) / e; }
                    u32x4 v; v.x = pk2(qo[0], qo[1]); v.y = pk2(qo[2], qo[3]); v.z = pk2(qo[4], qo[5]); v.w = pk2(qo[6], qo[7]);
                    *(LAS u32x4*)(qtd + t * 72 + c8) = v;
                    v.x = pk2(ko[0], ko[1]); v.y = pk2(ko[2], ko[3]); v.z = pk2(ko[4], ko[5]); v.w = pk2(ko[6], ko[7]);
                    *(LAS u32x4*)(ktd + t * 72 + c8) = v;
                    const int dk = tid >> 3, dv16 = (tid & 7) * 16;
                    const float* src = U + ((size_t)(ch * 2 + d) * 4 + h) * 8192 + dk * 128 + dv16;
                    const f32x4 s0 = *(const f32x4*)src, s1 = *(const f32x4*)(src + 4), s2 = *(const f32x4*)(src + 8), s3 = *(const f32x4*)(src + 12);
                    v.x = pk2(s0[0], s0[1]); v.y = pk2(s0[2], s0[3]); v.z = pk2(s1[0], s1[1]); v.w = pk2(s1[2], s1[3]);
                    *(LAS u32x4*)(St + dk * 136 + dv16) = v;
                    v.x = pk2(s2[0], s2[1]); v.y = pk2(s2[2], s2[3]); v.z = pk2(s3[0], s3[1]); v.w = pk2(s3[2], s3[3]);
                    *(LAS u32x4*)(St + dk * 136 + dv16 + 8) = v;
                }
                __syncthreads();
                {
                    const int tt = w >> 1;
#pragma unroll
                    for (int e = 0; e < 2; ++e) {
                        const int st = (w & 1) * 2 + e;
                        f32x4 acc = {0.f, 0.f, 0.f, 0.f};
#pragma unroll
                        for (int ks = 0; ks < 2; ++ks) acc = mfma16(frag_row(ktd, 72, st * 16, ks * 32, lane), frag_row(qtd, 72, tt * 16, ks * 32, lane), acc);
                        const int t = tt * 16 + (lane & 15), s0 = st * 16 + 4 * (lane >> 4);
                        float a[4];
#pragma unroll
                        for (int j = 0; j < 4; ++j) { const int s = s0 + j; a[j] = (d == 0 ? s <= t : s >= t) ? acc[j] : 0.f; }
                        u32x2 v; v.x = pk2(a[0], a[1]); v.y = pk2(a[2], a[3]);
                        *(LAS u32x2*)(at + t * 72 + s0) = v;
                    }
                }
                __syncthreads();
                {
                    bf16x8 af[2], qf[2];
#pragma unroll
                    for (int ks = 0; ks < 2; ++ks) { af[ks] = frag_row(at, 72, ott * 16, ks * 32, lane); qf[ks] = frag_row(qtd, 72, ott * 16, ks * 32, lane); }
#pragma unroll
                    for (int i = 0; i < 4; ++i) {
                        const int dvt = odv0 + i;
#pragma unroll
                        for (int ks = 0; ks < 2; ++ks) {
                            oacc[i] = mfma16(frag_tr(vt, 136, ks * 32, dvt * 16, lane), af[ks], oacc[i]);
                            oacc[i] = mfma16(frag_tr(St, 136, ks * 32, dvt * 16, lane), qf[ks], oacc[i]);
                        }
                    }
                }
                __syncthreads();
            }
#pragma unroll
            for (int i = 0; i < 4; ++i) *(LAS f32x4*)(ot + (ott * 16 + (lane & 15)) * 132 + (odv0 + i) * 16 + 4 * (lane >> 4)) = oacc[i];
            __syncthreads();
            {
                const int t = tid >> 3, dv16 = (tid & 7) * 16;
                float o[16]; float ss = 0.f;
#pragma unroll
                for (int j = 0; j < 16; ++j) { o[j] = ot[t * 132 + dv16 + j]; ss += o[j] * o[j]; }
                ss += __shfl_xor(ss, 1); ss += __shfl_xor(ss, 2); ss += __shfl_xor(ss, 4);
                const float rs = rsqrtf(ss * (1.f / 128.f) + EPS);
                const bf16_t* gp = P + (size_t)(r0 + t) * ABIN + PC_G + h * 128 + dv16;
                const u32x4 g0 = *(const u32x4*)gp, g1 = *(const u32x4*)(gp + 8);
                const unsigned gw[8] = {g0.x, g0.y, g0.z, g0.w, g1.x, g1.y, g1.z, g1.w};
                float r[16];
#pragma unroll
                for (int j = 0; j < 8; ++j) {
                    r[2 * j] = o[2 * j] * rs * p->gla_norm_g[h * 128 + dv16 + 2 * j] * siluf_(lo_bf(gw[j]));
                    r[2 * j + 1] = o[2 * j + 1] * rs * p->gla_norm_g[h * 128 + dv16 + 2 * j + 1] * siluf_(hi_bf(gw[j]));
                }
                bf16_t* dst = act + (size_t)(r0 + t) * 1024 + h * 128 + dv16;
                u32x4 v; v.x = pk2(r[0], r[1]); v.y = pk2(r[2], r[3]); v.z = pk2(r[4], r[5]); v.w = pk2(r[6], r[7]);
                *(u32x4*)dst = v;
                v.x = pk2(r[8], r[9]); v.y = pk2(r[10], r[11]); v.z = pk2(r[12], r[13]); v.w = pk2(r[14], r[15]);
                *(u32x4*)(dst + 8) = v;
            }
            __syncthreads();
        } else {
            const int ch = task - NGLA, r0 = ch * 64, c = tid;
            LAS float* hf = (LAS float*)lds;
            float hs = HST[(size_t)(ch * 2 + 0) * 512 + c];
            for (int tb = 0; tb < 64; tb += 16) {
                float la[16]; bf16_t uu[16];
#pragma unroll
                for (int j = 0; j < 16; ++j) { const size_t o = ((size_t)(r0 + tb + j) * 2 + 0) * 512 + c; la[j] = LA[o]; uu[j] = UU[o]; }
#pragma unroll
                for (int j = 0; j < 16; ++j) { hs = __expf(la[j]) * hs + bf2f(uu[j]); hf[(tb + j) * 512 + c] = hs; }
            }
            hs = HST[(size_t)(ch * 2 + 1) * 512 + c];
            for (int tb = 48; tb >= 0; tb -= 16) {
                float la[16]; bf16_t uu[16], gg[16];
#pragma unroll
                for (int j = 0; j < 16; ++j) { const size_t o = ((size_t)(r0 + tb + j) * 2 + 1) * 512 + c; la[j] = LA[o]; uu[j] = UU[o]; gg[j] = P[(size_t)(r0 + tb + j) * ABIN + PC_RGG + c]; }
#pragma unroll
                for (int j = 15; j >= 0; --j) {
                    hs = __expf(la[j]) * hs + bf2f(uu[j]);
                    act[(size_t)(r0 + tb + j) * 1024 + 512 + c] = f2bf((hf[(tb + j) * 512 + c] + hs) * gelu_tanh(bf2f(gg[j])));
                }
            }
            __syncthreads();
        }
    }
}


DI void phase_outproj0(PP p, lds_t lds) {
    const bf16_t* act = (const bf16_t*)(p->ws + OFF_ACT);
    float* X = (float*)(p->ws + OFF_ARENA + A_X);
    constexpr int NM = NTOK / 256, NN = 4;
    for_units_xcd(1, NM, NN, 8, 4, [&](int, int pm, int pn) {
        const int set = row_set(pm * 256);
        const float* g1 = mods_ptr(p, 0, set, 2);
        const float* xin = pm * 256 < NLAT ? p->x + (size_t)pm * 256 * 1024 : p->ctx + (size_t)(pm * 256 - NLAT) * 1024;
        gemm_unit<256, 64>(lds, 1024, 1024,
            [&](int r) { return act + (size_t)(pm * 256 + r) * 1024; },
            [&](int j) -> const float* { return p->ab_w_out + pn * 256 + j; },
            [&](const f32x4 (&acc)[8][4], int wr, int wc, int lane) {
                epi_each<4>(acc, wr, wc, lane, [&](int r, int c, f32x4 v) {
                    const int col = pn * 256 + c;
                    const f32x4 xi = *(const f32x4*)(xin + (size_t)r * 1024 + col), g = *(const f32x4*)(g1 + col);
                    *(f32x4*)(X + (size_t)(pm * 256 + r) * 1024 + col) = xi + g * v;
                });
            });
    });
}

struct MoeBufs { float* PT; float* PE; int* ROWID; int* ROWTOK; bf16_t* HDN; bf16_t* Y; int rpe; int nrows; };
DI MoeBufs moe_bufs(PP p, int layer) {
    MoeBufs m;
    char* a = p->ws + OFF_ARENA;
    if (layer == 0) { m.PT = (float*)(a + A_PT); m.PE = (float*)(a + A_PE); m.ROWID = (int*)(a + A_ROWID); m.ROWTOK = (int*)(a + A_ROWTOK); m.HDN = (bf16_t*)(a + A_HDN); m.Y = (bf16_t*)(a + A_Y); m.rpe = 4352; m.nrows = NTOK; }
    else { m.PT = (float*)(a + A_HB); m.PE = (float*)(a + A_HB + (size_t)NTOK * 64); m.ROWID = (int*)(a + A_HB + (size_t)NTOK * 128); m.ROWTOK = (int*)(a + A_HB + (size_t)NTOK * 192); m.HDN = (bf16_t*)(a + A_XM); m.Y = (bf16_t*)(a + A_XC); m.rpe = 4096; m.nrows = NLAT; }
    return m;
}

DI void phase_router(PP p, lds_t lds, int layer) {
    const int tid = get_tid(), lane = tid & 63;
    const MoeBufs m = moe_bufs(p, layer);
    const float* X = (const float*)(p->ws + OFF_ARENA + A_X);
    bf16_t* act = (bf16_t*)(p->ws + OFF_ACT);
    LAS float* rwT = (LAS float*)lds;
    for (int i = tid; i < 16384; i += NTHREADS) { const int k = i >> 4, e = i & 15; rwT[e * 1024 + k] = p->router_w[(size_t)layer * 16384 + i]; }
    __syncthreads();
    const int gw = get_bid() * 8 + (tid >> 6), nw = gridDim.x * 8;
    for (int r = gw; r < m.nrows; r += nw) {
        f32x4 v[4];
        row_load_f32(X + (size_t)r * 1024, v, lane);
        const float rs = rsqrtf(row_sumsq(v) * (1.f / 1024.f) + EPS);
        const int set = row_set(r);
        row_modulate(v, rs, p->norm2_g + layer * 1024, mods_ptr(p, layer, set, 4), mods_ptr(p, layer, set, 3), lane);
        row_store_bf16(act + (size_t)r * 1024, v, lane);
        float lg[16];
#pragma unroll
        for (int e = 0; e < 16; ++e) {
            float a = 0.f;
#pragma unroll
            for (int i = 0; i < 4; ++i) { const f32x4 wv = *(const LAS f32x4*)(rwT + e * 1024 + 4 * lane + 256 * i); a += v[i][0] * wv[0] + v[i][1] * wv[1] + v[i][2] * wv[2] + v[i][3] * wv[3]; }
            lg[e] = wave_sum(a);
            asm volatile("" ::: "memory");
        }
        float mx = lg[0];
#pragma unroll
        for (int e = 1; e < 16; ++e) mx = fmaxf(mx, lg[e]);
        float sum = 0.f;
#pragma unroll
        for (int e = 0; e < 16; ++e) { lg[e] = __expf(lg[e] - mx); sum += lg[e]; }
        const float inv = 1.f / sum;
        float mine = 0.f;
#pragma unroll
        for (int e = 0; e < 16; ++e) if (lane == e) mine = lg[e] * inv;
        if (lane < 16) {
            m.PT[(size_t)r * 16 + lane] = mine;
            if (r < NLAT) m.PE[((size_t)(r >> 13) * 16 + lane) * 8192 + (r & 8191)] = mine;
            else { const int rc = r - NLAT; m.PE[(size_t)NBATCH * 16 * 8192 + ((size_t)(rc >> 8) * 16 + lane) * 256 + (rc & 255)] = mine; }
        }
    }
}

DI int block_excl_scan(int v, LAS int* tmp, int* total) {
    const int tid = get_tid(), lane = tid & 63, w = tid >> 6;
    int inc = v;
#pragma unroll
    for (int o = 1; o < 64; o <<= 1) { const int t = __shfl_up(inc, o); if (lane >= o) inc += t; }
    __syncthreads();
    if (lane == 63) tmp[w] = inc;
    __syncthreads();
    int base = 0, tot = 0;
#pragma unroll
    for (int i = 0; i < 8; ++i) { const int t = tmp[i]; if (i < w) base += t; tot += t; }
    *total = tot;
    return base + inc - v;
}

DI void phase_topk(PP p, lds_t lds, int layer) {
    const int tid = get_tid();
    const MoeBufs m = moe_bufs(p, layer);
    LAS unsigned* keys = (LAS unsigned*)lds;
    LAS int* hist = (LAS int*)(keys + 8192);
    LAS int* tmp = hist + 256;
    LAS int* sel = tmp + 16;
    const int ntask = layer == 0 ? 128 : 64;
    for (int task = get_bid(); task < ntask; task += gridDim.x) {
        const bool isctx = task >= 64;
        const int b = (task & 63) >> 4, e = task & 15;
        const int n = isctx ? 256 : 8192, cap = isctx ? 32 : 1024;
        const float* src = isctx ? m.PE + (size_t)NBATCH * 16 * 8192 + ((size_t)b * 16 + e) * 256 : m.PE + ((size_t)b * 16 + e) * 8192;
        for (int i = tid; i < n; i += NTHREADS) keys[i] = __float_as_uint(src[i]);
        __syncthreads();
        unsigned prefix = 0u, mask = 0u; int kk = cap;
        for (int pass = 3; pass >= 0; --pass) {
            const int shift = pass * 8;
            if (tid < 256) hist[tid] = 0;
            __syncthreads();
            for (int i = tid; i < n; i += NTHREADS) { const unsigned k = keys[i]; if ((k & mask) == prefix) __hip_atomic_fetch_add((int*)(hist + ((k >> shift) & 255)), 1, __ATOMIC_RELAXED, __HIP_MEMORY_SCOPE_WORKGROUP); }
            __syncthreads();
            if (tid < 256) {
                int above = 0;
                for (int j = tid + 1; j < 256; ++j) above += hist[j];
                const int mineh = hist[tid];
                if (above < kk && kk <= above + mineh) { sel[0] = tid; sel[1] = above; }
            }
            __syncthreads();
            prefix |= (unsigned)sel[0] << shift; mask |= 0xffu << shift; kk -= sel[1];
            __syncthreads();
        }
        const unsigned T = prefix; const int need_eq = kk;
        const int ipt = n / NTHREADS > 0 ? n / NTHREADS : 1;
        const int i0 = tid * ipt;
        int cgt = 0, ceq = 0;
        if (i0 < n) for (int j = 0; j < ipt; ++j) { const unsigned k = keys[i0 + j]; cgt += k > T; ceq += k == T; }
        int tot;
        const int egt = block_excl_scan(cgt, tmp, &tot);
        const int eeq = block_excl_scan(ceq, tmp, &tot);
        const int slot0 = e * m.rpe + (isctx ? 4096 + b * 32 : b * 1024);
        const int row0 = isctx ? NLAT + b * 256 : b * 8192;
        if (i0 < n) {
            int ngt = egt, neq = eeq;
            for (int j = 0; j < ipt; ++j) {
                const unsigned k = keys[i0 + j];
                int slot = -1;
                if (k > T) { slot = slot0 + ngt + (neq < need_eq ? neq : need_eq); ++ngt; }
                else if (k == T) { if (neq < need_eq) slot = slot0 + ngt + neq; ++neq; }
                m.ROWID[(size_t)(row0 + i0 + j) * 16 + e] = slot;
                if (slot >= 0) m.ROWTOK[slot] = row0 + i0 + j;
            }
        }
        if (isctx && b == 0 && layer == 0) for (int i = tid; i < 128; i += NTHREADS) m.ROWTOK[e * m.rpe + 4224 + i] = -1;
        __syncthreads();
    }
}

DI void phase_moe_up(PP p, lds_t lds, int layer) {
    const MoeBufs m = moe_bufs(p, layer);
    const bf16_t* act = (const bf16_t*)(p->ws + OFF_ACT);
    auto unit = [&](int e, int mt, int nt) {
        const float* Wg = p->exp_w_gate + ((size_t)layer * 16 + e) * 1048576;
        const float* Wu = p->exp_w_up + ((size_t)layer * 16 + e) * 1048576;
        const int* rt = m.ROWTOK + e * m.rpe + mt * 256;
        bf16_t* H = m.HDN + ((size_t)e * m.rpe + mt * 256) * 1024 + nt * 128;
        gemm_unit<256, 64>(lds, 1024, 1024,
            [&](int r) -> const bf16_t* { const int tok = rt[r]; return tok >= 0 ? act + (size_t)tok * 1024 : nullptr; },
            [&](int j) -> const float* { const int wcq = j >> 6, within = j & 63; const int hc = nt * 128 + wcq * 32 + (within & 31); return (within < 32 ? Wg : Wu) + hc; },
            [&](const f32x4 (&acc)[8][4], int wr, int wc, int lane) {
#pragma unroll
                for (int mi = 0; mi < 8; ++mi)
#pragma unroll
                    for (int ni = 0; ni < 2; ++ni) {
                        const f32x4 g = acc[mi][ni], uu = acc[mi][ni + 2];
                        f32x4 h;
#pragma unroll
                        for (int j = 0; j < 4; ++j) h[j] = siluf_(g[j]) * uu[j];
                        store_bf16x4(H + (size_t)(wr * 128 + mi * 16 + (lane & 15)) * 1024 + wc * 32 + ni * 16 + 4 * (lane >> 4), h);
                    }
            });
    };
    for_units_xcd(16, 16, 8, 4, 8, unit);
    if (layer == 0) for_units_xcd(16, 1, 8, 1, 8, [&](int e, int, int nt) { unit(e, 16, nt); });
}

DI void phase_moe_down(PP p, lds_t lds, int layer) {
    const MoeBufs m = moe_bufs(p, layer);
    auto unit = [&](int e, int mt, int nt) {
        const float* Wd = p->exp_w_down + ((size_t)layer * 16 + e) * 1048576;
        const bf16_t* H = m.HDN + ((size_t)e * m.rpe + mt * 256) * 1024;
        bf16_t* Y = m.Y + ((size_t)e * m.rpe + mt * 256) * 1024 + nt * 256;
        gemm_unit<256, 64>(lds, 1024, 1024,
            [&](int r) { return H + (size_t)r * 1024; },
            [&](int j) -> const float* { return Wd + nt * 256 + j; },
            [&](const f32x4 (&acc)[8][4], int wr, int wc, int lane) {
                epi_each<4>(acc, wr, wc, lane, [&](int r, int c, f32x4 v) { store_bf16x4(Y + (size_t)r * 1024 + c, v); });
            });
    };
    for_units_xcd(16, 16, 4, 8, 4, unit);
    if (layer == 0) for_units_xcd(16, 1, 4, 1, 4, [&](int e, int, int nt) { unit(e, 16, nt); });
}

DI void phase_combine(PP p, int layer) {
    const int tid = get_tid(), lane = tid & 63;
    const MoeBufs m = moe_bufs(p, layer);
    float* X = (float*)(p->ws + OFF_ARENA + A_X);
    bf16_t* act = (bf16_t*)(p->ws + OFF_ACT);
    const int gw = get_bid() * 8 + (tid >> 6), nw = gridDim.x * 8;
    for (int r = gw; r < m.nrows; r += nw) {
        f32x4 v[4], a[4];
        row_load_f32(X + (size_t)r * 1024, v, lane);
#pragma unroll
        for (int i = 0; i < 4; ++i) a[i] = (f32x4){0.f, 0.f, 0.f, 0.f};
        for (int e = 0; e < 16; ++e) {
            const int rid = m.ROWID[(size_t)r * 16 + e];
            if (rid >= 0) {
                const float pe = m.PT[(size_t)r * 16 + e];
                const bf16_t* y = m.Y + (size_t)rid * 1024;
#pragma unroll
                for (int i = 0; i < 4; ++i) { const u32x2 yy = *(const u32x2*)(y + 4 * lane + 256 * i); a[i][0] += pe * lo_bf(yy.x); a[i][1] += pe * hi_bf(yy.x); a[i][2] += pe * lo_bf(yy.y); a[i][3] += pe * hi_bf(yy.y); }
            }
        }
        const int set = row_set(r);
        const float* g2 = mods_ptr(p, layer, set, 5);
#pragma unroll
        for (int i = 0; i < 4; ++i) { const f32x4 g = *(const f32x4*)(g2 + 4 * lane + 256 * i); v[i] = v[i] + g * a[i]; }
        const float rs = rsqrtf(row_sumsq(v) * (1.f / 1024.f) + EPS);
        if (layer == 0) {
#pragma unroll
            for (int i = 0; i < 4; ++i) *(f32x4*)(X + (size_t)r * 1024 + 4 * lane + 256 * i) = v[i];
            row_modulate(v, rs, p->norm1_g + 1024, mods_ptr(p, 1, set, 1), mods_ptr(p, 1, set, 0), lane);
            row_store_bf16(act + (size_t)r * 1024, v, lane);
        } else {
#pragma unroll
            for (int i = 0; i < 4; ++i) { const f32x4 g = *(const f32x4*)(p->final_g + 4 * lane + 256 * i); *(f32x4*)(p->out + (size_t)r * 1024 + 4 * lane + 256 * i) = v[i] * rs * g; }
        }
    }
}


DI void phase_upproj(PP p, lds_t lds, int half) {
    const bf16_t* act = (const bf16_t*)(p->ws + OFF_ACT);
    bf16_t* O = (bf16_t*)(p->ws + OFF_ARENA + A_XM);
    const int NM = half == 0 ? NTOK / 256 : NLAT / 256, NN = 8;
    for_units_xcd(1, NM, NN, 8, 4, [&](int, int pm, int pn) {
        gemm_unit<256, 64>(lds, 1024, 4096,
            [&](int r) { return act + (size_t)(pm * 256 + r) * 1024; },
            [&](int j) -> const float* { return p->m_w_up + half * 2048 + pn * 256 + j; },
            [&](const f32x4 (&acc)[8][4], int wr, int wc, int lane) {
                epi_each<4>(acc, wr, wc, lane, [&](int r, int c, f32x4 v) { store_bf16x4(O + (size_t)(pm * 256 + r) * 2048 + pn * 256 + c, v); });
            });
    });
}

DI void phase_mfeat(PP p, lds_t lds) {
    const int tid = get_tid(), lane = tid & 63, w = tid >> 6;
    bf16_t* XM = (bf16_t*)(p->ws + OFF_ARENA + A_XM);
    bf16_t* XC = (bf16_t*)(p->ws + OFF_ARENA + A_XC);
    bf16_t* CTXV = (bf16_t*)(p->ws + OFF_ACT + ACT_CTXV);
    bf16_t* RAWS = (bf16_t*)(p->ws + OFF_ACT + ACT_RAWS);
    float* GP = (float*)(p->ws + OFF_ACT + ACT_GP);
    const bf16_t* GC = (const bf16_t*)(p->ws + OFF_GCAT);
    const float* MM = (const float*)(p->ws + OFF_MMAT);
    LAS bf16_t* xin = (LAS bf16_t*)lds;
    LAS bf16_t* xct = xin + 67 * 136;
    LAS bf16_t* qpt = xct + 64 * 136;
    LAS bf16_t* gxc = qpt + 64 * 136;
    LAS bf16_t* gxm = gxc + 128 * 16;
    LAS float* mq = (LAS float*)(gxm + 128 * 16);
    LAS float* wvq = mq + 512;
    LAS float* cw = wvq + 512;
    LAS float* gred = cw + 640;
    for (int task = get_bid(); task < NCH * 4; task += gridDim.x) {
        const int ch = task >> 2, h = task & 3, r0 = ch * 64;
        const int seg_lo = ch < NCHL ? r0 : NLAT + ((r0 - NLAT) >> 8) * 256, seg_hi = ch < NCHL ? r0 + 64 : seg_lo + 256;
        f32x4 rs_acc[2] = {{0.f, 0.f, 0.f, 0.f}, {0.f, 0.f, 0.f, 0.f}};
        f32x4 g_acc = {0.f, 0.f, 0.f, 0.f};
        for (int q4 = 0; q4 < 4; ++q4) {
            const int col0 = h * 512 + q4 * 128;
            for (int i = tid; i < 67 * 16; i += NTHREADS) {
                const int row = i >> 4, chunk = i & 15, r = r0 - 2 + row;
                u32x4 v = {0u, 0u, 0u, 0u};
                if (r >= seg_lo && r < seg_hi) v = *(const u32x4*)(XM + (size_t)r * 2048 + col0 + chunk * 8);
                *(LAS u32x4*)(xin + row * 136 + chunk * 8) = v;
            }
            if (tid < 256) *(LAS u32x4*)(gxc + tid * 8) = *(const u32x4*)(GC + (size_t)col0 * 16 + tid * 8);
            else *(LAS u32x4*)(gxm + (tid - 256) * 8) = *(const u32x4*)(GC + (size_t)(2048 + col0) * 16 + (tid - 256) * 8);
            mq[tid] = bf2f(f2bf(MM[(size_t)(col0 >> 2) * 16 + tid]));
            wvq[tid] = p->m_wv[(size_t)(col0 >> 2) * 16 + tid];
            for (int i = tid; i < 640; i += NTHREADS) cw[i] = i < 512 ? p->m_conv_w[(size_t)(i >> 7) * 2048 + col0 + (i & 127)] : p->m_conv_b[col0 + i - 512];
            __syncthreads();
            {
                const int t = tid >> 3, c16 = (tid & 7) * 16;
                float xc[16], xm[16];
#pragma unroll
                for (int j = 0; j < 16; ++j) { xc[j] = cw[512 + c16 + j]; xm[j] = bf2f(xin[(t + 2) * 136 + c16 + j]); }
#pragma unroll
                for (int tap = 0; tap < 4; ++tap)
#pragma unroll
                    for (int j = 0; j < 16; ++j) xc[j] += cw[tap * 128 + c16 + j] * bf2f(xin[(t + tap) * 136 + c16 + j]);
                unsigned xcp[8];
#pragma unroll
                for (int j = 0; j < 8; ++j) { xcp[j] = pk2(siluf_(xc[2 * j]), siluf_(xc[2 * j + 1])); xc[2 * j] = lo_bf(xcp[j]); xc[2 * j + 1] = hi_bf(xcp[j]); }
                float vv[16], qp[16];
#pragma unroll
                for (int n = 0; n < 4; ++n) {
                    const int nb = (c16 >> 2) + n;
#pragma unroll
                    for (int o = 0; o < 4; ++o) {
                        float a = 0.f, b = 0.f;
#pragma unroll
                        for (int i = 0; i < 4; ++i) { a += xm[4 * n + i] * wvq[nb * 16 + i * 4 + o]; b += xc[4 * n + i] * mq[nb * 16 + i * 4 + o]; }
                        vv[4 * n + o] = a; qp[4 * n + o] = b;
                    }
                }
                u32x4 v0, v1;
                v0.x = xcp[0]; v0.y = xcp[1]; v0.z = xcp[2]; v0.w = xcp[3]; v1.x = xcp[4]; v1.y = xcp[5]; v1.z = xcp[6]; v1.w = xcp[7];
                *(LAS u32x4*)(xct + t * 136 + c16) = v0; *(LAS u32x4*)(xct + t * 136 + c16 + 8) = v1;
                bf16_t* xcg = XC + (size_t)(r0 + t) * 2048 + col0 + c16;
                *(u32x4*)xcg = v0; *(u32x4*)(xcg + 8) = v1;
                v0.x = pk2(qp[0], qp[1]); v0.y = pk2(qp[2], qp[3]); v0.z = pk2(qp[4], qp[5]); v0.w = pk2(qp[6], qp[7]);
                v1.x = pk2(qp[8], qp[9]); v1.y = pk2(qp[10], qp[11]); v1.z = pk2(qp[12], qp[13]); v1.w = pk2(qp[14], qp[15]);
                *(LAS u32x4*)(qpt + t * 136 + c16) = v0; *(LAS u32x4*)(qpt + t * 136 + c16 + 8) = v1;
                v0.x = pk2(vv[0], vv[1]); v0.y = pk2(vv[2], vv[3]); v0.z = pk2(vv[4], vv[5]); v0.w = pk2(vv[6], vv[7]);
                v1.x = pk2(vv[8], vv[9]); v1.y = pk2(vv[10], vv[11]); v1.z = pk2(vv[12], vv[13]); v1.w = pk2(vv[14], vv[15]);
                bf16_t* vg = ch < NCHL ? XM + (size_t)(r0 + t) * 2048 + col0 + c16 : CTXV + (size_t)(r0 + t - NLAT) * 2048 + col0 + c16;
                *(u32x4*)vg = v0; *(u32x4*)(vg + 8) = v1;
            }
            __syncthreads();
            {
                const int tt = w >> 1;
#pragma unroll
                for (int e = 0; e < 2; ++e) {
                    const int st = (w & 1) * 2 + e;
#pragma unroll
                    for (int ks = 0; ks < 4; ++ks) rs_acc[e] = mfma16(frag_row(xct, 136, st * 16, ks * 32, lane), frag_row(qpt, 136, tt * 16, ks * 32, lane), rs_acc[e]);
                }
                const int gt = w & 3, src = w >> 2;
                const LAS bf16_t* gm = src ? gxm : gxc;
                const LAS bf16_t* ft = src ? xin + 2 * 136 : xct;
#pragma unroll
                for (int ks = 0; ks < 4; ++ks) g_acc = mfma16(frag_tr(gm, 16, ks * 32, 0, lane), frag_row(ft, 136, gt * 16, ks * 32, lane), g_acc);
            }
            __syncthreads();
        }
        {
            const int tt = w >> 1;
#pragma unroll
            for (int e = 0; e < 2; ++e) {
                const int st = (w & 1) * 2 + e;
                store_bf16x4(RAWS + ((size_t)task * 64 + tt * 16 + (lane & 15)) * 64 + st * 16 + 4 * (lane >> 4), rs_acc[e]);
            }
            const int gt = w & 3, src = w >> 2;
            *(LAS f32x4*)(gred + (src * 64 + gt * 16 + (lane & 15)) * 16 + 4 * (lane >> 4)) = g_acc;
        }
        __syncthreads();
        if (tid < 256) {
            const int t = tid >> 2, q = tid & 3;
            const f32x4 a = *(const LAS f32x4*)(gred + t * 16 + q * 4), b = *(const LAS f32x4*)(gred + (64 + t) * 16 + q * 4);
            *(f32x4*)(GP + ((size_t)(r0 + t) * 4 + h) * 16 + q * 4) = a + b;
        }
        __syncthreads();
    }
}

constexpr int MS_KLD = 1056, MS_QLD = 1040;
constexpr size_t ACT_MSC = 32u << 20;
static_assert(ACT_MSC >= ACT_CTXV + (size_t)NCTX * 2048 * 2 && ACT_MSC + (size_t)256 * 132 * 192 * 4 <= ACT_BYTES, "msc scratch");
#define MS_REGIONS(L) \
    lds_t xct = (L);                                                         \
    lds_t qpt = (L) + 64 * MS_KLD;                                           \
    LAS bf16_t* vt = (LAS bf16_t*)((L) + 64 * MS_KLD + 64 * MS_QLD);         \
    LAS bf16_t* St = vt + 4096;                                              \
    LAS bf16_t* vwt = St + 4096;                                             \
    LAS float* sc_b = (LAS float*)(vwt + 4096); \
    LAS float* sc_m = sc_b + 64; LAS float* sc_li = sc_m + 64; LAS float* sc_w = sc_li + 64; LAS float* sc_di = sc_w + 64; LAS float* sc_rs = sc_di + 64; \
    LAS float* sc_misc = sc_rs + 64;                                         \
    LAS float* qn = sc_misc + 8;                                             \
    LAS float* nvec = qn + 64;                                               \
    LAS float* red = (LAS float*)qpt;
DI void phase_mscan(PP p, lds_t lds) {
    const int tid = get_tid(), lane = tid & 63, w = tid >> 6, bid = get_bid();
    if (bid >= 256) return;
    const int grp = bid & 31, sl = bid >> 5, b = grp >> 3, h = (grp >> 1) & 3, d = grp & 1;
    const bf16_t* XC = (const bf16_t*)(p->ws + OFF_ARENA + A_XC);
    const bf16_t* V = (const bf16_t*)(p->ws + OFF_ARENA + A_XM);
    const bf16_t* CTXV = (const bf16_t*)(p->ws + OFF_ACT + ACT_CTXV);
    const bf16_t* RAWS = (const bf16_t*)(p->ws + OFF_ACT + ACT_RAWS);
    const float* GP = (const float*)(p->ws + OFF_ACT + ACT_GP);
    float* MSC = (float*)(p->ws + OFF_ACT + ACT_MSC) + (size_t)bid * 132 * 192;
    bf16_t* H = d == 0 ? (bf16_t*)p->out : (bf16_t*)(p->ws + OFF_ARENA + A_HB);
    static_assert(64 * MS_KLD + 64 * MS_QLD + 3 * 8192 + (6 * 64 + 8 + 64 + 512) * 4 <= LDS_BYTES, "mscan lds");
    {
        const float bias_i = p->m_b_gates[d * 8 + h], bias_f = p->m_b_gates[d * 8 + 4 + h];
        for (int st = w; st < 132; st += 8) {
            const int cid = scan_chunk(b, d, st), t = d ? 63 - lane : lane;
            const float* gp = GP + (size_t)(cid * 64 + t) * 64;
            const float gli = gp[d * 8 + h] + gp[16 + d * 8 + h] + gp[32 + d * 8 + h] + gp[48 + d * 8 + h] + bias_i;
            const float gf = gp[d * 8 + 4 + h] + gp[16 + d * 8 + 4 + h] + gp[32 + d * 8 + 4 + h] + gp[48 + d * 8 + 4 + h] + bias_f;
            float bb = log_sigmoidf_(gf);
#pragma unroll
            for (int o = 1; o < 64; o <<= 1) { const float t_ = __shfl_up(bb, o); if (lane >= o) bb += t_; }
            float pm = gli - bb;
#pragma unroll
            for (int o = 1; o < 64; o <<= 1) { const float t_ = __shfl_up(pm, o); if (lane >= o) pm = fmaxf(pm, t_); }
            float* dst = MSC + (size_t)st * 192;
            dst[lane] = bb; dst[64 + lane] = gli; dst[128 + lane] = pm;
        }
    }
    const int c16o = tid & 63;
    bf16x2_t Mp[2][4][2];
#pragma unroll
    for (int n = 0; n < 2; ++n) {
        const float* mm = (const float*)(p->ws + OFF_MMAT) + (size_t)(h * 128 + 2 * c16o + n) * 16;
#pragma unroll
        for (int o = 0; o < 4; ++o) { Mp[n][o][0] = __builtin_bit_cast(bf16x2_t, pk2(mm[o], mm[4 + o])); Mp[n][o][1] = __builtin_bit_cast(bf16x2_t, pk2(mm[8 + o], mm[12 + o])); }
    }
    f32x4 C[16];
#pragma unroll
    for (int i = 0; i < 16; ++i) C[i] = (f32x4){0.f, 0.f, 0.f, 0.f};
    f32x4 Nacc[4];
#pragma unroll
    for (int i = 0; i < 4; ++i) Nacc[i] = (f32x4){0.f, 0.f, 0.f, 0.f};
    { MS_REGIONS(lds) nvec[tid] = 0.f; (void)xct; (void)vt; (void)sc_b; (void)red; }
    float m_prev = 0.f;
    u32x4 xcr[8], vr, rr; float g_b = 0.f, g_li = 0.f, g_pm = 0.f;
    asm volatile("s_waitcnt vmcnt(0)" ::: "memory");
    __syncthreads();
    auto prefetch = [&](int st) {
        int tp = get_tid();
        const int tid = tp, lane = tid & 63, w = tid >> 6;
        const int cid = scan_chunk(b, d, st), r0 = cid * 64;
        const bf16_t* xp = XC + (size_t)(r0 + (tid >> 6)) * 2048 + h * 512 + (tid & 63) * 8;
#pragma unroll
        for (int i = 0; i < 8; ++i) xcr[i] = *(const u32x4*)(xp + (size_t)i * 8 * 2048);
        { const int s_ = tid >> 3, chunk = tid & 7;
          vr = cid < NCHL ? *(const u32x4*)(V + (size_t)(r0 + s_) * 2048 + h * 512 + sl * 64 + chunk * 8) : *(const u32x4*)(CTXV + (size_t)(r0 + s_ - NLAT) * 2048 + h * 512 + sl * 64 + chunk * 8);
          rr = *(const u32x4*)(RAWS + ((size_t)(cid * 4 + h) * 64 + s_) * 64 + chunk * 8); }
        if (w == 0) { const float* src = MSC + (size_t)st * 192; g_b = src[lane]; g_li = src[64 + lane]; g_pm = src[128 + lane]; }
    };
    prefetch(0);
    for (int st = 0; st < 132; ++st) {
        const int cid = scan_chunk(b, d, st);
        const bool emit = cid < NCHL;
        int tl = tid, zoff = 0;
        asm volatile("" : "+v"(tl), "+v"(zoff));
        const int tid = tl, lane = tid & 63, w = tid >> 6, cg = w & 3, kh = w >> 2, g4 = lane >> 4, l15 = lane & 15, c16 = tid & 63, srow0 = tid >> 6;
        MS_REGIONS(lds + zoff)
        __syncthreads();
        {
            lds_t xw_ = xct + srow0 * MS_KLD + c16 * 16;
            lds_t qw_ = qpt + srow0 * MS_QLD + c16 * 16;
#pragma unroll
            for (int i = 0; i < 8; ++i) {
                const unsigned xw[4] = {xcr[i].x, xcr[i].y, xcr[i].z, xcr[i].w};
                float q[8];
#pragma unroll
                for (int n = 0; n < 2; ++n)
#pragma unroll
                    for (int o = 0; o < 4; ++o)
                        q[4 * n + o] = __builtin_amdgcn_fdot2_f32_bf16(__builtin_bit_cast(bf16x2_t, xw[2 * n + 1]), Mp[n][o][1], __builtin_amdgcn_fdot2_f32_bf16(__builtin_bit_cast(bf16x2_t, xw[2 * n]), Mp[n][o][0], 0.f, false), false);
                u32x4 qv; qv.x = pk2(q[0], q[1]); qv.y = pk2(q[2], q[3]); qv.z = pk2(q[4], q[5]); qv.w = pk2(q[6], q[7]);
                *(LAS u32x4*)(xw_ + i * 8 * MS_KLD) = xcr[i];
                *(LAS u32x4*)(qw_ + i * 8 * MS_QLD) = qv;
            }
        }
        { const int s_ = tid >> 3, chunk = tid & 7;
          *(LAS u32x4*)(vt + s_ * 64 + chunk * 8) = vr;
          *(LAS u32x4*)(St + s_ * 64 + chunk * 8) = rr; }
        if (w == 0) {
            const float my_m = g_b + fmaxf(m_prev, g_pm);
            const float m_new = __shfl(my_m, 63), b_last = __shfl(g_b, 63);
            const int t = d ? 63 - lane : lane;
            sc_b[t] = g_b; sc_m[t] = my_m; sc_li[t] = g_li - g_b; sc_w[t] = __expf(b_last - g_b + g_li - m_new); sc_di[t] = __expf(g_b + m_prev - my_m);
            qn[lane] = 0.f;
            if (lane == 0) sc_misc[0] = __expf(b_last + m_prev - m_new);
            m_prev = m_new;
        }
        __syncthreads();
        if (emit) {
            const int t = tid & 63, part = tid >> 6;
            float a = 0.f;
            lds_t qr = qpt + t * MS_QLD + part * 128;
            const LAS float* nn = nvec + part * 64;
#pragma unroll
            for (int i = 0; i < 8; ++i) {
                const u32x4 qq = *(const LAS u32x4*)(qr + i * 16);
                const f32x4 n0 = *(const LAS f32x4*)(nn + 8 * i), n1 = *(const LAS f32x4*)(nn + 8 * i + 4);
                a += lo_bf(qq.x) * n0[0] + hi_bf(qq.x) * n0[1] + lo_bf(qq.y) * n0[2] + hi_bf(qq.y) * n0[3] + lo_bf(qq.z) * n1[0] + hi_bf(qq.z) * n1[1] + lo_bf(qq.w) * n1[2] + hi_bf(qq.w) * n1[3];
            }
            __hip_atomic_fetch_add((float*)(qn + t), a, __ATOMIC_RELAXED, __HIP_MEMORY_SCOPE_WORKGROUP);
        }
        {
            const int t = tid >> 3, s8 = (tid & 7) * 8;
            if (emit) {
                const u32x4 rw = *(const LAS u32x4*)(St + t * 64 + s8);
                const unsigned rwv[4] = {rw.x, rw.y, rw.z, rw.w};
                const float base = sc_b[t] - sc_m[t];
                const f32x4 e0 = *(const LAS f32x4*)(sc_li + s8), e1 = *(const LAS f32x4*)(sc_li + s8 + 4);
                float sv[8]; float rsum = 0.f;
#pragma unroll
                for (int j = 0; j < 8; ++j) {
                    const int s_ = s8 + j;
                    const float raw = (j & 1) ? hi_bf(rwv[j >> 1]) : lo_bf(rwv[j >> 1]);
                    const bool keep = d == 0 ? s_ <= t : s_ >= t;
                    const float ex = __expf(base + (j < 4 ? e0[j & 3] : e1[j & 3]));
                    sv[j] = keep ? raw * ex : 0.f;
                    rsum += sv[j];
                }
                u32x4 o; o.x = pk2(sv[0], sv[1]); o.y = pk2(sv[2], sv[3]); o.z = pk2(sv[4], sv[5]); o.w = pk2(sv[6], sv[7]);
                *(LAS u32x4*)(St + t * 64 + s8) = o;
                rsum += __shfl_xor(rsum, 1); rsum += __shfl_xor(rsum, 2); rsum += __shfl_xor(rsum, 4);
                if ((tid & 7) == 0) sc_rs[t] = rsum;
            }
            {
                const u32x4 vv = *(const LAS u32x4*)(vt + t * 64 + s8);
                const float ww = sc_w[t];
                u32x4 o; o.x = pk2(lo_bf(vv.x) * ww, hi_bf(vv.x) * ww); o.y = pk2(lo_bf(vv.y) * ww, hi_bf(vv.y) * ww); o.z = pk2(lo_bf(vv.z) * ww, hi_bf(vv.z) * ww); o.w = pk2(lo_bf(vv.w) * ww, hi_bf(vv.w) * ww);
                *(LAS u32x4*)(vwt + t * 64 + s8) = o;
            }
        }
        __syncthreads();
        f32x4 acc2[4];
#pragma unroll
        for (int tt = 0; tt < 4; ++tt) acc2[tt] = (f32x4){0.f, 0.f, 0.f, 0.f};
        if (emit) {
            lds_t qa = qpt + l15 * MS_QLD + (kh * 256 + 4 * g4) * 2;
            u32x2 qb[2][4][2];
#pragma unroll
            for (int tt = 0; tt < 4; ++tt) { qb[0][tt][0] = *(const LAS u32x2*)(qa + tt * 16 * MS_QLD); qb[0][tt][1] = *(const LAS u32x2*)(qa + tt * 16 * MS_QLD + 32); }
#pragma unroll
            for (int m = 0; m < 8; ++m) {
                if (m + 1 < 8) {
#pragma unroll
                    for (int tt = 0; tt < 4; ++tt) { qb[(m + 1) & 1][tt][0] = *(const LAS u32x2*)(qa + tt * 16 * MS_QLD + (m + 1) * 64); qb[(m + 1) & 1][tt][1] = *(const LAS u32x2*)(qa + tt * 16 * MS_QLD + (m + 1) * 64 + 32); }
                }
                u32x4 cb; cb.x = pk2(C[2 * m][0], C[2 * m][1]); cb.y = pk2(C[2 * m][2], C[2 * m][3]); cb.z = pk2(C[2 * m + 1][0], C[2 * m + 1][1]); cb.w = pk2(C[2 * m + 1][2], C[2 * m + 1][3]);
                const bf16x8 cf = __builtin_bit_cast(bf16x8, cb);
#pragma unroll
                for (int tt = 0; tt < 4; ++tt) {
                    u32x4 av; av.x = qb[m & 1][tt][0].x; av.y = qb[m & 1][tt][0].y; av.z = qb[m & 1][tt][1].x; av.w = qb[m & 1][tt][1].y;
                    acc2[tt] = mfma16(cf, __builtin_bit_cast(bf16x8, av), acc2[tt]);
                }
            }
            const bf16x8 vf = frag_tr(vt, 64, kh * 32, cg * 16, lane);
#pragma unroll
            for (int tt = 0; tt < 4; ++tt) {
                acc2[tt] = acc2[tt] * sc_di[tt * 16 + l15];
                acc2[tt] = mfma16(vf, frag_row(St, 64, tt * 16, kh * 32, lane), acc2[tt]);
            }
        }
        if (st + 1 < 132) prefetch(st + 1);
        {
            const float gd = sc_misc[0];
            bf16x8 vb[2], wf[2];
#pragma unroll
            for (int ks = 0; ks < 2; ++ks) {
                vb[ks] = frag_tr(vwt, 64, ks * 32, cg * 16, lane);
                const f32x4 w0 = *(const LAS f32x4*)(sc_w + ks * 32 + 8 * g4), w1 = *(const LAS f32x4*)(sc_w + ks * 32 + 8 * g4 + 4);
                u32x4 wp; wp.x = pk2(w0[0], w0[1]); wp.y = pk2(w0[2], w0[3]); wp.z = pk2(w1[0], w1[1]); wp.w = pk2(w1[2], w1[3]);
                if (l15 != 0) wp = (u32x4){0u, 0u, 0u, 0u};
                wf[ks] = __builtin_bit_cast(bf16x8, wp);
            }
#pragma unroll
            for (int j = 0; j < 4; ++j) Nacc[j] = Nacc[j] * gd;
            lds_t ka = xct + (8 * g4 + (l15 >> 2)) * MS_KLD + (kh * 256 + 4 * (l15 & 3)) * 2;
            const int cg_s = __builtin_amdgcn_readfirstlane(cg);
            s16x4 kb[2][2][2];
#pragma unroll
            for (int ks = 0; ks < 2; ++ks) {
                kb[0][ks][0] = __builtin_amdgcn_ds_read_tr16_b64_v4i16((LAS s16x4*)(ka + ks * 32 * MS_KLD));
                kb[0][ks][1] = __builtin_amdgcn_ds_read_tr16_b64_v4i16((LAS s16x4*)(ka + ks * 32 * MS_KLD + 4 * MS_KLD));
            }
#pragma unroll
            for (int i = 0; i < 16; ++i) {
                if (i + 1 < 16) {
#pragma unroll
                    for (int ks = 0; ks < 2; ++ks) {
                        kb[(i + 1) & 1][ks][0] = __builtin_amdgcn_ds_read_tr16_b64_v4i16((LAS s16x4*)(ka + ks * 32 * MS_KLD + (i + 1) * 32));
                        kb[(i + 1) & 1][ks][1] = __builtin_amdgcn_ds_read_tr16_b64_v4i16((LAS s16x4*)(ka + ks * 32 * MS_KLD + 4 * MS_KLD + (i + 1) * 32));
                    }
                }
                C[i] = C[i] * gd;
                const bool own = ((i >> 1) & 3) == cg_s;
#pragma unroll
                for (int ks = 0; ks < 2; ++ks) {
                    const bf16x8 kf = __builtin_shufflevector(kb[i & 1][ks][0], kb[i & 1][ks][1], 0, 1, 2, 3, 4, 5, 6, 7);
                    C[i] = mfma16(kf, vb[ks], C[i]);
                    if (own) Nacc[(i >> 3) * 2 + (i & 1)] = mfma16(kf, wf[ks], Nacc[(i >> 3) * 2 + (i & 1)]);
                }
            }
            if (l15 == 0) {
#pragma unroll
                for (int j = 0; j < 4; ++j) *(LAS f32x4*)(nvec + kh * 256 + (2 * cg + (j & 1) + 8 * (j >> 1)) * 16 + 4 * g4) = Nacc[j];
            }
        }
        __syncthreads();
        if (emit && kh == 1) {
#pragma unroll
            for (int tt = 0; tt < 4; ++tt) *(LAS f32x4*)(red + ((cg * 4 + tt) * 64 + lane) * 4) = acc2[tt];
        }
        __syncthreads();
        if (emit && kh == 0) {
#pragma unroll
            for (int tt = 0; tt < 4; ++tt) {
                const int t = tt * 16 + l15;
                const f32x4 o = acc2[tt] + *(const LAS f32x4*)(red + ((cg * 4 + tt) * 64 + lane) * 4);
                const float dn = fmaxf(fabsf(sc_di[t] * qn[t] + sc_rs[t]), __expf(-sc_m[t]));
                store_bf16x4(H + (size_t)(cid * 64 + t) * 2048 + h * 512 + sl * 64 + cg * 16 + 4 * g4, o * (1.f / dn));
            }
        }
    }
}

DI void phase_merge(PP p) {
    const int tid = get_tid(), lane = tid & 63;
    const bf16_t* HF = (const bf16_t*)p->out;
    bf16_t* HB = (bf16_t*)(p->ws + OFF_ARENA + A_HB);
    const bf16_t* XC = (const bf16_t*)(p->ws + OFF_ARENA + A_XC);
    const bf16_t* Z = (const bf16_t*)(p->ws + OFF_ARENA + A_XM);
    const int gw = get_bid() * 8 + (tid >> 6), nw = gridDim.x * 8;
    for (int r = gw; r < NLAT; r += nw) {
#pragma unroll
        for (int hh = 0; hh < 4; ++hh) {
            const size_t o = (size_t)r * 2048 + hh * 512 + lane * 8;
            const u32x4 a = *(const u32x4*)(HF + o), b = *(const u32x4*)(HB + o), xq = *(const u32x4*)(XC + o), zq = *(const u32x4*)(Z + o);
            const unsigned aw[4] = {a.x, a.y, a.z, a.w}, bw[4] = {b.x, b.y, b.z, b.w}, xw[4] = {xq.x, xq.y, xq.z, xq.w}, zw[4] = {zq.x, zq.y, zq.z, zq.w};
            float hv[8]; float sum = 0.f;
#pragma unroll
            for (int j = 0; j < 4; ++j) { hv[2 * j] = lo_bf(aw[j]) + lo_bf(bw[j]); hv[2 * j + 1] = hi_bf(aw[j]) + hi_bf(bw[j]); sum += hv[2 * j] + hv[2 * j + 1]; }
            const float mean = wave_sum(sum) * (1.f / 512.f);
            float sq = 0.f;
#pragma unroll
            for (int j = 0; j < 8; ++j) { hv[j] -= mean; sq += hv[j] * hv[j]; }
            const float rs = rsqrtf(wave_sum(sq) * (1.f / 512.f) + EPS);
            float ov[8];
#pragma unroll
            for (int j = 0; j < 8; ++j) {
                const int c = hh * 512 + lane * 8 + j;
                const float xcv = (j & 1) ? hi_bf(xw[j >> 1]) : lo_bf(xw[j >> 1]);
                const float zv = (j & 1) ? hi_bf(zw[j >> 1]) : lo_bf(zw[j >> 1]);
                ov[j] = (hv[j] * rs * p->m_norm_g[c] + p->m_skip[c] * xcv) * siluf_(zv);
            }
            u32x4 v; v.x = pk2(ov[0], ov[1]); v.y = pk2(ov[2], ov[3]); v.z = pk2(ov[4], ov[5]); v.w = pk2(ov[6], ov[7]);
            *(u32x4*)(HB + o) = v;
        }
    }
}

DI void phase_downproj(PP p, lds_t lds) {
    const bf16_t* A = (const bf16_t*)(p->ws + OFF_ARENA + A_HB);
    float* X = (float*)(p->ws + OFF_ARENA + A_X);
    constexpr int NM = NLAT / 256, NN = 4;
    for_units_xcd(1, NM, NN, 8, 4, [&](int, int pm, int pn) {
        const float* g1 = mods_ptr(p, 1, pm >> 5, 2);
        gemm_unit<256, 64>(lds, 2048, 1024,
            [&](int r) { return A + (size_t)(pm * 256 + r) * 2048; },
            [&](int j) -> const float* { return p->m_w_down + pn * 256 + j; },
            [&](const f32x4 (&acc)[8][4], int wr, int wc, int lane) {
                epi_each<4>(acc, wr, wc, lane, [&](int r, int c, f32x4 v) {
                    const int col = pn * 256 + c;
                    float* xp = X + (size_t)(pm * 256 + r) * 1024 + col;
                    const f32x4 g = *(const f32x4*)(g1 + col);
                    *(f32x4*)xp = *(const f32x4*)xp + g * v;
                });
            });
    });
}

DI void phase_dbg_final(PP p, int mode) {
    const int tid = get_tid(), lane = tid & 63;
    const int gw = get_bid() * 8 + (tid >> 6), nw = gridDim.x * 8;
    if (mode == 4) {
        const int* rid = (const int*)(p->ws + OFF_ARENA + A_ROWID);
        for (int r = gw; r < NLAT; r += nw)
            for (int c = lane; c < 1024; c += 64) p->out[(size_t)r * 1024 + c] = (float)rid[(size_t)r * 16 + (c & 15)];
        return;
    }
    if (mode == 7) {
        const bf16_t* y = (const bf16_t*)(p->ws + OFF_ARENA + A_Y);
        for (int r = gw; r < NLAT; r += nw)
            for (int c = lane; c < 1024; c += 64) { const float v = bf2f(y[(size_t)r * 1024 + c]); p->out[(size_t)r * 1024 + c] = (v == v && fabsf(v) < 1e30f) ? 0.f : 1000.f; }
        return;
    }
    if (mode >= 2) {
        const bf16_t* src = mode == 2 ? (const bf16_t*)(p->ws + OFF_ARENA + A_P) : mode == 5 ? (const bf16_t*)(p->ws + OFF_ARENA + A_HDN) : mode == 6 ? (const bf16_t*)(p->ws + OFF_ARENA + A_Y) : (const bf16_t*)(p->ws + OFF_ACT);
        const int ld = mode == 2 ? ABIN : 1024;
        for (int r = gw; r < NLAT; r += nw)
            for (int c = lane; c < 1024; c += 64) p->out[(size_t)r * 1024 + c] = bf2f(src[(size_t)r * ld + (mode == 2 ? c + DBG_COL0 : c)]);
        return;
    }
    const float* X = mode ? (const float*)(p->ws + OFF_ARENA + A_X) : p->x;
    for (int r = gw; r < NLAT; r += nw) {
        f32x4 v[4];
        row_load_f32(X + (size_t)r * 1024, v, lane);
        const float rs = rsqrtf(row_sumsq(v) * (1.f / 1024.f) + EPS);
#pragma unroll
        for (int i = 0; i < 4; ++i) { const f32x4 g = *(const f32x4*)(p->final_g + 4 * lane + 256 * i); *(f32x4*)(p->out + (size_t)r * 1024 + 4 * lane + 256 * i) = v[i] * rs * g; }
    }
}

DI void grid_barrier(cg::grid_group& grid, PP p, unsigned& nbar) {
    asm volatile("s_waitcnt vmcnt(0) lgkmcnt(0)" ::: "memory");
    unsigned* ctr = (unsigned*)(p->ws + OFF_BAR);
    if (nbar == 0) {
        if (blockIdx.x == 0 && threadIdx.x == 0) __hip_atomic_store(ctr, 0u, __ATOMIC_RELAXED, __HIP_MEMORY_SCOPE_AGENT);
        asm volatile("s_waitcnt vmcnt(0)" ::: "memory");
        grid.sync();
        __builtin_amdgcn_fence(__ATOMIC_ACQUIRE, "agent");
        asm volatile("s_waitcnt vmcnt(0)" ::: "memory");
    } else {
        __syncthreads();
        if (threadIdx.x == 0) {
            __builtin_amdgcn_fence(__ATOMIC_RELEASE, "agent");
            asm volatile("s_waitcnt vmcnt(0)" ::: "memory");
            __hip_atomic_fetch_add(ctr, 1u, __ATOMIC_RELAXED, __HIP_MEMORY_SCOPE_AGENT);
            const unsigned target = nbar * gridDim.x;
            while (__hip_atomic_load(ctr, __ATOMIC_RELAXED, __HIP_MEMORY_SCOPE_AGENT) < target) __builtin_amdgcn_s_sleep(1);
            __builtin_amdgcn_fence(__ATOMIC_ACQUIRE, "agent");
            asm volatile("s_waitcnt vmcnt(0)" ::: "memory");
        }
        __syncthreads();
    }
    ++nbar;
}
#define RUN_PHASE(K, CALL) if (ph_lo <= (K) && (K) < ph_hi && ((K) <= DBG_STOP)) { PP p = kp; asm volatile("" : "+s"(p)); CALL; if ((DUP_MASK >> (K)) & 1) { grid_barrier(grid, p, nbar); asm volatile("" : "+s"(p)); CALL; } if ((K) + 1 < ph_hi) { grid_barrier(grid, p, nbar); if (EXTRA_BARRIERS) grid_barrier(grid, p, nbar); } }
__global__ void __launch_bounds__(NTHREADS) mega(Params p_in) {
    extern __shared__ __attribute__((aligned(16))) unsigned char lds_raw[];
    lds_t lds = (lds_t)lds_raw;
    cg::grid_group grid = cg::this_grid();
    PP kp = (PP)__builtin_amdgcn_kernarg_segment_ptr();
    const int ph_lo = kp->ph_lo, ph_hi = kp->ph_hi;
    unsigned nbar = 0;
    RUN_PHASE(0, phase_mods(p, lds))
    RUN_PHASE(1, phase_norm(p, 0, NTOK, [&](int r) { return r < NLAT ? p->x + (size_t)r * 1024 : p->ctx + (size_t)(r - NLAT) * 1024; }))
    RUN_PHASE(2, phase_inproj(p, lds))
    RUN_PHASE(3, phase_g1(p, lds))
    RUN_PHASE(4, phase_scan0(p))
    RUN_PHASE(5, phase_g3(p, lds))
    RUN_PHASE(6, phase_outproj0(p, lds))
    RUN_PHASE(7, phase_router(p, lds, 0))
    RUN_PHASE(8, phase_topk(p, lds, 0))
    RUN_PHASE(9, phase_moe_up(p, lds, 0))
    RUN_PHASE(10, phase_moe_down(p, lds, 0))
    RUN_PHASE(11, phase_combine(p, 0))
    RUN_PHASE(12, phase_upproj(p, lds, 0))
    RUN_PHASE(13, phase_mfeat(p, lds))
    RUN_PHASE(14, phase_mscan(p, lds))
    RUN_PHASE(15, phase_norm(p, 1, NLAT, [&](int r) { return (const float*)(p->ws + OFF_ARENA + A_X) + (size_t)r * 1024; }))
    RUN_PHASE(16, phase_upproj(p, lds, 1))
    RUN_PHASE(17, phase_merge(p))
    RUN_PHASE(18, phase_downproj(p, lds))
    RUN_PHASE(19, phase_router(p, lds, 1))
    RUN_PHASE(20, phase_topk(p, lds, 1))
    RUN_PHASE(21, phase_moe_up(p, lds, 1))
    RUN_PHASE(22, phase_moe_down(p, lds, 1))
    RUN_PHASE(23, phase_combine(p, 1))
    if (DBG_STOP < 23 && DBG_STOP + 1 < ph_hi) { PP p = kp; asm volatile("" : "+s"(p)); phase_dbg_final(p, DBG_MODE); }
}

extern "C" void kernel_launch(void* const* d_in, const int* in_sizes, int n_in, void* d_out, int out_size, void* d_ws, size_t ws_size, hipStream_t stream) {
    static int grid = 0;
    if (grid == 0) {
        int dev = 0, cus = 0, per_cu = 0;
        hipGetDevice(&dev);
        hipDeviceGetAttribute(&cus, hipDeviceAttributeMultiprocessorCount, dev);
        hipFuncSetAttribute((const void*)mega, hipFuncAttributeMaxDynamicSharedMemorySize, LDS_BYTES);
        hipOccupancyMaxActiveBlocksPerMultiprocessor(&per_cu, (const void*)mega, NTHREADS, LDS_BYTES);
        if (per_cu < 1) { fprintf(stderr, "occupancy query says %d blocks/CU\n", per_cu); per_cu = 1; }
        grid = cus;
        if (ws_size < WS_NEED) { fprintf(stderr, "workspace too small: %zu < %zu\n", ws_size, (size_t)WS_NEED); grid = -1; }
    }
    if (grid < 0) return;
    Params hp{};
    const float** pp = (const float**)&hp;
    for (int i = 0; i < 36; ++i) pp[i] = (const float*)d_in[i];
    hp.out = (float*)d_out; hp.ws = (char*)d_ws; hp.ph_lo = 0; hp.ph_hi = DBG_STOP < 23 ? DBG_STOP + 2 : 24;
    void* args[] = {&hp};
    hipError_t e = hipLaunchCooperativeKernel((const void*)mega, dim3(grid), dim3(NTHREADS), args, LDS_BYTES, stream);
    if (e != hipSuccess) fprintf(stderr, "cooperative launch failed: %s\n", hipGetErrorString(e));
}
```

```cpp
#include <hip/hip_runtime.h>
#include <hip/hip_cooperative_groups.h>
#include <cstdio>
#include <cstdint>
namespace cg = cooperative_groups;

#define LAS __attribute__((address_space(3)))
#define DI __device__ __forceinline__
typedef unsigned short bf16_t;
typedef short bf16x8 __attribute__((ext_vector_type(8)));
typedef short s16x4 __attribute__((ext_vector_type(4)));
typedef float f32x4 __attribute__((ext_vector_type(4)));
typedef float f32x2 __attribute__((ext_vector_type(2)));
typedef unsigned u32x4 __attribute__((ext_vector_type(4)));
typedef unsigned u32x2 __attribute__((ext_vector_type(2)));
typedef LAS char* lds_t;

constexpr int D = 1024, NBATCH = 4, SEQ = 8192, CTXL = 256;
constexpr int NLAT = NBATCH * SEQ;
constexpr int NCTX = NBATCH * CTXL;
constexpr int NTOK = NLAT + NCTX;
constexpr int NCH = NTOK / 64;
constexpr int NCHL = NLAT / 64;
constexpr int ABIN = 2592;
constexpr int PC_Q = 0, PC_K = 256, PC_V = 512, PC_G = 1024, PC_LRF = 1536, PC_LRB = 1552, PC_RGG = 1568, PC_RGX = 2080;
constexpr float EPS = 1e-6f;
constexpr int NTHREADS = 512;
constexpr int LDS_BYTES = 160 * 1024;
#define DBG_MODE 1
#ifndef DUP_MASK
#define DUP_MASK 0
#endif
#ifndef GEMM_PROBE
#define GEMM_PROBE -1
#endif
#ifndef EXTRA_BARRIERS
#define EXTRA_BARRIERS 0
#endif
#define DBG_STOP 23
#define DBG_COL0 0

constexpr size_t OFF_MODS = 0;
constexpr size_t OFF_GCAT = 245760;
constexpr size_t OFF_MMAT = 376832;
constexpr size_t OFF_BAR = 409600;
constexpr size_t OFF_ACT = 1u << 20;
constexpr size_t ACT_BYTES = (size_t)NTOK * 1024 * 2;
constexpr size_t OFF_ARENA = OFF_ACT + ACT_BYTES;
constexpr size_t A_P = 0;
constexpr size_t A_U = A_P + (size_t)NTOK * ABIN * 2;
constexpr size_t A_LA = A_U + (size_t)NCH * 2 * 4 * 8192 * 4;
constexpr size_t A_UU = A_LA + (size_t)NTOK * 2 * 512 * 4;
constexpr size_t A_DEC = A_UU + (size_t)NTOK * 2 * 512 * 2;
constexpr size_t A_AGGA = A_DEC + (size_t)NCH * 2 * 256 * 4;
constexpr size_t A_AGGH = A_AGGA + (size_t)NCH * 2 * 512 * 4;
constexpr size_t A_L0_END = A_AGGH + (size_t)NCH * 2 * 512 * 4;
constexpr size_t A_X = 0;
constexpr size_t A_PT = A_X + (size_t)NTOK * 1024 * 4;
constexpr size_t A_PE = A_PT + (size_t)NTOK * 16 * 4;
constexpr size_t A_ROWID = A_PE + (size_t)NTOK * 16 * 4;
constexpr size_t A_ROWTOK = A_ROWID + (size_t)NTOK * 16 * 4;
constexpr size_t A_HDN = A_ROWTOK + (size_t)16 * 4352 * 4;
constexpr size_t A_Y = A_HDN + (size_t)16 * 4352 * 1024 * 2;
constexpr size_t A_MOE0_END = A_Y + (size_t)16 * 4352 * 1024 * 2;
constexpr size_t A_XM = A_X + (size_t)NTOK * 1024 * 4;
constexpr size_t A_XC = A_XM + (size_t)NTOK * 2048 * 2;
constexpr size_t A_HB = A_XC + (size_t)NTOK * 2048 * 2;
constexpr size_t A_L1_END = A_HB + (size_t)NLAT * 2048 * 2;
constexpr size_t ACT_RAWS = 0;
constexpr size_t ACT_GP = ACT_RAWS + (size_t)NCH * 4 * 4096 * 2;
constexpr size_t ACT_CTXV = ACT_GP + (size_t)NTOK * 64 * 4;
constexpr size_t WS_NEED0 = OFF_ARENA + (A_L1_END > A_L0_END ? A_L1_END : A_L0_END);
constexpr size_t OFF_WUPT = WS_NEED0;
constexpr size_t OFF_WDNT = OFF_WUPT + (size_t)4096 * 1024 * 2;
constexpr size_t WS_NEED = OFF_WDNT + (size_t)1024 * 2048 * 2;
constexpr size_t DO_WIN = 0;
constexpr size_t DO_WOUT = (size_t)2816 * 1024 * 2;
constexpr size_t DO_EXP = 8u << 20;
constexpr size_t EXP_STRIDE = (size_t)3072 * 1024 * 2;
constexpr int GUG = 32;
static_assert(DO_EXP + 16 * EXP_STRIDE <= (size_t)NLAT * 1024 * 4, "d_out staging");
static_assert(A_MOE0_END < A_L1_END, "arena");
static_assert(ACT_CTXV + (size_t)NCTX * 2048 * 2 <= ACT_BYTES, "act region");

struct Params {
    const float *x, *c, *ctx, *c_ctx, *mod_w, *mod_b, *norm1_g, *norm2_g, *ab_w_in, *gla_wa2, *gla_ba, *gla_norm_g;
    const float *rg_conv_w, *rg_conv_b, *rg_wr, *rg_br, *rg_wi, *rg_bi, *rg_lambda, *ab_w_out, *m_w_up, *m_conv_w, *m_conv_b;
    const float *m_wq, *m_wk, *m_wv, *m_w_gates, *m_b_gates, *m_skip, *m_norm_g, *m_w_down, *router_w, *exp_w_gate, *exp_w_up, *exp_w_down, *final_g;
    float* out;
    char* ws;
    int ph_lo, ph_hi;
};

typedef const Params __attribute__((address_space(4)))* PP;

DI int get_tid() { int t = threadIdx.x; asm volatile("" : "+v"(t)); return t; }
DI int get_bid() { int b = blockIdx.x; asm volatile("" : "+s"(b)); return b; }
DI float bf2f(bf16_t h) { return __uint_as_float((unsigned)h << 16); }
DI bf16_t f2bf(float x) { unsigned u = __float_as_uint(x); u += 0x7fffu + ((u >> 16) & 1u); return (bf16_t)(u >> 16); }
typedef __bf16 bf16x2_t __attribute__((ext_vector_type(2)));
DI unsigned pk2n(float lo, float hi) { const f32x2 v = {lo, hi}; return __builtin_bit_cast(unsigned, __builtin_convertvector(v, bf16x2_t)); }
DI unsigned pk2(float lo, float hi) { return pk2n(lo, hi); }
DI float lo_bf(unsigned u) { return __uint_as_float(u << 16); }
DI float hi_bf(unsigned u) { return __uint_as_float(u & 0xffff0000u); }
DI float sigmoidf_(float x) { return 1.f / (1.f + __expf(-x)); }
DI float siluf_(float x) { return x / (1.f + __expf(-x)); }
DI float log_sigmoidf_(float z) { return fminf(z, 0.f) - log1pf(__expf(-fabsf(z))); }
DI float softplusf_(float z) { return fmaxf(z, 0.f) + log1pf(__expf(-fabsf(z))); }
DI float gelu_tanh(float x) { const float u = 0.7978845608028654f * (x + 0.044715f * x * x * x); return 0.5f * x * (1.f + tanhf(u)); }
DI float wave_sum(float v) {
#pragma unroll
    for (int o = 32; o > 0; o >>= 1) v += __shfl_xor(v, o);
    return v;
}
DI f32x4 mfma16(bf16x8 a, bf16x8 b, f32x4 c) { return __builtin_amdgcn_mfma_f32_16x16x32_bf16(a, b, c, 0, 0, 0); }

DI bf16x8 frag_row(const LAS bf16_t* tile, int ld, int r0, int k0, int lane) {
    return *(const LAS bf16x8*)(tile + (r0 + (lane & 15)) * ld + k0 + 8 * (lane >> 4));
}
DI bf16x8 frag_tr(const LAS bf16_t* tile, int ld, int k0, int c0, int lane) {
    const int g = lane >> 4, i = lane & 15, q = i >> 2, p = i & 3;
    const LAS bf16_t* base = tile + (k0 + 8 * g + q) * ld + c0 + 4 * p;
    const s16x4 lo = __builtin_amdgcn_ds_read_tr16_b64_v4i16((LAS s16x4*)base);
    const s16x4 hi = __builtin_amdgcn_ds_read_tr16_b64_v4i16((LAS s16x4*)(base + 4 * ld));
    return __builtin_shufflevector(lo, hi, 0, 1, 2, 3, 4, 5, 6, 7);
}
DI const float* mods_ptr(PP p, int layer, int s, int which) { return (const float*)(p->ws + OFF_MODS) + ((size_t)(layer * 5 + s) * 6 + which) * 1024; }
DI int row_set(int r) { return r < NLAT ? (r >> 13) : 4; }

template <int BN, int BK, int PROBE = 0, class ARow, class BCol, class Epi>
DI void gemm_unit(lds_t lds, int K, int ldb, ARow arow, BCol bcol, Epi epi) {
    constexpr int NT = BN / 64;
    constexpr int LDA = BK + 8, LDB = BN + 16;
    constexpr int A_BYTES = 256 * LDA * 2, B_BYTES = BK * LDB * 2;
    static_assert(2 * A_BYTES + 2 * B_BYTES <= LDS_BYTES, "gemm lds");
    const int tid = get_tid(), lane = tid & 63, w = tid >> 6, wr = w >> 2, wc = w & 3;
    constexpr int ACH = BK / 8, ARP = NTHREADS / ACH, AP = 256 / ARP;
    const int achunk = tid % ACH, arow0 = tid / ACH;
    const bf16_t* ap[AP];
#pragma unroll
    for (int q = 0; q < AP; ++q) ap[q] = arow(arow0 + ARP * q);
    constexpr int CG = BN / 8, KR = NTHREADS / CG, BP = BK / KR;
    const int bc8 = tid % CG, bk0 = tid / CG;
    const float* bp = bcol(bc8 * 8);
    u32x4 areg[AP];
    f32x4 breg[BP][2];
    auto gload = [&](int kt) {
        const int k0 = kt * BK;
#pragma unroll
        for (int q = 0; q < AP; ++q) areg[q] = ap[q] ? *(const u32x4*)(ap[q] + k0 + achunk * 8) : (u32x4){0u, 0u, 0u, 0u};
#pragma unroll
        for (int q = 0; q < BP; ++q) {
            if (bp) { const float* s = bp + (size_t)(k0 + bk0 + KR * q) * ldb; breg[q][0] = *(const f32x4*)s; breg[q][1] = *(const f32x4*)(s + 4); }
            else { breg[q][0] = (f32x4){0.f, 0.f, 0.f, 0.f}; breg[q][1] = breg[q][0]; }
        }
    };
    auto lstore = [&](int buf) {
        LAS bf16_t* As = (LAS bf16_t*)(lds + buf * A_BYTES);
        LAS bf16_t* Bs = (LAS bf16_t*)(lds + 2 * A_BYTES + buf * B_BYTES);
#pragma unroll
        for (int q = 0; q < AP; ++q) *(LAS u32x4*)(As + (arow0 + ARP * q) * LDA + achunk * 8) = areg[q];
#pragma unroll
        for (int q = 0; q < BP; ++q) {
            u32x4 v; v.x = pk2(breg[q][0][0], breg[q][0][1]); v.y = pk2(breg[q][0][2], breg[q][0][3]); v.z = pk2(breg[q][1][0], breg[q][1][1]); v.w = pk2(breg[q][1][2], breg[q][1][3]);
            *(LAS u32x4*)(Bs + (bk0 + KR * q) * LDB + bc8 * 8) = v;
        }
    };
    f32x4 acc[8][NT];
#pragma unroll
    for (int mi = 0; mi < 8; ++mi)
#pragma unroll
        for (int ni = 0; ni < NT; ++ni) acc[mi][ni] = (f32x4){0.f, 0.f, 0.f, 0.f};
    const int nk = K / BK;
    gload(0);
    for (int kt = 0; kt < nk; ++kt) {
        lstore(kt & 1);
        __syncthreads();
        if (kt + 1 < nk && PROBE != 1) gload(kt + 1);
        if (PROBE == 2) continue;
        const LAS bf16_t* As = (const LAS bf16_t*)(lds + (kt & 1) * A_BYTES);
        const LAS bf16_t* Bs = (const LAS bf16_t*)(lds + 2 * A_BYTES + (kt & 1) * B_BYTES);
#pragma unroll
        for (int ks = 0; ks < BK / 32; ++ks) {
            bf16x8 wb[NT];
#pragma unroll
            for (int ni = 0; ni < NT; ++ni) wb[ni] = frag_tr(Bs, LDB, ks * 32, wc * (BN / 4) + ni * 16, lane);
#pragma unroll
            for (int mi = 0; mi < 8; ++mi) {
                const bf16x8 xa = frag_row(As, LDA, wr * 128 + mi * 16, ks * 32, lane);
#pragma unroll
                for (int ni = 0; ni < NT; ++ni) acc[mi][ni] = mfma16(wb[ni], xa, acc[mi][ni]);
            }
        }
    }
    epi(acc, wr, wc, lane);
    __syncthreads();
}


template <int BK, class ARow, class BRow, class Epi>
DI void gemm_unit_t(lds_t lds, int K, ARow arow, BRow brow, Epi epi) {
    constexpr int NT = 4;
    constexpr int LD = BK + 8;
    constexpr int T_BYTES = 256 * LD * 2;
    static_assert(4 * T_BYTES <= LDS_BYTES, "gemm lds");
    const int tid = get_tid(), lane = tid & 63, w = tid >> 6, wr = w >> 2, wc = w & 3;
    constexpr int CH = BK / 8, RP = NTHREADS / CH, NP = 256 / RP;
    const int chunk = tid % CH, row0 = tid / CH;
    const bf16_t* ap[NP]; const bf16_t* bp[NP];
#pragma unroll
    for (int q = 0; q < NP; ++q) { ap[q] = arow(row0 + RP * q); bp[q] = brow(row0 + RP * q); }
    u32x4 areg[NP], breg[NP];
    auto gload = [&](int kt) {
        const int k0 = kt * BK;
#pragma unroll
        for (int q = 0; q < NP; ++q) {
            areg[q] = ap[q] ? *(const u32x4*)(ap[q] + k0 + chunk * 8) : (u32x4){0u, 0u, 0u, 0u};
            breg[q] = bp[q] ? *(const u32x4*)(bp[q] + k0 + chunk * 8) : (u32x4){0u, 0u, 0u, 0u};
        }
    };
    auto lstore = [&](int buf) {
        LAS bf16_t* As = (LAS bf16_t*)(lds + buf * 2 * T_BYTES);
        LAS bf16_t* Bs = (LAS bf16_t*)(lds + buf * 2 * T_BYTES + T_BYTES);
#pragma unroll
        for (int q = 0; q < NP; ++q) {
            *(LAS u32x4*)(As + (row0 + RP * q) * LD + chunk * 8) = areg[q];
            *(LAS u32x4*)(Bs + (row0 + RP * q) * LD + chunk * 8) = breg[q];
        }
    };
    f32x4 acc[8][NT];
#pragma unroll
    for (int mi = 0; mi < 8; ++mi)
#pragma unroll
        for (int ni = 0; ni < NT; ++ni) acc[mi][ni] = (f32x4){0.f, 0.f, 0.f, 0.f};
    const int nk = K / BK;
    gload(0);
    for (int kt = 0; kt < nk; ++kt) {
        lstore(kt & 1);
        __syncthreads();
        if (kt + 1 < nk) gload(kt + 1);
        const LAS bf16_t* As = (const LAS bf16_t*)(lds + (kt & 1) * 2 * T_BYTES);
        const LAS bf16_t* Bs = (const LAS bf16_t*)(lds + (kt & 1) * 2 * T_BYTES + T_BYTES);
#pragma unroll
        for (int ks = 0; ks < BK / 32; ++ks) {
            bf16x8 wb[NT], xa[8];
#pragma unroll
            for (int ni = 0; ni < NT; ++ni) wb[ni] = frag_row(Bs, LD, wc * 64 + ni * 16, ks * 32, lane);
#pragma unroll
            for (int mi = 0; mi < 8; ++mi) xa[mi] = frag_row(As, LD, wr * 128 + mi * 16, ks * 32, lane);
            __builtin_amdgcn_sched_barrier(0);
#pragma unroll
            for (int mi = 0; mi < 8; ++mi)
#pragma unroll
                for (int ni = 0; ni < NT; ++ni) acc[mi][ni] = mfma16(wb[ni], xa[mi], acc[mi][ni]);
        }
    }
    epi(acc, wr, wc, lane);
    __syncthreads();
}

template <class F>
DI void for_units_xcd(int NB, int NM, int NN, int TM, int TN, F f) {
    const int bid = get_bid();
    if (gridDim.x != 256) {
        for (int u = bid; u < NB * NM * NN; u += gridDim.x) f(u / (NM * NN), (u % (NM * NN)) % NM, (u % (NM * NN)) / NM);
        return;
    }
    const int xcd = bid & 7, slot = bid >> 3, tsz = TM * TN, per = 32 / tsz;
    const int nsm = (NM + TM - 1) / TM, nsn = (NN + TN - 1) / TN, ntot = NB * nsm * nsn;
    for (int j = 0;; ++j) {
        const int S = (j * 8 + xcd) * per + slot / tsz;
        if ((j * 8) * per >= ntot) break;
        if (S >= ntot) continue;
        const int within = slot % tsz, batch = S / (nsm * nsn), sl = S % (nsm * nsn);
        const int pm = (sl % nsm) * TM + within % TM, pn = (sl / nsm) * TN + within / TM;
        if (pm < NM && pn < NN) f(batch, pm, pn);
    }
}

template <int NT, class F>
DI void epi_each(const f32x4 (&acc)[8][NT], int wr, int wc, int lane, F f) {
#pragma unroll
    for (int mi = 0; mi < 8; ++mi)
#pragma unroll
        for (int ni = 0; ni < NT; ++ni) f(wr * 128 + mi * 16 + (lane & 15), wc * (NT * 16) + ni * 16 + 4 * (lane >> 4), acc[mi][ni]);
}
DI void store_bf16x4(bf16_t* dst, f32x4 v) { u32x2 o; o.x = pk2(v[0], v[1]); o.y = pk2(v[2], v[3]); *(u32x2*)dst = o; }

DI void row_load_f32(const float* src, f32x4 (&v)[4], int lane) {
#pragma unroll
    for (int i = 0; i < 4; ++i) v[i] = *(const f32x4*)(src + 4 * lane + 256 * i);
}
DI float row_sumsq(const f32x4 (&v)[4]) {
    float s = 0.f;
#pragma unroll
    for (int i = 0; i < 4; ++i) s += v[i][0] * v[i][0] + v[i][1] * v[i][1] + v[i][2] * v[i][2] + v[i][3] * v[i][3];
    return wave_sum(s);
}
DI void row_modulate(f32x4 (&v)[4], float rs, const float* g, const float* sc, const float* sh, int lane) {
#pragma unroll
    for (int i = 0; i < 4; ++i) {
        const int c = 4 * lane + 256 * i;
        const f32x4 gg = *(const f32x4*)(g + c), ss = *(const f32x4*)(sc + c), hh = *(const f32x4*)(sh + c);
#pragma unroll
        for (int j = 0; j < 4; ++j) v[i][j] = v[i][j] * rs * gg[j] * (1.f + ss[j]) + hh[j];
    }
}
DI void row_store_bf16(bf16_t* dst, const f32x4 (&v)[4], int lane) {
#pragma unroll
    for (int i = 0; i < 4; ++i) store_bf16x4(dst + 4 * lane + 256 * i, v[i]);
}


template <class RowMap>
DI void conv_tile(const float* W, int ldw, int k0, int n0, int nvalid, bf16_t* Wt, int ldt, RowMap rowmap, lds_t lds) {
    const int tid = get_tid();
    LAS float* t = (LAS float*)lds;
    {
        const int k = tid >> 3, c8 = (tid & 7) * 8;
        f32x4 a = {0.f, 0.f, 0.f, 0.f}, b = a;
        if (n0 + c8 < nvalid) { const float* src = W + (size_t)(k0 + k) * ldw + n0 + c8; a = *(const f32x4*)src; b = *(const f32x4*)(src + 4); }
#pragma unroll
        for (int j = 0; j < 4; ++j) { t[k * 65 + c8 + j] = a[j]; t[k * 65 + c8 + 4 + j] = b[j]; }
    }
    __syncthreads();
    {
        const int n = tid >> 3, k8 = (tid & 7) * 8;
        float v[8];
#pragma unroll
        for (int j = 0; j < 8; ++j) v[j] = t[(k8 + j) * 65 + n];
        u32x4 o; o.x = pk2(v[0], v[1]); o.y = pk2(v[2], v[3]); o.z = pk2(v[4], v[5]); o.w = pk2(v[6], v[7]);
        *(u32x4*)(Wt + (size_t)rowmap(n0 + n) * ldt + k0 + k8) = o;
    }
    __syncthreads();
}
DI int gu_row(int c, int up) { return (c / GUG) * (2 * GUG) + up * GUG + (c % GUG); }
DI void conv_expert_tile(PP p, int layer, int t, lds_t lds) {
    const int e = t / 768, r = t % 768, m = r >> 8, tt = r & 255, kt = tt & 15, nt = tt >> 4;
    bf16_t* base = (bf16_t*)((char*)p->out + DO_EXP + (size_t)e * EXP_STRIDE);
    const size_t woff = ((size_t)layer * 16 + e) * 1048576;
    if (m == 0) conv_tile(p->exp_w_gate + woff, 1024, kt * 64, nt * 64, 1024, base, 1024, [](int n) { return gu_row(n, 0); }, lds);
    else if (m == 1) conv_tile(p->exp_w_up + woff, 1024, kt * 64, nt * 64, 1024, base, 1024, [](int n) { return gu_row(n, 1); }, lds);
    else conv_tile(p->exp_w_down + woff, 1024, kt * 64, nt * 64, 1024, base + (size_t)2048 * 1024, 1024, [](int n) { return n; }, lds);
}
constexpr int NCONV_DENSE = 704 + 256 + 1024 + 512;
DI void conv_dense_tile(PP p, int t, lds_t lds) {
    auto id = [](int n) { return n; };
    if (t < 704) { const int kt = t & 15, nt = t >> 4; conv_tile(p->ab_w_in, ABIN, kt * 64, nt * 64, ABIN, (bf16_t*)((char*)p->out + DO_WIN), 1024, id, lds); return; }
    t -= 704;
    if (t < 256) { const int kt = t & 15, nt = t >> 4; conv_tile(p->ab_w_out, 1024, kt * 64, nt * 64, 1024, (bf16_t*)((char*)p->out + DO_WOUT), 1024, id, lds); return; }
    t -= 256;
    if (t < 1024) { const int kt = t & 15, nt = t >> 4; conv_tile(p->m_w_up, 4096, kt * 64, nt * 64, 4096, (bf16_t*)(p->ws + OFF_WUPT), 1024, id, lds); return; }
    t -= 1024;
    { const int kt = t & 31, nt = t >> 5; conv_tile(p->m_w_down, 1024, kt * 64, nt * 64, 1024, (bf16_t*)(p->ws + OFF_WDNT), 2048, id, lds); }
}

DI void phase_mods(PP p, lds_t lds) {
    const int tid = get_tid();
    LAS float* sil = (LAS float*)lds;
    LAS float* red = sil + 5 * 1024;
    for (int u = get_bid(); u < 192 + 32; u += gridDim.x) {
        if (u < 192) {
            const int layer = u / 96, c0 = (u % 96) * 64;
            for (int i = tid; i < 5 * 1024; i += NTHREADS) { const int s = i >> 10, k = i & 1023; const float cv = s < 4 ? p->c[s * 1024 + k] : p->c_ctx[k]; sil[i] = siluf_(cv); }
            __syncthreads();
            const int col = tid & 63, kp = tid >> 6;
            float a[5] = {0.f, 0.f, 0.f, 0.f, 0.f};
            const float* wp = p->mod_w + (size_t)layer * 1024 * 6144 + c0 + col;
            for (int k = kp * 128; k < kp * 128 + 128; ++k) {
                const float wv = wp[(size_t)k * 6144];
#pragma unroll
                for (int s = 0; s < 5; ++s) a[s] += sil[s * 1024 + k] * wv;
            }
#pragma unroll
            for (int s = 0; s < 5; ++s) red[(kp * 5 + s) * 64 + col] = a[s];
            __syncthreads();
            if (tid < 320) {
                const int s = tid >> 6, cc = tid & 63;
                float t = p->mod_b[layer * 6144 + c0 + cc];
#pragma unroll
                for (int k = 0; k < 8; ++k) t += red[(k * 5 + s) * 64 + cc];
                ((float*)(p->ws + OFF_MODS))[(size_t)(layer * 5 + s) * 6144 + c0 + cc] = t;
            }
            __syncthreads();
        } else {
            const int f0 = (u - 192) * 64;
            const int fl = tid >> 3, dgp = (tid & 7) * 2, f = f0 + fl, n = f >> 2, i = f & 3;
            bf16_t* gxc = (bf16_t*)(p->ws + OFF_GCAT);
            bf16_t* gxm = gxc + 2048 * 16;
#pragma unroll
            for (int e = 0; e < 2; ++e) {
                const int dg = dgp + e, d = dg >> 3, g = dg & 7;
                const float* wg = p->m_w_gates + (size_t)d * 6144 * 8;
                float a = 0.f, b = 0.f;
#pragma unroll
                for (int o = 0; o < 4; ++o) {
                    a += p->m_wq[n * 16 + i * 4 + o] * wg[(size_t)(4 * n + o) * 8 + g];
                    a += p->m_wk[n * 16 + i * 4 + o] * wg[(size_t)(2048 + 4 * n + o) * 8 + g] * 0.04419417382415922f;
                    b += p->m_wv[n * 16 + i * 4 + o] * wg[(size_t)(4096 + 4 * n + o) * 8 + g];
                }
                gxc[f * 16 + dg] = f2bf(a); gxm[f * 16 + dg] = f2bf(b);
            }
            if (tid < 256) {
                const int nn = (f0 >> 2) + (tid >> 4), e = tid & 15, ii = e >> 2, jj = e & 3;
                float a = 0.f;
#pragma unroll
                for (int o = 0; o < 4; ++o) a += p->m_wq[nn * 16 + ii * 4 + o] * p->m_wk[nn * 16 + jj * 4 + o];
                ((float*)(p->ws + OFF_MMAT))[nn * 16 + e] = a * 0.04419417382415922f;
            }
        }
    }
    __syncthreads();
    for (int t = get_bid(); t < NCONV_DENSE + 16 * 768; t += gridDim.x) { if (t < NCONV_DENSE) conv_dense_tile(p, t, lds); else conv_expert_tile(p, 0, t - NCONV_DENSE, lds); }
}

template <class Src>
DI void phase_norm(PP p, int layer, int nrows, Src src) {
    const int lane = get_tid() & 63, gw = get_bid() * 8 + (get_tid() >> 6), nw = gridDim.x * 8;
    bf16_t* act = (bf16_t*)(p->ws + OFF_ACT);
    for (int r = gw; r < nrows; r += nw) {
        f32x4 v[4];
        row_load_f32(src(r), v, lane);
        const float rs = rsqrtf(row_sumsq(v) * (1.f / 1024.f) + EPS);
        const int s = row_set(r);
        row_modulate(v, rs, p->norm1_g + layer * 1024, mods_ptr(p, layer, s, 1), mods_ptr(p, layer, s, 0), lane);
        row_store_bf16(act + (size_t)r * 1024, v, lane);
    }
}

DI void phase_inproj(PP p, lds_t lds) {
    const bf16_t* act = (const bf16_t*)(p->ws + OFF_ACT);
    bf16_t* P = (bf16_t*)(p->ws + OFF_ARENA + A_P);
    constexpr int NM = NTOK / 256, NN = 11;
    for (int u = get_bid(); u < NM * NN; u += gridDim.x) {
        const int pn = u / NM, pm = u % NM;
        gemm_unit_t<64>(lds, 1024,
            [&](int r) { return act + (size_t)(pm * 256 + r) * 1024; },
            [&](int r) { return (const bf16_t*)((const char*)p->out + DO_WIN) + (size_t)(pn * 256 + r) * 1024; },
            [&](const f32x4 (&acc)[8][4], int wr, int wc, int lane) {
                epi_each<4>(acc, wr, wc, lane, [&](int r, int c, f32x4 v) { const int col = pn * 256 + c; if (col < ABIN) store_bf16x4(P + (size_t)(pm * 256 + r) * ABIN + col, v); });
            });
    }
}


DI void gla_bcum(LAS float* bc, const LAS float* lrt, const LAS float* wat, const LAS float* bat, int d, LAS float* seg_tot) {
    const int tid = get_tid();
    {
        const int c = tid & 63, tq = tid >> 6;
        float wcol[16];
#pragma unroll
        for (int r = 0; r < 16; ++r) wcol[r] = wat[r * 64 + c];
        const float bias = bat[c];
        for (int t = tq * 8; t < tq * 8 + 8; ++t) {
            float z = bias;
#pragma unroll
            for (int r = 0; r < 16; ++r) z += lrt[t * 16 + r] * wcol[r];
            bc[t * 64 + c] = log_sigmoidf_(z) * (1.f / 16.f);
        }
    }
    __syncthreads();
    {
        const int c = tid & 63, seg = tid >> 6;
        float v[8]; float run = 0.f;
#pragma unroll
        for (int j = 0; j < 8; ++j) { const int pp = seg * 8 + j, t = d == 0 ? pp : 63 - pp; run += bc[t * 64 + c]; v[j] = run; }
        LAS float* tot = seg_tot + seg * 64 + c;
        *tot = run;
        __syncthreads();
        float off = 0.f;
#pragma unroll
        for (int k = 0; k < 7; ++k) off += (k < seg) ? seg_tot[k * 64 + c] : 0.f;
#pragma unroll
        for (int j = 0; j < 8; ++j) { const int pp = seg * 8 + j, t = d == 0 ? pp : 63 - pp; bc[t * 64 + c] = v[j] + off; }
    }
    __syncthreads();
}
DI void gla_load_decay_inputs(PP p, const bf16_t* P, int r0, int h, LAS float* lrt, LAS float* wat, LAS float* bat) {
    const int tid = get_tid();
    if (tid < 256) {
        const int d = tid >> 7, t = (tid >> 1) & 63, half = tid & 1;
        const u32x4 v = *(const u32x4*)(P + (size_t)(r0 + t) * ABIN + PC_LRF + d * 16 + half * 8);
        LAS float* o = lrt + (d * 64 + t) * 16 + half * 8;
        o[0] = lo_bf(v.x); o[1] = hi_bf(v.x); o[2] = lo_bf(v.y); o[3] = hi_bf(v.y); o[4] = lo_bf(v.z); o[5] = hi_bf(v.z); o[6] = lo_bf(v.w); o[7] = hi_bf(v.w);
    }
    {
        const int i = tid * 4, d = i >> 10, r = (i >> 6) & 15, c = i & 63;
        *(LAS f32x4*)(wat + i) = *(const f32x4*)(p->gla_wa2 + (size_t)(d * 16 + r) * 256 + h * 64 + c);
    }
    if (tid < 128) bat[tid] = p->gla_ba[(tid >> 6) * 256 + h * 64 + (tid & 63)];
}

DI void phase_g1(PP p, lds_t lds) {
    const int tid = get_tid(), lane = tid & 63, w = tid >> 6;
    const bf16_t* P = (const bf16_t*)(p->ws + OFF_ARENA + A_P);
    float* U = (float*)(p->ws + OFF_ARENA + A_U);
    float* DEC = (float*)(p->ws + OFF_ARENA + A_DEC);
    float* LA = (float*)(p->ws + OFF_ARENA + A_LA);
    bf16_t* UU = (bf16_t*)(p->ws + OFF_ARENA + A_UU);
    float* AGGA = (float*)(p->ws + OFF_ARENA + A_AGGA);
    float* AGGH = (float*)(p->ws + OFF_ARENA + A_AGGH);
    constexpr int NGLA = NCH * 4, NLRU = NCH * 4;
    for (int task = get_bid(); task < NGLA + NLRU; task += gridDim.x) {
        if (task < NGLA) {
            const int ch = task >> 2, h = task & 3, r0 = ch * 64;
            LAS float* lrt = (LAS float*)lds;
            LAS float* wat = lrt + 2048;
            LAS float* bat = wat + 2048;
            LAS float* bc = bat + 128;
            LAS bf16_t* kt = (LAS bf16_t*)(bc + 8192);
            LAS bf16_t* ktd = kt + 64 * 72;
            LAS bf16_t* vt = ktd + 2 * 64 * 72;
            gla_load_decay_inputs(p, P, r0, h, lrt, wat, bat);
            { const int row = tid >> 3, chunk = tid & 7; *(LAS u32x4*)(kt + row * 72 + chunk * 8) = *(const u32x4*)(P + (size_t)(r0 + row) * ABIN + PC_K + h * 64 + chunk * 8); }
#pragma unroll
            for (int q = 0; q < 2; ++q) { const int i = tid + 512 * q, row = i >> 4, chunk = i & 15; *(LAS u32x4*)(vt + row * 136 + chunk * 8) = *(const u32x4*)(P + (size_t)(r0 + row) * ABIN + PC_V + h * 128 + chunk * 8); }
            __syncthreads();
            gla_bcum(bc, lrt, wat, bat, 0, (LAS float*)(vt + 64 * 136));
            gla_bcum(bc + 4096, lrt + 1024, wat + 1024, bat + 64, 1, (LAS float*)(vt + 64 * 136));
            {
                const int t = tid >> 3, c8 = (tid & 7) * 8;
#pragma unroll
                for (int d = 0; d < 2; ++d) {
                    const LAS float* b = bc + d * 4096;
                    const int tl = d == 0 ? 63 : 0;
                    float o[8];
#pragma unroll
                    for (int j = 0; j < 8; ++j) o[j] = bf2f(kt[t * 72 + c8 + j]) * __expf(b[tl * 64 + c8 + j] - b[t * 64 + c8 + j]);
                    u32x4 v; v.x = pk2(o[0], o[1]); v.y = pk2(o[2], o[3]); v.z = pk2(o[4], o[5]); v.w = pk2(o[6], o[7]);
                    *(LAS u32x4*)(ktd + d * 64 * 72 + t * 72 + c8) = v;
                }
                if (tid < 128) { const int d = tid >> 6, c = tid & 63; DEC[(size_t)(ch * 2 + d) * 256 + h * 64 + c] = __expf(bc[d * 4096 + (d == 0 ? 63 : 0) * 64 + c]); }
            }
            __syncthreads();
            {
                const int d = w >> 2, dkt = w & 3;
                const LAS bf16_t* kd = ktd + d * 64 * 72;
                bf16x8 kb[2];
#pragma unroll
                for (int ks = 0; ks < 2; ++ks) kb[ks] = frag_tr(kd, 72, ks * 32, dkt * 16, lane);
                float* Ud = U + ((size_t)(ch * 2 + d) * 4 + h) * 8192;
#pragma unroll
                for (int dvt = 0; dvt < 8; ++dvt) {
                    f32x4 acc = {0.f, 0.f, 0.f, 0.f};
#pragma unroll
                    for (int ks = 0; ks < 2; ++ks) acc = mfma16(frag_tr(vt, 136, ks * 32, dvt * 16, lane), kb[ks], acc);
                    *(f32x4*)(Ud + (dkt * 16 + (lane & 15)) * 128 + dvt * 16 + 4 * (lane >> 4)) = acc;
                }
            }
            __syncthreads();
        } else {
            const int t2 = task - NGLA, ch = t2 >> 2, cq = t2 & 3, r0 = ch * 64;
            const int seg_lo = ch < NCHL ? r0 : NLAT + ((r0 - NLAT) >> 8) * 256, seg_hi = ch < NCHL ? r0 + 64 : seg_lo + 256;
            LAS bf16_t* xin = (LAS bf16_t*)lds;
            LAS bf16_t* xb = xin + 67 * 136;
            LAS float* lat = (LAS float*)(xb + 64 * 136);
            LAS bf16_t* git = (LAS bf16_t*)(lat + 2 * 64 * 128);
            for (int i = tid; i < 67 * 16; i += NTHREADS) {
                const int row = i >> 4, chunk = i & 15, r = r0 - 2 + row;
                u32x4 v = {0u, 0u, 0u, 0u};
                if (r >= seg_lo && r < seg_hi) v = *(const u32x4*)(P + (size_t)r * ABIN + PC_RGX + cq * 128 + chunk * 8);
                *(LAS u32x4*)(xin + row * 136 + chunk * 8) = v;
            }
            __syncthreads();
            {
                const int t = tid >> 3, c16 = (tid & 7) * 16;
                float o[16];
#pragma unroll
                for (int j = 0; j < 16; ++j) o[j] = p->rg_conv_b[cq * 128 + c16 + j];
#pragma unroll
                for (int tap = 0; tap < 4; ++tap)
#pragma unroll
                    for (int j = 0; j < 16; ++j) o[j] += p->rg_conv_w[tap * 512 + cq * 128 + c16 + j] * bf2f(xin[(t + tap) * 136 + c16 + j]);
#pragma unroll
                for (int j = 0; j < 16; j += 8) {
                    u32x4 v; v.x = pk2(o[j], o[j + 1]); v.y = pk2(o[j + 2], o[j + 3]); v.z = pk2(o[j + 4], o[j + 5]); v.w = pk2(o[j + 6], o[j + 7]);
                    *(LAS u32x4*)(xb + t * 136 + c16 + j) = v;
                }
            }
            __syncthreads();
            {
                const int blk = w & 1, d = (w >> 1) & 1, mat = w >> 2, n = cq * 2 + blk;
                const float* W = (mat ? p->rg_wi : p->rg_wr) + (size_t)(d * 8 + n) * 4096;
                const float* bias = (mat ? p->rg_bi : p->rg_br) + d * 512 + n * 64;
                bf16x8 wf[4][2];
#pragma unroll
                for (int ot = 0; ot < 4; ++ot)
#pragma unroll
                    for (int ks = 0; ks < 2; ++ks) {
                        const float* src = W + (size_t)(ks * 32 + 8 * (lane >> 4)) * 64 + ot * 16 + (lane & 15);
                        float f[8];
#pragma unroll
                        for (int j = 0; j < 8; ++j) f[j] = src[j * 64];
                        u32x4 v; v.x = pk2n(f[0], f[1]); v.y = pk2n(f[2], f[3]); v.z = pk2n(f[4], f[5]); v.w = pk2n(f[6], f[7]);
                        wf[ot][ks] = __builtin_bit_cast(bf16x8, v);
                    }
#pragma unroll
                for (int tt = 0; tt < 4; ++tt) {
                    bf16x8 xf[2];
#pragma unroll
                    for (int ks = 0; ks < 2; ++ks) xf[ks] = frag_row(xb, 136, tt * 16, blk * 64 + ks * 32, lane);
#pragma unroll
                    for (int ot = 0; ot < 4; ++ot) {
                        f32x4 acc = {0.f, 0.f, 0.f, 0.f};
#pragma unroll
                        for (int ks = 0; ks < 2; ++ks) acc = mfma16(wf[ot][ks], xf[ks], acc);
                        const int t = tt * 16 + (lane & 15), o = ot * 16 + 4 * (lane >> 4), c = blk * 64 + o;
                        const f32x4 bv = *(const f32x4*)(bias + o);
                        if (mat == 0) {
                            const f32x4 lam = *(const f32x4*)(p->rg_lambda + d * 512 + n * 64 + o);
                            f32x4 la;
#pragma unroll
                            for (int j = 0; j < 4; ++j) la[j] = -8.f * softplusf_(-lam[j]) * sigmoidf_(acc[j] + bv[j]);
                            *(LAS f32x4*)(lat + (d * 64 + t) * 128 + c) = la;
                        } else {
                            float gi[4];
#pragma unroll
                            for (int j = 0; j < 4; ++j) gi[j] = sigmoidf_(acc[j] + bv[j]) * bf2f(xb[t * 136 + c + j]);
                            u32x2 v; v.x = pk2(gi[0], gi[1]); v.y = pk2(gi[2], gi[3]);
                            *(LAS u32x2*)(git + (d * 64 + t) * 128 + c) = v;
                        }
                    }
                }
            }
            __syncthreads();
            {
                const int c4 = (tid & 31) * 4, rest = tid >> 5, d = rest >> 3, t0 = (rest & 7) * 8, gc = cq * 128 + c4;
#pragma unroll
                for (int j = 0; j < 8; ++j) {
                    const int t = t0 + j;
                    const f32x4 la = *(const LAS f32x4*)(lat + (d * 64 + t) * 128 + c4);
                    const u32x2 gg = *(const LAS u32x2*)(git + (d * 64 + t) * 128 + c4);
                    f32x4 av; float u[4];
                    const float gi[4] = {lo_bf(gg.x), hi_bf(gg.x), lo_bf(gg.y), hi_bf(gg.y)};
#pragma unroll
                    for (int e = 0; e < 4; ++e) { av[e] = __expf(la[e]); u[e] = sqrtf(-expm1f(2.f * la[e])) * gi[e]; }
                    u32x2 uo; uo.x = pk2(u[0], u[1]); uo.y = pk2(u[2], u[3]);
                    *(f32x4*)(LA + ((size_t)(r0 + t) * 2 + d) * 512 + gc) = la;
                    *(u32x2*)(UU + ((size_t)(r0 + t) * 2 + d) * 512 + gc) = uo;
                    *(LAS f32x4*)(lat + (d * 64 + t) * 128 + c4) = av;
                    *(LAS u32x2*)(git + (d * 64 + t) * 128 + c4) = uo;
                }
            }
            __syncthreads();
            {
                const int half = tid >> 8, d = (tid >> 7) & 1, c = tid & 127, gc = cq * 128 + c;
                float hacc = 0.f, aprod = 1.f;
#pragma unroll 8
                for (int s_ = 0; s_ < 32; ++s_) {
                    const int pp = half * 32 + s_, t = d == 0 ? pp : 63 - pp;
                    const float a = lat[(d * 64 + t) * 128 + c], u = bf2f(git[(d * 64 + t) * 128 + c]);
                    hacc = a * hacc + u; aprod *= a;
                }
                LAS float* comb = (LAS float*)xin;
                comb[(half * 256 + d * 128 + c) * 2] = aprod; comb[(half * 256 + d * 128 + c) * 2 + 1] = hacc;
                __syncthreads();
                if (half == 0) {
                    const float a1 = comb[(256 + d * 128 + c) * 2], h1 = comb[(256 + d * 128 + c) * 2 + 1];
                    AGGA[(size_t)(ch * 2 + d) * 512 + gc] = aprod * a1;
                    AGGH[(size_t)(ch * 2 + d) * 512 + gc] = a1 * hacc + h1;
                }
            }
            __syncthreads();
        }
    }
}

DI int scan_chunk(int b, int d, int st) {
    if (st < 4) return NCHL + b * 4 + (d == 0 ? st : 3 - st);
    const int j = st - 4;
    return b * 128 + (d == 0 ? j : 127 - j);
}

DI void phase_scan0(PP p) {
    float* U = (float*)(p->ws + OFF_ARENA + A_U);
    const float* DEC = (const float*)(p->ws + OFF_ARENA + A_DEC);
    const float* AGGA = (const float*)(p->ws + OFF_ARENA + A_AGGA);
    float* AGGH = (float*)(p->ws + OFF_ARENA + A_AGGH);
    const int gid = get_bid() * NTHREADS + get_tid(), nthr = gridDim.x * NTHREADS;
    for (int idx = gid; idx < 65536 + 4096; idx += nthr) {
        if (idx < 65536) {
            const int dv4 = idx & 31, dk = (idx >> 5) & 63, h = (idx >> 11) & 3, d = (idx >> 13) & 1, b = idx >> 14;
            f32x4 S = {0.f, 0.f, 0.f, 0.f};
            for (int st = 0; st < 132; st += 4) {
                f32x4 u[4]; float dc[4]; float* ptr[4];
#pragma unroll
                for (int q = 0; q < 4; ++q) {
                    const int cid = scan_chunk(b, d, st + q);
                    ptr[q] = U + ((size_t)(cid * 2 + d) * 4 + h) * 8192 + dk * 128 + dv4 * 4;
                    u[q] = *(const f32x4*)ptr[q];
                    dc[q] = DEC[(size_t)(cid * 2 + d) * 256 + h * 64 + dk];
                }
#pragma unroll
                for (int q = 0; q < 4; ++q) { *(f32x4*)ptr[q] = S; S = S * dc[q] + u[q]; }
            }
        } else {
            const int i2 = idx - 65536, c = i2 & 511, d = (i2 >> 9) & 1, b = i2 >> 10;
            float hs = 0.f;
            for (int st = 0; st < 132; st += 4) {
                float a[4], hh[4]; float* ptr[4];
#pragma unroll
                for (int q = 0; q < 4; ++q) {
                    const int cid = scan_chunk(b, d, st + q);
                    ptr[q] = AGGH + (size_t)(cid * 2 + d) * 512 + c;
                    hh[q] = *ptr[q]; a[q] = AGGA[(size_t)(cid * 2 + d) * 512 + c];
                }
#pragma unroll
                for (int q = 0; q < 4; ++q) { *ptr[q] = hs; hs = a[q] * hs + hh[q]; }
            }
        }
    }
}

DI void phase_g3(PP p, lds_t lds) {
    const int tid = get_tid(), lane = tid & 63, w = tid >> 6;
    const bf16_t* P = (const bf16_t*)(p->ws + OFF_ARENA + A_P);
    const float* U = (const float*)(p->ws + OFF_ARENA + A_U);
    const float* LA = (const float*)(p->ws + OFF_ARENA + A_LA);
    const bf16_t* UU = (const bf16_t*)(p->ws + OFF_ARENA + A_UU);
    const float* HST = (const float*)(p->ws + OFF_ARENA + A_AGGH);
    bf16_t* act = (bf16_t*)(p->ws + OFF_ACT);
    constexpr int NGLA = NCH * 4;
    for (int task = get_bid(); task < NGLA + NCH; task += gridDim.x) {
        if (task < NGLA) {
            const int ch = task >> 2, h = task & 3, r0 = ch * 64;
            LAS float* lrt = (LAS float*)lds;
            LAS float* wat = lrt + 2048;
            LAS float* bat = wat + 2048;
            LAS float* bc = bat + 128;
            LAS bf16_t* qt = (LAS bf16_t*)(bc + 4096);
            LAS bf16_t* kt = qt + 64 * 72;
            LAS bf16_t* qtd = kt + 64 * 72;
            LAS bf16_t* ktd = qtd + 64 * 72;
            LAS bf16_t* at = ktd + 64 * 72;
            LAS bf16_t* vt = at + 64 * 72;
            LAS bf16_t* St = vt + 64 * 136;
            LAS float* ot = (LAS float*)(St + 64 * 136);
            gla_load_decay_inputs(p, P, r0, h, lrt, wat, bat);
            { const int row = tid >> 3, chunk = tid & 7;
              *(LAS u32x4*)(qt + row * 72 + chunk * 8) = *(const u32x4*)(P + (size_t)(r0 + row) * ABIN + PC_Q + h * 64 + chunk * 8);
              *(LAS u32x4*)(kt + row * 72 + chunk * 8) = *(const u32x4*)(P + (size_t)(r0 + row) * ABIN + PC_K + h * 64 + chunk * 8); }
#pragma unroll
            for (int q = 0; q < 2; ++q) { const int i = tid + 512 * q, row = i >> 4, chunk = i & 15; *(LAS u32x4*)(vt + row * 136 + chunk * 8) = *(const u32x4*)(P + (size_t)(r0 + row) * ABIN + PC_V + h * 128 + chunk * 8); }
            __syncthreads();
            f32x4 oacc[4];
#pragma unroll
            for (int i = 0; i < 4; ++i) oacc[i] = (f32x4){0.f, 0.f, 0.f, 0.f};
            const int ott = w & 3, odv0 = (w >> 2) * 4;
            for (int d = 0; d < 2; ++d) {
                gla_bcum(bc, lrt + d * 1024, wat + d * 1024, bat + d * 64, d, ot);
                {
                    const int t = tid >> 3, c8 = (tid & 7) * 8;
                    float qo[8], ko[8];
#pragma unroll
                    for (int j = 0; j < 8; ++j) { const float e = __expf(bc[t * 64 + c8 + j]); qo[j] = bf2f(qt[t * 72 + c8 + j]) * 0.125f * e; ko[j] = bf2f(kt[t * 72 + c8 + j]) / e; }
                    u32x4 v; v.x = pk2(qo[0], qo[1]); v.y = pk2(qo[2], qo[3]); v.z = pk2(qo[4], qo[5]); v.w = pk2(qo[6], qo[7]);
                    *(LAS u32x4*)(qtd + t * 72 + c8) = v;
                    v.x = pk2(ko[0], ko[1]); v.y = pk2(ko[2], ko[3]); v.z = pk2(ko[4], ko[5]); v.w = pk2(ko[6], ko[7]);
                    *(LAS u32x4*)(ktd + t * 72 + c8) = v;
                    const int dk = tid >> 3, dv16 = (tid & 7) * 16;
                    const float* src = U + ((size_t)(ch * 2 + d) * 4 + h) * 8192 + dk * 128 + dv16;
                    const f32x4 s0 = *(const f32x4*)src, s1 = *(const f32x4*)(src + 4), s2 = *(const f32x4*)(src + 8), s3 = *(const f32x4*)(src + 12);
                    v.x = pk2(s0[0], s0[1]); v.y = pk2(s0[2], s0[3]); v.z = pk2(s1[0], s1[1]); v.w = pk2(s1[2], s1[3]);
                    *(LAS u32x4*)(St + dk * 136 + dv16) = v;
                    v.x = pk2(s2[0], s2[1]); v.y = pk2(s2[2], s2[3]); v.z = pk2(s3[0], s3[1]); v.w = pk2(s3[2], s3[3]);
                    *(LAS u32x4*)(St + dk * 136 + dv16 + 8) = v;
                }
                __syncthreads();
                {
                    const int tt = w >> 1;
#pragma unroll
                    for (int e = 0; e < 2; ++e) {
                        const int st = (w & 1) * 2 + e;
                        f32x4 acc = {0.f, 0.f, 0.f, 0.f};
#pragma unroll
                        for (int ks = 0; ks < 2; ++ks) acc = mfma16(frag_row(ktd, 72, st * 16, ks * 32, lane), frag_row(qtd, 72, tt * 16, ks * 32, lane), acc);
                        const int t = tt * 16 + (lane & 15), s0 = st * 16 + 4 * (lane >> 4);
                        float a[4];
#pragma unroll
                        for (int j = 0; j < 4; ++j) { const int s = s0 + j; a[j] = (d == 0 ? s <= t : s >= t) ? acc[j] : 0.f; }
                        u32x2 v; v.x = pk2(a[0], a[1]); v.y = pk2(a[2], a[3]);
                        *(LAS u32x2*)(at + t * 72 + s0) = v;
                    }
                }
                __syncthreads();
                {
                    bf16x8 af[2], qf[2];
#pragma unroll
                    for (int ks = 0; ks < 2; ++ks) { af[ks] = frag_row(at, 72, ott * 16, ks * 32, lane); qf[ks] = frag_row(qtd, 72, ott * 16, ks * 32, lane); }
#pragma unroll
                    for (int i = 0; i < 4; ++i) {
                        const int dvt = odv0 + i;
#pragma unroll
                        for (int ks = 0; ks < 2; ++ks) {
                            oacc[i] = mfma16(frag_tr(vt, 136, ks * 32, dvt * 16, lane), af[ks], oacc[i]);
                            oacc[i] = mfma16(frag_tr(St, 136, ks * 32, dvt * 16, lane), qf[ks], oacc[i]);
                        }
                    }
                }
                __syncthreads();
            }
#pragma unroll
            for (int i = 0; i < 4; ++i) *(LAS f32x4*)(ot + (ott * 16 + (lane & 15)) * 132 + (odv0 + i) * 16 + 4 * (lane >> 4)) = oacc[i];
            __syncthreads();
            {
                const int t = tid >> 3, dv16 = (tid & 7) * 16;
                float o[16]; float ss = 0.f;
#pragma unroll
                for (int j = 0; j < 16; ++j) { o[j] = ot[t * 132 + dv16 + j]; ss += o[j] * o[j]; }
                ss += __shfl_xor(ss, 1); ss += __shfl_xor(ss, 2); ss += __shfl_xor(ss, 4);
                const float rs = rsqrtf(ss * (1.f / 128.f) + EPS);
                const bf16_t* gp = P + (size_t)(r0 + t) * ABIN + PC_G + h * 128 + dv16;
                const u32x4 g0 = *(const u32x4*)gp, g1 = *(const u32x4*)(gp + 8);
                const unsigned gw[8] = {g0.x, g0.y, g0.z, g0.w, g1.x, g1.y, g1.z, g1.w};
                float r[16];
#pragma unroll
                for (int j = 0; j < 8; ++j) {
                    r[2 * j] = o[2 * j] * rs * p->gla_norm_g[h * 128 + dv16 + 2 * j] * siluf_(lo_bf(gw[j]));
                    r[2 * j + 1] = o[2 * j + 1] * rs * p->gla_norm_g[h * 128 + dv16 + 2 * j + 1] * siluf_(hi_bf(gw[j]));
                }
                bf16_t* dst = act + (size_t)(r0 + t) * 1024 + h * 128 + dv16;
                u32x4 v; v.x = pk2(r[0], r[1]); v.y = pk2(r[2], r[3]); v.z = pk2(r[4], r[5]); v.w = pk2(r[6], r[7]);
                *(u32x4*)dst = v;
                v.x = pk2(r[8], r[9]); v.y = pk2(r[10], r[11]); v.z = pk2(r[12], r[13]); v.w = pk2(r[14], r[15]);
                *(u32x4*)(dst + 8) = v;
            }
            __syncthreads();
        } else {
            const int ch = task - NGLA, r0 = ch * 64, c = tid;
            LAS float* hf = (LAS float*)lds;
            float hs = HST[(size_t)(ch * 2 + 0) * 512 + c];
            for (int tb = 0; tb < 64; tb += 16) {
                float la[16]; bf16_t uu[16];
#pragma unroll
                for (int j = 0; j < 16; ++j) { const size_t o = ((size_t)(r0 + tb + j) * 2 + 0) * 512 + c; la[j] = LA[o]; uu[j] = UU[o]; }
#pragma unroll
                for (int j = 0; j < 16; ++j) { hs = __expf(la[j]) * hs + bf2f(uu[j]); hf[(tb + j) * 512 + c] = hs; }
            }
            hs = HST[(size_t)(ch * 2 + 1) * 512 + c];
            for (int tb = 48; tb >= 0; tb -= 16) {
                float la[16]; bf16_t uu[16], gg[16];
#pragma unroll
                for (int j = 0; j < 16; ++j) { const size_t o = ((size_t)(r0 + tb + j) * 2 + 1) * 512 + c; la[j] = LA[o]; uu[j] = UU[o]; gg[j] = P[(size_t)(r0 + tb + j) * ABIN + PC_RGG + c]; }
#pragma unroll
                for (int j = 15; j >= 0; --j) {
                    hs = __expf(la[j]) * hs + bf2f(uu[j]);
                    act[(size_t)(r0 + tb + j) * 1024 + 512 + c] = f2bf((hf[(tb + j) * 512 + c] + hs) * gelu_tanh(bf2f(gg[j])));
                }
            }
            __syncthreads();
        }
    }
}


DI void phase_outproj0(PP p, lds_t lds) {
    const bf16_t* act = (const bf16_t*)(p->ws + OFF_ACT);
    float* X = (float*)(p->ws + OFF_ARENA + A_X);
    constexpr int NM = NTOK / 256, NN = 4;
    for_units_xcd(1, NM, NN, 8, 4, [&](int, int pm, int pn) {
        const int set = row_set(pm * 256);
        const float* g1 = mods_ptr(p, 0, set, 2);
        const float* xin = pm * 256 < NLAT ? p->x + (size_t)pm * 256 * 1024 : p->ctx + (size_t)(pm * 256 - NLAT) * 1024;
        gemm_unit_t<64>(lds, 1024,
            [&](int r) { return act + (size_t)(pm * 256 + r) * 1024; },
            [&](int r) { return (const bf16_t*)((const char*)p->out + DO_WOUT) + (size_t)(pn * 256 + r) * 1024; },
            [&](const f32x4 (&acc)[8][4], int wr, int wc, int lane) {
                epi_each<4>(acc, wr, wc, lane, [&](int r, int c, f32x4 v) {
                    const int col = pn * 256 + c;
                    const f32x4 xi = *(const f32x4*)(xin + (size_t)r * 1024 + col), g = *(const f32x4*)(g1 + col);
                    *(f32x4*)(X + (size_t)(pm * 256 + r) * 1024 + col) = xi + g * v;
                });
            });
    });
}

struct MoeBufs { float* PT; float* PE; int* ROWID; int* ROWTOK; bf16_t* HDN; bf16_t* Y; int rpe; int nrows; };
DI MoeBufs moe_bufs(PP p, int layer) {
    MoeBufs m;
    char* a = p->ws + OFF_ARENA;
    if (layer == 0) { m.PT = (float*)(a + A_PT); m.PE = (float*)(a + A_PE); m.ROWID = (int*)(a + A_ROWID); m.ROWTOK = (int*)(a + A_ROWTOK); m.HDN = (bf16_t*)(a + A_HDN); m.Y = (bf16_t*)(a + A_Y); m.rpe = 4352; m.nrows = NTOK; }
    else { m.PT = (float*)(a + A_HB); m.PE = (float*)(a + A_HB + (size_t)NTOK * 64); m.ROWID = (int*)(a + A_HB + (size_t)NTOK * 128); m.ROWTOK = (int*)(a + A_HB + (size_t)NTOK * 192); m.HDN = (bf16_t*)(a + A_XM); m.Y = (bf16_t*)(a + A_XC); m.rpe = 4096; m.nrows = NLAT; }
    return m;
}

DI void phase_router(PP p, lds_t lds, int layer) {
    const int tid = get_tid(), lane = tid & 63;
    const MoeBufs m = moe_bufs(p, layer);
    const float* X = (const float*)(p->ws + OFF_ARENA + A_X);
    bf16_t* act = (bf16_t*)(p->ws + OFF_ACT);
    LAS float* rwT = (LAS float*)lds;
    for (int i = tid; i < 16384; i += NTHREADS) { const int k = i >> 4, e = i & 15; rwT[e * 1024 + k] = p->router_w[(size_t)layer * 16384 + i]; }
    __syncthreads();
    const int gw = get_bid() * 8 + (tid >> 6), nw = gridDim.x * 8;
    for (int r = gw; r < m.nrows; r += nw) {
        f32x4 v[4];
        row_load_f32(X + (size_t)r * 1024, v, lane);
        const float rs = rsqrtf(row_sumsq(v) * (1.f / 1024.f) + EPS);
        const int set = row_set(r);
        row_modulate(v, rs, p->norm2_g + layer * 1024, mods_ptr(p, layer, set, 4), mods_ptr(p, layer, set, 3), lane);
        row_store_bf16(act + (size_t)r * 1024, v, lane);
        float lg[16];
#pragma unroll
        for (int e = 0; e < 16; ++e) {
            float a = 0.f;
#pragma unroll
            for (int i = 0; i < 4; ++i) { const f32x4 wv = *(const LAS f32x4*)(rwT + e * 1024 + 4 * lane + 256 * i); a += v[i][0] * wv[0] + v[i][1] * wv[1] + v[i][2] * wv[2] + v[i][3] * wv[3]; }
            lg[e] = wave_sum(a);
            asm volatile("" ::: "memory");
        }
        float mx = lg[0];
#pragma unroll
        for (int e = 1; e < 16; ++e) mx = fmaxf(mx, lg[e]);
        float sum = 0.f;
#pragma unroll
        for (int e = 0; e < 16; ++e) { lg[e] = __expf(lg[e] - mx); sum += lg[e]; }
        const float inv = 1.f / sum;
        float mine = 0.f;
#pragma unroll
        for (int e = 0; e < 16; ++e) if (lane == e) mine = lg[e] * inv;
        if (lane < 16) {
            m.PT[(size_t)r * 16 + lane] = mine;
            if (r < NLAT) m.PE[((size_t)(r >> 13) * 16 + lane) * 8192 + (r & 8191)] = mine;
            else { const int rc = r - NLAT; m.PE[(size_t)NBATCH * 16 * 8192 + ((size_t)(rc >> 8) * 16 + lane) * 256 + (rc & 255)] = mine; }
        }
    }
}

DI int block_excl_scan(int v, LAS int* tmp, int* total) {
    const int tid = get_tid(), lane = tid & 63, w = tid >> 6;
    int inc = v;
#pragma unroll
    for (int o = 1; o < 64; o <<= 1) { const int t = __shfl_up(inc, o); if (lane >= o) inc += t; }
    __syncthreads();
    if (lane == 63) tmp[w] = inc;
    __syncthreads();
    int base = 0, tot = 0;
#pragma unroll
    for (int i = 0; i < 8; ++i) { const int t = tmp[i]; if (i < w) base += t; tot += t; }
    *total = tot;
    return base + inc - v;
}

DI void phase_topk(PP p, lds_t lds, int layer) {
    const int tid = get_tid();
    const MoeBufs m = moe_bufs(p, layer);
    LAS unsigned* keys = (LAS unsigned*)lds;
    LAS int* hist = (LAS int*)(keys + 8192);
    LAS int* tmp = hist + 256;
    LAS int* sel = tmp + 16;
    const int ntask = layer == 0 ? 128 : 64;
    if (layer == 1 && get_bid() >= 64) {
        for (int t = get_bid() - 64; t < 16 * 768; t += gridDim.x - 64) conv_expert_tile(p, 1, t, lds);
        return;
    }
    for (int task = get_bid(); task < ntask; task += gridDim.x) {
        const bool isctx = task >= 64;
        const int b = (task & 63) >> 4, e = task & 15;
        const int n = isctx ? 256 : 8192, cap = isctx ? 32 : 1024;
        const float* src = isctx ? m.PE + (size_t)NBATCH * 16 * 8192 + ((size_t)b * 16 + e) * 256 : m.PE + ((size_t)b * 16 + e) * 8192;
        for (int i = tid; i < n; i += NTHREADS) keys[i] = __float_as_uint(src[i]);
        __syncthreads();
        unsigned prefix = 0u, mask = 0u; int kk = cap;
        for (int pass = 3; pass >= 0; --pass) {
            const int shift = pass * 8;
            if (tid < 256) hist[tid] = 0;
            __syncthreads();
            for (int i = tid; i < n; i += NTHREADS) { const unsigned k = keys[i]; if ((k & mask) == prefix) __hip_atomic_fetch_add((int*)(hist + ((k >> shift) & 255)), 1, __ATOMIC_RELAXED, __HIP_MEMORY_SCOPE_WORKGROUP); }
            __syncthreads();
            if (tid < 256) {
                int above = 0;
                for (int j = tid + 1; j < 256; ++j) above += hist[j];
                const int mineh = hist[tid];
                if (above < kk && kk <= above + mineh) { sel[0] = tid; sel[1] = above; }
            }
            __syncthreads();
            prefix |= (unsigned)sel[0] << shift; mask |= 0xffu << shift; kk -= sel[1];
            __syncthreads();
        }
        const unsigned T = prefix; const int need_eq = kk;
        const int ipt = n / NTHREADS > 0 ? n / NTHREADS : 1;
        const int i0 = tid * ipt;
        int cgt = 0, ceq = 0;
        if (i0 < n) for (int j = 0; j < ipt; ++j) { const unsigned k = keys[i0 + j]; cgt += k > T; ceq += k == T; }
        int tot;
        const int egt = block_excl_scan(cgt, tmp, &tot);
        const int eeq = block_excl_scan(ceq, tmp, &tot);
        const int slot0 = e * m.rpe + (isctx ? 4096 + b * 32 : b * 1024);
        const int row0 = isctx ? NLAT + b * 256 : b * 8192;
        if (i0 < n) {
            int ngt = egt, neq = eeq;
            for (int j = 0; j < ipt; ++j) {
                const unsigned k = keys[i0 + j];
                int slot = -1;
                if (k > T) { slot = slot0 + ngt + (neq < need_eq ? neq : need_eq); ++ngt; }
                else if (k == T) { if (neq < need_eq) slot = slot0 + ngt + neq; ++neq; }
                m.ROWID[(size_t)(row0 + i0 + j) * 16 + e] = slot;
                if (slot >= 0) m.ROWTOK[slot] = row0 + i0 + j;
            }
        }
        if (isctx && b == 0 && layer == 0) for (int i = tid; i < 128; i += NTHREADS) m.ROWTOK[e * m.rpe + 4224 + i] = -1;
        __syncthreads();
    }
}

DI void phase_moe_up(PP p, lds_t lds, int layer) {
    const MoeBufs m = moe_bufs(p, layer);
    const bf16_t* act = (const bf16_t*)(p->ws + OFF_ACT);
    auto unit = [&](int e, int mt, int nt) {
        const float* Wg = p->exp_w_gate + ((size_t)layer * 16 + e) * 1048576;
        const float* Wu = p->exp_w_up + ((size_t)layer * 16 + e) * 1048576;
        const int* rt = m.ROWTOK + e * m.rpe + mt * 256;
        bf16_t* H = m.HDN + ((size_t)e * m.rpe + mt * 256) * 1024 + nt * 128;
        gemm_unit_t<64>(lds, 1024,
            [&](int r) -> const bf16_t* { const int tok = rt[r]; return tok >= 0 ? act + (size_t)tok * 1024 : nullptr; },
            [&](int r) { return (const bf16_t*)((const char*)p->out + DO_EXP + (size_t)e * EXP_STRIDE) + (size_t)(nt * 256 + r) * 1024; },
            [&](const f32x4 (&acc)[8][4], int wr, int wc, int lane) {
#pragma unroll
                for (int mi = 0; mi < 8; ++mi)
#pragma unroll
                    for (int ni = 0; ni < 2; ++ni) {
                        const f32x4 g = acc[mi][ni], uu = acc[mi][ni + 2];
                        f32x4 h;
#pragma unroll
                        for (int j = 0; j < 4; ++j) h[j] = siluf_(g[j]) * uu[j];
                        store_bf16x4(H + (size_t)(wr * 128 + mi * 16 + (lane & 15)) * 1024 + wc * 32 + ni * 16 + 4 * (lane >> 4), h);
                    }
            });
    };
    for_units_xcd(16, 16, 8, 4, 8, unit);
    if (layer == 0) for_units_xcd(16, 1, 8, 1, 8, [&](int e, int, int nt) { unit(e, 16, nt); });
}

template <int PROBE>
DI void phase_moe_down_t(PP p, lds_t lds, int layer) {
    const MoeBufs m = moe_bufs(p, layer);
    auto unit = [&](int e, int mt, int nt) {
        const float* Wd = p->exp_w_down + ((size_t)layer * 16 + e) * 1048576;
        const bf16_t* H = m.HDN + ((size_t)e * m.rpe + mt * 256) * 1024;
        bf16_t* Y = m.Y + ((size_t)e * m.rpe + mt * 256) * 1024 + nt * 256;
        gemm_unit_t<64>(lds, 1024,
            [&](int r) { return H + (size_t)r * 1024; },
            [&](int r) { return (const bf16_t*)((const char*)p->out + DO_EXP + (size_t)e * EXP_STRIDE) + (size_t)(2048 + nt * 256 + r) * 1024; },
            [&](const f32x4 (&acc)[8][4], int wr, int wc, int lane) {
                epi_each<4>(acc, wr, wc, lane, [&](int r, int c, f32x4 v) { store_bf16x4(Y + (size_t)r * 1024 + c, v); });
            });
    };
    for_units_xcd(16, 16, 4, 8, 4, unit);
    if (layer == 0) for_units_xcd(16, 1, 4, 1, 4, [&](int e, int, int nt) { unit(e, 16, nt); });
}

DI void phase_moe_down(PP p, lds_t lds, int layer) { phase_moe_down_t<0>(p, lds, layer); }

DI void phase_combine(PP p, int layer) {
    const int tid = get_tid(), lane = tid & 63;
    const MoeBufs m = moe_bufs(p, layer);
    float* X = (float*)(p->ws + OFF_ARENA + A_X);
    bf16_t* act = (bf16_t*)(p->ws + OFF_ACT);
    const int gw = get_bid() * 8 + (tid >> 6), nw = gridDim.x * 8;
    for (int r = gw; r < m.nrows; r += nw) {
        f32x4 v[4], a[4];
        row_load_f32(X + (size_t)r * 1024, v, lane);
#pragma unroll
        for (int i = 0; i < 4; ++i) a[i] = (f32x4){0.f, 0.f, 0.f, 0.f};
        for (int e = 0; e < 16; ++e) {
            const int rid = m.ROWID[(size_t)r * 16 + e];
            if (rid >= 0) {
                const float pe = m.PT[(size_t)r * 16 + e];
                const bf16_t* y = m.Y + (size_t)rid * 1024;
#pragma unroll
                for (int i = 0; i < 4; ++i) { const u32x2 yy = *(const u32x2*)(y + 4 * lane + 256 * i); a[i][0] += pe * lo_bf(yy.x); a[i][1] += pe * hi_bf(yy.x); a[i][2] += pe * lo_bf(yy.y); a[i][3] += pe * hi_bf(yy.y); }
            }
        }
        const int set = row_set(r);
        const float* g2 = mods_ptr(p, layer, set, 5);
#pragma unroll
        for (int i = 0; i < 4; ++i) { const f32x4 g = *(const f32x4*)(g2 + 4 * lane + 256 * i); v[i] = v[i] + g * a[i]; }
        const float rs = rsqrtf(row_sumsq(v) * (1.f / 1024.f) + EPS);
        if (layer == 0) {
#pragma unroll
            for (int i = 0; i < 4; ++i) *(f32x4*)(X + (size_t)r * 1024 + 4 * lane + 256 * i) = v[i];
            row_modulate(v, rs, p->norm1_g + 1024, mods_ptr(p, 1, set, 1), mods_ptr(p, 1, set, 0), lane);
            row_store_bf16(act + (size_t)r * 1024, v, lane);
        } else {
#pragma unroll
            for (int i = 0; i < 4; ++i) { const f32x4 g = *(const f32x4*)(p->final_g + 4 * lane + 256 * i); *(f32x4*)(p->out + (size_t)r * 1024 + 4 * lane + 256 * i) = v[i] * rs * g; }
        }
    }
}


DI void phase_upproj(PP p, lds_t lds, int half) {
    const bf16_t* act = (const bf16_t*)(p->ws + OFF_ACT);
    bf16_t* O = (bf16_t*)(p->ws + OFF_ARENA + A_XM);
    const int NM = half == 0 ? NTOK / 256 : NLAT / 256, NN = 8;
    for_units_xcd(1, NM, NN, 8, 4, [&](int, int pm, int pn) {
        gemm_unit_t<64>(lds, 1024,
            [&](int r) { return act + (size_t)(pm * 256 + r) * 1024; },
            [&](int r) { return (const bf16_t*)(p->ws + OFF_WUPT) + (size_t)(half * 2048 + pn * 256 + r) * 1024; },
            [&](const f32x4 (&acc)[8][4], int wr, int wc, int lane) {
                epi_each<4>(acc, wr, wc, lane, [&](int r, int c, f32x4 v) { store_bf16x4(O + (size_t)(pm * 256 + r) * 2048 + pn * 256 + c, v); });
            });
    });
}

DI void phase_mfeat(PP p, lds_t lds) {
    const int tid = get_tid(), lane = tid & 63, w = tid >> 6;
    bf16_t* XM = (bf16_t*)(p->ws + OFF_ARENA + A_XM);
    bf16_t* XC = (bf16_t*)(p->ws + OFF_ARENA + A_XC);
    bf16_t* CTXV = (bf16_t*)(p->ws + OFF_ACT + ACT_CTXV);
    bf16_t* RAWS = (bf16_t*)(p->ws + OFF_ACT + ACT_RAWS);
    float* GP = (float*)(p->ws + OFF_ACT + ACT_GP);
    const bf16_t* GC = (const bf16_t*)(p->ws + OFF_GCAT);
    const float* MM = (const float*)(p->ws + OFF_MMAT);
    LAS bf16_t* xin = (LAS bf16_t*)lds;
    LAS bf16_t* xct = xin + 67 * 136;
    LAS bf16_t* qpt = xct + 64 * 136;
    LAS bf16_t* gxc = qpt + 64 * 136;
    LAS bf16_t* gxm = gxc + 128 * 16;
    LAS float* mq = (LAS float*)(gxm + 128 * 16);
    LAS float* wvq = mq + 512;
    LAS float* cw = wvq + 512;
    LAS float* gred = cw + 640;
    for (int task = get_bid(); task < NCH * 4; task += gridDim.x) {
        const int ch = task >> 2, h = task & 3, r0 = ch * 64;
        const int seg_lo = ch < NCHL ? r0 : NLAT + ((r0 - NLAT) >> 8) * 256, seg_hi = ch < NCHL ? r0 + 64 : seg_lo + 256;
        f32x4 rs_acc[2] = {{0.f, 0.f, 0.f, 0.f}, {0.f, 0.f, 0.f, 0.f}};
        f32x4 g_acc = {0.f, 0.f, 0.f, 0.f};
        for (int q4 = 0; q4 < 4; ++q4) {
            const int col0 = h * 512 + q4 * 128;
            for (int i = tid; i < 67 * 16; i += NTHREADS) {
                const int row = i >> 4, chunk = i & 15, r = r0 - 2 + row;
                u32x4 v = {0u, 0u, 0u, 0u};
                if (r >= seg_lo && r < seg_hi) v = *(const u32x4*)(XM + (size_t)r * 2048 + col0 + chunk * 8);
                *(LAS u32x4*)(xin + row * 136 + chunk * 8) = v;
            }
            if (tid < 256) *(LAS u32x4*)(gxc + tid * 8) = *(const u32x4*)(GC + (size_t)col0 * 16 + tid * 8);
            else *(LAS u32x4*)(gxm + (tid - 256) * 8) = *(const u32x4*)(GC + (size_t)(2048 + col0) * 16 + (tid - 256) * 8);
            mq[tid] = bf2f(f2bf(MM[(size_t)(col0 >> 2) * 16 + tid]));
            wvq[tid] = p->m_wv[(size_t)(col0 >> 2) * 16 + tid];
            for (int i = tid; i < 640; i += NTHREADS) cw[i] = i < 512 ? p->m_conv_w[(size_t)(i >> 7) * 2048 + col0 + (i & 127)] : p->m_conv_b[col0 + i - 512];
            __syncthreads();
            {
                const int t = tid >> 3, c16 = (tid & 7) * 16;
                float xc[16], xm[16];
#pragma unroll
                for (int j = 0; j < 16; ++j) { xc[j] = cw[512 + c16 + j]; xm[j] = bf2f(xin[(t + 2) * 136 + c16 + j]); }
#pragma unroll
                for (int tap = 0; tap < 4; ++tap)
#pragma unroll
                    for (int j = 0; j < 16; ++j) xc[j] += cw[tap * 128 + c16 + j] * bf2f(xin[(t + tap) * 136 + c16 + j]);
                unsigned xcp[8];
#pragma unroll
                for (int j = 0; j < 8; ++j) { xcp[j] = pk2(siluf_(xc[2 * j]), siluf_(xc[2 * j + 1])); xc[2 * j] = lo_bf(xcp[j]); xc[2 * j + 1] = hi_bf(xcp[j]); }
                float vv[16], qp[16];
#pragma unroll
                for (int n = 0; n < 4; ++n) {
                    const int nb = (c16 >> 2) + n;
#pragma unroll
                    for (int o = 0; o < 4; ++o) {
                        float a = 0.f, b = 0.f;
#pragma unroll
                        for (int i = 0; i < 4; ++i) { a += xm[4 * n + i] * wvq[nb * 16 + i * 4 + o]; b += xc[4 * n + i] * mq[nb * 16 + i * 4 + o]; }
                        vv[4 * n + o] = a; qp[4 * n + o] = b;
                    }
                }
                u32x4 v0, v1;
                v0.x = xcp[0]; v0.y = xcp[1]; v0.z = xcp[2]; v0.w = xcp[3]; v1.x = xcp[4]; v1.y = xcp[5]; v1.z = xcp[6]; v1.w = xcp[7];
                *(LAS u32x4*)(xct + t * 136 + c16) = v0; *(LAS u32x4*)(xct + t * 136 + c16 + 8) = v1;
                bf16_t* xcg = XC + (size_t)(r0 + t) * 2048 + col0 + c16;
                *(u32x4*)xcg = v0; *(u32x4*)(xcg + 8) = v1;
                v0.x = pk2(qp[0], qp[1]); v0.y = pk2(qp[2], qp[3]); v0.z = pk2(qp[4], qp[5]); v0.w = pk2(qp[6], qp[7]);
                v1.x = pk2(qp[8], qp[9]); v1.y = pk2(qp[10], qp[11]); v1.z = pk2(qp[12], qp[13]); v1.w = pk2(qp[14], qp[15]);
                *(LAS u32x4*)(qpt + t * 136 + c16) = v0; *(LAS u32x4*)(qpt + t * 136 + c16 + 8) = v1;
                v0.x = pk2(vv[0], vv[1]); v0.y = pk2(vv[2], vv[3]); v0.z = pk2(vv[4], vv[5]); v0.w = pk2(vv[6], vv[7]);
                v1.x = pk2(vv[8], vv[9]); v1.y = pk2(vv[10], vv[11]); v1.z = pk2(vv[12], vv[13]); v1.w = pk2(vv[14], vv[15]);
                bf16_t* vg = ch < NCHL ? XM + (size_t)(r0 + t) * 2048 + col0 + c16 : CTXV + (size_t)(r0 + t - NLAT) * 2048 + col0 + c16;
                *(u32x4*)vg = v0; *(u32x4*)(vg + 8) = v1;
            }
            __syncthreads();
            {
                const int tt = w >> 1;
#pragma unroll
                for (int e = 0; e < 2; ++e) {
                    const int st = (w & 1) * 2 + e;
#pragma unroll
                    for (int ks = 0; ks < 4; ++ks) rs_acc[e] = mfma16(frag_row(xct, 136, st * 16, ks * 32, lane), frag_row(qpt, 136, tt * 16, ks * 32, lane), rs_acc[e]);
                }
                const int gt = w & 3, src = w >> 2;
                const LAS bf16_t* gm = src ? gxm : gxc;
                const LAS bf16_t* ft = src ? xin + 2 * 136 : xct;
#pragma unroll
                for (int ks = 0; ks < 4; ++ks) g_acc = mfma16(frag_tr(gm, 16, ks * 32, 0, lane), frag_row(ft, 136, gt * 16, ks * 32, lane), g_acc);
            }
            __syncthreads();
        }
        {
            const int tt = w >> 1;
#pragma unroll
            for (int e = 0; e < 2; ++e) {
                const int st = (w & 1) * 2 + e;
                store_bf16x4(RAWS + ((size_t)task * 64 + tt * 16 + (lane & 15)) * 64 + st * 16 + 4 * (lane >> 4), rs_acc[e]);
            }
            const int gt = w & 3, src = w >> 2;
            *(LAS f32x4*)(gred + (src * 64 + gt * 16 + (lane & 15)) * 16 + 4 * (lane >> 4)) = g_acc;
        }
        __syncthreads();
        if (tid < 256) {
            const int t = tid >> 2, q = tid & 3;
            const f32x4 a = *(const LAS f32x4*)(gred + t * 16 + q * 4), b = *(const LAS f32x4*)(gred + (64 + t) * 16 + q * 4);
            *(f32x4*)(GP + ((size_t)(r0 + t) * 4 + h) * 16 + q * 4) = a + b;
        }
        __syncthreads();
    }
}

constexpr int MS_KLD = 1056, MS_QLD = 1040;
constexpr size_t ACT_MSC = 32u << 20;
static_assert(ACT_MSC >= ACT_CTXV + (size_t)NCTX * 2048 * 2 && ACT_MSC + (size_t)256 * 132 * 192 * 4 <= ACT_BYTES, "msc scratch");
#define MS_REGIONS(L) \
    lds_t xct = (L);                                                         \
    lds_t qpt = (L) + 64 * MS_KLD;                                           \
    LAS bf16_t* vt = (LAS bf16_t*)((L) + 64 * MS_KLD + 64 * MS_QLD);         \
    LAS bf16_t* St = vt + 4096;                                              \
    LAS bf16_t* vwt = St + 4096;                                             \
    LAS float* sc_b = (LAS float*)(vwt + 4096); \
    LAS float* sc_m = sc_b + 64; LAS float* sc_li = sc_m + 64; LAS float* sc_w = sc_li + 64; LAS float* sc_di = sc_w + 64; LAS float* sc_rs = sc_di + 64; \
    LAS float* sc_misc = sc_rs + 64;                                         \
    LAS float* qn = sc_misc + 8;                                             \
    LAS float* nvec = qn + 64;                                               \
    LAS float* red = (LAS float*)qpt;
DI void phase_mscan(PP p, lds_t lds) {
    const int tid = get_tid(), lane = tid & 63, w = tid >> 6, bid = get_bid();
    if (bid >= 256) return;
    const int grp = bid & 31, sl = bid >> 5, b = grp >> 3, h = (grp >> 1) & 3, d = grp & 1;
    const bf16_t* XC = (const bf16_t*)(p->ws + OFF_ARENA + A_XC);
    const bf16_t* V = (const bf16_t*)(p->ws + OFF_ARENA + A_XM);
    const bf16_t* CTXV = (const bf16_t*)(p->ws + OFF_ACT + ACT_CTXV);
    const bf16_t* RAWS = (const bf16_t*)(p->ws + OFF_ACT + ACT_RAWS);
    const float* GP = (const float*)(p->ws + OFF_ACT + ACT_GP);
    float* MSC = (float*)(p->ws + OFF_ACT + ACT_MSC) + (size_t)bid * 132 * 192;
    bf16_t* H = d == 0 ? (bf16_t*)p->out : (bf16_t*)(p->ws + OFF_ARENA + A_HB);
    static_assert(64 * MS_KLD + 64 * MS_QLD + 3 * 8192 + (6 * 64 + 8 + 64 + 512) * 4 <= LDS_BYTES, "mscan lds");
    {
        const float bias_i = p->m_b_gates[d * 8 + h], bias_f = p->m_b_gates[d * 8 + 4 + h];
        for (int st = w; st < 132; st += 8) {
            const int cid = scan_chunk(b, d, st), t = d ? 63 - lane : lane;
            const float* gp = GP + (size_t)(cid * 64 + t) * 64;
            const float gli = gp[d * 8 + h] + gp[16 + d * 8 + h] + gp[32 + d * 8 + h] + gp[48 + d * 8 + h] + bias_i;
            const float gf = gp[d * 8 + 4 + h] + gp[16 + d * 8 + 4 + h] + gp[32 + d * 8 + 4 + h] + gp[48 + d * 8 + 4 + h] + bias_f;
            float bb = log_sigmoidf_(gf);
#pragma unroll
            for (int o = 1; o < 64; o <<= 1) { const float t_ = __shfl_up(bb, o); if (lane >= o) bb += t_; }
            float pm = gli - bb;
#pragma unroll
            for (int o = 1; o < 64; o <<= 1) { const float t_ = __shfl_up(pm, o); if (lane >= o) pm = fmaxf(pm, t_); }
            float* dst = MSC + (size_t)st * 192;
            dst[lane] = bb; dst[64 + lane] = gli; dst[128 + lane] = pm;
        }
    }
    const int c16o = tid & 63;
    bf16x2_t Mp[2][4][2];
#pragma unroll
    for (int n = 0; n < 2; ++n) {
        const float* mm = (const float*)(p->ws + OFF_MMAT) + (size_t)(h * 128 + 2 * c16o + n) * 16;
#pragma unroll
        for (int o = 0; o < 4; ++o) { Mp[n][o][0] = __builtin_bit_cast(bf16x2_t, pk2(mm[o], mm[4 + o])); Mp[n][o][1] = __builtin_bit_cast(bf16x2_t, pk2(mm[8 + o], mm[12 + o])); }
    }
    f32x4 C[16];
#pragma unroll
    for (int i = 0; i < 16; ++i) C[i] = (f32x4){0.f, 0.f, 0.f, 0.f};
    f32x4 Nacc[4];
#pragma unroll
    for (int i = 0; i < 4; ++i) Nacc[i] = (f32x4){0.f, 0.f, 0.f, 0.f};
    { MS_REGIONS(lds) nvec[tid] = 0.f; (void)xct; (void)vt; (void)sc_b; (void)red; }
    float m_prev = 0.f;
    u32x4 xcr[8], vr, rr; float g_b = 0.f, g_li = 0.f, g_pm = 0.f;
    asm volatile("s_waitcnt vmcnt(0)" ::: "memory");
    __syncthreads();
    auto prefetch = [&](int st) {
        int tp = get_tid();
        const int tid = tp, lane = tid & 63, w = tid >> 6;
        const int cid = scan_chunk(b, d, st), r0 = cid * 64;
        const bf16_t* xp = XC + (size_t)(r0 + (tid >> 6)) * 2048 + h * 512 + (tid & 63) * 8;
#pragma unroll
        for (int i = 0; i < 8; ++i) xcr[i] = *(const u32x4*)(xp + (size_t)i * 8 * 2048);
        { const int s_ = tid >> 3, chunk = tid & 7;
          vr = cid < NCHL ? *(const u32x4*)(V + (size_t)(r0 + s_) * 2048 + h * 512 + sl * 64 + chunk * 8) : *(const u32x4*)(CTXV + (size_t)(r0 + s_ - NLAT) * 2048 + h * 512 + sl * 64 + chunk * 8);
          rr = *(const u32x4*)(RAWS + ((size_t)(cid * 4 + h) * 64 + s_) * 64 + chunk * 8); }
        if (w == 0) { const float* src = MSC + (size_t)st * 192; g_b = src[lane]; g_li = src[64 + lane]; g_pm = src[128 + lane]; }
    };
    prefetch(0);
    for (int st = 0; st < 132; ++st) {
        const int cid = scan_chunk(b, d, st);
        const bool emit = cid < NCHL;
        int tl = tid, zoff = 0;
        asm volatile("" : "+v"(tl), "+v"(zoff));
        const int tid = tl, lane = tid & 63, w = tid >> 6, cg = w & 3, kh = w >> 2, g4 = lane >> 4, l15 = lane & 15, c16 = tid & 63, srow0 = tid >> 6;
        MS_REGIONS(lds + zoff)
        __syncthreads();
        {
            lds_t xw_ = xct + srow0 * MS_KLD + c16 * 16;
            lds_t qw_ = qpt + srow0 * MS_QLD + c16 * 16;
#pragma unroll
            for (int i = 0; i < 8; ++i) {
                const unsigned xw[4] = {xcr[i].x, xcr[i].y, xcr[i].z, xcr[i].w};
                float q[8];
#pragma unroll
                for (int n = 0; n < 2; ++n)
#pragma unroll
                    for (int o = 0; o < 4; ++o)
                        q[4 * n + o] = __builtin_amdgcn_fdot2_f32_bf16(__builtin_bit_cast(bf16x2_t, xw[2 * n + 1]), Mp[n][o][1], __builtin_amdgcn_fdot2_f32_bf16(__builtin_bit_cast(bf16x2_t, xw[2 * n]), Mp[n][o][0], 0.f, false), false);
                u32x4 qv; qv.x = pk2(q[0], q[1]); qv.y = pk2(q[2], q[3]); qv.z = pk2(q[4], q[5]); qv.w = pk2(q[6], q[7]);
                *(LAS u32x4*)(xw_ + i * 8 * MS_KLD) = xcr[i];
                *(LAS u32x4*)(qw_ + i * 8 * MS_QLD) = qv;
            }
        }
        { const int s_ = tid >> 3, chunk = tid & 7;
          *(LAS u32x4*)(vt + s_ * 64 + chunk * 8) = vr;
          *(LAS u32x4*)(St + s_ * 64 + chunk * 8) = rr; }
        if (w == 0) {
            const float my_m = g_b + fmaxf(m_prev, g_pm);
            const float m_new = __shfl(my_m, 63), b_last = __shfl(g_b, 63);
            const int t = d ? 63 - lane : lane;
            sc_b[t] = g_b; sc_m[t] = my_m; sc_li[t] = g_li - g_b; sc_w[t] = __expf(b_last - g_b + g_li - m_new); sc_di[t] = __expf(g_b + m_prev - my_m);
            qn[lane] = 0.f;
            if (lane == 0) sc_misc[0] = __expf(b_last + m_prev - m_new);
            m_prev = m_new;
        }
        __syncthreads();
        if (emit) {
            const int t = tid & 63, part = tid >> 6;
            float a = 0.f;
            lds_t qr = qpt + t * MS_QLD + part * 128;
            const LAS float* nn = nvec + part * 64;
#pragma unroll
            for (int i = 0; i < 8; ++i) {
                const u32x4 qq = *(const LAS u32x4*)(qr + i * 16);
                const f32x4 n0 = *(const LAS f32x4*)(nn + 8 * i), n1 = *(const LAS f32x4*)(nn + 8 * i + 4);
                a += lo_bf(qq.x) * n0[0] + hi_bf(qq.x) * n0[1] + lo_bf(qq.y) * n0[2] + hi_bf(qq.y) * n0[3] + lo_bf(qq.z) * n1[0] + hi_bf(qq.z) * n1[1] + lo_bf(qq.w) * n1[2] + hi_bf(qq.w) * n1[3];
            }
            __hip_atomic_fetch_add((float*)(qn + t), a, __ATOMIC_RELAXED, __HIP_MEMORY_SCOPE_WORKGROUP);
        }
        {
            const int t = tid >> 3, s8 = (tid & 7) * 8;
            if (emit) {
                const u32x4 rw = *(const LAS u32x4*)(St + t * 64 + s8);
                const unsigned rwv[4] = {rw.x, rw.y, rw.z, rw.w};
                const float base = sc_b[t] - sc_m[t];
                const f32x4 e0 = *(const LAS f32x4*)(sc_li + s8), e1 = *(const LAS f32x4*)(sc_li + s8 + 4);
                float sv[8]; float rsum = 0.f;
#pragma unroll
                for (int j = 0; j < 8; ++j) {
                    const int s_ = s8 + j;
                    const float raw = (j & 1) ? hi_bf(rwv[j >> 1]) : lo_bf(rwv[j >> 1]);
                    const bool keep = d == 0 ? s_ <= t : s_ >= t;
                    const float ex = __expf(base + (j < 4 ? e0[j & 3] : e1[j & 3]));
                    sv[j] = keep ? raw * ex : 0.f;
                    rsum += sv[j];
                }
                u32x4 o; o.x = pk2(sv[0], sv[1]); o.y = pk2(sv[2], sv[3]); o.z = pk2(sv[4], sv[5]); o.w = pk2(sv[6], sv[7]);
                *(LAS u32x4*)(St + t * 64 + s8) = o;
                rsum += __shfl_xor(rsum, 1); rsum += __shfl_xor(rsum, 2); rsum += __shfl_xor(rsum, 4);
                if ((tid & 7) == 0) sc_rs[t] = rsum;
            }
            {
                const u32x4 vv = *(const LAS u32x4*)(vt + t * 64 + s8);
                const float ww = sc_w[t];
                u32x4 o; o.x = pk2(lo_bf(vv.x) * ww, hi_bf(vv.x) * ww); o.y = pk2(lo_bf(vv.y) * ww, hi_bf(vv.y) * ww); o.z = pk2(lo_bf(vv.z) * ww, hi_bf(vv.z) * ww); o.w = pk2(lo_bf(vv.w) * ww, hi_bf(vv.w) * ww);
                *(LAS u32x4*)(vwt + t * 64 + s8) = o;
            }
        }
        __syncthreads();
        f32x4 acc2[4];
#pragma unroll
        for (int tt = 0; tt < 4; ++tt) acc2[tt] = (f32x4){0.f, 0.f, 0.f, 0.f};
        if (emit) {
            lds_t qa = qpt + l15 * MS_QLD + (kh * 256 + 4 * g4) * 2;
            u32x2 qb[2][4][2];
#pragma unroll
            for (int tt = 0; tt < 4; ++tt) { qb[0][tt][0] = *(const LAS u32x2*)(qa + tt * 16 * MS_QLD); qb[0][tt][1] = *(const LAS u32x2*)(qa + tt * 16 * MS_QLD + 32); }
#pragma unroll
            for (int m = 0; m < 8; ++m) {
                if (m + 1 < 8) {
#pragma unroll
                    for (int tt = 0; tt < 4; ++tt) { qb[(m + 1) & 1][tt][0] = *(const LAS u32x2*)(qa + tt * 16 * MS_QLD + (m + 1) * 64); qb[(m + 1) & 1][tt][1] = *(const LAS u32x2*)(qa + tt * 16 * MS_QLD + (m + 1) * 64 + 32); }
                }
                u32x4 cb; cb.x = pk2(C[2 * m][0], C[2 * m][1]); cb.y = pk2(C[2 * m][2], C[2 * m][3]); cb.z = pk2(C[2 * m + 1][0], C[2 * m + 1][1]); cb.w = pk2(C[2 * m + 1][2], C[2 * m + 1][3]);
                const bf16x8 cf = __builtin_bit_cast(bf16x8, cb);
#pragma unroll
                for (int tt = 0; tt < 4; ++tt) {
                    u32x4 av; av.x = qb[m & 1][tt][0].x; av.y = qb[m & 1][tt][0].y; av.z = qb[m & 1][tt][1].x; av.w = qb[m & 1][tt][1].y;
                    acc2[tt] = mfma16(cf, __builtin_bit_cast(bf16x8, av), acc2[tt]);
                }
            }
            const bf16x8 vf = frag_tr(vt, 64, kh * 32, cg * 16, lane);
#pragma unroll
            for (int tt = 0; tt < 4; ++tt) {
                acc2[tt] = acc2[tt] * sc_di[tt * 16 + l15];
                acc2[tt] = mfma16(vf, frag_row(St, 64, tt * 16, kh * 32, lane), acc2[tt]);
            }
        }
        if (st + 1 < 132) prefetch(st + 1);
        {
            const float gd = sc_misc[0];
            bf16x8 vb[2], wf[2];
#pragma unroll
            for (int ks = 0; ks < 2; ++ks) {
                vb[ks] = frag_tr(vwt, 64, ks * 32, cg * 16, lane);
                const f32x4 w0 = *(const LAS f32x4*)(sc_w + ks * 32 + 8 * g4), w1 = *(const LAS f32x4*)(sc_w + ks * 32 + 8 * g4 + 4);
                u32x4 wp; wp.x = pk2(w0[0], w0[1]); wp.y = pk2(w0[2], w0[3]); wp.z = pk2(w1[0], w1[1]); wp.w = pk2(w1[2], w1[3]);
                if (l15 != 0) wp = (u32x4){0u, 0u, 0u, 0u};
                wf[ks] = __builtin_bit_cast(bf16x8, wp);
            }
#pragma unroll
            for (int j = 0; j < 4; ++j) Nacc[j] = Nacc[j] * gd;
            lds_t ka = xct + (8 * g4 + (l15 >> 2)) * MS_KLD + (kh * 256 + 4 * (l15 & 3)) * 2;
            const int cg_s = __builtin_amdgcn_readfirstlane(cg);
            s16x4 kb[2][2][2];
#pragma unroll
            for (int ks = 0; ks < 2; ++ks) {
                kb[0][ks][0] = __builtin_amdgcn_ds_read_tr16_b64_v4i16((LAS s16x4*)(ka + ks * 32 * MS_KLD));
                kb[0][ks][1] = __builtin_amdgcn_ds_read_tr16_b64_v4i16((LAS s16x4*)(ka + ks * 32 * MS_KLD + 4 * MS_KLD));
            }
#pragma unroll
            for (int i = 0; i < 16; ++i) {
                if (i + 1 < 16) {
#pragma unroll
                    for (int ks = 0; ks < 2; ++ks) {
                        kb[(i + 1) & 1][ks][0] = __builtin_amdgcn_ds_read_tr16_b64_v4i16((LAS s16x4*)(ka + ks * 32 * MS_KLD + (i + 1) * 32));
                        kb[(i + 1) & 1][ks][1] = __builtin_amdgcn_ds_read_tr16_b64_v4i16((LAS s16x4*)(ka + ks * 32 * MS_KLD + 4 * MS_KLD + (i + 1) * 32));
                    }
                }
                C[i] = C[i] * gd;
                const bool own = ((i >> 1) & 3) == cg_s;
#pragma unroll
                for (int ks = 0; ks < 2; ++ks) {
                    const bf16x8 kf = __builtin_shufflevector(kb[i & 1][ks][0], kb[i & 1][ks][1], 0, 1, 2, 3, 4, 5, 6, 7);
                    C[i] = mfma16(kf, vb[ks], C[i]);
                    if (own) Nacc[(i >> 3) * 2 + (i & 1)] = mfma16(kf, wf[ks], Nacc[(i >> 3) * 2 + (i & 1)]);
                }
            }
            if (l15 == 0) {
#pragma unroll
                for (int j = 0; j < 4; ++j) *(LAS f32x4*)(nvec + kh * 256 + (2 * cg + (j & 1) + 8 * (j >> 1)) * 16 + 4 * g4) = Nacc[j];
            }
        }
        __syncthreads();
        if (emit && kh == 1) {
#pragma unroll
            for (int tt = 0; tt < 4; ++tt) *(LAS f32x4*)(red + ((cg * 4 + tt) * 64 + lane) * 4) = acc2[tt];
        }
        __syncthreads();
        if (emit && kh == 0) {
#pragma unroll
            for (int tt = 0; tt < 4; ++tt) {
                const int t = tt * 16 + l15;
                const f32x4 o = acc2[tt] + *(const LAS f32x4*)(red + ((cg * 4 + tt) * 64 + lane) * 4);
                const float dn = fmaxf(fabsf(sc_di[t] * qn[t] + sc_rs[t]), __expf(-sc_m[t]));
                store_bf16x4(H + (size_t)(cid * 64 + t) * 2048 + h * 512 + sl * 64 + cg * 16 + 4 * g4, o * (1.f / dn));
            }
        }
    }
}

DI void phase_merge(PP p) {
    const int tid = get_tid(), lane = tid & 63;
    const bf16_t* HF = (const bf16_t*)p->out;
    bf16_t* HB = (bf16_t*)(p->ws + OFF_ARENA + A_HB);
    const bf16_t* XC = (const bf16_t*)(p->ws + OFF_ARENA + A_XC);
    const bf16_t* Z = (const bf16_t*)(p->ws + OFF_ARENA + A_XM);
    const int gw = get_bid() * 8 + (tid >> 6), nw = gridDim.x * 8;
    for (int r = gw; r < NLAT; r += nw) {
#pragma unroll
        for (int hh = 0; hh < 4; ++hh) {
            const size_t o = (size_t)r * 2048 + hh * 512 + lane * 8;
            const u32x4 a = *(const u32x4*)(HF + o), b = *(const u32x4*)(HB + o), xq = *(const u32x4*)(XC + o), zq = *(const u32x4*)(Z + o);
            const unsigned aw[4] = {a.x, a.y, a.z, a.w}, bw[4] = {b.x, b.y, b.z, b.w}, xw[4] = {xq.x, xq.y, xq.z, xq.w}, zw[4] = {zq.x, zq.y, zq.z, zq.w};
            float hv[8]; float sum = 0.f;
#pragma unroll
            for (int j = 0; j < 4; ++j) { hv[2 * j] = lo_bf(aw[j]) + lo_bf(bw[j]); hv[2 * j + 1] = hi_bf(aw[j]) + hi_bf(bw[j]); sum += hv[2 * j] + hv[2 * j + 1]; }
            const float mean = wave_sum(sum) * (1.f / 512.f);
            float sq = 0.f;
#pragma unroll
            for (int j = 0; j < 8; ++j) { hv[j] -= mean; sq += hv[j] * hv[j]; }
            const float rs = rsqrtf(wave_sum(sq) * (1.f / 512.f) + EPS);
            float ov[8];
#pragma unroll
            for (int j = 0; j < 8; ++j) {
                const int c = hh * 512 + lane * 8 + j;
                const float xcv = (j & 1) ? hi_bf(xw[j >> 1]) : lo_bf(xw[j >> 1]);
                const float zv = (j & 1) ? hi_bf(zw[j >> 1]) : lo_bf(zw[j >> 1]);
                ov[j] = (hv[j] * rs * p->m_norm_g[c] + p->m_skip[c] * xcv) * siluf_(zv);
            }
            u32x4 v; v.x = pk2(ov[0], ov[1]); v.y = pk2(ov[2], ov[3]); v.z = pk2(ov[4], ov[5]); v.w = pk2(ov[6], ov[7]);
            *(u32x4*)(HB + o) = v;
        }
    }
}

DI void phase_downproj(PP p, lds_t lds) {
    const bf16_t* A = (const bf16_t*)(p->ws + OFF_ARENA + A_HB);
    float* X = (float*)(p->ws + OFF_ARENA + A_X);
    constexpr int NM = NLAT / 256, NN = 4;
    for_units_xcd(1, NM, NN, 8, 4, [&](int, int pm, int pn) {
        const float* g1 = mods_ptr(p, 1, pm >> 5, 2);
        gemm_unit_t<64>(lds, 2048,
            [&](int r) { return A + (size_t)(pm * 256 + r) * 2048; },
            [&](int r) { return (const bf16_t*)(p->ws + OFF_WDNT) + (size_t)(pn * 256 + r) * 2048; },
            [&](const f32x4 (&acc)[8][4], int wr, int wc, int lane) {
                epi_each<4>(acc, wr, wc, lane, [&](int r, int c, f32x4 v) {
                    const int col = pn * 256 + c;
                    float* xp = X + (size_t)(pm * 256 + r) * 1024 + col;
                    const f32x4 g = *(const f32x4*)(g1 + col);
                    *(f32x4*)xp = *(const f32x4*)xp + g * v;
                });
            });
    });
}

DI void phase_dbg_final(PP p, int mode) {
    const int tid = get_tid(), lane = tid & 63;
    const int gw = get_bid() * 8 + (tid >> 6), nw = gridDim.x * 8;
    if (mode == 4) {
        const int* rid = (const int*)(p->ws + OFF_ARENA + A_ROWID);
        for (int r = gw; r < NLAT; r += nw)
            for (int c = lane; c < 1024; c += 64) p->out[(size_t)r * 1024 + c] = (float)rid[(size_t)r * 16 + (c & 15)];
        return;
    }
    if (mode == 7) {
        const bf16_t* y = (const bf16_t*)(p->ws + OFF_ARENA + A_Y);
        for (int r = gw; r < NLAT; r += nw)
            for (int c = lane; c < 1024; c += 64) { const float v = bf2f(y[(size_t)r * 1024 + c]); p->out[(size_t)r * 1024 + c] = (v == v && fabsf(v) < 1e30f) ? 0.f : 1000.f; }
        return;
    }
    if (mode >= 2) {
        const bf16_t* src = mode == 2 ? (const bf16_t*)(p->ws + OFF_ARENA + A_P) : mode == 5 ? (const bf16_t*)(p->ws + OFF_ARENA + A_HDN) : mode == 6 ? (const bf16_t*)(p->ws + OFF_ARENA + A_Y) : (const bf16_t*)(p->ws + OFF_ACT);
        const int ld = mode == 2 ? ABIN : 1024;
        for (int r = gw; r < NLAT; r += nw)
            for (int c = lane; c < 1024; c += 64) p->out[(size_t)r * 1024 + c] = bf2f(src[(size_t)r * ld + (mode == 2 ? c + DBG_COL0 : c)]);
        return;
    }
    const float* X = mode ? (const float*)(p->ws + OFF_ARENA + A_X) : p->x;
    for (int r = gw; r < NLAT; r += nw) {
        f32x4 v[4];
        row_load_f32(X + (size_t)r * 1024, v, lane);
        const float rs = rsqrtf(row_sumsq(v) * (1.f / 1024.f) + EPS);
#pragma unroll
        for (int i = 0; i < 4; ++i) { const f32x4 g = *(const f32x4*)(p->final_g + 4 * lane + 256 * i); *(f32x4*)(p->out + (size_t)r * 1024 + 4 * lane + 256 * i) = v[i] * rs * g; }
    }
}

DI void grid_barrier(cg::grid_group& grid, PP p, unsigned& nbar) {
    asm volatile("s_waitcnt vmcnt(0) lgkmcnt(0)" ::: "memory");
    unsigned* ctr = (unsigned*)(p->ws + OFF_BAR);
    if (nbar == 0) {
        if (blockIdx.x == 0 && threadIdx.x == 0) __hip_atomic_store(ctr, 0u, __ATOMIC_RELAXED, __HIP_MEMORY_SCOPE_AGENT);
        asm volatile("s_waitcnt vmcnt(0)" ::: "memory");
        grid.sync();
        __builtin_amdgcn_fence(__ATOMIC_ACQUIRE, "agent");
        asm volatile("s_waitcnt vmcnt(0)" ::: "memory");
    } else {
        __syncthreads();
        if (threadIdx.x == 0) {
            __builtin_amdgcn_fence(__ATOMIC_RELEASE, "agent");
            asm volatile("s_waitcnt vmcnt(0)" ::: "memory");
            __hip_atomic_fetch_add(ctr, 1u, __ATOMIC_RELAXED, __HIP_MEMORY_SCOPE_AGENT);
            const unsigned target = nbar * gridDim.x;
            while (__hip_atomic_load(ctr, __ATOMIC_RELAXED, __HIP_MEMORY_SCOPE_AGENT) < target) __builtin_amdgcn_s_sleep(1);
            __builtin_amdgcn_fence(__ATOMIC_ACQUIRE, "agent");
            asm volatile("s_waitcnt vmcnt(0)" ::: "memory");
        }
        __syncthreads();
    }
    ++nbar;
}
#define RUN_PHASE(K, CALL) if (ph_lo <= (K) && (K) < ph_hi && ((K) <= DBG_STOP)) { PP p = kp; asm volatile("" : "+s"(p)); CALL; if ((DUP_MASK >> (K)) & 1) { grid_barrier(grid, p, nbar); asm volatile("" : "+s"(p)); CALL; } if ((K) + 1 < ph_hi) { grid_barrier(grid, p, nbar); if (EXTRA_BARRIERS) grid_barrier(grid, p, nbar); } }
__global__ void __launch_bounds__(NTHREADS) mega(Params p_in) {
    extern __shared__ __attribute__((aligned(16))) unsigned char lds_raw[];
    lds_t lds = (lds_t)lds_raw;
    cg::grid_group grid = cg::this_grid();
    PP kp = (PP)__builtin_amdgcn_kernarg_segment_ptr();
    const int ph_lo = kp->ph_lo, ph_hi = kp->ph_hi;
    unsigned nbar = 0;
    RUN_PHASE(0, phase_mods(p, lds))
    RUN_PHASE(1, phase_norm(p, 0, NTOK, [&](int r) { return r < NLAT ? p->x + (size_t)r * 1024 : p->ctx + (size_t)(r - NLAT) * 1024; }))
    RUN_PHASE(2, phase_inproj(p, lds))
    RUN_PHASE(3, phase_g1(p, lds))
    RUN_PHASE(4, phase_scan0(p))
    RUN_PHASE(5, phase_g3(p, lds))
    RUN_PHASE(6, phase_outproj0(p, lds))
    RUN_PHASE(7, phase_router(p, lds, 0))
    RUN_PHASE(8, phase_topk(p, lds, 0))
    RUN_PHASE(9, phase_moe_up(p, lds, 0))
    RUN_PHASE(10, phase_moe_down(p, lds, 0))
    RUN_PHASE(11, phase_combine(p, 0))
    RUN_PHASE(12, phase_upproj(p, lds, 0))
    RUN_PHASE(13, phase_mfeat(p, lds))
    RUN_PHASE(14, phase_mscan(p, lds))
    RUN_PHASE(15, phase_norm(p, 1, NLAT, [&](int r) { return (const float*)(p->ws + OFF_ARENA + A_X) + (size_t)r * 1024; }))
    RUN_PHASE(16, phase_upproj(p, lds, 1))
    RUN_PHASE(17, phase_merge(p))
    RUN_PHASE(18, phase_downproj(p, lds))
    RUN_PHASE(19, phase_router(p, lds, 1))
    RUN_PHASE(20, phase_topk(p, lds, 1))
    RUN_PHASE(21, phase_moe_up(p, lds, 1))
#if GEMM_PROBE >= 0
    if (ph_lo <= 22 && 22 < ph_hi) { PP p = kp; asm volatile("" : "+s"(p)); phase_moe_down_t<GEMM_PROBE>(p, lds, 1); grid_barrier(grid, p, nbar); }
#endif
    RUN_PHASE(22, phase_moe_down(p, lds, 1))
    RUN_PHASE(23, phase_combine(p, 1))
    if (DBG_STOP < 23 && DBG_STOP + 1 < ph_hi) { PP p = kp; asm volatile("" : "+s"(p)); phase_dbg_final(p, DBG_MODE); }
}

extern "C" void kernel_launch(void* const* d_in, const int* in_sizes, int n_in, void* d_out, int out_size, void* d_ws, size_t ws_size, hipStream_t stream) {
    static int grid = 0;
    if (grid == 0) {
        int dev = 0, cus = 0, per_cu = 0;
        hipGetDevice(&dev);
        hipDeviceGetAttribute(&cus, hipDeviceAttributeMultiprocessorCount, dev);
        hipFuncSetAttribute((const void*)mega, hipFuncAttributeMaxDynamicSharedMemorySize, LDS_BYTES);
        hipOccupancyMaxActiveBlocksPerMultiprocessor(&per_cu, (const void*)mega, NTHREADS, LDS_BYTES);
        if (per_cu < 1) { fprintf(stderr, "occupancy query says %d blocks/CU\n", per_cu); per_cu = 1; }
        grid = cus;
        if (ws_size < WS_NEED) { fprintf(stderr, "workspace too small: %zu < %zu\n", ws_size, (size_t)WS_NEED); grid = -1; }
    }
    if (grid < 0) return;
    Params hp{};
    const float** pp = (const float**)&hp;
    for (int i = 0; i < 36; ++i) pp[i] = (const float*)d_in[i];
    hp.out = (float*)d_out; hp.ws = (char*)d_ws; hp.ph_lo = 0; hp.ph_hi = DBG_STOP < 23 ? DBG_STOP + 2 : 24;
    void* args[] = {&hp};
    hipError_t e = hipLaunchCooperativeKernel((const void*)mega, dim3(grid), dim3(NTHREADS), args, LDS_BYTES, stream);
    if (e != hipSuccess) fprintf(stderr, "cooperative launch failed: %s\n", hipGetErrorString(e));
}
```

```cpp
#include <hip/hip_runtime.h>
#include <hip/hip_cooperative_groups.h>
#include <cstdio>
#include <cstdint>
namespace cg = cooperative_groups;

#define LAS __attribute__((address_space(3)))
#define DI __device__ __forceinline__
typedef unsigned short bf16_t;
typedef short bf16x8 __attribute__((ext_vector_type(8)));
typedef short s16x4 __attribute__((ext_vector_type(4)));
typedef float f32x4 __attribute__((ext_vector_type(4)));
typedef float f32x2 __attribute__((ext_vector_type(2)));
typedef unsigned u32x4 __attribute__((ext_vector_type(4)));
typedef unsigned u32x2 __attribute__((ext_vector_type(2)));
typedef LAS char* lds_t;

constexpr int D = 1024, NBATCH = 4, SEQ = 8192, CTXL = 256;
constexpr int NLAT = NBATCH * SEQ;
constexpr int NCTX = NBATCH * CTXL;
constexpr int NTOK = NLAT + NCTX;
constexpr int NCH = NTOK / 64;
constexpr int NCHL = NLAT / 64;
constexpr int ABIN = 2592;
constexpr int PC_Q = 0, PC_K = 256, PC_V = 512, PC_G = 1024, PC_LRF = 1536, PC_LRB = 1552, PC_RGG = 1568, PC_RGX = 2080;
constexpr float EPS = 1e-6f;
constexpr int NTHREADS = 512;
constexpr int LDS_BYTES = 160 * 1024;
#define DBG_MODE 1
#ifndef DUP_MASK
#define DUP_MASK 0
#endif
#ifndef GEMM_PROBE
#define GEMM_PROBE -1
#endif
#ifndef EXTRA_BARRIERS
#define EXTRA_BARRIERS 0
#endif
#define DBG_STOP 23
#define DBG_COL0 0

constexpr size_t OFF_MODS = 0;
constexpr size_t OFF_GCAT = 245760;
constexpr size_t OFF_MMAT = 376832;
constexpr size_t OFF_BAR = 409600;
constexpr size_t OFF_ACT = 1u << 20;
constexpr size_t ACT_BYTES = (size_t)NTOK * 1024 * 2;
constexpr size_t OFF_ARENA = OFF_ACT + ACT_BYTES;
constexpr size_t A_P = 0;
constexpr size_t A_U = A_P + (size_t)NTOK * ABIN * 2;
constexpr size_t A_LA = A_U + (size_t)NCH * 2 * 4 * 8192 * 4;
constexpr size_t A_UU = A_LA + (size_t)NTOK * 2 * 512 * 4;
constexpr size_t A_DEC = A_UU + (size_t)NTOK * 2 * 512 * 2;
constexpr size_t A_AGGA = A_DEC + (size_t)NCH * 2 * 256 * 4;
constexpr size_t A_AGGH = A_AGGA + (size_t)NCH * 2 * 512 * 4;
constexpr size_t A_L0_END = A_AGGH + (size_t)NCH * 2 * 512 * 4;
constexpr size_t A_X = 0;
constexpr size_t A_PT = A_X + (size_t)NTOK * 1024 * 4;
constexpr size_t A_PE = A_PT + (size_t)NTOK * 16 * 4;
constexpr size_t A_ROWID = A_PE + (size_t)NTOK * 16 * 4;
constexpr size_t A_ROWTOK = A_ROWID + (size_t)NTOK * 16 * 4;
constexpr size_t A_HDN = A_ROWTOK + (size_t)16 * 4352 * 4;
constexpr size_t A_Y = A_HDN + (size_t)16 * 4352 * 1024 * 2;
constexpr size_t A_MOE0_END = A_Y + (size_t)16 * 4352 * 1024 * 2;
constexpr size_t A_XM = A_X + (size_t)NTOK * 1024 * 4;
constexpr size_t A_XC = A_XM + (size_t)NTOK * 2048 * 2;
constexpr size_t A_HB = A_XC + (size_t)NTOK * 2048 * 2;
constexpr size_t A_L1_END = A_HB + (size_t)NLAT * 2048 * 2;
constexpr size_t ACT_RAWS = 0;
constexpr size_t ACT_GP = ACT_RAWS + (size_t)NCH * 4 * 4096 * 2;
constexpr size_t ACT_CTXV = ACT_GP + (size_t)NTOK * 64 * 4;
constexpr size_t WS_NEED0 = OFF_ARENA + (A_L1_END > A_L0_END ? A_L1_END : A_L0_END);
constexpr size_t OFF_WUPT = WS_NEED0;
constexpr size_t OFF_WDNT = OFF_WUPT + (size_t)4096 * 1024 * 2;
constexpr size_t WS_NEED = OFF_WDNT + (size_t)1024 * 2048 * 2;
constexpr size_t DO_WIN = 0;
constexpr size_t DO_WOUT = (size_t)2816 * 1024 * 2;
constexpr size_t DO_EXP = 8u << 20;
constexpr size_t EXP_STRIDE = (size_t)3072 * 1024 * 2;
constexpr int GUG = 32;
static_assert(DO_EXP + 16 * EXP_STRIDE <= (size_t)NLAT * 1024 * 4, "d_out staging");
static_assert(A_MOE0_END < A_L1_END, "arena");
static_assert(ACT_CTXV + (size_t)NCTX * 2048 * 2 <= ACT_BYTES, "act region");

struct Params {
    const float *x, *c, *ctx, *c_ctx, *mod_w, *mod_b, *norm1_g, *norm2_g, *ab_w_in, *gla_wa2, *gla_ba, *gla_norm_g;
    const float *rg_conv_w, *rg_conv_b, *rg_wr, *rg_br, *rg_wi, *rg_bi, *rg_lambda, *ab_w_out, *m_w_up, *m_conv_w, *m_conv_b;
    const float *m_wq, *m_wk, *m_wv, *m_w_gates, *m_b_gates, *m_skip, *m_norm_g, *m_w_down, *router_w, *exp_w_gate, *exp_w_up, *exp_w_down, *final_g;
    float* out;
    char* ws;
    int ph_lo, ph_hi;
};

typedef const Params __attribute__((address_space(4)))* PP;

DI int get_tid() { int t = threadIdx.x; asm volatile("" : "+v"(t)); return t; }
DI int get_bid() { int b = blockIdx.x; asm volatile("" : "+s"(b)); return b; }
DI float bf2f(bf16_t h) { return __uint_as_float((unsigned)h << 16); }
DI bf16_t f2bf(float x) { unsigned u = __float_as_uint(x); u += 0x7fffu + ((u >> 16) & 1u); return (bf16_t)(u >> 16); }
typedef __bf16 bf16x2_t __attribute__((ext_vector_type(2)));
DI unsigned pk2n(float lo, float hi) { const f32x2 v = {lo, hi}; return __builtin_bit_cast(unsigned, __builtin_convertvector(v, bf16x2_t)); }
DI unsigned pk2(float lo, float hi) { return pk2n(lo, hi); }
DI float lo_bf(unsigned u) { return __uint_as_float(u << 16); }
DI float hi_bf(unsigned u) { return __uint_as_float(u & 0xffff0000u); }
DI float sigmoidf_(float x) { return 1.f / (1.f + __expf(-x)); }
DI float siluf_(float x) { return x / (1.f + __expf(-x)); }
DI float log_sigmoidf_(float z) { return fminf(z, 0.f) - log1pf(__expf(-fabsf(z))); }
DI float softplusf_(float z) { return fmaxf(z, 0.f) + log1pf(__expf(-fabsf(z))); }
DI float gelu_tanh(float x) { const float u = 0.7978845608028654f * (x + 0.044715f * x * x * x); return 0.5f * x * (1.f + tanhf(u)); }
DI float wave_sum(float v) {
#pragma unroll
    for (int o = 32; o > 0; o >>= 1) v += __shfl_xor(v, o);
    return v;
}
DI f32x4 mfma16(bf16x8 a, bf16x8 b, f32x4 c) { return __builtin_amdgcn_mfma_f32_16x16x32_bf16(a, b, c, 0, 0, 0); }

DI bf16x8 frag_row(const LAS bf16_t* tile, int ld, int r0, int k0, int lane) {
    return *(const LAS bf16x8*)(tile + (r0 + (lane & 15)) * ld + k0 + 8 * (lane >> 4));
}
DI bf16x8 frag_tr(const LAS bf16_t* tile, int ld, int k0, int c0, int lane) {
    const int g = lane >> 4, i = lane & 15, q = i >> 2, p = i & 3;
    const LAS bf16_t* base = tile + (k0 + 8 * g + q) * ld + c0 + 4 * p;
    const s16x4 lo = __builtin_amdgcn_ds_read_tr16_b64_v4i16((LAS s16x4*)base);
    const s16x4 hi = __builtin_amdgcn_ds_read_tr16_b64_v4i16((LAS s16x4*)(base + 4 * ld));
    return __builtin_shufflevector(lo, hi, 0, 1, 2, 3, 4, 5, 6, 7);
}
DI const float* mods_ptr(PP p, int layer, int s, int which) { return (const float*)(p->ws + OFF_MODS) + ((size_t)(layer * 5 + s) * 6 + which) * 1024; }
DI int row_set(int r) { return r < NLAT ? (r >> 13) : 4; }

template <int BN, int BK, int PROBE = 0, class ARow, class BCol, class Epi>
DI void gemm_unit(lds_t lds, int K, int ldb, ARow arow, BCol bcol, Epi epi) {
    constexpr int NT = BN / 64;
    constexpr int LDA = BK + 8, LDB = BN + 16;
    constexpr int A_BYTES = 256 * LDA * 2, B_BYTES = BK * LDB * 2;
    static_assert(2 * A_BYTES + 2 * B_BYTES <= LDS_BYTES, "gemm lds");
    const int tid = get_tid(), lane = tid & 63, w = tid >> 6, wr = w >> 2, wc = w & 3;
    constexpr int ACH = BK / 8, ARP = NTHREADS / ACH, AP = 256 / ARP;
    const int achunk = tid % ACH, arow0 = tid / ACH;
    const bf16_t* ap[AP];
#pragma unroll
    for (int q = 0; q < AP; ++q) ap[q] = arow(arow0 + ARP * q);
    constexpr int CG = BN / 8, KR = NTHREADS / CG, BP = BK / KR;
    const int bc8 = tid % CG, bk0 = tid / CG;
    const float* bp = bcol(bc8 * 8);
    u32x4 areg[AP];
    f32x4 breg[BP][2];
    auto gload = [&](int kt) {
        const int k0 = kt * BK;
#pragma unroll
        for (int q = 0; q < AP; ++q) areg[q] = ap[q] ? *(const u32x4*)(ap[q] + k0 + achunk * 8) : (u32x4){0u, 0u, 0u, 0u};
#pragma unroll
        for (int q = 0; q < BP; ++q) {
            if (bp) { const float* s = bp + (size_t)(k0 + bk0 + KR * q) * ldb; breg[q][0] = *(const f32x4*)s; breg[q][1] = *(const f32x4*)(s + 4); }
            else { breg[q][0] = (f32x4){0.f, 0.f, 0.f, 0.f}; breg[q][1] = breg[q][0]; }
        }
    };
    auto lstore = [&](int buf) {
        LAS bf16_t* As = (LAS bf16_t*)(lds + buf * A_BYTES);
        LAS bf16_t* Bs = (LAS bf16_t*)(lds + 2 * A_BYTES + buf * B_BYTES);
#pragma unroll
        for (int q = 0; q < AP; ++q) *(LAS u32x4*)(As + (arow0 + ARP * q) * LDA + achunk * 8) = areg[q];
#pragma unroll
        for (int q = 0; q < BP; ++q) {
            u32x4 v; v.x = pk2(breg[q][0][0], breg[q][0][1]); v.y = pk2(breg[q][0][2], breg[q][0][3]); v.z = pk2(breg[q][1][0], breg[q][1][1]); v.w = pk2(breg[q][1][2], breg[q][1][3]);
            *(LAS u32x4*)(Bs + (bk0 + KR * q) * LDB + bc8 * 8) = v;
        }
    };
    f32x4 acc[8][NT];
#pragma unroll
    for (int mi = 0; mi < 8; ++mi)
#pragma unroll
        for (int ni = 0; ni < NT; ++ni) acc[mi][ni] = (f32x4){0.f, 0.f, 0.f, 0.f};
    const int nk = K / BK;
    gload(0);
    for (int kt = 0; kt < nk; ++kt) {
        lstore(kt & 1);
        __syncthreads();
        if (kt + 1 < nk && PROBE != 1) gload(kt + 1);
        if (PROBE == 2) continue;
        const LAS bf16_t* As = (const LAS bf16_t*)(lds + (kt & 1) * A_BYTES);
        const LAS bf16_t* Bs = (const LAS bf16_t*)(lds + 2 * A_BYTES + (kt & 1) * B_BYTES);
#pragma unroll
        for (int ks = 0; ks < BK / 32; ++ks) {
            bf16x8 wb[NT];
#pragma unroll
            for (int ni = 0; ni < NT; ++ni) wb[ni] = frag_tr(Bs, LDB, ks * 32, wc * (BN / 4) + ni * 16, lane);
#pragma unroll
            for (int mi = 0; mi < 8; ++mi) {
                const bf16x8 xa = frag_row(As, LDA, wr * 128 + mi * 16, ks * 32, lane);
#pragma unroll
                for (int ni = 0; ni < NT; ++ni) acc[mi][ni] = mfma16(wb[ni], xa, acc[mi][ni]);
            }
        }
    }
    epi(acc, wr, wc, lane);
    __syncthreads();
}


template <int BK, class ARow, class BRow, class Epi>
DI void gemm_unit_t(lds_t lds, int K, ARow arow, BRow brow, Epi epi) {
    constexpr int NT = 4;
    constexpr int LD = BK + 8;
    constexpr int T_BYTES = 256 * LD * 2;
    static_assert(4 * T_BYTES <= LDS_BYTES, "gemm lds");
    const int tid = get_tid(), lane = tid & 63, w = tid >> 6, wr = w >> 2, wc = w & 3;
    constexpr int CH = BK / 8, RP = NTHREADS / CH, NP = 256 / RP;
    const int chunk = tid % CH, row0 = tid / CH;
    const bf16_t* ap[NP]; const bf16_t* bp[NP];
#pragma unroll
    for (int q = 0; q < NP; ++q) { ap[q] = arow(row0 + RP * q); bp[q] = brow(row0 + RP * q); }
    u32x4 areg[NP], breg[NP];
    auto gload = [&](int kt) {
        const int k0 = kt * BK;
#pragma unroll
        for (int q = 0; q < NP; ++q) {
            areg[q] = ap[q] ? *(const u32x4*)(ap[q] + k0 + chunk * 8) : (u32x4){0u, 0u, 0u, 0u};
            breg[q] = bp[q] ? *(const u32x4*)(bp[q] + k0 + chunk * 8) : (u32x4){0u, 0u, 0u, 0u};
        }
    };
    auto lstore = [&](int buf) {
        LAS bf16_t* As = (LAS bf16_t*)(lds + buf * 2 * T_BYTES);
        LAS bf16_t* Bs = (LAS bf16_t*)(lds + buf * 2 * T_BYTES + T_BYTES);
#pragma unroll
        for (int q = 0; q < NP; ++q) {
            *(LAS u32x4*)(As + (row0 + RP * q) * LD + chunk * 8) = areg[q];
            *(LAS u32x4*)(Bs + (row0 + RP * q) * LD + chunk * 8) = breg[q];
        }
    };
    f32x4 acc[8][NT];
#pragma unroll
    for (int mi = 0; mi < 8; ++mi)
#pragma unroll
        for (int ni = 0; ni < NT; ++ni) acc[mi][ni] = (f32x4){0.f, 0.f, 0.f, 0.f};
    const int nk = K / BK;
    gload(0);
    for (int kt = 0; kt < nk; ++kt) {
        lstore(kt & 1);
        __syncthreads();
        if (kt + 1 < nk) gload(kt + 1);
        const LAS bf16_t* As = (const LAS bf16_t*)(lds + (kt & 1) * 2 * T_BYTES);
        const LAS bf16_t* Bs = (const LAS bf16_t*)(lds + (kt & 1) * 2 * T_BYTES + T_BYTES);
#pragma unroll
        for (int ks = 0; ks < BK / 32; ++ks) {
            bf16x8 wb[NT], xa[8];
#pragma unroll
            for (int ni = 0; ni < NT; ++ni) wb[ni] = frag_row(Bs, LD, wc * 64 + ni * 16, ks * 32, lane);
#pragma unroll
            for (int mi = 0; mi < 8; ++mi) xa[mi] = frag_row(As, LD, wr * 128 + mi * 16, ks * 32, lane);
            __builtin_amdgcn_sched_barrier(0);
#pragma unroll
            for (int mi = 0; mi < 8; ++mi)
#pragma unroll
                for (int ni = 0; ni < NT; ++ni) acc[mi][ni] = mfma16(wb[ni], xa[mi], acc[mi][ni]);
        }
    }
    epi(acc, wr, wc, lane);
    __syncthreads();
}

DI int g_lds_byte(int r, int c) { const int st = (r >> 4) * 2 + (c >> 5), ob = (r & 15) * 64 + (c & 31) * 2; return st * 1024 + (ob ^ (((ob >> 9) & 1) << 5)); }
DI void g_stage_rc(int b, int& R, int& C) { const int st = b >> 10, sb = b & 1023, swz = sb ^ (((sb >> 9) & 1) << 5); R = (st >> 1) * 16 + (swz >> 6); C = (st & 1) * 32 + ((swz & 63) >> 1); }
template <class ARow, class BRow, class Epi>
DI void gemm_unit_g(lds_t lds, int K, ARow arow, BRow brow, Epi epi) {
    constexpr int NT = 4, HTB = 16384;
    const int tid = get_tid(), lane = tid & 63, w = tid >> 6, wr = w >> 2, wc = w & 3, fr = lane & 15, fq = lane >> 4;
    const int wu = __builtin_amdgcn_readfirstlane(w);
    const bf16_t* sp[2][2][2];
#pragma unroll
    for (int i = 0; i < 2; ++i) {
        int R, C; g_stage_rc(tid * 16 + i * 8192, R, C);
#pragma unroll
        for (int h = 0; h < 2; ++h) { sp[0][h][i] = arow(h * 128 + R) + C; sp[1][h][i] = brow(h * 128 + R) + C; }
    }
    auto stage = [&](int buf, int kt) {
        const int k0 = kt * 64;
#pragma unroll
        for (int x = 0; x < 2; ++x)
#pragma unroll
            for (int h = 0; h < 2; ++h)
#pragma unroll
                for (int i = 0; i < 2; ++i)
                    __builtin_amdgcn_global_load_lds((const unsigned*)(sp[x][h][i] + k0), (LAS unsigned*)(lds + (buf * 4 + x * 2 + h) * HTB + wu * 1024 + i * 8192), 16, 0, 0);
    };
    const int aoff = wr * HTB + g_lds_byte(fr, fq * 8);
    const int boff = (2 + (wc >> 1)) * HTB + g_lds_byte((wc & 1) * 64 + fr, fq * 8);
    f32x4 acc[8][NT];
#pragma unroll
    for (int mi = 0; mi < 8; ++mi)
#pragma unroll
        for (int ni = 0; ni < NT; ++ni) acc[mi][ni] = (f32x4){0.f, 0.f, 0.f, 0.f};
    const int nk = K / 64;
    stage(0, 0);
    asm volatile("s_waitcnt vmcnt(0)" ::: "memory");
    __syncthreads();
    for (int kt = 0; kt < nk; ++kt) {
        const int buf = kt & 1;
        if (kt + 1 < nk) stage(buf ^ 1, kt + 1);
#pragma unroll
        for (int ks = 0; ks < 2; ++ks) {
            bf16x8 wb[NT], xa[8];
#pragma unroll
            for (int ni = 0; ni < NT; ++ni) wb[ni] = *(const LAS bf16x8*)(lds + buf * 4 * HTB + boff + ni * 2048 + ks * 1024);
#pragma unroll
            for (int mi = 0; mi < 8; ++mi) xa[mi] = *(const LAS bf16x8*)(lds + buf * 4 * HTB + aoff + mi * 2048 + ks * 1024);
            __builtin_amdgcn_sched_barrier(0);
#pragma unroll
            for (int mi = 0; mi < 8; ++mi)
#pragma unroll
                for (int ni = 0; ni < NT; ++ni) acc[mi][ni] = mfma16(wb[ni], xa[mi], acc[mi][ni]);
        }
        asm volatile("s_waitcnt vmcnt(0)" ::: "memory");
        __syncthreads();
    }
    epi(acc, wr, wc, lane);
    __syncthreads();
}

template <class F>
DI void for_units_xcd(int NB, int NM, int NN, int TM, int TN, F f) {
    const int bid = get_bid();
    if (gridDim.x != 256) {
        for (int u = bid; u < NB * NM * NN; u += gridDim.x) f(u / (NM * NN), (u % (NM * NN)) % NM, (u % (NM * NN)) / NM);
        return;
    }
    const int xcd = bid & 7, slot = bid >> 3, tsz = TM * TN, per = 32 / tsz;
    const int nsm = (NM + TM - 1) / TM, nsn = (NN + TN - 1) / TN, ntot = NB * nsm * nsn;
    for (int j = 0;; ++j) {
        const int S = (j * 8 + xcd) * per + slot / tsz;
        if ((j * 8) * per >= ntot) break;
        if (S >= ntot) continue;
        const int within = slot % tsz, batch = S / (nsm * nsn), sl = S % (nsm * nsn);
        const int pm = (sl % nsm) * TM + within % TM, pn = (sl / nsm) * TN + within / TM;
        if (pm < NM && pn < NN) f(batch, pm, pn);
    }
}

template <int NT, class F>
DI void epi_each(const f32x4 (&acc)[8][NT], int wr, int wc, int lane, F f) {
#pragma unroll
    for (int mi = 0; mi < 8; ++mi)
#pragma unroll
        for (int ni = 0; ni < NT; ++ni) f(wr * 128 + mi * 16 + (lane & 15), wc * (NT * 16) + ni * 16 + 4 * (lane >> 4), acc[mi][ni]);
}
DI void store_bf16x4(bf16_t* dst, f32x4 v) { u32x2 o; o.x = pk2(v[0], v[1]); o.y = pk2(v[2], v[3]); *(u32x2*)dst = o; }

DI void row_load_f32(const float* src, f32x4 (&v)[4], int lane) {
#pragma unroll
    for (int i = 0; i < 4; ++i) v[i] = *(const f32x4*)(src + 4 * lane + 256 * i);
}
DI float row_sumsq(const f32x4 (&v)[4]) {
    float s = 0.f;
#pragma unroll
    for (int i = 0; i < 4; ++i) s += v[i][0] * v[i][0] + v[i][1] * v[i][1] + v[i][2] * v[i][2] + v[i][3] * v[i][3];
    return wave_sum(s);
}
DI void row_modulate(f32x4 (&v)[4], float rs, const float* g, const float* sc, const float* sh, int lane) {
#pragma unroll
    for (int i = 0; i < 4; ++i) {
        const int c = 4 * lane + 256 * i;
        const f32x4 gg = *(const f32x4*)(g + c), ss = *(const f32x4*)(sc + c), hh = *(const f32x4*)(sh + c);
#pragma unroll
        for (int j = 0; j < 4; ++j) v[i][j] = v[i][j] * rs * gg[j] * (1.f + ss[j]) + hh[j];
    }
}
DI void row_store_bf16(bf16_t* dst, const f32x4 (&v)[4], int lane) {
#pragma unroll
    for (int i = 0; i < 4; ++i) store_bf16x4(dst + 4 * lane + 256 * i, v[i]);
}


template <class RowMap>
DI void conv_tile(const float* W, int ldw, int k0, int n0, int nvalid, bf16_t* Wt, int ldt, RowMap rowmap, lds_t lds) {
    const int tid = get_tid();
    LAS float* t = (LAS float*)lds;
    {
        const int k = tid >> 3, c8 = (tid & 7) * 8;
        f32x4 a = {0.f, 0.f, 0.f, 0.f}, b = a;
        if (n0 + c8 < nvalid) { const float* src = W + (size_t)(k0 + k) * ldw + n0 + c8; a = *(const f32x4*)src; b = *(const f32x4*)(src + 4); }
#pragma unroll
        for (int j = 0; j < 4; ++j) { t[k * 65 + c8 + j] = a[j]; t[k * 65 + c8 + 4 + j] = b[j]; }
    }
    __syncthreads();
    {
        const int n = tid >> 3, k8 = (tid & 7) * 8;
        float v[8];
#pragma unroll
        for (int j = 0; j < 8; ++j) v[j] = t[(k8 + j) * 65 + n];
        u32x4 o; o.x = pk2(v[0], v[1]); o.y = pk2(v[2], v[3]); o.z = pk2(v[4], v[5]); o.w = pk2(v[6], v[7]);
        *(u32x4*)(Wt + (size_t)rowmap(n0 + n) * ldt + k0 + k8) = o;
    }
    __syncthreads();
}
DI int gu_row(int c, int up) { return (c / GUG) * (2 * GUG) + up * GUG + (c % GUG); }
DI void conv_expert_tile(PP p, int layer, int t, lds_t lds) {
    const int e = t / 768, r = t % 768, m = r >> 8, tt = r & 255, kt = tt & 15, nt = tt >> 4;
    bf16_t* base = (bf16_t*)((char*)p->out + DO_EXP + (size_t)e * EXP_STRIDE);
    const size_t woff = ((size_t)layer * 16 + e) * 1048576;
    if (m == 0) conv_tile(p->exp_w_gate + woff, 1024, kt * 64, nt * 64, 1024, base, 1024, [](int n) { return gu_row(n, 0); }, lds);
    else if (m == 1) conv_tile(p->exp_w_up + woff, 1024, kt * 64, nt * 64, 1024, base, 1024, [](int n) { return gu_row(n, 1); }, lds);
    else conv_tile(p->exp_w_down + woff, 1024, kt * 64, nt * 64, 1024, base + (size_t)2048 * 1024, 1024, [](int n) { return n; }, lds);
}
constexpr int NCONV_DENSE = 704 + 256 + 1024 + 512;
DI void conv_dense_tile(PP p, int t, lds_t lds) {
    auto id = [](int n) { return n; };
    if (t < 704) { const int kt = t & 15, nt = t >> 4; conv_tile(p->ab_w_in, ABIN, kt * 64, nt * 64, ABIN, (bf16_t*)((char*)p->out + DO_WIN), 1024, id, lds); return; }
    t -= 704;
    if (t < 256) { const int kt = t & 15, nt = t >> 4; conv_tile(p->ab_w_out, 1024, kt * 64, nt * 64, 1024, (bf16_t*)((char*)p->out + DO_WOUT), 1024, id, lds); return; }
    t -= 256;
    if (t < 1024) { const int kt = t & 15, nt = t >> 4; conv_tile(p->m_w_up, 4096, kt * 64, nt * 64, 4096, (bf16_t*)(p->ws + OFF_WUPT), 1024, id, lds); return; }
    t -= 1024;
    { const int kt = t & 31, nt = t >> 5; conv_tile(p->m_w_down, 1024, kt * 64, nt * 64, 1024, (bf16_t*)(p->ws + OFF_WDNT), 2048, id, lds); }
}

DI void phase_mods(PP p, lds_t lds) {
    const int tid = get_tid();
    LAS float* sil = (LAS float*)lds;
    LAS float* red = sil + 5 * 1024;
    for (int u = get_bid(); u < 192 + 32; u += gridDim.x) {
        if (u < 192) {
            const int layer = u / 96, c0 = (u % 96) * 64;
            for (int i = tid; i < 5 * 1024; i += NTHREADS) { const int s = i >> 10, k = i & 1023; const float cv = s < 4 ? p->c[s * 1024 + k] : p->c_ctx[k]; sil[i] = siluf_(cv); }
            __syncthreads();
            const int col = tid & 63, kp = tid >> 6;
            float a[5] = {0.f, 0.f, 0.f, 0.f, 0.f};
            const float* wp = p->mod_w + (size_t)layer * 1024 * 6144 + c0 + col;
            for (int k = kp * 128; k < kp * 128 + 128; ++k) {
                const float wv = wp[(size_t)k * 6144];
#pragma unroll
                for (int s = 0; s < 5; ++s) a[s] += sil[s * 1024 + k] * wv;
            }
#pragma unroll
            for (int s = 0; s < 5; ++s) red[(kp * 5 + s) * 64 + col] = a[s];
            __syncthreads();
            if (tid < 320) {
                const int s = tid >> 6, cc = tid & 63;
                float t = p->mod_b[layer * 6144 + c0 + cc];
#pragma unroll
                for (int k = 0; k < 8; ++k) t += red[(k * 5 + s) * 64 + cc];
                ((float*)(p->ws + OFF_MODS))[(size_t)(layer * 5 + s) * 6144 + c0 + cc] = t;
            }
            __syncthreads();
        } else {
            const int f0 = (u - 192) * 64;
            const int fl = tid >> 3, dgp = (tid & 7) * 2, f = f0 + fl, n = f >> 2, i = f & 3;
            bf16_t* gxc = (bf16_t*)(p->ws + OFF_GCAT);
            bf16_t* gxm = gxc + 2048 * 16;
#pragma unroll
            for (int e = 0; e < 2; ++e) {
                const int dg = dgp + e, d = dg >> 3, g = dg & 7;
                const float* wg = p->m_w_gates + (size_t)d * 6144 * 8;
                float a = 0.f, b = 0.f;
#pragma unroll
                for (int o = 0; o < 4; ++o) {
                    a += p->m_wq[n * 16 + i * 4 + o] * wg[(size_t)(4 * n + o) * 8 + g];
                    a += p->m_wk[n * 16 + i * 4 + o] * wg[(size_t)(2048 + 4 * n + o) * 8 + g] * 0.04419417382415922f;
                    b += p->m_wv[n * 16 + i * 4 + o] * wg[(size_t)(4096 + 4 * n + o) * 8 + g];
                }
                gxc[f * 16 + dg] = f2bf(a); gxm[f * 16 + dg] = f2bf(b);
            }
            if (tid < 256) {
                const int nn = (f0 >> 2) + (tid >> 4), e = tid & 15, ii = e >> 2, jj = e & 3;
                float a = 0.f;
#pragma unroll
                for (int o = 0; o < 4; ++o) a += p->m_wq[nn * 16 + ii * 4 + o] * p->m_wk[nn * 16 + jj * 4 + o];
                ((float*)(p->ws + OFF_MMAT))[nn * 16 + e] = a * 0.04419417382415922f;
            }
        }
    }
    __syncthreads();
    for (int t = get_bid(); t < NCONV_DENSE + 16 * 768; t += gridDim.x) { if (t < NCONV_DENSE) conv_dense_tile(p, t, lds); else conv_expert_tile(p, 0, t - NCONV_DENSE, lds); }
}

template <class Src>
DI void phase_norm(PP p, int layer, int nrows, Src src) {
    const int lane = get_tid() & 63, gw = get_bid() * 8 + (get_tid() >> 6), nw = gridDim.x * 8;
    bf16_t* act = (bf16_t*)(p->ws + OFF_ACT);
    for (int r = gw; r < nrows; r += nw) {
        f32x4 v[4];
        row_load_f32(src(r), v, lane);
        const float rs = rsqrtf(row_sumsq(v) * (1.f / 1024.f) + EPS);
        const int s = row_set(r);
        row_modulate(v, rs, p->norm1_g + layer * 1024, mods_ptr(p, layer, s, 1), mods_ptr(p, layer, s, 0), lane);
        row_store_bf16(act + (size_t)r * 1024, v, lane);
    }
}

DI void phase_inproj(PP p, lds_t lds) {
    const bf16_t* act = (const bf16_t*)(p->ws + OFF_ACT);
    bf16_t* P = (bf16_t*)(p->ws + OFF_ARENA + A_P);
    constexpr int NM = NTOK / 256, NN = 11;
    for (int u = get_bid(); u < NM * NN; u += gridDim.x) {
        const int pn = u / NM, pm = u % NM;
        gemm_unit_t<64>(lds, 1024,
            [&](int r) { return act + (size_t)(pm * 256 + r) * 1024; },
            [&](int r) { return (const bf16_t*)((const char*)p->out + DO_WIN) + (size_t)(pn * 256 + r) * 1024; },
            [&](const f32x4 (&acc)[8][4], int wr, int wc, int lane) {
                epi_each<4>(acc, wr, wc, lane, [&](int r, int c, f32x4 v) { const int col = pn * 256 + c; if (col < ABIN) store_bf16x4(P + (size_t)(pm * 256 + r) * ABIN + col, v); });
            });
    }
}


DI void gla_bcum(LAS float* bc, const LAS float* lrt, const LAS float* wat, const LAS float* bat, int d, LAS float* seg_tot) {
    const int tid = get_tid();
    {
        const int c = tid & 63, tq = tid >> 6;
        float wcol[16];
#pragma unroll
        for (int r = 0; r < 16; ++r) wcol[r] = wat[r * 64 + c];
        const float bias = bat[c];
        for (int t = tq * 8; t < tq * 8 + 8; ++t) {
            float z = bias;
#pragma unroll
            for (int r = 0; r < 16; ++r) z += lrt[t * 16 + r] * wcol[r];
            bc[t * 64 + c] = log_sigmoidf_(z) * (1.f / 16.f);
        }
    }
    __syncthreads();
    {
        const int c = tid & 63, seg = tid >> 6;
        float v[8]; float run = 0.f;
#pragma unroll
        for (int j = 0; j < 8; ++j) { const int pp = seg * 8 + j, t = d == 0 ? pp : 63 - pp; run += bc[t * 64 + c]; v[j] = run; }
        LAS float* tot = seg_tot + seg * 64 + c;
        *tot = run;
        __syncthreads();
        float off = 0.f;
#pragma unroll
        for (int k = 0; k < 7; ++k) off += (k < seg) ? seg_tot[k * 64 + c] : 0.f;
#pragma unroll
        for (int j = 0; j < 8; ++j) { const int pp = seg * 8 + j, t = d == 0 ? pp : 63 - pp; bc[t * 64 + c] = v[j] + off; }
    }
    __syncthreads();
}
DI void gla_load_decay_inputs(PP p, const bf16_t* P, int r0, int h, LAS float* lrt, LAS float* wat, LAS float* bat) {
    const int tid = get_tid();
    if (tid < 256) {
        const int d = tid >> 7, t = (tid >> 1) & 63, half = tid & 1;
        const u32x4 v = *(const u32x4*)(P + (size_t)(r0 + t) * ABIN + PC_LRF + d * 16 + half * 8);
        LAS float* o = lrt + (d * 64 + t) * 16 + half * 8;
        o[0] = lo_bf(v.x); o[1] = hi_bf(v.x); o[2] = lo_bf(v.y); o[3] = hi_bf(v.y); o[4] = lo_bf(v.z); o[5] = hi_bf(v.z); o[6] = lo_bf(v.w); o[7] = hi_bf(v.w);
    }
    {
        const int i = tid * 4, d = i >> 10, r = (i >> 6) & 15, c = i & 63;
        *(LAS f32x4*)(wat + i) = *(const f32x4*)(p->gla_wa2 + (size_t)(d * 16 + r) * 256 + h * 64 + c);
    }
    if (tid < 128) bat[tid] = p->gla_ba[(tid >> 6) * 256 + h * 64 + (tid & 63)];
}

DI void phase_g1(PP p, lds_t lds) {
    const int tid = get_tid(), lane = tid & 63, w = tid >> 6;
    const bf16_t* P = (const bf16_t*)(p->ws + OFF_ARENA + A_P);
    float* U = (float*)(p->ws + OFF_ARENA + A_U);
    float* DEC = (float*)(p->ws + OFF_ARENA + A_DEC);
    float* LA = (float*)(p->ws + OFF_ARENA + A_LA);
    bf16_t* UU = (bf16_t*)(p->ws + OFF_ARENA + A_UU);
    float* AGGA = (float*)(p->ws + OFF_ARENA + A_AGGA);
    float* AGGH = (float*)(p->ws + OFF_ARENA + A_AGGH);
    constexpr int NGLA = NCH * 4, NLRU = NCH * 4;
    for (int task = get_bid(); task < NGLA + NLRU; task += gridDim.x) {
        if (task < NGLA) {
            const int ch = task >> 2, h = task & 3, r0 = ch * 64;
            LAS float* lrt = (LAS float*)lds;
            LAS float* wat = lrt + 2048;
            LAS float* bat = wat + 2048;
            LAS float* bc = bat + 128;
            LAS bf16_t* kt = (LAS bf16_t*)(bc + 8192);
            LAS bf16_t* ktd = kt + 64 * 72;
            LAS bf16_t* vt = ktd + 2 * 64 * 72;
            gla_load_decay_inputs(p, P, r0, h, lrt, wat, bat);
            { const int row = tid >> 3, chunk = tid & 7; *(LAS u32x4*)(kt + row * 72 + chunk * 8) = *(const u32x4*)(P + (size_t)(r0 + row) * ABIN + PC_K + h * 64 + chunk * 8); }
#pragma unroll
            for (int q = 0; q < 2; ++q) { const int i = tid + 512 * q, row = i >> 4, chunk = i & 15; *(LAS u32x4*)(vt + row * 136 + chunk * 8) = *(const u32x4*)(P + (size_t)(r0 + row) * ABIN + PC_V + h * 128 + chunk * 8); }
            __syncthreads();
            gla_bcum(bc, lrt, wat, bat, 0, (LAS float*)(vt + 64 * 136));
            gla_bcum(bc + 4096, lrt + 1024, wat + 1024, bat + 64, 1, (LAS float*)(vt + 64 * 136));
            {
                const int t = tid >> 3, c8 = (tid & 7) * 8;
#pragma unroll
                for (int d = 0; d < 2; ++d) {
                    const LAS float* b = bc + d * 4096;
                    const int tl = d == 0 ? 63 : 0;
                    float o[8];
#pragma unroll
                    for (int j = 0; j < 8; ++j) o[j] = bf2f(kt[t * 72 + c8 + j]) * __expf(b[tl * 64 + c8 + j] - b[t * 64 + c8 + j]);
                    u32x4 v; v.x = pk2(o[0], o[1]); v.y = pk2(o[2], o[3]); v.z = pk2(o[4], o[5]); v.w = pk2(o[6], o[7]);
                    *(LAS u32x4*)(ktd + d * 64 * 72 + t * 72 + c8) = v;
                }
                if (tid < 128) { const int d = tid >> 6, c = tid & 63; DEC[(size_t)(ch * 2 + d) * 256 + h * 64 + c] = __expf(bc[d * 4096 + (d == 0 ? 63 : 0) * 64 + c]); }
            }
            __syncthreads();
            {
                const int d = w >> 2, dkt = w & 3;
                const LAS bf16_t* kd = ktd + d * 64 * 72;
                bf16x8 kb[2];
#pragma unroll
                for (int ks = 0; ks < 2; ++ks) kb[ks] = frag_tr(kd, 72, ks * 32, dkt * 16, lane);
                float* Ud = U + ((size_t)(ch * 2 + d) * 4 + h) * 8192;
#pragma unroll
                for (int dvt = 0; dvt < 8; ++dvt) {
                    f32x4 acc = {0.f, 0.f, 0.f, 0.f};
#pragma unroll
                    for (int ks = 0; ks < 2; ++ks) acc = mfma16(frag_tr(vt, 136, ks * 32, dvt * 16, lane), kb[ks], acc);
                    *(f32x4*)(Ud + (dkt * 16 + (lane & 15)) * 128 + dvt * 16 + 4 * (lane >> 4)) = acc;
                }
            }
            __syncthreads();
        } else {
            const int t2 = task - NGLA, ch = t2 >> 2, cq = t2 & 3, r0 = ch * 64;
            const int seg_lo = ch < NCHL ? r0 : NLAT + ((r0 - NLAT) >> 8) * 256, seg_hi = ch < NCHL ? r0 + 64 : seg_lo + 256;
            LAS bf16_t* xin = (LAS bf16_t*)lds;
            LAS bf16_t* xb = xin + 67 * 136;
            LAS float* lat = (LAS float*)(xb + 64 * 136);
            LAS bf16_t* git = (LAS bf16_t*)(lat + 2 * 64 * 128);
            for (int i = tid; i < 67 * 16; i += NTHREADS) {
                const int row = i >> 4, chunk = i & 15, r = r0 - 2 + row;
                u32x4 v = {0u, 0u, 0u, 0u};
                if (r >= seg_lo && r < seg_hi) v = *(const u32x4*)(P + (size_t)r * ABIN + PC_RGX + cq * 128 + chunk * 8);
                *(LAS u32x4*)(xin + row * 136 + chunk * 8) = v;
            }
            __syncthreads();
            {
                const int t = tid >> 3, c16 = (tid & 7) * 16;
                float o[16];
#pragma unroll
                for (int j = 0; j < 16; ++j) o[j] = p->rg_conv_b[cq * 128 + c16 + j];
#pragma unroll
                for (int tap = 0; tap < 4; ++tap)
#pragma unroll
                    for (int j = 0; j < 16; ++j) o[j] += p->rg_conv_w[tap * 512 + cq * 128 + c16 + j] * bf2f(xin[(t + tap) * 136 + c16 + j]);
#pragma unroll
                for (int j = 0; j < 16; j += 8) {
                    u32x4 v; v.x = pk2(o[j], o[j + 1]); v.y = pk2(o[j + 2], o[j + 3]); v.z = pk2(o[j + 4], o[j + 5]); v.w = pk2(o[j + 6], o[j + 7]);
                    *(LAS u32x4*)(xb + t * 136 + c16 + j) = v;
                }
            }
            __syncthreads();
            {
                const int blk = w & 1, d = (w >> 1) & 1, mat = w >> 2, n = cq * 2 + blk;
                const float* W = (mat ? p->rg_wi : p->rg_wr) + (size_t)(d * 8 + n) * 4096;
                const float* bias = (mat ? p->rg_bi : p->rg_br) + d * 512 + n * 64;
                bf16x8 wf[4][2];
#pragma unroll
                for (int ot = 0; ot < 4; ++ot)
#pragma unroll
                    for (int ks = 0; ks < 2; ++ks) {
                        const float* src = W + (size_t)(ks * 32 + 8 * (lane >> 4)) * 64 + ot * 16 + (lane & 15);
                        float f[8];
#pragma unroll
                        for (int j = 0; j < 8; ++j) f[j] = src[j * 64];
                        u32x4 v; v.x = pk2n(f[0], f[1]); v.y = pk2n(f[2], f[3]); v.z = pk2n(f[4], f[5]); v.w = pk2n(f[6], f[7]);
                        wf[ot][ks] = __builtin_bit_cast(bf16x8, v);
                    }
#pragma unroll
                for (int tt = 0; tt < 4; ++tt) {
                    bf16x8 xf[2];
#pragma unroll
                    for (int ks = 0; ks < 2; ++ks) xf[ks] = frag_row(xb, 136, tt * 16, blk * 64 + ks * 32, lane);
#pragma unroll
                    for (int ot = 0; ot < 4; ++ot) {
                        f32x4 acc = {0.f, 0.f, 0.f, 0.f};
#pragma unroll
                        for (int ks = 0; ks < 2; ++ks) acc = mfma16(wf[ot][ks], xf[ks], acc);
                        const int t = tt * 16 + (lane & 15), o = ot * 16 + 4 * (lane >> 4), c = blk * 64 + o;
                        const f32x4 bv = *(const f32x4*)(bias + o);
                        if (mat == 0) {
                            const f32x4 lam = *(const f32x4*)(p->rg_lambda + d * 512 + n * 64 + o);
                            f32x4 la;
#pragma unroll
                            for (int j = 0; j < 4; ++j) la[j] = -8.f * softplusf_(-lam[j]) * sigmoidf_(acc[j] + bv[j]);
                            *(LAS f32x4*)(lat + (d * 64 + t) * 128 + c) = la;
                        } else {
                            float gi[4];
#pragma unroll
                            for (int j = 0; j < 4; ++j) gi[j] = sigmoidf_(acc[j] + bv[j]) * bf2f(xb[t * 136 + c + j]);
                            u32x2 v; v.x = pk2(gi[0], gi[1]); v.y = pk2(gi[2], gi[3]);
                            *(LAS u32x2*)(git + (d * 64 + t) * 128 + c) = v;
                        }
                    }
                }
            }
            __syncthreads();
            {
                const int c4 = (tid & 31) * 4, rest = tid >> 5, d = rest >> 3, t0 = (rest & 7) * 8, gc = cq * 128 + c4;
#pragma unroll
                for (int j = 0; j < 8; ++j) {
                    const int t = t0 + j;
                    const f32x4 la = *(const LAS f32x4*)(lat + (d * 64 + t) * 128 + c4);
                    const u32x2 gg = *(const LAS u32x2*)(git + (d * 64 + t) * 128 + c4);
                    f32x4 av; float u[4];
                    const float gi[4] = {lo_bf(gg.x), hi_bf(gg.x), lo_bf(gg.y), hi_bf(gg.y)};
#pragma unroll
                    for (int e = 0; e < 4; ++e) { av[e] = __expf(la[e]); u[e] = sqrtf(-expm1f(2.f * la[e])) * gi[e]; }
                    u32x2 uo; uo.x = pk2(u[0], u[1]); uo.y = pk2(u[2], u[3]);
                    *(f32x4*)(LA + ((size_t)(r0 + t) * 2 + d) * 512 + gc) = la;
                    *(u32x2*)(UU + ((size_t)(r0 + t) * 2 + d) * 512 + gc) = uo;
                    *(LAS f32x4*)(lat + (d * 64 + t) * 128 + c4) = av;
                    *(LAS u32x2*)(git + (d * 64 + t) * 128 + c4) = uo;
                }
            }
            __syncthreads();
            {
                const int half = tid >> 8, d = (tid >> 7) & 1, c = tid & 127, gc = cq * 128 + c;
                float hacc = 0.f, aprod = 1.f;
#pragma unroll 8
                for (int s_ = 0; s_ < 32; ++s_) {
                    const int pp = half * 32 + s_, t = d == 0 ? pp : 63 - pp;
                    const float a = lat[(d * 64 + t) * 128 + c], u = bf2f(git[(d * 64 + t) * 128 + c]);
                    hacc = a * hacc + u; aprod *= a;
                }
                LAS float* comb = (LAS float*)xin;
                comb[(half * 256 + d * 128 + c) * 2] = aprod; comb[(half * 256 + d * 128 + c) * 2 + 1] = hacc;
                __syncthreads();
                if (half == 0) {
                    const float a1 = comb[(256 + d * 128 + c) * 2], h1 = comb[(256 + d * 128 + c) * 2 + 1];
                    AGGA[(size_t)(ch * 2 + d) * 512 + gc] = aprod * a1;
                    AGGH[(size_t)(ch * 2 + d) * 512 + gc] = a1 * hacc + h1;
                }
            }
            __syncthreads();
        }
    }
}

DI int scan_chunk(int b, int d, int st) {
    if (st < 4) return NCHL + b * 4 + (d == 0 ? st : 3 - st);
    const int j = st - 4;
    return b * 128 + (d == 0 ? j : 127 - j);
}

DI void phase_scan0(PP p) {
    float* U = (float*)(p->ws + OFF_ARENA + A_U);
    const float* DEC = (const float*)(p->ws + OFF_ARENA + A_DEC);
    const float* AGGA = (const float*)(p->ws + OFF_ARENA + A_AGGA);
    float* AGGH = (float*)(p->ws + OFF_ARENA + A_AGGH);
    const int gid = get_bid() * NTHREADS + get_tid(), nthr = gridDim.x * NTHREADS;
    for (int idx = gid; idx < 65536 + 4096; idx += nthr) {
        if (idx < 65536) {
            const int dv4 = idx & 31, dk = (idx >> 5) & 63, h = (idx >> 11) & 3, d = (idx >> 13) & 1, b = idx >> 14;
            f32x4 S = {0.f, 0.f, 0.f, 0.f};
            for (int st = 0; st < 132; st += 4) {
                f32x4 u[4]; float dc[4]; float* ptr[4];
#pragma unroll
                for (int q = 0; q < 4; ++q) {
                    const int cid = scan_chunk(b, d, st + q);
                    ptr[q] = U + ((size_t)(cid * 2 + d) * 4 + h) * 8192 + dk * 128 + dv4 * 4;
                    u[q] = *(const f32x4*)ptr[q];
                    dc[q] = DEC[(size_t)(cid * 2 + d) * 256 + h * 64 + dk];
                }
#pragma unroll
                for (int q = 0; q < 4; ++q) { *(f32x4*)ptr[q] = S; S = S * dc[q] + u[q]; }
            }
        } else {
            const int i2 = idx - 65536, c = i2 & 511, d = (i2 >> 9) & 1, b = i2 >> 10;
            float hs = 0.f;
            for (int st = 0; st < 132; st += 4) {
                float a[4], hh[4]; float* ptr[4];
#pragma unroll
                for (int q = 0; q < 4; ++q) {
                    const int cid = scan_chunk(b, d, st + q);
                    ptr[q] = AGGH + (size_t)(cid * 2 + d) * 512 + c;
                    hh[q] = *ptr[q]; a[q] = AGGA[(size_t)(cid * 2 + d) * 512 + c];
                }
#pragma unroll
                for (int q = 0; q < 4; ++q) { *ptr[q] = hs; hs = a[q] * hs + hh[q]; }
            }
        }
    }
}

DI void phase_g3(PP p, lds_t lds) {
    const int tid = get_tid(), lane = tid & 63, w = tid >> 6;
    const bf16_t* P = (const bf16_t*)(p->ws + OFF_ARENA + A_P);
    const float* U = (const float*)(p->ws + OFF_ARENA + A_U);
    const float* LA = (const float*)(p->ws + OFF_ARENA + A_LA);
    const bf16_t* UU = (const bf16_t*)(p->ws + OFF_ARENA + A_UU);
    const float* HST = (const float*)(p->ws + OFF_ARENA + A_AGGH);
    bf16_t* act = (bf16_t*)(p->ws + OFF_ACT);
    constexpr int NGLA = NCH * 4;
    for (int task = get_bid(); task < NGLA + NCH; task += gridDim.x) {
        if (task < NGLA) {
            const int ch = task >> 2, h = task & 3, r0 = ch * 64;
            LAS float* lrt = (LAS float*)lds;
            LAS float* wat = lrt + 2048;
            LAS float* bat = wat + 2048;
            LAS float* bc = bat + 128;
            LAS bf16_t* qt = (LAS bf16_t*)(bc + 4096);
            LAS bf16_t* kt = qt + 64 * 72;
            LAS bf16_t* qtd = kt + 64 * 72;
            LAS bf16_t* ktd = qtd + 64 * 72;
            LAS bf16_t* at = ktd + 64 * 72;
            LAS bf16_t* vt = at + 64 * 72;
            LAS bf16_t* St = vt + 64 * 136;
            LAS float* ot = (LAS float*)(St + 64 * 136);
            gla_load_decay_inputs(p, P, r0, h, lrt, wat, bat);
            { const int row = tid >> 3, chunk = tid & 7;
              *(LAS u32x4*)(qt + row * 72 + chunk * 8) = *(const u32x4*)(P + (size_t)(r0 + row) * ABIN + PC_Q + h * 64 + chunk * 8);
              *(LAS u32x4*)(kt + row * 72 + chunk * 8) = *(const u32x4*)(P + (size_t)(r0 + row) * ABIN + PC_K + h * 64 + chunk * 8); }
#pragma unroll
            for (int q = 0; q < 2; ++q) { const int i = tid + 512 * q, row = i >> 4, chunk = i & 15; *(LAS u32x4*)(vt + row * 136 + chunk * 8) = *(const u32x4*)(P + (size_t)(r0 + row) * ABIN + PC_V + h * 128 + chunk * 8); }
            __syncthreads();
            f32x4 oacc[4];
#pragma unroll
            for (int i = 0; i < 4; ++i) oacc[i] = (f32x4){0.f, 0.f, 0.f, 0.f};
            const int ott = w & 3, odv0 = (w >> 2) * 4;
            for (int d = 0; d < 2; ++d) {
                gla_bcum(bc, lrt + d * 1024, wat + d * 1024, bat + d * 64, d, ot);
                {
                    const int t = tid >> 3, c8 = (tid & 7) * 8;
                    float qo[8], ko[8];
#pragma unroll
                    for (int j = 0; j < 8; ++j) { const float e = __expf(bc[t * 64 + c8 + j]); qo[j] = bf2f(qt[t * 72 + c8 + j]) * 0.125f * e; ko[j] = bf2f(kt[t * 72 + c8 + j]) / e; }
                    u32x4 v; v.x = pk2(qo[0], qo[1]); v.y = pk2(qo[2], qo[3]); v.z = pk2(qo[4], qo[5]); v.w = pk2(qo[6], qo[7]);
                    *(LAS u32x4*)(qtd + t * 72 + c8) = v;
                    v.x = pk2(ko[0], ko[1]); v.y = pk2(ko[2], ko[3]); v.z = pk2(ko[4], ko[5]); v.w = pk2(ko[6], ko[7]);
                    *(LAS u32x4*)(ktd + t * 72 + c8) = v;
                    const int dk = tid >> 3, dv16 = (tid & 7) * 16;
                    const float* src = U + ((size_t)(ch * 2 + d) * 4 + h) * 8192 + dk * 128 + dv16;
                    const f32x4 s0 = *(const f32x4*)src, s1 = *(const f32x4*)(src + 4), s2 = *(const f32x4*)(src + 8), s3 = *(const f32x4*)(src + 12);
                    v.x = pk2(s0[0], s0[1]); v.y = pk2(s0[2], s0[3]); v.z = pk2(s1[0], s1[1]); v.w = pk2(s1[2], s1[3]);
                    *(LAS u32x4*)(St + dk * 136 + dv16) = v;
                    v.x = pk2(s2[0], s2[1]); v.y = pk2(s2[2], s2[3]); v.z = pk2(s3[0], s3[1]); v.w = pk2(s3[2], s3[3]);
                    *(LAS u32x4*)(St + dk * 136 + dv16 + 8) = v;
                }
                __syncthreads();
                {
                    const int tt = w >> 1;
#pragma unroll
                    for (int e = 0; e < 2; ++e) {
                        const int st = (w & 1) * 2 + e;
                        f32x4 acc = {0.f, 0.f, 0.f, 0.f};
#pragma unroll
                        for (int ks = 0; ks < 2; ++ks) acc = mfma16(frag_row(ktd, 72, st * 16, ks * 32, lane), frag_row(qtd, 72, tt * 16, ks * 32, lane), acc);
                        const int t = tt * 16 + (lane & 15), s0 = st * 16 + 4 * (lane >> 4);
                        float a[4];
#pragma unroll
                        for (int j = 0; j < 4; ++j) { const int s = s0 + j; a[j] = (d == 0 ? s <= t : s >= t) ? acc[j] : 0.f; }
                        u32x2 v; v.x = pk2(a[0], a[1]); v.y = pk2(a[2], a[3]);
                        *(LAS u32x2*)(at + t * 72 + s0) = v;
                    }
                }
                __syncthreads();
                {
                    bf16x8 af[2], qf[2];
#pragma unroll
                    for (int ks = 0; ks < 2; ++ks) { af[ks] = frag_row(at, 72, ott * 16, ks * 32, lane); qf[ks] = frag_row(qtd, 72, ott * 16, ks * 32, lane); }
#pragma unroll
                    for (int i = 0; i < 4; ++i) {
                        const int dvt = odv0 + i;
#pragma unroll
                        for (int ks = 0; ks < 2; ++ks) {
                            oacc[i] = mfma16(frag_tr(vt, 136, ks * 32, dvt * 16, lane), af[ks], oacc[i]);
                            oacc[i] = mfma16(frag_tr(St, 136, ks * 32, dvt * 16, lane), qf[ks], oacc[i]);
                        }
                    }
                }
                __syncthreads();
            }
#pragma unroll
            for (int i = 0; i < 4; ++i) *(LAS f32x4*)(ot + (ott * 16 + (lane & 15)) * 132 + (odv0 + i) * 16 + 4 * (lane >> 4)) = oacc[i];
            __syncthreads();
            {
                const int t = tid >> 3, dv16 = (tid & 7) * 16;
                float o[16]; float ss = 0.f;
#pragma unroll
                for (int j = 0; j < 16; ++j) { o[j] = ot[t * 132 + dv16 + j]; ss += o[j] * o[j]; }
                ss += __shfl_xor(ss, 1); ss += __shfl_xor(ss, 2); ss += __shfl_xor(ss, 4);
                const float rs = rsqrtf(ss * (1.f / 128.f) + EPS);
                const bf16_t* gp = P + (size_t)(r0 + t) * ABIN + PC_G + h * 128 + dv16;
                const u32x4 g0 = *(const u32x4*)gp, g1 = *(const u32x4*)(gp + 8);
                const unsigned gw[8] = {g0.x, g0.y, g0.z, g0.w, g1.x, g1.y, g1.z, g1.w};
                float r[16];
#pragma unroll
                for (int j = 0; j < 8; ++j) {
                    r[2 * j] = o[2 * j] * rs * p->gla_norm_g[h * 128 + dv16 + 2 * j] * siluf_(lo_bf(gw[j]));
                    r[2 * j + 1] = o[2 * j + 1] * rs * p->gla_norm_g[h * 128 + dv16 + 2 * j + 1] * siluf_(hi_bf(gw[j]));
                }
                bf16_t* dst = act + (size_t)(r0 + t) * 1024 + h * 128 + dv16;
                u32x4 v; v.x = pk2(r[0], r[1]); v.y = pk2(r[2], r[3]); v.z = pk2(r[4], r[5]); v.w = pk2(r[6], r[7]);
                *(u32x4*)dst = v;
                v.x = pk2(r[8], r[9]); v.y = pk2(r[10], r[11]); v.z = pk2(r[12], r[13]); v.w = pk2(r[14], r[15]);
                *(u32x4*)(dst + 8) = v;
            }
            __syncthreads();
        } else {
            const int ch = task - NGLA, r0 = ch * 64, c = tid;
            LAS float* hf = (LAS float*)lds;
            float hs = HST[(size_t)(ch * 2 + 0) * 512 + c];
            for (int tb = 0; tb < 64; tb += 16) {
                float la[16]; bf16_t uu[16];
#pragma unroll
                for (int j = 0; j < 16; ++j) { const size_t o = ((size_t)(r0 + tb + j) * 2 + 0) * 512 + c; la[j] = LA[o]; uu[j] = UU[o]; }
#pragma unroll
                for (int j = 0; j < 16; ++j) { hs = __expf(la[j]) * hs + bf2f(uu[j]); hf[(tb + j) * 512 + c] = hs; }
            }
            hs = HST[(size_t)(ch * 2 + 1) * 512 + c];
            for (int tb = 48; tb >= 0; tb -= 16) {
                float la[16]; bf16_t uu[16], gg[16];
#pragma unroll
                for (int j = 0; j < 16; ++j) { const size_t o = ((size_t)(r0 + tb + j) * 2 + 1) * 512 + c; la[j] = LA[o]; uu[j] = UU[o]; gg[j] = P[(size_t)(r0 + tb + j) * ABIN + PC_RGG + c]; }
#pragma unroll
                for (int j = 15; j >= 0; --j) {
                    hs = __expf(la[j]) * hs + bf2f(uu[j]);
                    act[(size_t)(r0 + tb + j) * 1024 + 512 + c] = f2bf((hf[(tb + j) * 512 + c] + hs) * gelu_tanh(bf2f(gg[j])));
                }
            }
            __syncthreads();
        }
    }
}


DI void phase_outproj0(PP p, lds_t lds) {
    const bf16_t* act = (const bf16_t*)(p->ws + OFF_ACT);
    float* X = (float*)(p->ws + OFF_ARENA + A_X);
    constexpr int NM = NTOK / 256, NN = 4;
    for_units_xcd(1, NM, NN, 8, 4, [&](int, int pm, int pn) {
        const int set = row_set(pm * 256);
        const float* g1 = mods_ptr(p, 0, set, 2);
        const float* xin = pm * 256 < NLAT ? p->x + (size_t)pm * 256 * 1024 : p->ctx + (size_t)(pm * 256 - NLAT) * 1024;
        gemm_unit_t<64>(lds, 1024,
            [&](int r) { return act + (size_t)(pm * 256 + r) * 1024; },
            [&](int r) { return (const bf16_t*)((const char*)p->out + DO_WOUT) + (size_t)(pn * 256 + r) * 1024; },
            [&](const f32x4 (&acc)[8][4], int wr, int wc, int lane) {
                epi_each<4>(acc, wr, wc, lane, [&](int r, int c, f32x4 v) {
                    const int col = pn * 256 + c;
                    const f32x4 xi = *(const f32x4*)(xin + (size_t)r * 1024 + col), g = *(const f32x4*)(g1 + col);
                    *(f32x4*)(X + (size_t)(pm * 256 + r) * 1024 + col) = xi + g * v;
                });
            });
    });
}

struct MoeBufs { float* PT; float* PE; int* ROWID; int* ROWTOK; bf16_t* HDN; bf16_t* Y; int rpe; int nrows; };
DI MoeBufs moe_bufs(PP p, int layer) {
    MoeBufs m;
    char* a = p->ws + OFF_ARENA;
    if (layer == 0) { m.PT = (float*)(a + A_PT); m.PE = (float*)(a + A_PE); m.ROWID = (int*)(a + A_ROWID); m.ROWTOK = (int*)(a + A_ROWTOK); m.HDN = (bf16_t*)(a + A_HDN); m.Y = (bf16_t*)(a + A_Y); m.rpe = 4352; m.nrows = NTOK; }
    else { m.PT = (float*)(a + A_HB); m.PE = (float*)(a + A_HB + (size_t)NTOK * 64); m.ROWID = (int*)(a + A_HB + (size_t)NTOK * 128); m.ROWTOK = (int*)(a + A_HB + (size_t)NTOK * 192); m.HDN = (bf16_t*)(a + A_XM); m.Y = (bf16_t*)(a + A_XC); m.rpe = 4096; m.nrows = NLAT; }
    return m;
}

DI void phase_router(PP p, lds_t lds, int layer) {
    const int tid = get_tid(), lane = tid & 63;
    const MoeBufs m = moe_bufs(p, layer);
    const float* X = (const float*)(p->ws + OFF_ARENA + A_X);
    bf16_t* act = (bf16_t*)(p->ws + OFF_ACT);
    LAS float* rwT = (LAS float*)lds;
    for (int i = tid; i < 16384; i += NTHREADS) { const int k = i >> 4, e = i & 15; rwT[e * 1024 + k] = p->router_w[(size_t)layer * 16384 + i]; }
    __syncthreads();
    const int gw = get_bid() * 8 + (tid >> 6), nw = gridDim.x * 8;
    for (int r = gw; r < m.nrows; r += nw) {
        f32x4 v[4];
        row_load_f32(X + (size_t)r * 1024, v, lane);
        const float rs = rsqrtf(row_sumsq(v) * (1.f / 1024.f) + EPS);
        const int set = row_set(r);
        row_modulate(v, rs, p->norm2_g + layer * 1024, mods_ptr(p, layer, set, 4), mods_ptr(p, layer, set, 3), lane);
        row_store_bf16(act + (size_t)r * 1024, v, lane);
        float lg[16];
#pragma unroll
        for (int e = 0; e < 16; ++e) {
            float a = 0.f;
#pragma unroll
            for (int i = 0; i < 4; ++i) { const f32x4 wv = *(const LAS f32x4*)(rwT + e * 1024 + 4 * lane + 256 * i); a += v[i][0] * wv[0] + v[i][1] * wv[1] + v[i][2] * wv[2] + v[i][3] * wv[3]; }
            lg[e] = wave_sum(a);
            asm volatile("" ::: "memory");
        }
        float mx = lg[0];
#pragma unroll
        for (int e = 1; e < 16; ++e) mx = fmaxf(mx, lg[e]);
        float sum = 0.f;
#pragma unroll
        for (int e = 0; e < 16; ++e) { lg[e] = __expf(lg[e] - mx); sum += lg[e]; }
        const float inv = 1.f / sum;
        float mine = 0.f;
#pragma unroll
        for (int e = 0; e < 16; ++e) if (lane == e) mine = lg[e] * inv;
        if (lane < 16) {
            m.PT[(size_t)r * 16 + lane] = mine;
            if (r < NLAT) m.PE[((size_t)(r >> 13) * 16 + lane) * 8192 + (r & 8191)] = mine;
            else { const int rc = r - NLAT; m.PE[(size_t)NBATCH * 16 * 8192 + ((size_t)(rc >> 8) * 16 + lane) * 256 + (rc & 255)] = mine; }
        }
    }
}

DI int block_excl_scan(int v, LAS int* tmp, int* total) {
    const int tid = get_tid(), lane = tid & 63, w = tid >> 6;
    int inc = v;
#pragma unroll
    for (int o = 1; o < 64; o <<= 1) { const int t = __shfl_up(inc, o); if (lane >= o) inc += t; }
    __syncthreads();
    if (lane == 63) tmp[w] = inc;
    __syncthreads();
    int base = 0, tot = 0;
#pragma unroll
    for (int i = 0; i < 8; ++i) { const int t = tmp[i]; if (i < w) base += t; tot += t; }
    *total = tot;
    return base + inc - v;
}

DI void phase_topk(PP p, lds_t lds, int layer) {
    const int tid = get_tid();
    const MoeBufs m = moe_bufs(p, layer);
    LAS unsigned* keys = (LAS unsigned*)lds;
    LAS int* hist = (LAS int*)(keys + 8192);
    LAS int* tmp = hist + 256;
    LAS int* sel = tmp + 16;
    const int ntask = layer == 0 ? 128 : 64;
    if (layer == 1 && get_bid() >= 64) {
        for (int t = get_bid() - 64; t < 16 * 768; t += gridDim.x - 64) conv_expert_tile(p, 1, t, lds);
        return;
    }
    for (int task = get_bid(); task < ntask; task += gridDim.x) {
        const bool isctx = task >= 64;
        const int b = (task & 63) >> 4, e = task & 15;
        const int n = isctx ? 256 : 8192, cap = isctx ? 32 : 1024;
        const float* src = isctx ? m.PE + (size_t)NBATCH * 16 * 8192 + ((size_t)b * 16 + e) * 256 : m.PE + ((size_t)b * 16 + e) * 8192;
        for (int i = tid; i < n; i += NTHREADS) keys[i] = __float_as_uint(src[i]);
        __syncthreads();
        unsigned prefix = 0u, mask = 0u; int kk = cap;
        for (int pass = 3; pass >= 0; --pass) {
            const int shift = pass * 8;
            if (tid < 256) hist[tid] = 0;
            __syncthreads();
            for (int i = tid; i < n; i += NTHREADS) { const unsigned k = keys[i]; if ((k & mask) == prefix) __hip_atomic_fetch_add((int*)(hist + ((k >> shift) & 255)), 1, __ATOMIC_RELAXED, __HIP_MEMORY_SCOPE_WORKGROUP); }
            __syncthreads();
            if (tid < 256) {
                int above = 0;
                for (int j = tid + 1; j < 256; ++j) above += hist[j];
                const int mineh = hist[tid];
                if (above < kk && kk <= above + mineh) { sel[0] = tid; sel[1] = above; }
            }
            __syncthreads();
            prefix |= (unsigned)sel[0] << shift; mask |= 0xffu << shift; kk -= sel[1];
            __syncthreads();
        }
        const unsigned T = prefix; const int need_eq = kk;
        const int ipt = n / NTHREADS > 0 ? n / NTHREADS : 1;
        const int i0 = tid * ipt;
        int cgt = 0, ceq = 0;
        if (i0 < n) for (int j = 0; j < ipt; ++j) { const unsigned k = keys[i0 + j]; cgt += k > T; ceq += k == T; }
        int tot;
        const int egt = block_excl_scan(cgt, tmp, &tot);
        const int eeq = block_excl_scan(ceq, tmp, &tot);
        const int slot0 = e * m.rpe + (isctx ? 4096 + b * 32 : b * 1024);
        const int row0 = isctx ? NLAT + b * 256 : b * 8192;
        if (i0 < n) {
            int ngt = egt, neq = eeq;
            for (int j = 0; j < ipt; ++j) {
                const unsigned k = keys[i0 + j];
                int slot = -1;
                if (k > T) { slot = slot0 + ngt + (neq < need_eq ? neq : need_eq); ++ngt; }
                else if (k == T) { if (neq < need_eq) slot = slot0 + ngt + neq; ++neq; }
                m.ROWID[(size_t)(row0 + i0 + j) * 16 + e] = slot;
                if (slot >= 0) m.ROWTOK[slot] = row0 + i0 + j;
            }
        }
        if (isctx && b == 0 && layer == 0) for (int i = tid; i < 128; i += NTHREADS) m.ROWTOK[e * m.rpe + 4224 + i] = -1;
        __syncthreads();
    }
}

DI void phase_moe_up(PP p, lds_t lds, int layer) {
    const MoeBufs m = moe_bufs(p, layer);
    const bf16_t* act = (const bf16_t*)(p->ws + OFF_ACT);
    auto unit = [&](int e, int mt, int nt) {
        const float* Wg = p->exp_w_gate + ((size_t)layer * 16 + e) * 1048576;
        const float* Wu = p->exp_w_up + ((size_t)layer * 16 + e) * 1048576;
        const int* rt = m.ROWTOK + e * m.rpe + mt * 256;
        bf16_t* H = m.HDN + ((size_t)e * m.rpe + mt * 256) * 1024 + nt * 128;
        gemm_unit_t<64>(lds, 1024,
            [&](int r) -> const bf16_t* { const int tok = rt[r]; return tok >= 0 ? act + (size_t)tok * 1024 : nullptr; },
            [&](int r) { return (const bf16_t*)((const char*)p->out + DO_EXP + (size_t)e * EXP_STRIDE) + (size_t)(nt * 256 + r) * 1024; },
            [&](const f32x4 (&acc)[8][4], int wr, int wc, int lane) {
#pragma unroll
                for (int mi = 0; mi < 8; ++mi)
#pragma unroll
                    for (int ni = 0; ni < 2; ++ni) {
                        const f32x4 g = acc[mi][ni], uu = acc[mi][ni + 2];
                        f32x4 h;
#pragma unroll
                        for (int j = 0; j < 4; ++j) h[j] = siluf_(g[j]) * uu[j];
                        store_bf16x4(H + (size_t)(wr * 128 + mi * 16 + (lane & 15)) * 1024 + wc * 32 + ni * 16 + 4 * (lane >> 4), h);
                    }
            });
    };
    for_units_xcd(16, 16, 8, 4, 8, unit);
    if (layer == 0) for_units_xcd(16, 1, 8, 1, 8, [&](int e, int, int nt) { unit(e, 16, nt); });
}

template <int PROBE>
DI void phase_moe_down_t(PP p, lds_t lds, int layer) {
    const MoeBufs m = moe_bufs(p, layer);
    auto unit = [&](int e, int mt, int nt) {
        const float* Wd = p->exp_w_down + ((size_t)layer * 16 + e) * 1048576;
        const bf16_t* H = m.HDN + ((size_t)e * m.rpe + mt * 256) * 1024;
        bf16_t* Y = m.Y + ((size_t)e * m.rpe + mt * 256) * 1024 + nt * 256;
        gemm_unit_g(lds, 1024,
            [&](int r) { return H + (size_t)r * 1024; },
            [&](int r) { return (const bf16_t*)((const char*)p->out + DO_EXP + (size_t)e * EXP_STRIDE) + (size_t)(2048 + nt * 256 + r) * 1024; },
            [&](const f32x4 (&acc)[8][4], int wr, int wc, int lane) {
                epi_each<4>(acc, wr, wc, lane, [&](int r, int c, f32x4 v) { store_bf16x4(Y + (size_t)r * 1024 + c, v); });
            });
    };
    for_units_xcd(16, 16, 4, 8, 4, unit);
    if (layer == 0) for_units_xcd(16, 1, 4, 1, 4, [&](int e, int, int nt) { unit(e, 16, nt); });
}

DI void phase_moe_down(PP p, lds_t lds, int layer) { phase_moe_down_t<0>(p, lds, layer); }

DI void phase_combine(PP p, int layer) {
    const int tid = get_tid(), lane = tid & 63;
    const MoeBufs m = moe_bufs(p, layer);
    float* X = (float*)(p->ws + OFF_ARENA + A_X);
    bf16_t* act = (bf16_t*)(p->ws + OFF_ACT);
    const int gw = get_bid() * 8 + (tid >> 6), nw = gridDim.x * 8;
    for (int r = gw; r < m.nrows; r += nw) {
        f32x4 v[4], a[4];
        row_load_f32(X + (size_t)r * 1024, v, lane);
#pragma unroll
        for (int i = 0; i < 4; ++i) a[i] = (f32x4){0.f, 0.f, 0.f, 0.f};
        for (int e = 0; e < 16; ++e) {
            const int rid = m.ROWID[(size_t)r * 16 + e];
            if (rid >= 0) {
                const float pe = m.PT[(size_t)r * 16 + e];
                const bf16_t* y = m.Y + (size_t)rid * 1024;
#pragma unroll
                for (int i = 0; i < 4; ++i) { const u32x2 yy = *(const u32x2*)(y + 4 * lane + 256 * i); a[i][0] += pe * lo_bf(yy.x); a[i][1] += pe * hi_bf(yy.x); a[i][2] += pe * lo_bf(yy.y); a[i][3] += pe * hi_bf(yy.y); }
            }
        }
        const int set = row_set(r);
        const float* g2 = mods_ptr(p, layer, set, 5);
#pragma unroll
        for (int i = 0; i < 4; ++i) { const f32x4 g = *(const f32x4*)(g2 + 4 * lane + 256 * i); v[i] = v[i] + g * a[i]; }
        const float rs = rsqrtf(row_sumsq(v) * (1.f / 1024.f) + EPS);
        if (layer == 0) {
#pragma unroll
            for (int i = 0; i < 4; ++i) *(f32x4*)(X + (size_t)r * 1024 + 4 * lane + 256 * i) = v[i];
            row_modulate(v, rs, p->norm1_g + 1024, mods_ptr(p, 1, set, 1), mods_ptr(p, 1, set, 0), lane);
            row_store_bf16(act + (size_t)r * 1024, v, lane);
        } else {
#pragma unroll
            for (int i = 0; i < 4; ++i) { const f32x4 g = *(const f32x4*)(p->final_g + 4 * lane + 256 * i); *(f32x4*)(p->out + (size_t)r * 1024 + 4 * lane + 256 * i) = v[i] * rs * g; }
        }
    }
}


DI void phase_upproj(PP p, lds_t lds, int half) {
    const bf16_t* act = (const bf16_t*)(p->ws + OFF_ACT);
    bf16_t* O = (bf16_t*)(p->ws + OFF_ARENA + A_XM);
    const int NM = half == 0 ? NTOK / 256 : NLAT / 256, NN = 8;
    for_units_xcd(1, NM, NN, 8, 4, [&](int, int pm, int pn) {
        gemm_unit_t<64>(lds, 1024,
            [&](int r) { return act + (size_t)(pm * 256 + r) * 1024; },
            [&](int r) { return (const bf16_t*)(p->ws + OFF_WUPT) + (size_t)(half * 2048 + pn * 256 + r) * 1024; },
            [&](const f32x4 (&acc)[8][4], int wr, int wc, int lane) {
                epi_each<4>(acc, wr, wc, lane, [&](int r, int c, f32x4 v) { store_bf16x4(O + (size_t)(pm * 256 + r) * 2048 + pn * 256 + c, v); });
            });
    });
}

DI void phase_mfeat(PP p, lds_t lds) {
    const int tid = get_tid(), lane = tid & 63, w = tid >> 6;
    bf16_t* XM = (bf16_t*)(p->ws + OFF_ARENA + A_XM);
    bf16_t* XC = (bf16_t*)(p->ws + OFF_ARENA + A_XC);
    bf16_t* CTXV = (bf16_t*)(p->ws + OFF_ACT + ACT_CTXV);
    bf16_t* RAWS = (bf16_t*)(p->ws + OFF_ACT + ACT_RAWS);
    float* GP = (float*)(p->ws + OFF_ACT + ACT_GP);
    const bf16_t* GC = (const bf16_t*)(p->ws + OFF_GCAT);
    const float* MM = (const float*)(p->ws + OFF_MMAT);
    LAS bf16_t* xin = (LAS bf16_t*)lds;
    LAS bf16_t* xct = xin + 67 * 136;
    LAS bf16_t* qpt = xct + 64 * 136;
    LAS bf16_t* gxc = qpt + 64 * 136;
    LAS bf16_t* gxm = gxc + 128 * 16;
    LAS float* mq = (LAS float*)(gxm + 128 * 16);
    LAS float* wvq = mq + 512;
    LAS float* cw = wvq + 512;
    LAS float* gred = cw + 640;
    for (int task = get_bid(); task < NCH * 4; task += gridDim.x) {
        const int ch = task >> 2, h = task & 3, r0 = ch * 64;
        const int seg_lo = ch < NCHL ? r0 : NLAT + ((r0 - NLAT) >> 8) * 256, seg_hi = ch < NCHL ? r0 + 64 : seg_lo + 256;
        f32x4 rs_acc[2] = {{0.f, 0.f, 0.f, 0.f}, {0.f, 0.f, 0.f, 0.f}};
        f32x4 g_acc = {0.f, 0.f, 0.f, 0.f};
        for (int q4 = 0; q4 < 4; ++q4) {
            const int col0 = h * 512 + q4 * 128;
            for (int i = tid; i < 67 * 16; i += NTHREADS) {
                const int row = i >> 4, chunk = i & 15, r = r0 - 2 + row;
                u32x4 v = {0u, 0u, 0u, 0u};
                if (r >= seg_lo && r < seg_hi) v = *(const u32x4*)(XM + (size_t)r * 2048 + col0 + chunk * 8);
                *(LAS u32x4*)(xin + row * 136 + chunk * 8) = v;
            }
            if (tid < 256) *(LAS u32x4*)(gxc + tid * 8) = *(const u32x4*)(GC + (size_t)col0 * 16 + tid * 8);
            else *(LAS u32x4*)(gxm + (tid - 256) * 8) = *(const u32x4*)(GC + (size_t)(2048 + col0) * 16 + (tid - 256) * 8);
            mq[tid] = bf2f(f2bf(MM[(size_t)(col0 >> 2) * 16 + tid]));
            wvq[tid] = p->m_wv[(size_t)(col0 >> 2) * 16 + tid];
            for (int i = tid; i < 640; i += NTHREADS) cw[i] = i < 512 ? p->m_conv_w[(size_t)(i >> 7) * 2048 + col0 + (i & 127)] : p->m_conv_b[col0 + i - 512];
            __syncthreads();
            {
                const int t = tid >> 3, c16 = (tid & 7) * 16;
                float xc[16], xm[16];
#pragma unroll
                for (int j = 0; j < 16; ++j) { xc[j] = cw[512 + c16 + j]; xm[j] = bf2f(xin[(t + 2) * 136 + c16 + j]); }
#pragma unroll
                for (int tap = 0; tap < 4; ++tap)
#pragma unroll
                    for (int j = 0; j < 16; ++j) xc[j] += cw[tap * 128 + c16 + j] * bf2f(xin[(t + tap) * 136 + c16 + j]);
                unsigned xcp[8];
#pragma unroll
                for (int j = 0; j < 8; ++j) { xcp[j] = pk2(siluf_(xc[2 * j]), siluf_(xc[2 * j + 1])); xc[2 * j] = lo_bf(xcp[j]); xc[2 * j + 1] = hi_bf(xcp[j]); }
                float vv[16], qp[16];
#pragma unroll
                for (int n = 0; n < 4; ++n) {
                    const int nb = (c16 >> 2) + n;
#pragma unroll
                    for (int o = 0; o < 4; ++o) {
                        float a = 0.f, b = 0.f;
#pragma unroll
                        for (int i = 0; i < 4; ++i) { a += xm[4 * n + i] * wvq[nb * 16 + i * 4 + o]; b += xc[4 * n + i] * mq[nb * 16 + i * 4 + o]; }
                        vv[4 * n + o] = a; qp[4 * n + o] = b;
                    }
                }
                u32x4 v0, v1;
                v0.x = xcp[0]; v0.y = xcp[1]; v0.z = xcp[2]; v0.w = xcp[3]; v1.x = xcp[4]; v1.y = xcp[5]; v1.z = xcp[6]; v1.w = xcp[7];
                *(LAS u32x4*)(xct + t * 136 + c16) = v0; *(LAS u32x4*)(xct + t * 136 + c16 + 8) = v1;
                bf16_t* xcg = XC + (size_t)(r0 + t) * 2048 + col0 + c16;
                *(u32x4*)xcg = v0; *(u32x4*)(xcg + 8) = v1;
                v0.x = pk2(qp[0], qp[1]); v0.y = pk2(qp[2], qp[3]); v0.z = pk2(qp[4], qp[5]); v0.w = pk2(qp[6], qp[7]);
                v1.x = pk2(qp[8], qp[9]); v1.y = pk2(qp[10], qp[11]); v1.z = pk2(qp[12], qp[13]); v1.w = pk2(qp[14], qp[15]);
                *(LAS u32x4*)(qpt + t * 136 + c16) = v0; *(LAS u32x4*)(qpt + t * 136 + c16 + 8) = v1;
                v0.x = pk2(vv[0], vv[1]); v0.y = pk2(vv[2], vv[3]); v0.z = pk2(vv[4], vv[5]); v0.w = pk2(vv[6], vv[7]);
                v1.x = pk2(vv[8], vv[9]); v1.y = pk2(vv[10], vv[11]); v1.z = pk2(vv[12], vv[13]); v1.w = pk2(vv[14], vv[15]);
                bf16_t* vg = ch < NCHL ? XM + (size_t)(r0 + t) * 2048 + col0 + c16 : CTXV + (size_t)(r0 + t - NLAT) * 2048 + col0 + c16;
                *(u32x4*)vg = v0; *(u32x4*)(vg + 8) = v1;
            }
            __syncthreads();
            {
                const int tt = w >> 1;
#pragma unroll
                for (int e = 0; e < 2; ++e) {
                    const int st = (w & 1) * 2 + e;
#pragma unroll
                    for (int ks = 0; ks < 4; ++ks) rs_acc[e] = mfma16(frag_row(xct, 136, st * 16, ks * 32, lane), frag_row(qpt, 136, tt * 16, ks * 32, lane), rs_acc[e]);
                }
                const int gt = w & 3, src = w >> 2;
                const LAS bf16_t* gm = src ? gxm : gxc;
                const LAS bf16_t* ft = src ? xin + 2 * 136 : xct;
#pragma unroll
                for (int ks = 0; ks < 4; ++ks) g_acc = mfma16(frag_tr(gm, 16, ks * 32, 0, lane), frag_row(ft, 136, gt * 16, ks * 32, lane), g_acc);
            }
            __syncthreads();
        }
        {
            const int tt = w >> 1;
#pragma unroll
            for (int e = 0; e < 2; ++e) {
                const int st = (w & 1) * 2 + e;
                store_bf16x4(RAWS + ((size_t)task * 64 + tt * 16 + (lane & 15)) * 64 + st * 16 + 4 * (lane >> 4), rs_acc[e]);
            }
            const int gt = w & 3, src = w >> 2;
            *(LAS f32x4*)(gred + (src * 64 + gt * 16 + (lane & 15)) * 16 + 4 * (lane >> 4)) = g_acc;
        }
        __syncthreads();
        if (tid < 256) {
            const int t = tid >> 2, q = tid & 3;
            const f32x4 a = *(const LAS f32x4*)(gred + t * 16 + q * 4), b = *(const LAS f32x4*)(gred + (64 + t) * 16 + q * 4);
            *(f32x4*)(GP + ((size_t)(r0 + t) * 4 + h) * 16 + q * 4) = a + b;
        }
        __syncthreads();
    }
}

constexpr int MS_KLD = 1056, MS_QLD = 1040;
constexpr size_t ACT_MSC = 32u << 20;
static_assert(ACT_MSC >= ACT_CTXV + (size_t)NCTX * 2048 * 2 && ACT_MSC + (size_t)256 * 132 * 192 * 4 <= ACT_BYTES, "msc scratch");
constexpr int MS_SCW = 6 * 64 + 8 + 64;
#define MS_REGIONS(L) \
    lds_t xct = (L);                                                         \
    lds_t qpt = (L) + 64 * MS_KLD;                                           \
    LAS bf16_t* vt = (LAS bf16_t*)((L) + 64 * MS_KLD + 64 * MS_QLD);         \
    LAS bf16_t* St = vt + 4096;                                              \
    LAS bf16_t* vwt = St + 4096;                                             \
    LAS float* scbase = (LAS float*)(vwt + 4096);                            \
    LAS float* red = (LAS float*)qpt;
#define MS_SC(SET) \
    LAS float* sc_b = scbase + (SET) * MS_SCW; LAS float* sc_m = sc_b + 64; LAS float* sc_e = sc_m + 64; LAS float* sc_w = sc_e + 64; \
    LAS float* sc_di = sc_w + 64; LAS float* sc_rs = sc_di + 64; LAS float* sc_misc = sc_rs + 64; LAS float* qn = sc_misc + 8;
DI void phase_mscan(PP p, lds_t lds) {
    const int tid = get_tid(), lane = tid & 63, w = tid >> 6, bid = get_bid();
    if (bid >= 256) return;
    const int grp = bid & 31, sl = bid >> 5, b = grp >> 3, h = (grp >> 1) & 3, d = grp & 1;
    const bf16_t* XC = (const bf16_t*)(p->ws + OFF_ARENA + A_XC);
    const bf16_t* V = (const bf16_t*)(p->ws + OFF_ARENA + A_XM);
    const bf16_t* CTXV = (const bf16_t*)(p->ws + OFF_ACT + ACT_CTXV);
    const bf16_t* RAWS = (const bf16_t*)(p->ws + OFF_ACT + ACT_RAWS);
    const float* GP = (const float*)(p->ws + OFF_ACT + ACT_GP);
    float* MSC = (float*)(p->ws + OFF_ACT + ACT_MSC) + (size_t)bid * 132 * 192;
    bf16_t* H = d == 0 ? (bf16_t*)p->out : (bf16_t*)(p->ws + OFF_ARENA + A_HB);
    static_assert(64 * MS_KLD + 64 * MS_QLD + 3 * 8192 + 2 * MS_SCW * 4 <= LDS_BYTES, "mscan lds");
    {
        const float bias_i = p->m_b_gates[d * 8 + h], bias_f = p->m_b_gates[d * 8 + 4 + h];
        for (int st = w; st < 132; st += 8) {
            const int cid = scan_chunk(b, d, st), t = d ? 63 - lane : lane;
            const float* gp = GP + (size_t)(cid * 64 + t) * 64;
            const float gli = gp[d * 8 + h] + gp[16 + d * 8 + h] + gp[32 + d * 8 + h] + gp[48 + d * 8 + h] + bias_i;
            const float gf = gp[d * 8 + 4 + h] + gp[16 + d * 8 + 4 + h] + gp[32 + d * 8 + 4 + h] + gp[48 + d * 8 + 4 + h] + bias_f;
            float bb = log_sigmoidf_(gf);
#pragma unroll
            for (int o = 1; o < 64; o <<= 1) { const float t_ = __shfl_up(bb, o); if (lane >= o) bb += t_; }
            float pm = gli - bb;
#pragma unroll
            for (int o = 1; o < 64; o <<= 1) { const float t_ = __shfl_up(pm, o); if (lane >= o) pm = fmaxf(pm, t_); }
            float* dst = MSC + (size_t)st * 192;
            dst[lane] = bb; dst[64 + lane] = gli; dst[128 + lane] = pm;
        }
    }
    const int c16o = tid & 63;
    bf16x2_t Mp[2][4][2];
#pragma unroll
    for (int n = 0; n < 2; ++n) {
        const float* mm = (const float*)(p->ws + OFF_MMAT) + (size_t)(h * 128 + 2 * c16o + n) * 16;
#pragma unroll
        for (int o = 0; o < 4; ++o) { Mp[n][o][0] = __builtin_bit_cast(bf16x2_t, pk2(mm[o], mm[4 + o])); Mp[n][o][1] = __builtin_bit_cast(bf16x2_t, pk2(mm[8 + o], mm[12 + o])); }
    }
    f32x4 C[16], Nacc[4];
#pragma unroll
    for (int i = 0; i < 16; ++i) C[i] = (f32x4){0.f, 0.f, 0.f, 0.f};
#pragma unroll
    for (int i = 0; i < 4; ++i) Nacc[i] = (f32x4){0.f, 0.f, 0.f, 0.f};
    float m_prev = 0.f;
    u32x4 xcr[8], vr, rr; float g_b = 0.f, g_li = 0.f, g_pm = 0.f;
    asm volatile("s_waitcnt vmcnt(0)" ::: "memory");
    __syncthreads();
    auto prefetch = [&](int st) {
        int tp = get_tid();
        const int tid = tp, lane = tid & 63, w = tid >> 6;
        const int cid = scan_chunk(b, d, st), r0 = cid * 64;
        const bf16_t* xp = XC + (size_t)(r0 + (tid >> 6)) * 2048 + h * 512 + (tid & 63) * 8;
#pragma unroll
        for (int i = 0; i < 8; ++i) xcr[i] = *(const u32x4*)(xp + (size_t)i * 8 * 2048);
        { const int s_ = tid >> 3, chunk = tid & 7;
          vr = cid < NCHL ? *(const u32x4*)(V + (size_t)(r0 + s_) * 2048 + h * 512 + sl * 64 + chunk * 8) : *(const u32x4*)(CTXV + (size_t)(r0 + s_ - NLAT) * 2048 + h * 512 + sl * 64 + chunk * 8);
          rr = *(const u32x4*)(RAWS + ((size_t)(cid * 4 + h) * 64 + s_) * 64 + chunk * 8); }
        if (w == 0) { const float* src = MSC + (size_t)st * 192; g_b = src[lane]; g_li = src[64 + lane]; g_pm = src[128 + lane]; }
    };
    auto scalars = [&](int set) {
        if (w == 0) {
            MS_REGIONS(lds) MS_SC(set) (void)xct; (void)vt; (void)red; (void)sc_rs;
            const float my_m = g_b + fmaxf(m_prev, g_pm);
            const float m_new = __shfl(my_m, 63), b_last = __shfl(g_b, 63);
            const int t = d ? 63 - lane : lane;
            sc_b[t] = g_b; sc_m[t] = my_m; sc_e[t] = g_li - g_b; sc_w[t] = __expf(b_last - g_b + g_li - m_new); sc_di[t] = __expf(g_b + m_prev - my_m);
            qn[lane] = 0.f;
            if (lane == 0) sc_misc[0] = __expf(b_last + m_prev - m_new);
            m_prev = m_new;
        }
    };
    prefetch(0);
    scalars(0);
    for (int st = 0; st < 132; ++st) {
        const int cid = scan_chunk(b, d, st);
        const bool emit = cid < NCHL;
        int tl = tid, zoff = 0;
        asm volatile("" : "+v"(tl), "+v"(zoff));
        const int tid = tl, lane = tid & 63, w = tid >> 6, cg = w & 3, kh = w >> 2, g4 = lane >> 4, l15 = lane & 15, c16 = tid & 63, srow0 = tid >> 6;
        MS_REGIONS(lds + zoff)
        MS_SC(st & 1)
        __syncthreads();
        {
            lds_t xw_ = xct + srow0 * MS_KLD + c16 * 16;
            lds_t qw_ = qpt + srow0 * MS_QLD + c16 * 16;
#pragma unroll
            for (int i = 0; i < 8; ++i) {
                const unsigned xw[4] = {xcr[i].x, xcr[i].y, xcr[i].z, xcr[i].w};
                float q[8];
#pragma unroll
                for (int n = 0; n < 2; ++n)
#pragma unroll
                    for (int o = 0; o < 4; ++o)
                        q[4 * n + o] = __builtin_amdgcn_fdot2_f32_bf16(__builtin_bit_cast(bf16x2_t, xw[2 * n + 1]), Mp[n][o][1], __builtin_amdgcn_fdot2_f32_bf16(__builtin_bit_cast(bf16x2_t, xw[2 * n]), Mp[n][o][0], 0.f, false), false);
                u32x4 qv; qv.x = pk2(q[0], q[1]); qv.y = pk2(q[2], q[3]); qv.z = pk2(q[4], q[5]); qv.w = pk2(q[6], q[7]);
                *(LAS u32x4*)(xw_ + i * 8 * MS_KLD) = xcr[i];
                *(LAS u32x4*)(qw_ + i * 8 * MS_QLD) = qv;
            }
        }
        {
            const int t = tid >> 3, s8 = (tid & 7) * 8;
            *(LAS u32x4*)(vt + t * 64 + s8) = vr;
            {
                const float ww = sc_w[t];
                u32x4 o; o.x = pk2(lo_bf(vr.x) * ww, hi_bf(vr.x) * ww); o.y = pk2(lo_bf(vr.y) * ww, hi_bf(vr.y) * ww); o.z = pk2(lo_bf(vr.z) * ww, hi_bf(vr.z) * ww); o.w = pk2(lo_bf(vr.w) * ww, hi_bf(vr.w) * ww);
                *(LAS u32x4*)(vwt + t * 64 + s8) = o;
            }
            if (emit) {
                const unsigned rwv[4] = {rr.x, rr.y, rr.z, rr.w};
                const float base = sc_b[t] - sc_m[t];
                const f32x4 e0 = *(const LAS f32x4*)(sc_e + s8), e1 = *(const LAS f32x4*)(sc_e + s8 + 4);
                float sv[8]; float rsum = 0.f;
#pragma unroll
                for (int j = 0; j < 8; ++j) {
                    const int s_ = s8 + j;
                    const float raw = (j & 1) ? hi_bf(rwv[j >> 1]) : lo_bf(rwv[j >> 1]);
                    const bool keep = d == 0 ? s_ <= t : s_ >= t;
                    const float ex = __expf(base + (j < 4 ? e0[j & 3] : e1[j & 3]));
                    sv[j] = keep ? raw * ex : 0.f;
                    rsum += sv[j];
                }
                u32x4 o; o.x = pk2(sv[0], sv[1]); o.y = pk2(sv[2], sv[3]); o.z = pk2(sv[4], sv[5]); o.w = pk2(sv[6], sv[7]);
                *(LAS u32x4*)(St + t * 64 + s8) = o;
                rsum += __shfl_xor(rsum, 1); rsum += __shfl_xor(rsum, 2); rsum += __shfl_xor(rsum, 4);
                if ((tid & 7) == 0) sc_rs[t] = rsum;
            }
        }
        __syncthreads();
        const int cg_s = __builtin_amdgcn_readfirstlane(cg);
        f32x4 acc2[4], accq[4];
#pragma unroll
        for (int tt = 0; tt < 4; ++tt) { acc2[tt] = (f32x4){0.f, 0.f, 0.f, 0.f}; accq[tt] = acc2[tt]; }
        if (emit) {
            lds_t qa = qpt + l15 * MS_QLD + (kh * 256 + 4 * g4) * 2;
            u32x2 qb[2][4][2];
#pragma unroll
            for (int tt = 0; tt < 4; ++tt) { qb[0][tt][0] = *(const LAS u32x2*)(qa + tt * 16 * MS_QLD); qb[0][tt][1] = *(const LAS u32x2*)(qa + tt * 16 * MS_QLD + 32); }
#pragma unroll
            for (int m = 0; m < 8; ++m) {
                if (m + 1 < 8) {
#pragma unroll
                    for (int tt = 0; tt < 4; ++tt) { qb[(m + 1) & 1][tt][0] = *(const LAS u32x2*)(qa + tt * 16 * MS_QLD + (m + 1) * 64); qb[(m + 1) & 1][tt][1] = *(const LAS u32x2*)(qa + tt * 16 * MS_QLD + (m + 1) * 64 + 32); }
                }
                u32x4 cb; cb.x = pk2(C[2 * m][0], C[2 * m][1]); cb.y = pk2(C[2 * m][2], C[2 * m][3]); cb.z = pk2(C[2 * m + 1][0], C[2 * m + 1][1]); cb.w = pk2(C[2 * m + 1][2], C[2 * m + 1][3]);
                const bf16x8 cf = __builtin_bit_cast(bf16x8, cb);
                const bool own = (m & 3) == cg_s;
                bf16x8 nf = cf;
                if (own) { const int pi = (m >> 2) * 2; u32x4 nb; nb.x = pk2(Nacc[pi][0], Nacc[pi][1]); nb.y = pk2(Nacc[pi][2], Nacc[pi][3]); nb.z = pk2(Nacc[pi + 1][0], Nacc[pi + 1][1]); nb.w = pk2(Nacc[pi + 1][2], Nacc[pi + 1][3]); nf = __builtin_bit_cast(bf16x8, nb); }
#pragma unroll
                for (int tt = 0; tt < 4; ++tt) {
                    u32x4 av; av.x = qb[m & 1][tt][0].x; av.y = qb[m & 1][tt][0].y; av.z = qb[m & 1][tt][1].x; av.w = qb[m & 1][tt][1].y;
                    const bf16x8 qf = __builtin_bit_cast(bf16x8, av);
                    acc2[tt] = mfma16(cf, qf, acc2[tt]);
                    if (own) accq[tt] = mfma16(nf, qf, accq[tt]);
                }
            }
            const bf16x8 vf = frag_tr(vt, 64, kh * 32, cg * 16, lane);
#pragma unroll
            for (int tt = 0; tt < 4; ++tt) {
                acc2[tt] = acc2[tt] * sc_di[tt * 16 + l15];
                acc2[tt] = mfma16(vf, frag_row(St, 64, tt * 16, kh * 32, lane), acc2[tt]);
            }
            if (g4 == 0) {
#pragma unroll
                for (int tt = 0; tt < 4; ++tt) __hip_atomic_fetch_add((float*)(qn + tt * 16 + l15), accq[tt][0], __ATOMIC_RELAXED, __HIP_MEMORY_SCOPE_WORKGROUP);
            }
        }
        if (st + 1 < 132) prefetch(st + 1);
        {
            const float gd = sc_misc[0];
            bf16x8 vb[2], wf[2];
#pragma unroll
            for (int ks = 0; ks < 2; ++ks) {
                vb[ks] = frag_tr(vwt, 64, ks * 32, cg * 16, lane);
                const f32x4 w0 = *(const LAS f32x4*)(sc_w + ks * 32 + 8 * g4), w1 = *(const LAS f32x4*)(sc_w + ks * 32 + 8 * g4 + 4);
                u32x4 wp; wp.x = pk2(w0[0], w0[1]); wp.y = pk2(w0[2], w0[3]); wp.z = pk2(w1[0], w1[1]); wp.w = pk2(w1[2], w1[3]);
                if (l15 != 0) wp = (u32x4){0u, 0u, 0u, 0u};
                wf[ks] = __builtin_bit_cast(bf16x8, wp);
            }
#pragma unroll
            for (int j = 0; j < 4; ++j) Nacc[j] = Nacc[j] * gd;
            lds_t ka = xct + (8 * g4 + (l15 >> 2)) * MS_KLD + (kh * 256 + 4 * (l15 & 3)) * 2;
            s16x4 kb[2][2][2];
#pragma unroll
            for (int ks = 0; ks < 2; ++ks) {
                kb[0][ks][0] = __builtin_amdgcn_ds_read_tr16_b64_v4i16((LAS s16x4*)(ka + ks * 32 * MS_KLD));
                kb[0][ks][1] = __builtin_amdgcn_ds_read_tr16_b64_v4i16((LAS s16x4*)(ka + ks * 32 * MS_KLD + 4 * MS_KLD));
            }
#pragma unroll
            for (int i = 0; i < 16; ++i) {
                if (i + 1 < 16) {
#pragma unroll
                    for (int ks = 0; ks < 2; ++ks) {
                        kb[(i + 1) & 1][ks][0] = __builtin_amdgcn_ds_read_tr16_b64_v4i16((LAS s16x4*)(ka + ks * 32 * MS_KLD + (i + 1) * 32));
                        kb[(i + 1) & 1][ks][1] = __builtin_amdgcn_ds_read_tr16_b64_v4i16((LAS s16x4*)(ka + ks * 32 * MS_KLD + 4 * MS_KLD + (i + 1) * 32));
                    }
                }
                C[i] = C[i] * gd;
                const bool own = ((i >> 1) & 3) == cg_s;
#pragma unroll
                for (int ks = 0; ks < 2; ++ks) {
                    const bf16x8 kf = __builtin_shufflevector(kb[i & 1][ks][0], kb[i & 1][ks][1], 0, 1, 2, 3, 4, 5, 6, 7);
                    C[i] = mfma16(kf, vb[ks], C[i]);
                    if (own) Nacc[(i >> 3) * 2 + (i & 1)] = mfma16(kf, wf[ks], Nacc[(i >> 3) * 2 + (i & 1)]);
                }
            }
        }
        __syncthreads();
        if (emit && kh == 1) {
#pragma unroll
            for (int tt = 0; tt < 4; ++tt) *(LAS f32x4*)(red + ((cg * 4 + tt) * 64 + lane) * 4) = acc2[tt];
        }
        if (st + 1 < 132) scalars((st + 1) & 1);
        __syncthreads();
        if (emit && kh == 0) {
#pragma unroll
            for (int tt = 0; tt < 4; ++tt) {
                const int t = tt * 16 + l15;
                const f32x4 o = acc2[tt] + *(const LAS f32x4*)(red + ((cg * 4 + tt) * 64 + lane) * 4);
                const float dn = fmaxf(fabsf(sc_di[t] * qn[t] + sc_rs[t]), __expf(-sc_m[t]));
                store_bf16x4(H + (size_t)(cid * 64 + t) * 2048 + h * 512 + sl * 64 + cg * 16 + 4 * g4, o * (1.f / dn));
            }
        }
    }
}

DI void phase_merge(PP p) {
    const int tid = get_tid(), lane = tid & 63;
    const bf16_t* HF = (const bf16_t*)p->out;
    bf16_t* HB = (bf16_t*)(p->ws + OFF_ARENA + A_HB);
    const bf16_t* XC = (const bf16_t*)(p->ws + OFF_ARENA + A_XC);
    const bf16_t* Z = (const bf16_t*)(p->ws + OFF_ARENA + A_XM);
    const int gw = get_bid() * 8 + (tid >> 6), nw = gridDim.x * 8;
    for (int r = gw; r < NLAT; r += nw) {
#pragma unroll
        for (int hh = 0; hh < 4; ++hh) {
            const size_t o = (size_t)r * 2048 + hh * 512 + lane * 8;
            const u32x4 a = *(const u32x4*)(HF + o), b = *(const u32x4*)(HB + o), xq = *(const u32x4*)(XC + o), zq = *(const u32x4*)(Z + o);
            const unsigned aw[4] = {a.x, a.y, a.z, a.w}, bw[4] = {b.x, b.y, b.z, b.w}, xw[4] = {xq.x, xq.y, xq.z, xq.w}, zw[4] = {zq.x, zq.y, zq.z, zq.w};
            float hv[8]; float sum = 0.f;
#pragma unroll
            for (int j = 0; j < 4; ++j) { hv[2 * j] = lo_bf(aw[j]) + lo_bf(bw[j]); hv[2 * j + 1] = hi_bf(aw[j]) + hi_bf(bw[j]); sum += hv[2 * j] + hv[2 * j + 1]; }
            const float mean = wave_sum(sum) * (1.f / 512.f);
            float sq = 0.f;
#pragma unroll
            for (int j = 0; j < 8; ++j) { hv[j] -= mean; sq += hv[j] * hv[j]; }
            const float rs = rsqrtf(wave_sum(sq) * (1.f / 512.f) + EPS);
            float ov[8];
#pragma unroll
            for (int j = 0; j < 8; ++j) {
                const int c = hh * 512 + lane * 8 + j;
                const float xcv = (j & 1) ? hi_bf(xw[j >> 1]) : lo_bf(xw[j >> 1]);
                const float zv = (j & 1) ? hi_bf(zw[j >> 1]) : lo_bf(zw[j >> 1]);
                ov[j] = (hv[j] * rs * p->m_norm_g[c] + p->m_skip[c] * xcv) * siluf_(zv);
            }
            u32x4 v; v.x = pk2(ov[0], ov[1]); v.y = pk2(ov[2], ov[3]); v.z = pk2(ov[4], ov[5]); v.w = pk2(ov[6], ov[7]);
            *(u32x4*)(HB + o) = v;
        }
    }
}

DI void phase_downproj(PP p, lds_t lds) {
    const bf16_t* A = (const bf16_t*)(p->ws + OFF_ARENA + A_HB);
    float* X = (float*)(p->ws + OFF_ARENA + A_X);
    constexpr int NM = NLAT / 256, NN = 4;
    for_units_xcd(1, NM, NN, 8, 4, [&](int, int pm, int pn) {
        const float* g1 = mods_ptr(p, 1, pm >> 5, 2);
        gemm_unit_t<64>(lds, 2048,
            [&](int r) { return A + (size_t)(pm * 256 + r) * 2048; },
            [&](int r) { return (const bf16_t*)(p->ws + OFF_WDNT) + (size_t)(pn * 256 + r) * 2048; },
            [&](const f32x4 (&acc)[8][4], int wr, int wc, int lane) {
                epi_each<4>(acc, wr, wc, lane, [&](int r, int c, f32x4 v) {
                    const int col = pn * 256 + c;
                    float* xp = X + (size_t)(pm * 256 + r) * 1024 + col;
                    const f32x4 g = *(const f32x4*)(g1 + col);
                    *(f32x4*)xp = *(const f32x4*)xp + g * v;
                });
            });
    });
}

DI void phase_dbg_final(PP p, int mode) {
    const int tid = get_tid(), lane = tid & 63;
    const int gw = get_bid() * 8 + (tid >> 6), nw = gridDim.x * 8;
    if (mode == 4) {
        const int* rid = (const int*)(p->ws + OFF_ARENA + A_ROWID);
        for (int r = gw; r < NLAT; r += nw)
            for (int c = lane; c < 1024; c += 64) p->out[(size_t)r * 1024 + c] = (float)rid[(size_t)r * 16 + (c & 15)];
        return;
    }
    if (mode == 7) {
        const bf16_t* y = (const bf16_t*)(p->ws + OFF_ARENA + A_Y);
        for (int r = gw; r < NLAT; r += nw)
            for (int c = lane; c < 1024; c += 64) { const float v = bf2f(y[(size_t)r * 1024 + c]); p->out[(size_t)r * 1024 + c] = (v == v && fabsf(v) < 1e30f) ? 0.f : 1000.f; }
        return;
    }
    if (mode >= 2) {
        const bf16_t* src = mode == 2 ? (const bf16_t*)(p->ws + OFF_ARENA + A_P) : mode == 5 ? (const bf16_t*)(p->ws + OFF_ARENA + A_HDN) : mode == 6 ? (const bf16_t*)(p->ws + OFF_ARENA + A_Y) : (const bf16_t*)(p->ws + OFF_ACT);
        const int ld = mode == 2 ? ABIN : 1024;
        for (int r = gw; r < NLAT; r += nw)
            for (int c = lane; c < 1024; c += 64) p->out[(size_t)r * 1024 + c] = bf2f(src[(size_t)r * ld + (mode == 2 ? c + DBG_COL0 : c)]);
        return;
    }
    const float* X = mode ? (const float*)(p->ws + OFF_ARENA + A_X) : p->x;
    for (int r = gw; r < NLAT; r += nw) {
        f32x4 v[4];
        row_load_f32(X + (size_t)r * 1024, v, lane);
        const float rs = rsqrtf(row_sumsq(v) * (1.f / 1024.f) + EPS);
#pragma unroll
        for (int i = 0; i < 4; ++i) { const f32x4 g = *(const f32x4*)(p->final_g + 4 * lane + 256 * i); *(f32x4*)(p->out + (size_t)r * 1024 + 4 * lane + 256 * i) = v[i] * rs * g; }
    }
}

DI void grid_barrier(cg::grid_group& grid, PP p, unsigned& nbar) {
    asm volatile("s_waitcnt vmcnt(0) lgkmcnt(0)" ::: "memory");
    unsigned* ctr = (unsigned*)(p->ws + OFF_BAR);
    if (nbar == 0) {
        if (blockIdx.x == 0 && threadIdx.x == 0) __hip_atomic_store(ctr, 0u, __ATOMIC_RELAXED, __HIP_MEMORY_SCOPE_AGENT);
        asm volatile("s_waitcnt vmcnt(0)" ::: "memory");
        grid.sync();
        __builtin_amdgcn_fence(__ATOMIC_ACQUIRE, "agent");
        asm volatile("s_waitcnt vmcnt(0)" ::: "memory");
    } else {
        __syncthreads();
        if (threadIdx.x == 0) {
            __builtin_amdgcn_fence(__ATOMIC_RELEASE, "agent");
            asm volatile("s_waitcnt vmcnt(0)" ::: "memory");
            __hip_atomic_fetch_add(ctr, 1u, __ATOMIC_RELAXED, __HIP_MEMORY_SCOPE_AGENT);
            const unsigned target = nbar * gridDim.x;
            while (__hip_atomic_load(ctr, __ATOMIC_RELAXED, __HIP_MEMORY_SCOPE_AGENT) < target) __builtin_amdgcn_s_sleep(1);
            __builtin_amdgcn_fence(__ATOMIC_ACQUIRE, "agent");
            asm volatile("s_waitcnt vmcnt(0)" ::: "memory");
        }
        __syncthreads();
    }
    ++nbar;
}
#define RUN_PHASE(K, CALL) if (ph_lo <= (K) && (K) < ph_hi && ((K) <= DBG_STOP)) { PP p = kp; asm volatile("" : "+s"(p)); CALL; if ((DUP_MASK >> (K)) & 1) { grid_barrier(grid, p, nbar); asm volatile("" : "+s"(p)); CALL; } if ((K) + 1 < ph_hi) { grid_barrier(grid, p, nbar); if (EXTRA_BARRIERS) grid_barrier(grid, p, nbar); } }
__global__ void __launch_bounds__(NTHREADS) mega(Params p_in) {
    extern __shared__ __attribute__((aligned(16))) unsigned char lds_raw[];
    lds_t lds = (lds_t)lds_raw;
    cg::grid_group grid = cg::this_grid();
    PP kp = (PP)__builtin_amdgcn_kernarg_segment_ptr();
    const int ph_lo = kp->ph_lo, ph_hi = kp->ph_hi;
    unsigned nbar = 0;
    RUN_PHASE(0, phase_mods(p, lds))
    RUN_PHASE(1, phase_norm(p, 0, NTOK, [&](int r) { return r < NLAT ? p->x + (size_t)r * 1024 : p->ctx + (size_t)(r - NLAT) * 1024; }))
    RUN_PHASE(2, phase_inproj(p, lds))
    RUN_PHASE(3, phase_g1(p, lds))
    RUN_PHASE(4, phase_scan0(p))
    RUN_PHASE(5, phase_g3(p, lds))
    RUN_PHASE(6, phase_outproj0(p, lds))
    RUN_PHASE(7, phase_router(p, lds, 0))
    RUN_PHASE(8, phase_topk(p, lds, 0))
    RUN_PHASE(9, phase_moe_up(p, lds, 0))
    RUN_PHASE(10, phase_moe_down(p, lds, 0))
    RUN_PHASE(11, phase_combine(p, 0))
    RUN_PHASE(12, phase_upproj(p, lds, 0))
    RUN_PHASE(13, phase_mfeat(p, lds))
    RUN_PHASE(14, phase_mscan(p, lds))
    RUN_PHASE(15, phase_norm(p, 1, NLAT, [&](int r) { return (const float*)(p->ws + OFF_ARENA + A_X) + (size_t)r * 1024; }))
    RUN_PHASE(16, phase_upproj(p, lds, 1))
    RUN_PHASE(17, phase_merge(p))
    RUN_PHASE(18, phase_downproj(p, lds))
    RUN_PHASE(19, phase_router(p, lds, 1))
    RUN_PHASE(20, phase_topk(p, lds, 1))
    RUN_PHASE(21, phase_moe_up(p, lds, 1))
#if GEMM_PROBE >= 0
    if (ph_lo <= 22 && 22 < ph_hi) { PP p = kp; asm volatile("" : "+s"(p)); phase_moe_down_t<GEMM_PROBE>(p, lds, 1); grid_barrier(grid, p, nbar); }
#endif
    RUN_PHASE(22, phase_moe_down(p, lds, 1))
    RUN_PHASE(23, phase_combine(p, 1))
    if (DBG_STOP < 23 && DBG_STOP + 1 < ph_hi) { PP p = kp; asm volatile("" : "+s"(p)); phase_dbg_final(p, DBG_MODE); }
}

extern "C" void kernel_launch(void* const* d_in, const int* in_sizes, int n_in, void* d_out, int out_size, void* d_ws, size_t ws_size, hipStream_t stream) {
    static int grid = 0;
    if (grid == 0) {
        int dev = 0, cus = 0, per_cu = 0;
        hipGetDevice(&dev);
        hipDeviceGetAttribute(&cus, hipDeviceAttributeMultiprocessorCount, dev);
        hipFuncSetAttribute((const void*)mega, hipFuncAttributeMaxDynamicSharedMemorySize, LDS_BYTES);
        hipOccupancyMaxActiveBlocksPerMultiprocessor(&per_cu, (const void*)mega, NTHREADS, LDS_BYTES);
        if (per_cu < 1) { fprintf(stderr, "occupancy query says %d blocks/CU\n", per_cu); per_cu = 1; }
        grid = cus;
        if (ws_size < WS_NEED) { fprintf(stderr, "workspace too small: %zu < %zu\n", ws_size, (size_t)WS_NEED); grid = -1; }
    }
    if (grid < 0) return;
    Params hp{};
    const float** pp = (const float**)&hp;
    for (int i = 0; i < 36; ++i) pp[i] = (const float*)d_in[i];
    hp.out = (float*)d_out; hp.ws = (char*)d_ws; hp.ph_lo = 0; hp.ph_hi = DBG_STOP < 23 ? DBG_STOP + 2 : 24;
    void* args[] = {&hp};
    hipError_t e = hipLaunchCooperativeKernel((const void*)mega, dim3(grid), dim3(NTHREADS), args, LDS_BYTES, stream);
    if (e != hipSuccess) fprintf(stderr, "cooperative launch failed: %s\n", hipGetErrorString(e));
}
```

```cpp
#include <hip/hip_runtime.h>
#include <hip/hip_cooperative_groups.h>
#include <cstdio>
#include <cstdint>
namespace cg = cooperative_groups;

#define LAS __attribute__((address_space(3)))
#define DI __device__ __forceinline__
typedef unsigned short bf16_t;
typedef short bf16x8 __attribute__((ext_vector_type(8)));
typedef short s16x4 __attribute__((ext_vector_type(4)));
typedef float f32x4 __attribute__((ext_vector_type(4)));
typedef float f32x2 __attribute__((ext_vector_type(2)));
typedef unsigned u32x4 __attribute__((ext_vector_type(4)));
typedef unsigned u32x2 __attribute__((ext_vector_type(2)));
typedef LAS char* lds_t;

constexpr int D = 1024, NBATCH = 4, SEQ = 8192, CTXL = 256;
constexpr int NLAT = NBATCH * SEQ;
constexpr int NCTX = NBATCH * CTXL;
constexpr int NTOK = NLAT + NCTX;
constexpr int NCH = NTOK / 64;
constexpr int NCHL = NLAT / 64;
constexpr int ABIN = 2592;
constexpr int PC_Q = 0, PC_K = 256, PC_V = 512, PC_G = 1024, PC_LRF = 1536, PC_LRB = 1552, PC_RGG = 1568, PC_RGX = 2080;
constexpr float EPS = 1e-6f;
constexpr int NTHREADS = 512;
constexpr int LDS_BYTES = 160 * 1024;
#define DBG_MODE 1
#ifndef DUP_MASK
#define DUP_MASK 0
#endif
#ifndef SHADOW_PH
#define SHADOW_PH -1
#endif
#ifndef PROF_SEC
#define PROF_SEC -1
#endif
#ifndef GEMM_PROBE
#define GEMM_PROBE -1
#endif
#ifndef EXTRA_BARRIERS
#define EXTRA_BARRIERS 0
#endif
#define DBG_STOP 23
#define DBG_COL0 0

constexpr size_t OFF_MODS = 0;
constexpr size_t OFF_GCAT = 245760;
constexpr size_t OFF_MMAT = 376832;
constexpr size_t OFF_BAR = 409600;
constexpr size_t OFF_ZROW = 413696;
constexpr size_t OFF_ACT = 1u << 20;
constexpr size_t ACT_BYTES = (size_t)NTOK * 1024 * 2;
constexpr size_t OFF_ARENA = OFF_ACT + ACT_BYTES;
constexpr size_t A_P = 0;
constexpr size_t A_U = A_P + (size_t)NTOK * ABIN * 2;
constexpr size_t A_LA = A_U + (size_t)NCH * 2 * 4 * 8192 * 4;
constexpr size_t A_UU = A_LA + (size_t)NTOK * 2 * 512 * 4;
constexpr size_t A_DEC = A_UU + (size_t)NTOK * 2 * 512 * 2;
constexpr size_t A_AGGA = A_DEC + (size_t)NCH * 2 * 256 * 4;
constexpr size_t A_AGGH = A_AGGA + (size_t)NCH * 2 * 512 * 4;
constexpr size_t A_L0_END = A_AGGH + (size_t)NCH * 2 * 512 * 4;
constexpr size_t A_X = 0;
constexpr size_t A_PT = A_X + (size_t)NTOK * 1024 * 4;
constexpr size_t A_PE = A_PT + (size_t)NTOK * 16 * 4;
constexpr size_t A_ROWID = A_PE + (size_t)NTOK * 16 * 4;
constexpr size_t A_ROWTOK = A_ROWID + (size_t)NTOK * 16 * 4;
constexpr size_t A_HDN = A_ROWTOK + (size_t)16 * 4352 * 4;
constexpr size_t A_Y = A_HDN + (size_t)16 * 4352 * 1024 * 2;
constexpr size_t A_MOE0_END = A_Y + (size_t)16 * 4352 * 1024 * 2;
constexpr size_t A_XM = A_X + (size_t)NTOK * 1024 * 4;
constexpr size_t A_XC = A_XM + (size_t)NTOK * 2048 * 2;
constexpr size_t A_HB = A_XC + (size_t)NTOK * 2048 * 2;
constexpr size_t A_L1_END = A_HB + (size_t)NLAT * 2048 * 2;
constexpr size_t ACT_RAWS = 0;
constexpr size_t ACT_GP = ACT_RAWS + (size_t)NCH * 4 * 4096 * 2;
constexpr size_t ACT_CTXV = ACT_GP + (size_t)NTOK * 64 * 4;
constexpr size_t WS_NEED0 = OFF_ARENA + (A_L1_END > A_L0_END ? A_L1_END : A_L0_END);
constexpr size_t OFF_WUPT = WS_NEED0;
constexpr size_t OFF_WDNT = OFF_WUPT + (size_t)4096 * 1024 * 2;
constexpr size_t WS_NEED = OFF_WDNT + (size_t)1024 * 2048 * 2;
constexpr size_t DO_WIN = 0;
constexpr size_t DO_WOUT = (size_t)2816 * 1024 * 2;
constexpr size_t DO_EXP = 8u << 20;
constexpr size_t EXP_STRIDE = (size_t)3072 * 1024 * 2;
constexpr int GUG = 32;
static_assert(DO_EXP + 16 * EXP_STRIDE <= (size_t)NLAT * 1024 * 4, "d_out staging");
static_assert(A_MOE0_END < A_L1_END, "arena");
static_assert(ACT_CTXV + (size_t)NCTX * 2048 * 2 <= ACT_BYTES, "act region");

struct Params {
    const float *x, *c, *ctx, *c_ctx, *mod_w, *mod_b, *norm1_g, *norm2_g, *ab_w_in, *gla_wa2, *gla_ba, *gla_norm_g;
    const float *rg_conv_w, *rg_conv_b, *rg_wr, *rg_br, *rg_wi, *rg_bi, *rg_lambda, *ab_w_out, *m_w_up, *m_conv_w, *m_conv_b;
    const float *m_wq, *m_wk, *m_wv, *m_w_gates, *m_b_gates, *m_skip, *m_norm_g, *m_w_down, *router_w, *exp_w_gate, *exp_w_up, *exp_w_down, *final_g;
    float* out;
    char* ws;
    int ph_lo, ph_hi;
};

typedef const Params __attribute__((address_space(4)))* PP;

DI int get_tid() { int t = threadIdx.x; asm volatile("" : "+v"(t)); return t; }
DI int get_bid() { int b = blockIdx.x; asm volatile("" : "+s"(b)); return b; }
DI float bf2f(bf16_t h) { return __uint_as_float((unsigned)h << 16); }
DI bf16_t f2bf(float x) { unsigned u = __float_as_uint(x); u += 0x7fffu + ((u >> 16) & 1u); return (bf16_t)(u >> 16); }
typedef __bf16 bf16x2_t __attribute__((ext_vector_type(2)));
DI unsigned pk2n(float lo, float hi) { const f32x2 v = {lo, hi}; return __builtin_bit_cast(unsigned, __builtin_convertvector(v, bf16x2_t)); }
DI unsigned pk2(float lo, float hi) { return pk2n(lo, hi); }
DI float lo_bf(unsigned u) { return __uint_as_float(u << 16); }
DI float hi_bf(unsigned u) { return __uint_as_float(u & 0xffff0000u); }
DI float rcpf_(float x) { return __builtin_amdgcn_rcpf(x); }
DI float sigmoidf_(float x) { return rcpf_(1.f + __expf(-x)); }
DI float siluf_(float x) { return x * rcpf_(1.f + __expf(-x)); }
DI float log_sigmoidf_(float z) { return fminf(z, 0.f) - __logf(1.f + __expf(-fabsf(z))); }
DI float softplusf_(float z) { return fmaxf(z, 0.f) + __logf(1.f + __expf(-fabsf(z))); }
DI float gelu_tanh(float x) { const float u = 0.7978845608028654f * (x + 0.044715f * x * x * x); return x * rcpf_(1.f + __expf(-2.f * u)); }
DI float wave_sum(float v) {
#pragma unroll
    for (int o = 32; o > 0; o >>= 1) v += __shfl_xor(v, o);
    return v;
}
DI f32x4 mfma16(bf16x8 a, bf16x8 b, f32x4 c) { return __builtin_amdgcn_mfma_f32_16x16x32_bf16(a, b, c, 0, 0, 0); }

DI bf16x8 frag_row(const LAS bf16_t* tile, int ld, int r0, int k0, int lane) {
    return *(const LAS bf16x8*)(tile + (r0 + (lane & 15)) * ld + k0 + 8 * (lane >> 4));
}
DI bf16x8 frag_tr(const LAS bf16_t* tile, int ld, int k0, int c0, int lane) {
    const int g = lane >> 4, i = lane & 15, q = i >> 2, p = i & 3;
    const LAS bf16_t* base = tile + (k0 + 8 * g + q) * ld + c0 + 4 * p;
    const s16x4 lo = __builtin_amdgcn_ds_read_tr16_b64_v4i16((LAS s16x4*)base);
    const s16x4 hi = __builtin_amdgcn_ds_read_tr16_b64_v4i16((LAS s16x4*)(base + 4 * ld));
    return __builtin_shufflevector(lo, hi, 0, 1, 2, 3, 4, 5, 6, 7);
}
DI bf16x8 frag_tr_swp(const LAS bf16_t* tile, int ld, int k0, int c0, int lane) {
    const int g = lane >> 4, i = lane & 15, q = i >> 2, p = i & 3, sw = (g & 1) * 4;
    const LAS bf16_t* base = tile + (k0 + 8 * g + q) * ld + c0 + 4 * p;
    const s16x4 lo = __builtin_amdgcn_ds_read_tr16_b64_v4i16((LAS s16x4*)(base + sw * ld));
    const s16x4 hi = __builtin_amdgcn_ds_read_tr16_b64_v4i16((LAS s16x4*)(base + (4 - sw) * ld));
    return __builtin_shufflevector(lo, hi, 0, 1, 2, 3, 4, 5, 6, 7);
}
DI const float* mods_ptr(PP p, int layer, int s, int which) { return (const float*)(p->ws + OFF_MODS) + ((size_t)(layer * 5 + s) * 6 + which) * 1024; }
DI int row_set(int r) { return r < NLAT ? (r >> 13) : 4; }

template <int BN, int BK, int PROBE = 0, class ARow, class BCol, class Epi>
DI void gemm_unit(lds_t lds, int K, int ldb, ARow arow, BCol bcol, Epi epi) {
    constexpr int NT = BN / 64;
    constexpr int LDA = BK + 8, LDB = BN + 16;
    constexpr int A_BYTES = 256 * LDA * 2, B_BYTES = BK * LDB * 2;
    static_assert(2 * A_BYTES + 2 * B_BYTES <= LDS_BYTES, "gemm lds");
    const int tid = get_tid(), lane = tid & 63, w = tid >> 6, wr = w >> 2, wc = w & 3;
    constexpr int ACH = BK / 8, ARP = NTHREADS / ACH, AP = 256 / ARP;
    const int achunk = tid % ACH, arow0 = tid / ACH;
    const bf16_t* ap[AP];
#pragma unroll
    for (int q = 0; q < AP; ++q) ap[q] = arow(arow0 + ARP * q);
    constexpr int CG = BN / 8, KR = NTHREADS / CG, BP = BK / KR;
    const int bc8 = tid % CG, bk0 = tid / CG;
    const float* bp = bcol(bc8 * 8);
    u32x4 areg[AP];
    f32x4 breg[BP][2];
    auto gload = [&](int kt) {
        const int k0 = kt * BK;
#pragma unroll
        for (int q = 0; q < AP; ++q) areg[q] = ap[q] ? *(const u32x4*)(ap[q] + k0 + achunk * 8) : (u32x4){0u, 0u, 0u, 0u};
#pragma unroll
        for (int q = 0; q < BP; ++q) {
            if (bp) { const float* s = bp + (size_t)(k0 + bk0 + KR * q) * ldb; breg[q][0] = *(const f32x4*)s; breg[q][1] = *(const f32x4*)(s + 4); }
            else { breg[q][0] = (f32x4){0.f, 0.f, 0.f, 0.f}; breg[q][1] = breg[q][0]; }
        }
    };
    auto lstore = [&](int buf) {
        LAS bf16_t* As = (LAS bf16_t*)(lds + buf * A_BYTES);
        LAS bf16_t* Bs = (LAS bf16_t*)(lds + 2 * A_BYTES + buf * B_BYTES);
#pragma unroll
        for (int q = 0; q < AP; ++q) *(LAS u32x4*)(As + (arow0 + ARP * q) * LDA + achunk * 8) = areg[q];
#pragma unroll
        for (int q = 0; q < BP; ++q) {
            u32x4 v; v.x = pk2(breg[q][0][0], breg[q][0][1]); v.y = pk2(breg[q][0][2], breg[q][0][3]); v.z = pk2(breg[q][1][0], breg[q][1][1]); v.w = pk2(breg[q][1][2], breg[q][1][3]);
            *(LAS u32x4*)(Bs + (bk0 + KR * q) * LDB + bc8 * 8) = v;
        }
    };
    f32x4 acc[8][NT];
#pragma unroll
    for (int mi = 0; mi < 8; ++mi)
#pragma unroll
        for (int ni = 0; ni < NT; ++ni) acc[mi][ni] = (f32x4){0.f, 0.f, 0.f, 0.f};
    const int nk = K / BK;
    gload(0);
    for (int kt = 0; kt < nk; ++kt) {
        lstore(kt & 1);
        __syncthreads();
        if (kt + 1 < nk && PROBE != 1) gload(kt + 1);
        if (PROBE == 2) continue;
        const LAS bf16_t* As = (const LAS bf16_t*)(lds + (kt & 1) * A_BYTES);
        const LAS bf16_t* Bs = (const LAS bf16_t*)(lds + 2 * A_BYTES + (kt & 1) * B_BYTES);
#pragma unroll
        for (int ks = 0; ks < BK / 32; ++ks) {
            bf16x8 wb[NT];
#pragma unroll
            for (int ni = 0; ni < NT; ++ni) wb[ni] = frag_tr(Bs, LDB, ks * 32, wc * (BN / 4) + ni * 16, lane);
#pragma unroll
            for (int mi = 0; mi < 8; ++mi) {
                const bf16x8 xa = frag_row(As, LDA, wr * 128 + mi * 16, ks * 32, lane);
#pragma unroll
                for (int ni = 0; ni < NT; ++ni) acc[mi][ni] = mfma16(wb[ni], xa, acc[mi][ni]);
            }
        }
    }
    epi(acc, wr, wc, lane);
    __syncthreads();
}


DI int perm32_(int rho) { const int n = rho >> 4, i = rho & 15; return 8 * (i >> 2) + 4 * n + (i & 3); }
template <int BK, bool PERM = false, class ARow, class BRow, class Epi>
DI void gemm_unit_t(lds_t lds, int K, ARow arow, BRow brow, Epi epi) {
    constexpr int NT = 4;
    constexpr int LD = BK + 8;
    constexpr int T_BYTES = 256 * LD * 2;
    static_assert(4 * T_BYTES <= LDS_BYTES, "gemm lds");
    const int tid = get_tid(), lane = tid & 63, w = tid >> 6, wr = w >> 2, wc = w & 3;
    constexpr int CH = BK / 8, RP = NTHREADS / CH, NP = 256 / RP;
    const int chunk = tid % CH, row0 = tid / CH;
    const bf16_t* ap[NP]; const bf16_t* bp[NP];
#pragma unroll
    for (int q = 0; q < NP; ++q) { const int rs_ = row0 + RP * q; ap[q] = arow(rs_); bp[q] = brow(PERM ? (rs_ & ~31) + perm32_(rs_ & 31) : rs_); }
    u32x4 areg[NP], breg[NP];
    auto gload = [&](int kt) {
        const int k0 = kt * BK;
#pragma unroll
        for (int q = 0; q < NP; ++q) {
            areg[q] = ap[q] ? *(const u32x4*)(ap[q] + k0 + chunk * 8) : (u32x4){0u, 0u, 0u, 0u};
            breg[q] = bp[q] ? *(const u32x4*)(bp[q] + k0 + chunk * 8) : (u32x4){0u, 0u, 0u, 0u};
        }
    };
    auto lstore = [&](int buf) {
        LAS bf16_t* As = (LAS bf16_t*)(lds + buf * 2 * T_BYTES);
        LAS bf16_t* Bs = (LAS bf16_t*)(lds + buf * 2 * T_BYTES + T_BYTES);
#pragma unroll
        for (int q = 0; q < NP; ++q) {
            *(LAS u32x4*)(As + (row0 + RP * q) * LD + chunk * 8) = areg[q];
            *(LAS u32x4*)(Bs + (row0 + RP * q) * LD + chunk * 8) = breg[q];
        }
    };
    f32x4 acc[8][NT];
#pragma unroll
    for (int mi = 0; mi < 8; ++mi)
#pragma unroll
        for (int ni = 0; ni < NT; ++ni) acc[mi][ni] = (f32x4){0.f, 0.f, 0.f, 0.f};
    const int nk = K / BK;
    gload(0);
    for (int kt = 0; kt < nk; ++kt) {
        lstore(kt & 1);
        __syncthreads();
        if (kt + 1 < nk) gload(kt + 1);
        const LAS bf16_t* As = (const LAS bf16_t*)(lds + (kt & 1) * 2 * T_BYTES);
        const LAS bf16_t* Bs = (const LAS bf16_t*)(lds + (kt & 1) * 2 * T_BYTES + T_BYTES);
#pragma unroll
        for (int ks = 0; ks < BK / 32; ++ks) {
            bf16x8 wb[NT], xa[8];
#pragma unroll
            for (int ni = 0; ni < NT; ++ni) wb[ni] = frag_row(Bs, LD, wc * 64 + ni * 16, ks * 32, lane);
#pragma unroll
            for (int mi = 0; mi < 8; ++mi) xa[mi] = frag_row(As, LD, wr * 128 + mi * 16, ks * 32, lane);
            __builtin_amdgcn_sched_barrier(0);
#pragma unroll
            for (int mi = 0; mi < 8; ++mi)
#pragma unroll
                for (int ni = 0; ni < NT; ++ni) acc[mi][ni] = mfma16(wb[ni], xa[mi], acc[mi][ni]);
        }
    }
    epi(acc, wr, wc, lane);
    __syncthreads();
}

DI int g_lds_byte(int r, int c) { const int st = (r >> 4) * 2 + (c >> 5), ob = (r & 15) * 64 + (c & 31) * 2; return st * 1024 + (ob ^ (((ob >> 9) & 1) << 5)); }
DI void g_stage_rc(int b, int& R, int& C) { const int st = b >> 10, sb = b & 1023, swz = sb ^ (((sb >> 9) & 1) << 5); R = (st >> 1) * 16 + (swz >> 6); C = (st & 1) * 32 + ((swz & 63) >> 1); }
template <class ARow, class BRow, class Epi>
DI void gemm_unit_g(lds_t lds, int K, ARow arow, BRow brow, Epi epi) {
    constexpr int NT = 4, HTB = 16384;
    const int tid = get_tid(), lane = tid & 63, w = tid >> 6, wr = w >> 2, wc = w & 3, fr = lane & 15, fq = lane >> 4;
    const int wu = __builtin_amdgcn_readfirstlane(w);
    const bf16_t* sp[2][2][2];
#pragma unroll
    for (int i = 0; i < 2; ++i) {
        int R, C; g_stage_rc(tid * 16 + i * 8192, R, C);
#pragma unroll
        for (int h = 0; h < 2; ++h) { sp[0][h][i] = arow(h * 128 + R) + C; sp[1][h][i] = brow(h * 128 + R) + C; }
    }
    auto stage = [&](int buf, int kt) {
        const int k0 = kt * 64;
#pragma unroll
        for (int x = 0; x < 2; ++x)
#pragma unroll
            for (int h = 0; h < 2; ++h)
#pragma unroll
                for (int i = 0; i < 2; ++i)
                    __builtin_amdgcn_global_load_lds((const unsigned*)(sp[x][h][i] + k0), (LAS unsigned*)(lds + (buf * 4 + x * 2 + h) * HTB + wu * 1024 + i * 8192), 16, 0, 0);
    };
    const int aoff = wr * HTB + g_lds_byte(fr, fq * 8);
    const int boff = (2 + (wc >> 1)) * HTB + g_lds_byte((wc & 1) * 64 + fr, fq * 8);
    f32x4 acc[8][NT];
#pragma unroll
    for (int mi = 0; mi < 8; ++mi)
#pragma unroll
        for (int ni = 0; ni < NT; ++ni) acc[mi][ni] = (f32x4){0.f, 0.f, 0.f, 0.f};
    const int nk = K / 64;
    stage(0, 0);
    asm volatile("s_waitcnt vmcnt(0)" ::: "memory");
    __syncthreads();
    for (int kt = 0; kt < nk; ++kt) {
        const int buf = kt & 1;
        if (kt + 1 < nk) stage(buf ^ 1, kt + 1);
#pragma unroll
        for (int ks = 0; ks < 2; ++ks) {
            bf16x8 wb[NT], xa[8];
#pragma unroll
            for (int ni = 0; ni < NT; ++ni) wb[ni] = *(const LAS bf16x8*)(lds + buf * 4 * HTB + boff + ni * 2048 + ks * 1024);
#pragma unroll
            for (int mi = 0; mi < 8; ++mi) xa[mi] = *(const LAS bf16x8*)(lds + buf * 4 * HTB + aoff + mi * 2048 + ks * 1024);
            __builtin_amdgcn_sched_barrier(0);
#pragma unroll
            for (int mi = 0; mi < 8; ++mi)
#pragma unroll
                for (int ni = 0; ni < NT; ++ni) acc[mi][ni] = mfma16(wb[ni], xa[mi], acc[mi][ni]);
        }
        asm volatile("s_waitcnt vmcnt(0)" ::: "memory");
        __syncthreads();
    }
    epi(acc, wr, wc, lane);
    __syncthreads();
}

struct U3 { int b, m, n; };
DI bool xcd_unit(int i, int NB, int NM, int NN, int TM, int TN, U3& u) {
    const int bid = get_bid();
    if (gridDim.x != 256) {
        const long L = (long)i * gridDim.x + bid; if (L >= (long)NB * NM * NN) return false;
        const int r = (int)(L % (NM * NN)); u.b = (int)(L / (NM * NN)); u.m = r % NM; u.n = r / NM; return true;
    }
    const int xcd = bid & 7, slot = bid >> 3, tsz = TM * TN, per = 32 / tsz;
    const int nsm = (NM + TM - 1) / TM, nsn = (NN + TN - 1) / TN, ntot = NB * nsm * nsn;
    int cnt = 0;
    for (int j = 0;; ++j) {
        if ((j * 8) * per >= ntot) return false;
        const int S = (j * 8 + xcd) * per + slot / tsz;
        if (S >= ntot) continue;
        const int within = slot % tsz, sl = S % (nsm * nsn);
        const int pm = (sl % nsm) * TM + within % TM, pn = (sl / nsm) * TN + within / TM;
        if (pm < NM && pn < NN) { if (cnt == i) { u.b = S / (nsm * nsn); u.m = pm; u.n = pn; return true; } ++cnt; }
    }
}
DI bool lin_unit(int i, int NB, int NM, int NN, int TM, int TN, U3& u) {
    const int bid = get_bid();
    const int T = NB * NM * NN, xcd = bid & 7, slot = bid >> 3;
    const bool gen = gridDim.x != 256;
    const int lo = gen ? 0 : (xcd * T) >> 3, hi = gen ? T : ((xcd + 1) * T) >> 3;
    const int idx = gen ? i * (int)gridDim.x + bid : lo + i * 32 + slot;
    if (idx >= hi) return false;
    const int per = NM * NN, r = idx % per, FG = NM / TM, gsz = TM * NN;
    u.b = idx / per;
    if (r < FG * gsz) { const int g = r / gsz, rr = r % gsz; u.n = rr / TM; u.m = g * TM + rr % TM; }
    else { const int rr = r - FG * gsz, h = NM - FG * TM; u.n = rr / h; u.m = FG * TM + rr % h; }
    return true;
}
template <int BK, bool PERM, int XG = 8, bool LIN = false, bool GATHER = false, class ARow, class BBase, class Epi>
DI void gemm_multi(lds_t lds, int K, int NB, int NM, int NN, int TM, int TN, ARow arow, BBase bbase, Epi epi) {
    static_assert(BK == 64, "LDS-DMA staging uses 64-deep K-tiles");
    constexpr int NT = 4, HTB = 16384;
    const int tid = get_tid(), lane = tid & 63, w = tid >> 6, wr = w >> 2, wc = w & 3, fr = lane & 15, fq = lane >> 4;
    const int wu = __builtin_amdgcn_readfirstlane(w);
    U3 cur, nxt;
    if (!(LIN ? lin_unit(0, NB, NM, NN, TM, TN, cur) : xcd_unit(0, NB, NM, NN, TM, TN, cur))) return;
    unsigned sao[2][2]; int pidx[2][2];
    const char* abase;
    if constexpr (GATHER) abase = (const char*)arow.row(arow.idx(cur, 0)) - (1u << 30); else abase = (const char*)arow(cur, 0) - (1u << 30);
    auto fetch_idx = [&](const U3& u) {
        if constexpr (GATHER) {
#pragma unroll
            for (int i = 0; i < 2; ++i) {
                int R, C; g_stage_rc(tid * 16 + i * 8192, R, C);
#pragma unroll
                for (int h = 0; h < 2; ++h) pidx[h][i] = arow.idx(u, h * 128 + R);
            }
        }
    };
    const char* bbp = nullptr;
    unsigned sbo0;
    { int R, C; g_stage_rc(tid * 16, R, C); sbo0 = (unsigned)(((PERM ? (R & ~31) + perm32_(R & 31) : R) * K + C) * 2); }
    auto set_ptrs = [&](const U3& u) {
        bbp = (const char*)bbase(u);
#pragma unroll
        for (int i = 0; i < 2; ++i) {
            int R, C; g_stage_rc(tid * 16 + i * 8192, R, C);
#pragma unroll
            for (int h = 0; h < 2; ++h) {
                if constexpr (GATHER) sao[h][i] = (unsigned)((const char*)(arow.row(pidx[h][i]) + C) - abase);
                else sao[h][i] = (unsigned)((const char*)(arow(u, h * 128 + R) + C) - abase);
            }
        }
    };
    auto stage = [&](int buf, int kt) {
        const int k0 = kt * 128;
#pragma unroll
        for (int h = 0; h < 2; ++h)
#pragma unroll
            for (int i = 0; i < 2; ++i) {
                __builtin_amdgcn_global_load_lds((const unsigned*)(abase + (sao[h][i] + (unsigned)k0)), (LAS unsigned*)(lds + (buf * 4 + h) * HTB + wu * 1024 + i * 8192), 16, 0, 0);
                __builtin_amdgcn_global_load_lds((const unsigned*)(bbp + (sbo0 + (unsigned)((h * 128 + i * 64) * K * 2 + k0))), (LAS unsigned*)(lds + (buf * 4 + 2 + h) * HTB + wu * 1024 + i * 8192), 16, 0, 0);
            }
    };
    auto stage_piece = [&](int buf, int k0, int pc) {
        const int h = pc >> 2, i = (pc >> 1) & 1;
        if ((pc & 1) == 0) __builtin_amdgcn_global_load_lds((const unsigned*)(abase + (sao[h][i] + (unsigned)k0)), (LAS unsigned*)(lds + (buf * 4 + h) * HTB + wu * 1024 + i * 8192), 16, 0, 0);
        else __builtin_amdgcn_global_load_lds((const unsigned*)(bbp + (sbo0 + (unsigned)((h * 128 + i * 64) * K * 2 + k0))), (LAS unsigned*)(lds + (buf * 4 + 2 + h) * HTB + wu * 1024 + i * 8192), 16, 0, 0);
    };
    const int aoff = wr * HTB + g_lds_byte(fr, fq * 8);
    const int boff = (2 + (wc >> 1)) * HTB + g_lds_byte((wc & 1) * 64 + fr, fq * 8);
    const int nk = K / 64;
    fetch_idx(cur);
    set_ptrs(cur);
    stage(0, 0);
    asm volatile("s_waitcnt vmcnt(0)" ::: "memory");
    __syncthreads();
    stage(1, 1);
    for (int ui = 0;; ++ui) {
        const bool has_next = LIN ? lin_unit(ui + 1, NB, NM, NN, TM, TN, nxt) : xcd_unit(ui + 1, NB, NM, NN, TM, TN, nxt);
        f32x4 acc[8][NT];
#pragma unroll
        for (int mi = 0; mi < 8; ++mi)
#pragma unroll
            for (int ni = 0; ni < NT; ++ni) acc[mi][ni] = (f32x4){0.f, 0.f, 0.f, 0.f};
        bf16x8 xa[8], wb[NT];
#pragma unroll
        for (int ni = 0; ni < NT; ++ni) wb[ni] = *(const LAS bf16x8*)(lds + boff + ni * 2048);
#pragma unroll
        for (int mi = 0; mi < 8; ++mi) xa[mi] = *(const LAS bf16x8*)(lds + aoff + mi * 2048);
        for (int kt = 0; kt < nk; ++kt) {
            const int buf = kt & 1;
            static_assert(XG == 8, "the mid-step refill assumes all fragment reads of a k-half are issued together");
            if (GATHER && kt + 3 == nk && has_next) fetch_idx(nxt);
            if (kt + 2 == nk && has_next) set_ptrs(nxt);
            {
                const int nb_ = buf * 4 * HTB + 1024;
#pragma unroll
                for (int mi = 0; mi < 8; ++mi) {
                    __builtin_amdgcn_sched_barrier(0);
#pragma unroll
                    for (int ni = 0; ni < NT; ++ni) acc[mi][ni] = mfma16(wb[ni], xa[mi], acc[mi][ni]);
                    xa[mi] = *(const LAS bf16x8*)(lds + nb_ + aoff + mi * 2048);
                }
                __builtin_amdgcn_sched_barrier(0);
#pragma unroll
                for (int ni = 0; ni < NT; ++ni) wb[ni] = *(const LAS bf16x8*)(lds + nb_ + boff + ni * 2048);
            }
            __builtin_amdgcn_sched_barrier(0);
            asm volatile("s_waitcnt vmcnt(0)" ::: "memory");
            __syncthreads();
            const int ksrc = (kt + 2 < nk ? kt + 2 : kt + 2 - nk) * 128;
            {
                const int nb_ = (buf ^ 1) * 4 * HTB;
#pragma unroll
                for (int mi = 0; mi < 8; ++mi) {
                    __builtin_amdgcn_sched_barrier(0);
#pragma unroll
                    for (int ni = 0; ni < NT; ++ni) acc[mi][ni] = mfma16(wb[ni], xa[mi], acc[mi][ni]);
                    stage_piece(buf, ksrc, mi < 4 ? 2 * mi : 2 * (mi - 4) + 1);
                    xa[mi] = *(const LAS bf16x8*)(lds + nb_ + aoff + mi * 2048);
                }
                __builtin_amdgcn_sched_barrier(0);
#pragma unroll
                for (int ni = 0; ni < NT; ++ni) wb[ni] = *(const LAS bf16x8*)(lds + nb_ + boff + ni * 2048);
            }
            __builtin_amdgcn_sched_barrier(0);
        }
        epi(cur, acc, wr, wc, lane);
        if (!has_next) break;
        cur = nxt;
    }
    asm volatile("s_waitcnt vmcnt(0)" ::: "memory");
    __syncthreads();
}

template <class F>
DI void for_units_xcd(int NB, int NM, int NN, int TM, int TN, F f) {
    const int bid = get_bid();
    if (gridDim.x != 256) {
        for (int u = bid; u < NB * NM * NN; u += gridDim.x) f(u / (NM * NN), (u % (NM * NN)) % NM, (u % (NM * NN)) / NM);
        return;
    }
    const int xcd = bid & 7, slot = bid >> 3, tsz = TM * TN, per = 32 / tsz;
    const int nsm = (NM + TM - 1) / TM, nsn = (NN + TN - 1) / TN, ntot = NB * nsm * nsn;
    for (int j = 0;; ++j) {
        const int S = (j * 8 + xcd) * per + slot / tsz;
        if ((j * 8) * per >= ntot) break;
        if (S >= ntot) continue;
        const int within = slot % tsz, batch = S / (nsm * nsn), sl = S % (nsm * nsn);
        const int pm = (sl % nsm) * TM + within % TM, pn = (sl / nsm) * TN + within / TM;
        if (pm < NM && pn < NN) f(batch, pm, pn);
    }
}

template <int NT, class F>
DI void epi_each(const f32x4 (&acc)[8][NT], int wr, int wc, int lane, F f) {
#pragma unroll
    for (int mi = 0; mi < 8; ++mi)
#pragma unroll
        for (int ni = 0; ni < NT; ++ni) f(wr * 128 + mi * 16 + (lane & 15), wc * (NT * 16) + ni * 16 + 4 * (lane >> 4), acc[mi][ni]);
}
template <class F>
DI void epi_each8(const f32x4 (&acc)[8][4], int wr, int wc, int lane, F f) {
#pragma unroll
    for (int mi = 0; mi < 8; ++mi)
#pragma unroll
        for (int k = 0; k < 2; ++k) f(wr * 128 + mi * 16 + (lane & 15), wc * 64 + k * 32 + 8 * (lane >> 4), acc[mi][2 * k], acc[mi][2 * k + 1]);
}
DI void store_bf16x8(bf16_t* dst, f32x4 a, f32x4 b) { u32x4 o; o.x = pk2(a[0], a[1]); o.y = pk2(a[2], a[3]); o.z = pk2(b[0], b[1]); o.w = pk2(b[2], b[3]); *(u32x4*)dst = o; }
DI void store_bf16x4(bf16_t* dst, f32x4 v) { u32x2 o; o.x = pk2(v[0], v[1]); o.y = pk2(v[2], v[3]); *(u32x2*)dst = o; }

DI int rcol(int lane, int i) { return 8 * lane + 512 * (i >> 1) + 4 * (i & 1); }
DI void row_load_f32(const float* src, f32x4 (&v)[4], int lane) {
#pragma unroll
    for (int i = 0; i < 4; ++i) v[i] = *(const f32x4*)(src + rcol(lane, i));
}
DI float row_sumsq(const f32x4 (&v)[4]) {
    float s = 0.f;
#pragma unroll
    for (int i = 0; i < 4; ++i) s += v[i][0] * v[i][0] + v[i][1] * v[i][1] + v[i][2] * v[i][2] + v[i][3] * v[i][3];
    return wave_sum(s);
}
DI void row_modulate(f32x4 (&v)[4], float rs, const float* g, const float* sc, const float* sh, int lane) {
#pragma unroll
    for (int i = 0; i < 4; ++i) {
        const int c = rcol(lane, i);
        const f32x4 gg = *(const f32x4*)(g + c), ss = *(const f32x4*)(sc + c), hh = *(const f32x4*)(sh + c);
#pragma unroll
        for (int j = 0; j < 4; ++j) v[i][j] = v[i][j] * rs * gg[j] * (1.f + ss[j]) + hh[j];
    }
}
struct ModCache { f32x4 a[4], b[4]; int s; };
DI void mod_fetch(ModCache& m, int s, const float* g, const float* sc, const float* sh, int lane) {
    if (s == m.s) return;
    m.s = s;
#pragma unroll
    for (int i = 0; i < 4; ++i) {
        const int c = rcol(lane, i);
        const f32x4 gg = *(const f32x4*)(g + c), ss = *(const f32x4*)(sc + c);
        m.b[i] = *(const f32x4*)(sh + c);
#pragma unroll
        for (int j = 0; j < 4; ++j) m.a[i][j] = gg[j] * (1.f + ss[j]);
    }
}
DI void row_modulate_c(f32x4 (&v)[4], float rs, const ModCache& m) {
#pragma unroll
    for (int i = 0; i < 4; ++i)
#pragma unroll
        for (int j = 0; j < 4; ++j) v[i][j] = v[i][j] * rs * m.a[i][j] + m.b[i][j];
}
DI void row_store_bf16(bf16_t* dst, const f32x4 (&v)[4], int lane) {
#pragma unroll
    for (int i = 0; i < 4; i += 2) store_bf16x8(dst + rcol(lane, i), v[i], v[i + 1]);
}


struct CT { const float* W; bf16_t* Wt; int ldw, k0, n0, nvalid, ldt, mode; };
DI int gu_row(int c, int up) { return (c / GUG) * (2 * GUG) + up * GUG + (c % GUG); }
DI CT conv_desc_expert(PP p, int layer, int t) {
    const int e = t / 768, r = t % 768, m = r >> 8, tt = r & 255, kt = tt & 15, nt = tt >> 4;
    bf16_t* base = (bf16_t*)((char*)p->out + DO_EXP + (size_t)e * EXP_STRIDE);
    const size_t woff = ((size_t)layer * 16 + e) * 1048576;
    CT c; c.ldw = 1024; c.k0 = kt * 64; c.n0 = nt * 64; c.nvalid = 1024; c.ldt = 1024;
    if (m == 0) { c.W = p->exp_w_gate + woff; c.Wt = base; c.mode = 1; }
    else if (m == 1) { c.W = p->exp_w_up + woff; c.Wt = base; c.mode = 2; }
    else { c.W = p->exp_w_down + woff; c.Wt = base + (size_t)2048 * 1024; c.mode = 0; }
    return c;
}
constexpr int NCONV_DENSE = 704 + 256 + 1024 + 512;
DI CT conv_desc_dense(PP p, int t) {
    CT c; c.mode = 0;
    if (t < 704) { c.W = p->ab_w_in; c.ldw = ABIN; c.k0 = (t & 15) * 64; c.n0 = (t >> 4) * 64; c.nvalid = ABIN; c.Wt = (bf16_t*)((char*)p->out + DO_WIN); c.ldt = 1024; return c; }
    t -= 704;
    if (t < 256) { c.W = p->ab_w_out; c.ldw = 1024; c.k0 = (t & 15) * 64; c.n0 = (t >> 4) * 64; c.nvalid = 1024; c.Wt = (bf16_t*)((char*)p->out + DO_WOUT); c.ldt = 1024; return c; }
    t -= 256;
    if (t < 1024) { c.W = p->m_w_up; c.ldw = 4096; c.k0 = (t & 15) * 64; c.n0 = (t >> 4) * 64; c.nvalid = 4096; c.Wt = (bf16_t*)(p->ws + OFF_WUPT); c.ldt = 1024; return c; }
    t -= 1024;
    c.W = p->m_w_down; c.ldw = 1024; c.k0 = (t & 31) * 64; c.n0 = (t >> 5) * 64; c.nvalid = 1024; c.Wt = (bf16_t*)(p->ws + OFF_WDNT); c.ldt = 2048;
    return c;
}
DI void conv_load(const CT& c, f32x4& a, f32x4& b) {
    const int tid = get_tid(), k = tid >> 3, c8 = (tid & 7) * 8;
    a = (f32x4){0.f, 0.f, 0.f, 0.f}; b = a;
    if (c.n0 + c8 < c.nvalid) { const float* src = c.W + (size_t)(c.k0 + k) * c.ldw + c.n0 + c8; a = *(const f32x4*)src; b = *(const f32x4*)(src + 4); }
}
DI void conv_to_lds(LAS float* t, f32x4 a, f32x4 b) {
    const int tid = get_tid(), k = tid >> 3, c8 = (tid & 7) * 8;
#pragma unroll
    for (int j = 0; j < 4; ++j) { t[k * 65 + c8 + j] = a[j]; t[k * 65 + c8 + 4 + j] = b[j]; }
}
DI void conv_from_lds(const CT& c, const LAS float* t) {
    const int tid = get_tid(), n = tid >> 3, k8 = (tid & 7) * 8;
    float v[8];
#pragma unroll
    for (int j = 0; j < 8; ++j) v[j] = t[(k8 + j) * 65 + n];
    u32x4 o; o.x = pk2(v[0], v[1]); o.y = pk2(v[2], v[3]); o.z = pk2(v[4], v[5]); o.w = pk2(v[6], v[7]);
    const int col = c.n0 + n, row = c.mode == 0 ? col : gu_row(col, c.mode - 1);
    *(u32x4*)(c.Wt + (size_t)row * c.ldt + c.k0 + k8) = o;
}
template <class Desc>
DI void conv_stream(int first, int end, int stride, Desc desc, lds_t lds) {
    constexpr int NB_ = 4, TS = 64 * 65 + 16;
    LAS float* tl = (LAS float*)lds;
    for (int t = first; t < end; t += NB_ * stride) {
        CT c[NB_]; f32x4 a[NB_], b[NB_];
#pragma unroll
        for (int q = 0; q < NB_; ++q) { const int tq = t + q * stride; c[q] = desc(tq < end ? tq : t); conv_load(c[q], a[q], b[q]); }
#pragma unroll
        for (int q = 0; q < NB_; ++q) conv_to_lds(tl + q * TS, a[q], b[q]);
        __syncthreads();
#pragma unroll
        for (int q = 0; q < NB_; ++q) if (t + q * stride < end) conv_from_lds(c[q], tl + q * TS);
        __syncthreads();
    }
}

DI void phase_mods(PP p, lds_t lds) {
    const int tid = get_tid();
    if (get_bid() == 0 && tid < 128) *(u32x4*)(p->ws + OFF_ZROW + tid * 16) = (u32x4){0u, 0u, 0u, 0u};
    LAS float* sil = (LAS float*)lds;
    LAS float* red = sil + 5 * 1024;
    for (int u = get_bid(); u < 192 + 32; u += gridDim.x) {
        if (u < 192) {
            const int layer = u / 96, c0 = (u % 96) * 64;
            for (int i = tid; i < 5 * 1024; i += NTHREADS) { const int s = i >> 10, k = i & 1023; const float cv = s < 4 ? p->c[s * 1024 + k] : p->c_ctx[k]; sil[i] = siluf_(cv); }
            __syncthreads();
            const int col = tid & 63, kp = tid >> 6;
            float a[5] = {0.f, 0.f, 0.f, 0.f, 0.f};
            const float* wp = p->mod_w + (size_t)layer * 1024 * 6144 + c0 + col;
            for (int k0 = kp * 128; k0 < kp * 128 + 128; k0 += 16) {
                float wv[16];
#pragma unroll
                for (int j = 0; j < 16; ++j) wv[j] = wp[(size_t)(k0 + j) * 6144];
#pragma unroll
                for (int j = 0; j < 16; ++j)
#pragma unroll
                    for (int s = 0; s < 5; ++s) a[s] += sil[s * 1024 + k0 + j] * wv[j];
            }
#pragma unroll
            for (int s = 0; s < 5; ++s) red[(kp * 5 + s) * 64 + col] = a[s];
            __syncthreads();
            if (tid < 320) {
                const int s = tid >> 6, cc = tid & 63;
                float t = p->mod_b[layer * 6144 + c0 + cc];
#pragma unroll
                for (int k = 0; k < 8; ++k) t += red[(k * 5 + s) * 64 + cc];
                ((float*)(p->ws + OFF_MODS))[(size_t)(layer * 5 + s) * 6144 + c0 + cc] = t;
            }
            __syncthreads();
        } else {
            const int f0 = (u - 192) * 64;
            const int fl = tid >> 3, dgp = (tid & 7) * 2, f = f0 + fl, n = f >> 2, i = f & 3;
            bf16_t* gxc = (bf16_t*)(p->ws + OFF_GCAT);
            bf16_t* gxm = gxc + 2048 * 16;
#pragma unroll
            for (int e = 0; e < 2; ++e) {
                const int dg = dgp + e, d = dg >> 3, g = dg & 7;
                const float* wg = p->m_w_gates + (size_t)d * 6144 * 8;
                float a = 0.f, b = 0.f;
#pragma unroll
                for (int o = 0; o < 4; ++o) {
                    a += p->m_wq[n * 16 + i * 4 + o] * wg[(size_t)(4 * n + o) * 8 + g];
                    a += p->m_wk[n * 16 + i * 4 + o] * wg[(size_t)(2048 + 4 * n + o) * 8 + g] * 0.04419417382415922f;
                    b += p->m_wv[n * 16 + i * 4 + o] * wg[(size_t)(4096 + 4 * n + o) * 8 + g];
                }
                gxc[f * 16 + dg] = f2bf(a); gxm[f * 16 + dg] = f2bf(b);
            }
            if (tid < 256) {
                const int nn = (f0 >> 2) + (tid >> 4), e = tid & 15, ii = e >> 2, jj = e & 3;
                float a = 0.f;
#pragma unroll
                for (int o = 0; o < 4; ++o) a += p->m_wq[nn * 16 + ii * 4 + o] * p->m_wk[nn * 16 + jj * 4 + o];
                ((float*)(p->ws + OFF_MMAT))[nn * 16 + e] = a * 0.04419417382415922f;
            }
        }
    }
    __syncthreads();
    conv_stream(get_bid(), NCONV_DENSE + 16 * 768, gridDim.x, [&](int t) { return t < NCONV_DENSE ? conv_desc_dense(p, t) : conv_desc_expert(p, 0, t - NCONV_DENSE); }, lds);
}

template <class Src>
DI void phase_norm(PP p, int layer, int nrows, Src src) {
    const int lane = get_tid() & 63, gw = get_bid() * 8 + (get_tid() >> 6), nw = gridDim.x * 8;
    bf16_t* act = (bf16_t*)(p->ws + OFF_ACT);
    ModCache mc; mc.s = -1;
    constexpr int RB = 4;
    for (int r0 = gw; r0 < nrows; r0 += RB * nw) {
        f32x4 v[RB][4];
#pragma unroll
        for (int q = 0; q < RB; ++q) { const int r = r0 + q * nw; row_load_f32(src(r < nrows ? r : r0), v[q], lane); }
#pragma unroll
        for (int q = 0; q < RB; ++q) {
            const int r = r0 + q * nw;
            if (r < nrows) {
                const int s = row_set(r);
                mod_fetch(mc, s, p->norm1_g + layer * 1024, mods_ptr(p, layer, s, 1), mods_ptr(p, layer, s, 0), lane);
                const float rs = rsqrtf(row_sumsq(v[q]) * (1.f / 1024.f) + EPS);
                row_modulate_c(v[q], rs, mc);
                row_store_bf16(act + (size_t)r * 1024, v[q], lane);
            }
        }
    }
}

DI void phase_inproj(PP p, lds_t lds) {
    const bf16_t* act = (const bf16_t*)(p->ws + OFF_ACT);
    bf16_t* P = (bf16_t*)(p->ws + OFF_ARENA + A_P);
    constexpr int NM = NTOK / 256, NN = 11;
    gemm_multi<64, true, 8, true>(lds, 1024, 1, NM, NN, 8, 4,
        [&](const U3& u, int r) { return act + (size_t)(u.m * 256 + r) * 1024; },
        [&](const U3& u) { return (const bf16_t*)((const char*)p->out + DO_WIN) + (size_t)(u.n * 256) * 1024; },
        [&](const U3& u, const f32x4 (&acc)[8][4], int wr, int wc, int lane) {
            epi_each8(acc, wr, wc, lane, [&](int r, int c, f32x4 v0, f32x4 v1) { const int col = u.n * 256 + c; if (col < ABIN) store_bf16x8(P + (size_t)(u.m * 256 + r) * ABIN + col, v0, v1); });
        });
}

DI void gla_bcum(LAS float* bc, const LAS float* lrt, const LAS float* wat, const LAS float* bat, int d, LAS float* seg_tot) {
    const int tid = get_tid();
    {
        const int c = tid & 63, tq = tid >> 6;
        float wcol[16];
#pragma unroll
        for (int r = 0; r < 16; ++r) wcol[r] = wat[r * 64 + c];
        const float bias = bat[c];
        for (int t = tq * 8; t < tq * 8 + 8; ++t) {
            float z = bias;
#pragma unroll
            for (int r = 0; r < 16; ++r) z += lrt[t * 16 + r] * wcol[r];
            bc[t * 64 + c] = log_sigmoidf_(z) * (1.f / 16.f);
        }
    }
    __syncthreads();
    {
        const int c = tid & 63, seg = tid >> 6;
        float v[8]; float run = 0.f;
#pragma unroll
        for (int j = 0; j < 8; ++j) { const int pp = seg * 8 + j, t = d == 0 ? pp : 63 - pp; run += bc[t * 64 + c]; v[j] = run; }
        LAS float* tot = seg_tot + seg * 64 + c;
        *tot = run;
        __syncthreads();
        float off = 0.f;
#pragma unroll
        for (int k = 0; k < 7; ++k) off += (k < seg) ? seg_tot[k * 64 + c] : 0.f;
#pragma unroll
        for (int j = 0; j < 8; ++j) { const int pp = seg * 8 + j, t = d == 0 ? pp : 63 - pp; bc[t * 64 + c] = v[j] + off; }
    }
    __syncthreads();
}
DI void gla_bcum2(LAS float* bc, const LAS float* lrt, const LAS float* wat, const LAS float* bat, LAS float* seg_tot) {
    const int tid = get_tid(), c = tid & 63, tq = tid >> 6;
#pragma unroll
    for (int d = 0; d < 2; ++d) {
        float wcol[16];
#pragma unroll
        for (int r = 0; r < 16; ++r) wcol[r] = wat[d * 1024 + r * 64 + c];
        const float bias = bat[d * 64 + c];
        for (int t = tq * 8; t < tq * 8 + 8; ++t) {
            float z = bias;
#pragma unroll
            for (int r = 0; r < 16; ++r) z += lrt[d * 1024 + t * 16 + r] * wcol[r];
            bc[d * 4096 + t * 64 + c] = log_sigmoidf_(z) * (1.f / 16.f);
        }
    }
    __syncthreads();
    {
        const int seg = tq;
        float v[2][8];
#pragma unroll
        for (int d = 0; d < 2; ++d) {
            float run = 0.f;
#pragma unroll
            for (int j = 0; j < 8; ++j) { const int pp = seg * 8 + j, t = d == 0 ? pp : 63 - pp; run += bc[d * 4096 + t * 64 + c]; v[d][j] = run; }
            seg_tot[(d * 8 + seg) * 64 + c] = run;
        }
        __syncthreads();
#pragma unroll
        for (int d = 0; d < 2; ++d) {
            float off = 0.f;
#pragma unroll
            for (int k = 0; k < 7; ++k) off += (k < seg) ? seg_tot[(d * 8 + k) * 64 + c] : 0.f;
#pragma unroll
            for (int j = 0; j < 8; ++j) { const int pp = seg * 8 + j, t = d == 0 ? pp : 63 - pp; bc[d * 4096 + t * 64 + c] = v[d][j] + off; }
        }
    }
    __syncthreads();
}
DI void gla_load_decay_inputs(PP p, const bf16_t* P, int r0, int h, LAS float* lrt, LAS float* wat, LAS float* bat, bool loadw) {
    const int tid = get_tid();
    if (tid < 256) {
        const int d = tid >> 7, t = (tid >> 1) & 63, half = tid & 1;
        const u32x4 v = *(const u32x4*)(P + (size_t)(r0 + t) * ABIN + PC_LRF + d * 16 + half * 8);
        LAS float* o = lrt + (d * 64 + t) * 16 + half * 8;
        o[0] = lo_bf(v.x); o[1] = hi_bf(v.x); o[2] = lo_bf(v.y); o[3] = hi_bf(v.y); o[4] = lo_bf(v.z); o[5] = hi_bf(v.z); o[6] = lo_bf(v.w); o[7] = hi_bf(v.w);
    }
    if (loadw) {
        const int i = tid * 4, d = i >> 10, r = (i >> 6) & 15, c = i & 63;
        *(LAS f32x4*)(wat + i) = *(const f32x4*)(p->gla_wa2 + (size_t)(d * 16 + r) * 256 + h * 64 + c);
        if (tid < 128) bat[tid] = p->gla_ba[(tid >> 6) * 256 + h * 64 + (tid & 63)];
    }
}

DI void phase_g1(PP p, lds_t lds) {
    const int tid = get_tid(), lane = tid & 63, w = tid >> 6;
    const bf16_t* P = (const bf16_t*)(p->ws + OFF_ARENA + A_P);
    float* U = (float*)(p->ws + OFF_ARENA + A_U);
    float* DEC = (float*)(p->ws + OFF_ARENA + A_DEC);
    float* LA = (float*)(p->ws + OFF_ARENA + A_LA);
    bf16_t* UU = (bf16_t*)(p->ws + OFF_ARENA + A_UU);
    float* AGGA = (float*)(p->ws + OFF_ARENA + A_AGGA);
    float* AGGH = (float*)(p->ws + OFF_ARENA + A_AGGH);
    constexpr int NGLA = NCH * 4, NLRU = NCH * 4;
    unsigned long long pg0 = 0, pg_acc = 0; if (PROF_SEC >= 10) pg0 = __builtin_amdgcn_s_memtime();
    int h_loaded = -1;
    for (int task = get_bid(); task < NGLA; task += gridDim.x) {
        {
            const int ch = task >> 2, h = task & 3, r0 = ch * 64;
            LAS float* lrt = (LAS float*)lds;
            LAS float* wat = lrt + 2048;
            LAS float* bat = wat + 2048;
            LAS float* bc = bat + 128;
            LAS bf16_t* kt = (LAS bf16_t*)(bc + 8192);
            LAS bf16_t* ktd = kt + 64 * 72;
            LAS bf16_t* vt = ktd + 2 * 64 * 72;
            gla_load_decay_inputs(p, P, r0, h, lrt, wat, bat, h != h_loaded); h_loaded = h;
            { const int row = tid >> 3, chunk = tid & 7; *(LAS u32x4*)(kt + row * 72 + chunk * 8) = *(const u32x4*)(P + (size_t)(r0 + row) * ABIN + PC_K + h * 64 + chunk * 8); }
#pragma unroll
            for (int q = 0; q < 2; ++q) { const int i = tid + 512 * q, row = i >> 4, chunk = i & 15; *(LAS u32x4*)(vt + row * 136 + chunk * 8) = *(const u32x4*)(P + (size_t)(r0 + row) * ABIN + PC_V + h * 128 + chunk * 8); }
            __syncthreads();
            gla_bcum2(bc, lrt, wat, bat, (LAS float*)(vt + 64 * 136));
            {
                const int t = tid >> 3, c8 = (tid & 7) * 8;
#pragma unroll
                for (int d = 0; d < 2; ++d) {
                    const LAS float* b = bc + d * 4096;
                    const int tl = d == 0 ? 63 : 0;
                    float o[8];
#pragma unroll
                    for (int j = 0; j < 8; ++j) o[j] = bf2f(kt[t * 72 + c8 + j]) * __expf(b[tl * 64 + c8 + j] - b[t * 64 + c8 + j]);
                    u32x4 v; v.x = pk2(o[0], o[1]); v.y = pk2(o[2], o[3]); v.z = pk2(o[4], o[5]); v.w = pk2(o[6], o[7]);
                    *(LAS u32x4*)(ktd + d * 64 * 72 + t * 72 + c8) = v;
                }
                if (tid < 128) { const int d = tid >> 6, c = tid & 63; DEC[(size_t)(ch * 2 + d) * 256 + h * 64 + c] = __expf(bc[d * 4096 + (d == 0 ? 63 : 0) * 64 + c]); }
            }
            __syncthreads();
            {
                const int d = w >> 2, dkt = w & 3;
                const LAS bf16_t* kd = ktd + d * 64 * 72;
                bf16x8 kb[2];
#pragma unroll
                for (int ks = 0; ks < 2; ++ks) kb[ks] = frag_tr(kd, 72, ks * 32, dkt * 16, lane);
                float* Ud = U + ((size_t)(ch * 2 + d) * 4 + h) * 8192;
#pragma unroll
                for (int dvt = 0; dvt < 8; ++dvt) {
                    f32x4 acc = {0.f, 0.f, 0.f, 0.f};
#pragma unroll
                    for (int ks = 0; ks < 2; ++ks) acc = mfma16(frag_tr(vt, 136, ks * 32, dvt * 16, lane), kb[ks], acc);
                    *(f32x4*)(Ud + (dkt * 16 + (lane & 15)) * 128 + dvt * 16 + 4 * (lane >> 4)) = acc;
                }
            }
            __syncthreads();
        }
    }
    if (PROF_SEC == 10) pg_acc = __builtin_amdgcn_s_memtime() - pg0;
    if (PROF_SEC >= 10) pg0 = __builtin_amdgcn_s_memtime();
    int cq_loaded = -1;
    bf16x8 wf[4][2]; f32x4 bvq[4], coefq[4];
    for (int t2 = get_bid(); t2 < NLRU; t2 += gridDim.x) {
        {
            const int ch = t2 >> 2, cq = t2 & 3, r0 = ch * 64;
            const int seg_lo = ch < NCHL ? r0 : NLAT + ((r0 - NLAT) >> 8) * 256, seg_hi = ch < NCHL ? r0 + 64 : seg_lo + 256;
            LAS bf16_t* xin = (LAS bf16_t*)lds;
            LAS bf16_t* xb = xin + 67 * 136;
            LAS float* lat = (LAS float*)(xb + 64 * 136);
            LAS bf16_t* git = (LAS bf16_t*)(lat + 2 * 64 * 128);
            LAS float* cwl = (LAS float*)(git + 2 * 64 * 128);
            if (cq != cq_loaded) {
                cq_loaded = cq;
                for (int i = tid; i < 640; i += NTHREADS) cwl[i] = i < 512 ? p->rg_conv_w[(i >> 7) * 512 + cq * 128 + (i & 127)] : p->rg_conv_b[cq * 128 + i - 512];
                const int blk = w & 1, d = (w >> 1) & 1, mat = w >> 2, n = cq * 2 + blk;
                const float* W = (mat ? p->rg_wi : p->rg_wr) + (size_t)(d * 8 + n) * 4096;
                const float* bias = (mat ? p->rg_bi : p->rg_br) + d * 512 + n * 64;
#pragma unroll
                for (int ot = 0; ot < 4; ++ot) {
#pragma unroll
                    for (int ks = 0; ks < 2; ++ks) {
                        const float* src = W + (size_t)(ks * 32 + 8 * (lane >> 4)) * 64 + ot * 16 + (lane & 15);
                        float f[8];
#pragma unroll
                        for (int j = 0; j < 8; ++j) f[j] = src[j * 64];
                        u32x4 v; v.x = pk2n(f[0], f[1]); v.y = pk2n(f[2], f[3]); v.z = pk2n(f[4], f[5]); v.w = pk2n(f[6], f[7]);
                        wf[ot][ks] = __builtin_bit_cast(bf16x8, v);
                    }
                    const int o = ot * 16 + 4 * (lane >> 4);
                    bvq[ot] = *(const f32x4*)(bias + o);
                    const f32x4 lam = *(const f32x4*)(p->rg_lambda + d * 512 + n * 64 + o);
#pragma unroll
                    for (int j = 0; j < 4; ++j) coefq[ot][j] = -8.f * softplusf_(-lam[j]);
                }
            }
            for (int i = tid; i < 67 * 16; i += NTHREADS) {
                const int row = i >> 4, chunk = i & 15, r = r0 - 2 + row;
                u32x4 v = {0u, 0u, 0u, 0u};
                if (r >= seg_lo && r < seg_hi) v = *(const u32x4*)(P + (size_t)r * ABIN + PC_RGX + cq * 128 + chunk * 8);
                *(LAS u32x4*)(xin + row * 136 + chunk * 8) = v;
            }
            __syncthreads();
            {
                const int t = tid >> 3, c16 = (tid & 7) * 16;
                float o[16];
#pragma unroll
                for (int j = 0; j < 16; ++j) o[j] = cwl[512 + c16 + j];
#pragma unroll
                for (int tap = 0; tap < 4; ++tap)
#pragma unroll
                    for (int j = 0; j < 16; ++j) o[j] += cwl[tap * 128 + c16 + j] * bf2f(xin[(t + tap) * 136 + c16 + j]);
#pragma unroll
                for (int j = 0; j < 16; j += 8) {
                    u32x4 v; v.x = pk2(o[j], o[j + 1]); v.y = pk2(o[j + 2], o[j + 3]); v.z = pk2(o[j + 4], o[j + 5]); v.w = pk2(o[j + 6], o[j + 7]);
                    *(LAS u32x4*)(xb + t * 136 + c16 + j) = v;
                }
            }
            __syncthreads();
            {
                const int blk = w & 1, d = (w >> 1) & 1, mat = w >> 2;
#pragma unroll
                for (int tt = 0; tt < 4; ++tt) {
                    bf16x8 xf[2];
#pragma unroll
                    for (int ks = 0; ks < 2; ++ks) xf[ks] = frag_row(xb, 136, tt * 16, blk * 64 + ks * 32, lane);
#pragma unroll
                    for (int ot = 0; ot < 4; ++ot) {
                        f32x4 acc = {0.f, 0.f, 0.f, 0.f};
#pragma unroll
                        for (int ks = 0; ks < 2; ++ks) acc = mfma16(wf[ot][ks], xf[ks], acc);
                        const int t = tt * 16 + (lane & 15), o = ot * 16 + 4 * (lane >> 4), c = blk * 64 + o;
                        const f32x4 bv = bvq[ot];
                        if (mat == 0) {
                            f32x4 la;
#pragma unroll
                            for (int j = 0; j < 4; ++j) la[j] = coefq[ot][j] * sigmoidf_(acc[j] + bv[j]);
                            *(LAS f32x4*)(lat + (d * 64 + t) * 128 + c) = la;
                        } else {
                            float gi[4];
#pragma unroll
                            for (int j = 0; j < 4; ++j) gi[j] = sigmoidf_(acc[j] + bv[j]) * bf2f(xb[t * 136 + c + j]);
                            u32x2 v; v.x = pk2(gi[0], gi[1]); v.y = pk2(gi[2], gi[3]);
                            *(LAS u32x2*)(git + (d * 64 + t) * 128 + c) = v;
                        }
                    }
                }
            }
            __syncthreads();
            {
                const int c4 = (tid & 31) * 4, rest = tid >> 5, d = rest >> 3, t0 = (rest & 7) * 8, gc = cq * 128 + c4;
#pragma unroll
                for (int j = 0; j < 8; ++j) {
                    const int t = t0 + j;
                    const f32x4 la = *(const LAS f32x4*)(lat + (d * 64 + t) * 128 + c4);
                    const u32x2 gg = *(const LAS u32x2*)(git + (d * 64 + t) * 128 + c4);
                    f32x4 av; float u[4];
                    const float gi[4] = {lo_bf(gg.x), hi_bf(gg.x), lo_bf(gg.y), hi_bf(gg.y)};
#pragma unroll
                    for (int e = 0; e < 4; ++e) { av[e] = __expf(la[e]); u[e] = __builtin_amdgcn_sqrtf(fmaxf(1.f - av[e] * av[e], 0.f)) * gi[e]; }
                    u32x2 uo; uo.x = pk2(u[0], u[1]); uo.y = pk2(u[2], u[3]);
                    *(f32x4*)(LA + ((size_t)(r0 + t) * 2 + d) * 512 + gc) = av;
                    *(u32x2*)(UU + ((size_t)(r0 + t) * 2 + d) * 512 + gc) = uo;
                    *(LAS f32x4*)(lat + (d * 64 + t) * 128 + c4) = av;
                    *(LAS u32x2*)(git + (d * 64 + t) * 128 + c4) = uo;
                }
            }
            __syncthreads();
            {
                const int half = tid >> 8, d = (tid >> 7) & 1, c = tid & 127, gc = cq * 128 + c;
                float hacc = 0.f, aprod = 1.f;
#pragma unroll 8
                for (int s_ = 0; s_ < 32; ++s_) {
                    const int pp = half * 32 + s_, t = d == 0 ? pp : 63 - pp;
                    const float a = lat[(d * 64 + t) * 128 + c], u = bf2f(git[(d * 64 + t) * 128 + c]);
                    hacc = a * hacc + u; aprod *= a;
                }
                LAS float* comb = (LAS float*)xin;
                comb[(half * 256 + d * 128 + c) * 2] = aprod; comb[(half * 256 + d * 128 + c) * 2 + 1] = hacc;
                __syncthreads();
                if (half == 0) {
                    const float a1 = comb[(256 + d * 128 + c) * 2], h1 = comb[(256 + d * 128 + c) * 2 + 1];
                    AGGA[(size_t)(ch * 2 + d) * 512 + gc] = aprod * a1;
                    AGGH[(size_t)(ch * 2 + d) * 512 + gc] = a1 * hacc + h1;
                }
            }
            __syncthreads();
        }
    }
    if (PROF_SEC == 11) pg_acc = __builtin_amdgcn_s_memtime() - pg0;
    if (PROF_SEC >= 10 && get_bid() == 0) { const unsigned long long t0_ = __builtin_amdgcn_s_memtime(); while (__builtin_amdgcn_s_memtime() - t0_ < 4 * pg_acc) __builtin_amdgcn_s_sleep(8); }
}

DI int scan_chunk(int b, int d, int st) {
    if (st < 4) return NCHL + b * 4 + (d == 0 ? st : 3 - st);
    const int j = st - 4;
    return b * 128 + (d == 0 ? j : 127 - j);
}

DI void phase_scan0(PP p) {
    float* U = (float*)(p->ws + OFF_ARENA + A_U);
    const float* DEC = (const float*)(p->ws + OFF_ARENA + A_DEC);
    const float* AGGA = (const float*)(p->ws + OFF_ARENA + A_AGGA);
    float* AGGH = (float*)(p->ws + OFF_ARENA + A_AGGH);
    const int gid = get_bid() * NTHREADS + get_tid(), nthr = gridDim.x * NTHREADS;
    constexpr int DEPTH = 22;
    for (int idx = gid; idx < 65536 + 4096; idx += nthr) {
        if (idx < 65536) {
            const int dv4 = idx & 31, dk = (idx >> 5) & 63, h = (idx >> 11) & 3, d = (idx >> 13) & 1, b = idx >> 14;
            f32x4 S = {0.f, 0.f, 0.f, 0.f};
            for (int st = 0; st < 132; st += DEPTH) {
                f32x4 u[DEPTH]; float dc[DEPTH]; float* ptr[DEPTH];
#pragma unroll
                for (int q = 0; q < DEPTH; ++q) {
                    const int cid = scan_chunk(b, d, st + q);
                    ptr[q] = U + ((size_t)(cid * 2 + d) * 4 + h) * 8192 + dk * 128 + dv4 * 4;
                    u[q] = *(const f32x4*)ptr[q];
                    dc[q] = DEC[(size_t)(cid * 2 + d) * 256 + h * 64 + dk];
                }
#pragma unroll
                for (int q = 0; q < DEPTH; ++q) { *(f32x4*)ptr[q] = S; S = S * dc[q] + u[q]; }
            }
        } else {
            const int i2 = idx - 65536, c = i2 & 511, d = (i2 >> 9) & 1, b = i2 >> 10;
            float hs = 0.f;
            for (int st = 0; st < 132; st += DEPTH) {
                float a[DEPTH], hh[DEPTH]; float* ptr[DEPTH];
#pragma unroll
                for (int q = 0; q < DEPTH; ++q) {
                    const int cid = scan_chunk(b, d, st + q);
                    ptr[q] = AGGH + (size_t)(cid * 2 + d) * 512 + c;
                    hh[q] = *ptr[q]; a[q] = AGGA[(size_t)(cid * 2 + d) * 512 + c];
                }
#pragma unroll
                for (int q = 0; q < DEPTH; ++q) { *ptr[q] = hs; hs = a[q] * hs + hh[q]; }
            }
        }
    }
}

DI void phase_g3(PP p, lds_t lds) {
    const int tid = get_tid(), lane = tid & 63, w = tid >> 6;
    const bf16_t* P = (const bf16_t*)(p->ws + OFF_ARENA + A_P);
    const float* U = (const float*)(p->ws + OFF_ARENA + A_U);
    const float* LA = (const float*)(p->ws + OFF_ARENA + A_LA);
    const bf16_t* UU = (const bf16_t*)(p->ws + OFF_ARENA + A_UU);
    const float* HST = (const float*)(p->ws + OFF_ARENA + A_AGGH);
    bf16_t* act = (bf16_t*)(p->ws + OFF_ACT);
    constexpr int NGLA = NCH * 4;
    int h_loaded = -1;
    for (int task = get_bid(); task < NGLA + NCH; task += gridDim.x) {
        if (task < NGLA) {
            const int ch = task >> 2, h = task & 3, r0 = ch * 64;
            LAS float* lrt = (LAS float*)lds;
            LAS float* wat = lrt + 2048;
            LAS float* bat = wat + 2048;
            LAS float* bc = bat + 128;
            LAS bf16_t* qt = (LAS bf16_t*)(bc + 8192);
            LAS bf16_t* kt = qt + 64 * 72;
            LAS bf16_t* qtd = kt + 64 * 72;
            LAS bf16_t* ktd = qtd + 64 * 72;
            LAS bf16_t* at = ktd + 64 * 72;
            LAS bf16_t* vt = at + 64 * 72;
            LAS bf16_t* St = vt + 64 * 136;
            LAS float* segt = (LAS float*)(St + 64 * 136);
            LAS float* ot = bc;
            gla_load_decay_inputs(p, P, r0, h, lrt, wat, bat, h != h_loaded); h_loaded = h;
            { const int row = tid >> 3, chunk = tid & 7;
              *(LAS u32x4*)(qt + row * 72 + chunk * 8) = *(const u32x4*)(P + (size_t)(r0 + row) * ABIN + PC_Q + h * 64 + chunk * 8);
              *(LAS u32x4*)(kt + row * 72 + chunk * 8) = *(const u32x4*)(P + (size_t)(r0 + row) * ABIN + PC_K + h * 64 + chunk * 8); }
#pragma unroll
            for (int q = 0; q < 2; ++q) { const int i = tid + 512 * q, row = i >> 4, chunk = i & 15; *(LAS u32x4*)(vt + row * 136 + chunk * 8) = *(const u32x4*)(P + (size_t)(r0 + row) * ABIN + PC_V + h * 128 + chunk * 8); }
            __syncthreads();
            f32x4 oacc[4];
#pragma unroll
            for (int i = 0; i < 4; ++i) oacc[i] = (f32x4){0.f, 0.f, 0.f, 0.f};
            const int ott = w & 3, odv0 = (w >> 2) * 4;
            gla_bcum2(bc, lrt, wat, bat, segt);
            for (int d = 0; d < 2; ++d) {
                {
                    const int t = tid >> 3, c8 = (tid & 7) * 8;
                    float qo[8], ko[8];
#pragma unroll
                    for (int j = 0; j < 8; ++j) { const float e = __expf(bc[d * 4096 + t * 64 + c8 + j]); qo[j] = bf2f(qt[t * 72 + c8 + j]) * 0.125f * e; ko[j] = bf2f(kt[t * 72 + c8 + j]) * rcpf_(e); }
                    u32x4 v; v.x = pk2(qo[0], qo[1]); v.y = pk2(qo[2], qo[3]); v.z = pk2(qo[4], qo[5]); v.w = pk2(qo[6], qo[7]);
                    *(LAS u32x4*)(qtd + t * 72 + c8) = v;
                    v.x = pk2(ko[0], ko[1]); v.y = pk2(ko[2], ko[3]); v.z = pk2(ko[4], ko[5]); v.w = pk2(ko[6], ko[7]);
                    *(LAS u32x4*)(ktd + t * 72 + c8) = v;
                    const int dk = tid >> 3, dv16 = (tid & 7) * 16;
                    const float* src = U + ((size_t)(ch * 2 + d) * 4 + h) * 8192 + dk * 128 + dv16;
                    const f32x4 s0 = *(const f32x4*)src, s1 = *(const f32x4*)(src + 4), s2 = *(const f32x4*)(src + 8), s3 = *(const f32x4*)(src + 12);
                    v.x = pk2(s0[0], s0[1]); v.y = pk2(s0[2], s0[3]); v.z = pk2(s1[0], s1[1]); v.w = pk2(s1[2], s1[3]);
                    *(LAS u32x4*)(St + dk * 136 + dv16) = v;
                    v.x = pk2(s2[0], s2[1]); v.y = pk2(s2[2], s2[3]); v.z = pk2(s3[0], s3[1]); v.w = pk2(s3[2], s3[3]);
                    *(LAS u32x4*)(St + dk * 136 + dv16 + 8) = v;
                }
                __syncthreads();
                {
                    const int tt = w >> 1;
#pragma unroll
                    for (int e = 0; e < 2; ++e) {
                        const int st = (w & 1) * 2 + e;
                        f32x4 acc = {0.f, 0.f, 0.f, 0.f};
#pragma unroll
                        for (int ks = 0; ks < 2; ++ks) acc = mfma16(frag_row(ktd, 72, st * 16, ks * 32, lane), frag_row(qtd, 72, tt * 16, ks * 32, lane), acc);
                        const int t = tt * 16 + (lane & 15), s0 = st * 16 + 4 * (lane >> 4);
                        float a[4];
#pragma unroll
                        for (int j = 0; j < 4; ++j) { const int s = s0 + j; a[j] = (d == 0 ? s <= t : s >= t) ? acc[j] : 0.f; }
                        u32x2 v; v.x = pk2(a[0], a[1]); v.y = pk2(a[2], a[3]);
                        *(LAS u32x2*)(at + t * 72 + s0) = v;
                    }
                }
                __syncthreads();
                {
                    bf16x8 af[2], qf[2];
#pragma unroll
                    for (int ks = 0; ks < 2; ++ks) { af[ks] = frag_row(at, 72, ott * 16, ks * 32, lane); qf[ks] = frag_row(qtd, 72, ott * 16, ks * 32, lane); }
#pragma unroll
                    for (int i = 0; i < 4; ++i) {
                        const int dvt = odv0 + i;
#pragma unroll
                        for (int ks = 0; ks < 2; ++ks) {
                            oacc[i] = mfma16(frag_tr(vt, 136, ks * 32, dvt * 16, lane), af[ks], oacc[i]);
                            oacc[i] = mfma16(frag_tr(St, 136, ks * 32, dvt * 16, lane), qf[ks], oacc[i]);
                        }
                    }
                }
                __syncthreads();
            }
#pragma unroll
            for (int i = 0; i < 4; ++i) *(LAS f32x4*)(ot + (ott * 16 + (lane & 15)) * 132 + (odv0 + i) * 16 + 4 * (lane >> 4)) = oacc[i];
            __syncthreads();
            {
                const int t = tid >> 3, dv16 = (tid & 7) * 16;
                float o[16]; float ss = 0.f;
#pragma unroll
                for (int j = 0; j < 16; ++j) { o[j] = ot[t * 132 + dv16 + j]; ss += o[j] * o[j]; }
                ss += __shfl_xor(ss, 1); ss += __shfl_xor(ss, 2); ss += __shfl_xor(ss, 4);
                const float rs = rsqrtf(ss * (1.f / 128.f) + EPS);
                const bf16_t* gp = P + (size_t)(r0 + t) * ABIN + PC_G + h * 128 + dv16;
                const u32x4 g0 = *(const u32x4*)gp, g1 = *(const u32x4*)(gp + 8);
                const unsigned gw[8] = {g0.x, g0.y, g0.z, g0.w, g1.x, g1.y, g1.z, g1.w};
                float r[16], gn[16];
#pragma unroll
                for (int j4 = 0; j4 < 4; ++j4) { const f32x4 gv = *(const f32x4*)(p->gla_norm_g + h * 128 + dv16 + 4 * j4); gn[4 * j4] = gv[0]; gn[4 * j4 + 1] = gv[1]; gn[4 * j4 + 2] = gv[2]; gn[4 * j4 + 3] = gv[3]; }
#pragma unroll
                for (int j = 0; j < 8; ++j) {
                    r[2 * j] = o[2 * j] * rs * gn[2 * j] * siluf_(lo_bf(gw[j]));
                    r[2 * j + 1] = o[2 * j + 1] * rs * gn[2 * j + 1] * siluf_(hi_bf(gw[j]));
                }
                bf16_t* dst = act + (size_t)(r0 + t) * 1024 + h * 128 + dv16;
                u32x4 v; v.x = pk2(r[0], r[1]); v.y = pk2(r[2], r[3]); v.z = pk2(r[4], r[5]); v.w = pk2(r[6], r[7]);
                *(u32x4*)dst = v;
                v.x = pk2(r[8], r[9]); v.y = pk2(r[10], r[11]); v.z = pk2(r[12], r[13]); v.w = pk2(r[14], r[15]);
                *(u32x4*)(dst + 8) = v;
            }
            __syncthreads();
        } else {
            const int ch = task - NGLA, r0 = ch * 64;
            LAS unsigned* hq = (LAS unsigned*)lds;
            {
                int tl = tid; asm volatile("" : "+v"(tl));
                const int d = tl >> 8, cp = tl & 255;
                f32x2 hs = *(const f32x2*)(HST + (size_t)(ch * 2 + d) * 512 + 2 * cp);
                const long gstep = d ? -1024 : 1024;
                const int lstep = d ? -256 : 256;
                const float* lap = LA + ((size_t)(r0 + (d ? 63 : 0)) * 2 + d) * 512 + 2 * cp;
                const bf16_t* uup = UU + ((size_t)(r0 + (d ? 63 : 0)) * 2 + d) * 512 + 2 * cp;
                LAS unsigned* hw = hq + (d * 64 + (d ? 63 : 0)) * 256 + cp;
                f32x2 a0[16], a1[16]; unsigned u0[16], u1[16];
#define LRU_LOADB(A_, U_) _Pragma("unroll") for (int j = 0; j < 16; ++j) { A_[j] = *(const f32x2*)lap; U_[j] = *(const unsigned*)uup; lap += gstep; uup += gstep; }
#define LRU_STEPB(A_, U_) _Pragma("unroll") for (int j = 0; j < 16; ++j) { hs[0] = A_[j][0] * hs[0] + lo_bf(U_[j]); hs[1] = A_[j][1] * hs[1] + hi_bf(U_[j]); *hw = pk2(hs[0], hs[1]); hw += lstep; }
                LRU_LOADB(a0, u0)
                LRU_LOADB(a1, u1)
                LRU_STEPB(a0, u0)
                LRU_LOADB(a0, u0)
                LRU_STEPB(a1, u1)
                LRU_LOADB(a1, u1)
                LRU_STEPB(a0, u0)
                LRU_STEPB(a1, u1)
#undef LRU_LOADB
#undef LRU_STEPB
            }
            __syncthreads();
#pragma unroll
            for (int q = 0; q < 8; ++q) {
                const int i = tid + NTHREADS * q, row = i >> 6, c8 = (i & 63) * 8;
                const u32x4 hf = *(const LAS u32x4*)(hq + row * 256 + (c8 >> 1)), hb = *(const LAS u32x4*)(hq + (64 + row) * 256 + (c8 >> 1));
                const u32x4 gg = *(const u32x4*)(P + (size_t)(r0 + row) * ABIN + PC_RGG + c8);
                const unsigned fw[4] = {hf.x, hf.y, hf.z, hf.w}, bw[4] = {hb.x, hb.y, hb.z, hb.w}, gw[4] = {gg.x, gg.y, gg.z, gg.w};
                unsigned o[4];
#pragma unroll
                for (int j = 0; j < 4; ++j) o[j] = pk2((lo_bf(fw[j]) + lo_bf(bw[j])) * gelu_tanh(lo_bf(gw[j])), (hi_bf(fw[j]) + hi_bf(bw[j])) * gelu_tanh(hi_bf(gw[j])));
                u32x4 ov; ov.x = o[0]; ov.y = o[1]; ov.z = o[2]; ov.w = o[3];
                *(u32x4*)(act + (size_t)(r0 + row) * 1024 + 512 + c8) = ov;
            }
            __syncthreads();
        }
    }
}


DI void phase_outproj0(PP p, lds_t lds) {
    const bf16_t* act = (const bf16_t*)(p->ws + OFF_ACT);
    float* X = (float*)(p->ws + OFF_ARENA + A_X);
    constexpr int NM = NTOK / 256, NN = 4;
    gemm_multi<64, false>(lds, 1024, 1, NM, NN, 8, 4,
        [&](const U3& u, int r) { return act + (size_t)(u.m * 256 + r) * 1024; },
        [&](const U3& u) { return (const bf16_t*)((const char*)p->out + DO_WOUT) + (size_t)(u.n * 256) * 1024; },
        [&](const U3& u, const f32x4 (&acc)[8][4], int wr, int wc, int lane) {
            const int pm = u.m, pn = u.n, set = row_set(pm * 256);
            const float* g1 = mods_ptr(p, 0, set, 2);
            const float* xin = pm * 256 < NLAT ? p->x + (size_t)pm * 256 * 1024 : p->ctx + (size_t)(pm * 256 - NLAT) * 1024;
            const int c0 = pn * 256 + wc * 64 + 4 * (lane >> 4);
            f32x4 g[4];
#pragma unroll
            for (int ni = 0; ni < 4; ++ni) g[ni] = *(const f32x4*)(g1 + c0 + ni * 16);
            const float* xr = xin + (size_t)(wr * 128 + (lane & 15)) * 1024 + c0;
            float* Xr = X + (size_t)(pm * 256 + wr * 128 + (lane & 15)) * 1024 + c0;
#pragma unroll
            for (int mi = 0; mi < 8; ++mi) {
                f32x4 xi[4];
#pragma unroll
                for (int ni = 0; ni < 4; ++ni) xi[ni] = *(const f32x4*)(xr + mi * 16 * 1024 + ni * 16);
#pragma unroll
                for (int ni = 0; ni < 4; ++ni) *(f32x4*)(Xr + mi * 16 * 1024 + ni * 16) = xi[ni] + g[ni] * acc[mi][ni];
                asm volatile("" ::: "memory");
            }
        });
}

struct MoeBufs { float* PT; float* PE; int* ROWID; int* ROWTOK; bf16_t* HDN; bf16_t* Y; int rpe; int nrows; };
DI MoeBufs moe_bufs(PP p, int layer) {
    MoeBufs m;
    char* a = p->ws + OFF_ARENA;
    if (layer == 0) { m.PT = (float*)(a + A_PT); m.PE = (float*)(a + A_PE); m.ROWID = (int*)(a + A_ROWID); m.ROWTOK = (int*)(a + A_ROWTOK); m.HDN = (bf16_t*)(a + A_HDN); m.Y = (bf16_t*)(a + A_Y); m.rpe = 4352; m.nrows = NTOK; }
    else { m.PT = (float*)(a + A_HB); m.PE = (float*)(a + A_HB + (size_t)NTOK * 64); m.ROWID = (int*)(a + A_HB + (size_t)NTOK * 128); m.ROWTOK = (int*)(a + A_HB + (size_t)NTOK * 192); m.HDN = (bf16_t*)(a + A_XM); m.Y = (bf16_t*)(a + A_XC); m.rpe = 4096; m.nrows = NLAT; }
    return m;
}

DI void phase_router(PP p, lds_t lds, int layer) {
    const int tid = get_tid(), lane = tid & 63;
    const MoeBufs m = moe_bufs(p, layer);
    const float* X = (const float*)(p->ws + OFF_ARENA + A_X);
    bf16_t* act = (bf16_t*)(p->ws + OFF_ACT);
    LAS float* rwT = (LAS float*)lds;
    {
        f32x4 wv[8];
#pragma unroll
        for (int q = 0; q < 8; ++q) wv[q] = *(const f32x4*)(p->router_w + (size_t)layer * 16384 + (size_t)(tid + NTHREADS * q) * 4);
#pragma unroll
        for (int q = 0; q < 8; ++q) {
            const int i4 = (tid + NTHREADS * q) * 4, k = i4 >> 4, e0 = i4 & 15;
#pragma unroll
            for (int j = 0; j < 4; ++j) rwT[(e0 + j) * 1024 + k] = wv[q][j];
        }
    }
    __syncthreads();
    const int gw = get_bid() * 8 + (tid >> 6), nw = gridDim.x * 8;
    ModCache mc; mc.s = -1;
    f32x4 vb[4];
    for (int rr = gw; rr < m.nrows; rr += 2 * nw)
    for (int half = 0; half < 2; ++half) {
        const int r = rr + half * nw;
        f32x4 v[4];
        if (half == 0) {
            row_load_f32(X + (size_t)r * 1024, v, lane);
            row_load_f32(X + (size_t)(r + nw < m.nrows ? r + nw : r) * 1024, vb, lane);
        } else {
            if (r >= m.nrows) break;
#pragma unroll
            for (int i = 0; i < 4; ++i) v[i] = vb[i];
        }
        const int set = row_set(r);
        mod_fetch(mc, set, p->norm2_g + layer * 1024, mods_ptr(p, layer, set, 4), mods_ptr(p, layer, set, 3), lane);
        const float rs = rsqrtf(row_sumsq(v) * (1.f / 1024.f) + EPS);
        row_modulate_c(v, rs, mc);
        row_store_bf16(act + (size_t)r * 1024, v, lane);
        float pa[16];
#pragma unroll
        for (int e = 0; e < 16; ++e) {
            float a = 0.f;
#pragma unroll
            for (int i = 0; i < 4; ++i) { const f32x4 wv = *(const LAS f32x4*)(rwT + e * 1024 + rcol(lane, i)); a += v[i][0] * wv[0] + v[i][1] * wv[1] + v[i][2] * wv[2] + v[i][3] * wv[3]; }
            pa[e] = a;
            if ((e & 3) == 3) asm volatile("" ::: "memory");
        }
        float k8[8], k4[4], k2[2];
        { const bool hi = lane & 32;
#pragma unroll
          for (int j = 0; j < 8; ++j) { const float snd = hi ? pa[j] : pa[j + 8]; k8[j] = (hi ? pa[j + 8] : pa[j]) + __shfl_xor(snd, 32); } }
        { const bool hi = lane & 16;
#pragma unroll
          for (int j = 0; j < 4; ++j) { const float snd = hi ? k8[j] : k8[j + 4]; k4[j] = (hi ? k8[j + 4] : k8[j]) + __shfl_xor(snd, 16); } }
        { const bool hi = lane & 8;
#pragma unroll
          for (int j = 0; j < 2; ++j) { const float snd = hi ? k4[j] : k4[j + 2]; k2[j] = (hi ? k4[j + 2] : k4[j]) + __shfl_xor(snd, 8); } }
        float lgt;
        { const bool hi = lane & 4; const float snd = hi ? k2[0] : k2[1]; lgt = (hi ? k2[1] : k2[0]) + __shfl_xor(snd, 4); }
        lgt += __shfl_xor(lgt, 2); lgt += __shfl_xor(lgt, 1);
        float mx = lgt;
#pragma unroll
        for (int o = 4; o < 64; o <<= 1) mx = fmaxf(mx, __shfl_xor(mx, o));
        const float ex = __expf(lgt - mx);
        float sum = ex;
#pragma unroll
        for (int o = 4; o < 64; o <<= 1) sum += __shfl_xor(sum, o);
        const float mine = ex * rcpf_(sum);
        if ((lane & 3) == 0) {
            const int e = lane >> 2;
            m.PT[(size_t)r * 16 + e] = mine;
            if (r < NLAT) m.PE[((size_t)(r >> 13) * 16 + e) * 8192 + (r & 8191)] = mine;
            else { const int rc = r - NLAT; m.PE[(size_t)NBATCH * 16 * 8192 + ((size_t)(rc >> 8) * 16 + e) * 256 + (rc & 255)] = mine; }
        }
    }
}

DI int block_excl_scan(int v, LAS int* tmp, int* total) {
    const int tid = get_tid(), lane = tid & 63, w = tid >> 6;
    int inc = v;
#pragma unroll
    for (int o = 1; o < 64; o <<= 1) { const int t = __shfl_up(inc, o); if (lane >= o) inc += t; }
    __syncthreads();
    if (lane == 63) tmp[w] = inc;
    __syncthreads();
    int base = 0, tot = 0;
#pragma unroll
    for (int i = 0; i < 8; ++i) { const int t = tmp[i]; if (i < w) base += t; tot += t; }
    *total = tot;
    return base + inc - v;
}

DI void phase_topk(PP p, lds_t lds, int layer) {
    const int tid = get_tid();
    const MoeBufs m = moe_bufs(p, layer);
    LAS unsigned* keys = (LAS unsigned*)lds;
    LAS int* hist = (LAS int*)(keys + 8192);
    LAS int* tmp = hist + 256;
    LAS int* sel = tmp + 16;
    const int ntask = layer == 0 ? 128 : 64;
    if (layer == 1 && get_bid() >= 64) {
        conv_stream(get_bid() - 64, 16 * 768, gridDim.x - 64, [&](int t) { return conv_desc_expert(p, 1, t); }, lds);
        return;
    }
    for (int task = get_bid(); task < ntask; task += gridDim.x) {
        const bool isctx = task >= 64;
        const int b = (task & 63) >> 4, e = task & 15;
        const int n = isctx ? 256 : 8192, cap = isctx ? 32 : 1024;
        const float* src = isctx ? m.PE + (size_t)NBATCH * 16 * 8192 + ((size_t)b * 16 + e) * 256 : m.PE + ((size_t)b * 16 + e) * 8192;
        {
            u32x4 kv[4];
#pragma unroll
            for (int q = 0; q < 4; ++q) { const int i4 = (tid + NTHREADS * q) * 4; kv[q] = (u32x4){0u, 0u, 0u, 0u}; if (i4 < n) kv[q] = *(const u32x4*)(src + i4); }
#pragma unroll
            for (int q = 0; q < 4; ++q) { const int i4 = (tid + NTHREADS * q) * 4; if (i4 < n) *(LAS u32x4*)(keys + i4) = kv[q]; }
        }
        __syncthreads();
        unsigned prefix = 0u, mask = 0u; int kk = cap;
        for (int pass = 3; pass >= 0; --pass) {
            const int shift = pass * 8;
            if (tid < 256) hist[tid] = 0;
            __syncthreads();
            for (int i = tid; i < n; i += NTHREADS) { const unsigned k = keys[i]; if ((k & mask) == prefix) __hip_atomic_fetch_add((int*)(hist + ((k >> shift) & 255)), 1, __ATOMIC_RELAXED, __HIP_MEMORY_SCOPE_WORKGROUP); }
            __syncthreads();
            if (tid < 256) {
                int above = 0;
                for (int j = tid + 1; j < 256; ++j) above += hist[j];
                const int mineh = hist[tid];
                if (above < kk && kk <= above + mineh) { sel[0] = tid; sel[1] = above; }
            }
            __syncthreads();
            prefix |= (unsigned)sel[0] << shift; mask |= 0xffu << shift; kk -= sel[1];
            __syncthreads();
        }
        const unsigned T = prefix; const int need_eq = kk;
        const int ipt = n / NTHREADS > 0 ? n / NTHREADS : 1;
        const int i0 = tid * ipt;
        int cgt = 0, ceq = 0;
        if (i0 < n) for (int j = 0; j < ipt; ++j) { const unsigned k = keys[i0 + j]; cgt += k > T; ceq += k == T; }
        int tot;
        const int egt = block_excl_scan(cgt, tmp, &tot);
        const int eeq = block_excl_scan(ceq, tmp, &tot);
        const int slot0 = e * m.rpe + (isctx ? 4096 + b * 32 : b * 1024);
        const int row0 = isctx ? NLAT + b * 256 : b * 8192;
        if (i0 < n) {
            int ngt = egt, neq = eeq;
            for (int j = 0; j < ipt; ++j) {
                const unsigned k = keys[i0 + j];
                int slot = -1;
                if (k > T) { slot = slot0 + ngt + (neq < need_eq ? neq : need_eq); ++ngt; }
                else if (k == T) { if (neq < need_eq) slot = slot0 + ngt + neq; ++neq; }
                m.ROWID[(size_t)(row0 + i0 + j) * 16 + e] = slot;
                if (slot >= 0) m.ROWTOK[slot] = row0 + i0 + j;
            }
        }
        if (isctx && b == 0 && layer == 0) for (int i = tid; i < 128; i += NTHREADS) m.ROWTOK[e * m.rpe + 4224 + i] = -1;
        __syncthreads();
    }
}

DI void phase_moe_up(PP p, lds_t lds, int layer) {
    const MoeBufs m = moe_bufs(p, layer);
    const bf16_t* act = (const bf16_t*)(p->ws + OFF_ACT);
    auto run = [&](int NM, int mt0, int TM, int TN) {
        struct { const int* rt; const bf16_t* act; int rpe, mt0;
                 DI int idx(const U3& u, int r) const { return rt[u.b * rpe + (mt0 + u.m) * 256 + r]; }
                 DI const bf16_t* row(int tok) const { return act + (size_t)(tok < 0 ? 0 : tok) * 1024; } } ga{m.ROWTOK, act, m.rpe, mt0};
        gemm_multi<64, true, 8, false, true>(lds, 1024, 16, NM, 8, TM, TN, ga,
            [&](const U3& u) { return (const bf16_t*)((const char*)p->out + DO_EXP + (size_t)u.b * EXP_STRIDE) + (size_t)(u.n * 256) * 1024; },
            [&](const U3& u, const f32x4 (&acc)[8][4], int wr, int wc, int lane) {
                bf16_t* H = m.HDN + ((size_t)u.b * m.rpe + (mt0 + u.m) * 256) * 1024 + u.n * 128;
#pragma unroll
                for (int mi = 0; mi < 8; ++mi) {
                    f32x4 h0, h1;
#pragma unroll
                    for (int j = 0; j < 4; ++j) { h0[j] = siluf_(acc[mi][0][j]) * acc[mi][2][j]; h1[j] = siluf_(acc[mi][1][j]) * acc[mi][3][j]; }
                    store_bf16x8(H + (size_t)(wr * 128 + mi * 16 + (lane & 15)) * 1024 + wc * 32 + 8 * (lane >> 4), h0, h1);
                }
            });
    };
    run(16, 0, 4, 8);
    if (layer == 0) run(1, 16, 1, 8);
}

template <int PROBE>
DI void phase_moe_down_t(PP p, lds_t lds, int layer) {
    const MoeBufs m = moe_bufs(p, layer);
    auto run = [&](int NM, int mt0, int TM, int TN) {
        gemm_multi<64, true>(lds, 1024, 16, NM, 4, TM, TN,
            [&](const U3& u, int r) { return m.HDN + ((size_t)u.b * m.rpe + (mt0 + u.m) * 256 + r) * 1024; },
            [&](const U3& u) { return (const bf16_t*)((const char*)p->out + DO_EXP + (size_t)u.b * EXP_STRIDE) + (size_t)(2048 + u.n * 256) * 1024; },
            [&](const U3& u, const f32x4 (&acc)[8][4], int wr, int wc, int lane) {
                bf16_t* Y = m.Y + ((size_t)u.b * m.rpe + (mt0 + u.m) * 256) * 1024 + u.n * 256;
                epi_each8(acc, wr, wc, lane, [&](int r, int c, f32x4 v0, f32x4 v1) { store_bf16x8(Y + (size_t)r * 1024 + c, v0, v1); });
            });
    };
    run(16, 0, 8, 4);
    if (layer == 0) run(1, 16, 1, 4);
}

DI void phase_moe_down(PP p, lds_t lds, int layer) { phase_moe_down_t<0>(p, lds, layer); }

DI void phase_combine(PP p, int layer) {
    const int tid = get_tid(), lane = tid & 63;
    const MoeBufs m = moe_bufs(p, layer);
    float* X = (float*)(p->ws + OFF_ARENA + A_X);
    bf16_t* act = (bf16_t*)(p->ws + OFF_ACT);
    const int gw = get_bid() * 8 + (tid >> 6), nw = gridDim.x * 8;
    ModCache mc; mc.s = -1; f32x4 g2v[4]; int g2s = -1;
    for (int r = gw; r < m.nrows; r += nw) {
        f32x4 v[4], a[4];
        row_load_f32(X + (size_t)r * 1024, v, lane);
#pragma unroll
        for (int i = 0; i < 4; ++i) a[i] = (f32x4){0.f, 0.f, 0.f, 0.f};
        int rid = -1; float pe = 0.f;
        if (lane < 16) { rid = m.ROWID[(size_t)r * 16 + lane]; pe = m.PT[(size_t)r * 16 + lane]; }
        unsigned long long mask = __ballot(rid >= 0);
        while (mask) {
            int ee[4];
#pragma unroll
            for (int q = 0; q < 4; ++q) { ee[q] = mask ? __builtin_ctzll(mask) : 63; mask &= mask - 1; }
            u32x4 y0[4], y1[4]; float pq[4];
#pragma unroll
            for (int q = 0; q < 4; ++q) {
                const int rq = __shfl(rid, ee[q]); pq[q] = rq >= 0 ? __shfl(pe, ee[q]) : 0.f;
                const bf16_t* y = m.Y + (size_t)(rq >= 0 ? rq : 0) * 1024;
                y0[q] = *(const u32x4*)(y + 8 * lane); y1[q] = *(const u32x4*)(y + 512 + 8 * lane);
            }
#pragma unroll
            for (int q = 0; q < 4; ++q) {
                const float w_ = pq[q];
                a[0][0] += w_ * lo_bf(y0[q].x); a[0][1] += w_ * hi_bf(y0[q].x); a[0][2] += w_ * lo_bf(y0[q].y); a[0][3] += w_ * hi_bf(y0[q].y);
                a[1][0] += w_ * lo_bf(y0[q].z); a[1][1] += w_ * hi_bf(y0[q].z); a[1][2] += w_ * lo_bf(y0[q].w); a[1][3] += w_ * hi_bf(y0[q].w);
                a[2][0] += w_ * lo_bf(y1[q].x); a[2][1] += w_ * hi_bf(y1[q].x); a[2][2] += w_ * lo_bf(y1[q].y); a[2][3] += w_ * hi_bf(y1[q].y);
                a[3][0] += w_ * lo_bf(y1[q].z); a[3][1] += w_ * hi_bf(y1[q].z); a[3][2] += w_ * lo_bf(y1[q].w); a[3][3] += w_ * hi_bf(y1[q].w);
            }
        }
        const int set = row_set(r);
        if (set != g2s) {
            g2s = set;
            const float* g2 = mods_ptr(p, layer, set, 5);
#pragma unroll
            for (int i = 0; i < 4; ++i) g2v[i] = *(const f32x4*)(g2 + rcol(lane, i));
        }
#pragma unroll
        for (int i = 0; i < 4; ++i) v[i] = v[i] + g2v[i] * a[i];
        const float rs = rsqrtf(row_sumsq(v) * (1.f / 1024.f) + EPS);
        if (layer == 0) {
#pragma unroll
            for (int i = 0; i < 4; ++i) *(f32x4*)(X + (size_t)r * 1024 + rcol(lane, i)) = v[i];
            mod_fetch(mc, set, p->norm1_g + 1024, mods_ptr(p, 1, set, 1), mods_ptr(p, 1, set, 0), lane);
            row_modulate_c(v, rs, mc);
            row_store_bf16(act + (size_t)r * 1024, v, lane);
        } else {
            if (mc.s != 0) { mc.s = 0;
#pragma unroll
                for (int i = 0; i < 4; ++i) mc.a[i] = *(const f32x4*)(p->final_g + rcol(lane, i)); }
#pragma unroll
            for (int i = 0; i < 4; ++i) *(f32x4*)(p->out + (size_t)r * 1024 + rcol(lane, i)) = v[i] * rs * mc.a[i];
        }
    }
}


DI void phase_upproj(PP p, lds_t lds, int half) {
    const bf16_t* act = (const bf16_t*)(p->ws + OFF_ACT);
    bf16_t* O = (bf16_t*)(p->ws + OFF_ARENA + A_XM);
    const int NM = half == 0 ? NTOK / 256 : NLAT / 256, NN = 8;
    gemm_multi<64, true>(lds, 1024, 1, NM, NN, 8, 4,
        [&](const U3& u, int r) { return act + (size_t)(u.m * 256 + r) * 1024; },
        [&](const U3& u) { return (const bf16_t*)(p->ws + OFF_WUPT) + (size_t)(half * 2048 + u.n * 256) * 1024; },
        [&](const U3& u, const f32x4 (&acc)[8][4], int wr, int wc, int lane) {
            epi_each8(acc, wr, wc, lane, [&](int r, int c, f32x4 v0, f32x4 v1) { store_bf16x8(O + (size_t)(u.m * 256 + r) * 2048 + u.n * 256 + c, v0, v1); });
        });
}

DI void phase_mfeat(PP p, lds_t lds, bool shadow = false) {
    const int tid = get_tid(), lane = tid & 63, w = tid >> 6;
    bf16_t* XM = (bf16_t*)(p->ws + OFF_ARENA + A_XM);
    bf16_t* XC = (bf16_t*)(p->ws + OFF_ARENA + A_XC);
    bf16_t* CTXV = (bf16_t*)(p->ws + OFF_ACT + ACT_CTXV);
    bf16_t* RAWS = (bf16_t*)(p->ws + OFF_ACT + ACT_RAWS);
    float* GP = (float*)(p->ws + OFF_ACT + ACT_GP);
    const bf16_t* GC = (const bf16_t*)(p->ws + OFF_GCAT);
    const float* MM = (const float*)(p->ws + OFF_MMAT);
    LAS bf16_t* xin = (LAS bf16_t*)lds;
    LAS bf16_t* xct = xin + 67 * 136;
    LAS bf16_t* qpt = xct + 64 * 136;
    LAS float* gred = (LAS float*)(qpt + 64 * 136);
    LAS bf16_t* gxa = (LAS bf16_t*)(gred + 2048);
    LAS bf16_t* gma = gxa + 512 * 16;
    LAS float* mqa = (LAS float*)(gma + 512 * 16);
    LAS float* wva = mqa + 2048;
    LAS float* cwa = wva + 2048;
    int h_loaded = -1;
    u32x4 xr[3];
    auto load_xin = [&](int task, int q4) {
        const int ch = task >> 2, hh = task & 3, r0 = ch * 64, col0 = hh * 512 + q4 * 128;
        const int seg_lo = ch < NCHL ? r0 : NLAT + ((r0 - NLAT) >> 8) * 256, seg_hi = ch < NCHL ? r0 + 64 : seg_lo + 256;
#pragma unroll
        for (int k = 0; k < 3; ++k) {
            const int i = tid + k * NTHREADS, row = i >> 4, chunk = i & 15, r = r0 - 2 + row;
            xr[k] = (u32x4){0u, 0u, 0u, 0u};
            if (i < 67 * 16 && r >= seg_lo && r < seg_hi) xr[k] = *(const u32x4*)(XM + (size_t)r * 2048 + col0 + chunk * 8);
        }
    };
    const int task0 = get_bid();
    if (task0 < NCH * 4) load_xin(task0, 0);
    for (int task = task0; task < NCH * 4; task += gridDim.x) {
        const int ch = task >> 2, h = task & 3, r0 = ch * 64;
        if (h != h_loaded) {
            h_loaded = h;
            for (int i = tid; i < 1024; i += NTHREADS) { *(LAS u32x4*)(gxa + i * 8) = *(const u32x4*)(GC + (size_t)h * 512 * 16 + i * 8); *(LAS u32x4*)(gma + i * 8) = *(const u32x4*)(GC + (size_t)(2048 + h * 512) * 16 + i * 8); }
            for (int i = tid; i < 2048; i += NTHREADS) { const int nb_ = i >> 4, ii = (i >> 2) & 3, o_ = i & 3, j_ = (((nb_ & 3) * 4 + ii) * 32 + (nb_ >> 2)) * 4 + o_; mqa[j_] = bf2f(f2bf(MM[(size_t)h * 2048 + i])); wva[j_] = p->m_wv[(size_t)h * 2048 + i]; }
            for (int i = tid; i < 2560; i += NTHREADS) { const int tap_ = i >> 9, c_ = i & 511; cwa[((tap_ * 4 + ((c_ >> 2) & 3)) * 32 + (c_ >> 4)) * 4 + (c_ & 3)] = i < 2048 ? p->m_conv_w[(size_t)tap_ * 2048 + h * 512 + c_] : p->m_conv_b[h * 512 + c_]; }
        }
        f32x4 rs_acc[2] = {{0.f, 0.f, 0.f, 0.f}, {0.f, 0.f, 0.f, 0.f}};
        f32x4 g_acc = {0.f, 0.f, 0.f, 0.f};
        for (int q4 = 0; q4 < 4; ++q4) {
            const int col0 = h * 512 + q4 * 128;
#pragma unroll
            for (int k = 0; k < 3; ++k) { const int i = tid + k * NTHREADS; if (i < 67 * 16) *(LAS u32x4*)(xin + (i >> 4) * 136 + (i & 15) * 8) = xr[k]; }
            __syncthreads();
            if (q4 < 3) load_xin(task, q4 + 1); else if (task + (int)gridDim.x < NCH * 4) load_xin(task + gridDim.x, 0);
            {
                const int t = tid >> 3, c16 = (tid & 7) * 16, hc = q4 * 128 + c16;
                float xc[16], xm[16];
                {
                    const u32x4 a0 = *(const LAS u32x4*)(xin + (t + 2) * 136 + c16), a1 = *(const LAS u32x4*)(xin + (t + 2) * 136 + c16 + 8);
                    const unsigned aw[8] = {a0.x, a0.y, a0.z, a0.w, a1.x, a1.y, a1.z, a1.w};
#pragma unroll
                    for (int j = 0; j < 8; ++j) { xm[2 * j] = lo_bf(aw[j]); xm[2 * j + 1] = hi_bf(aw[j]); }
#pragma unroll
                    for (int j4 = 0; j4 < 4; ++j4) { const f32x4 bb = *(const LAS f32x4*)(cwa + ((16 + j4) * 32 + (hc >> 4)) * 4); xc[4 * j4] = bb[0]; xc[4 * j4 + 1] = bb[1]; xc[4 * j4 + 2] = bb[2]; xc[4 * j4 + 3] = bb[3]; }
                }
#pragma unroll
                for (int tap = 0; tap < 4; ++tap) {
                    const u32x4 a0 = *(const LAS u32x4*)(xin + (t + tap) * 136 + c16), a1 = *(const LAS u32x4*)(xin + (t + tap) * 136 + c16 + 8);
                    const unsigned aw[8] = {a0.x, a0.y, a0.z, a0.w, a1.x, a1.y, a1.z, a1.w};
#pragma unroll
                    for (int j4 = 0; j4 < 4; ++j4) {
                        const f32x4 ww = *(const LAS f32x4*)(cwa + ((tap * 4 + j4) * 32 + (hc >> 4)) * 4);
                        xc[4 * j4] += ww[0] * lo_bf(aw[2 * j4]); xc[4 * j4 + 1] += ww[1] * hi_bf(aw[2 * j4]); xc[4 * j4 + 2] += ww[2] * lo_bf(aw[2 * j4 + 1]); xc[4 * j4 + 3] += ww[3] * hi_bf(aw[2 * j4 + 1]);
                    }
                }
                unsigned xcp[8];
#pragma unroll
                for (int j = 0; j < 8; ++j) { xcp[j] = pk2(siluf_(xc[2 * j]), siluf_(xc[2 * j + 1])); xc[2 * j] = lo_bf(xcp[j]); xc[2 * j + 1] = hi_bf(xcp[j]); }
                float vv[16], qp[16];
#pragma unroll
                for (int n = 0; n < 4; ++n) {
                    const int g_ = hc >> 4;
                    f32x4 a = {0.f, 0.f, 0.f, 0.f}, bq = a;
#pragma unroll
                    for (int i = 0; i < 4; ++i) {
                        const f32x4 wr_ = *(const LAS f32x4*)(wva + ((n * 4 + i) * 32 + g_) * 4), mr_ = *(const LAS f32x4*)(mqa + ((n * 4 + i) * 32 + g_) * 4);
                        a = a + wr_ * xm[4 * n + i]; bq = bq + mr_ * xc[4 * n + i];
                    }
#pragma unroll
                    for (int o = 0; o < 4; ++o) { vv[4 * n + o] = a[o]; qp[4 * n + o] = bq[o]; }
                }
                u32x4 v0, v1;
                v0.x = xcp[0]; v0.y = xcp[1]; v0.z = xcp[2]; v0.w = xcp[3]; v1.x = xcp[4]; v1.y = xcp[5]; v1.z = xcp[6]; v1.w = xcp[7];
                *(LAS u32x4*)(xct + t * 136 + c16) = v0; *(LAS u32x4*)(xct + t * 136 + c16 + 8) = v1;
                bf16_t* xcg = XC + (size_t)(r0 + t) * 2048 + col0 + c16;
                *(u32x4*)xcg = v0; *(u32x4*)(xcg + 8) = v1;
                v0.x = pk2(qp[0], qp[1]); v0.y = pk2(qp[2], qp[3]); v0.z = pk2(qp[4], qp[5]); v0.w = pk2(qp[6], qp[7]);
                v1.x = pk2(qp[8], qp[9]); v1.y = pk2(qp[10], qp[11]); v1.z = pk2(qp[12], qp[13]); v1.w = pk2(qp[14], qp[15]);
                *(LAS u32x4*)(qpt + t * 136 + c16) = v0; *(LAS u32x4*)(qpt + t * 136 + c16 + 8) = v1;
                v0.x = pk2(vv[0], vv[1]); v0.y = pk2(vv[2], vv[3]); v0.z = pk2(vv[4], vv[5]); v0.w = pk2(vv[6], vv[7]);
                v1.x = pk2(vv[8], vv[9]); v1.y = pk2(vv[10], vv[11]); v1.z = pk2(vv[12], vv[13]); v1.w = pk2(vv[14], vv[15]);
                bf16_t* vg = ch < NCHL ? XM + (size_t)(r0 + t) * 2048 + col0 + c16 : CTXV + (size_t)(r0 + t - NLAT) * 2048 + col0 + c16;
                if (!shadow) { *(u32x4*)vg = v0; *(u32x4*)(vg + 8) = v1; }
            }
            __syncthreads();
            {
                const int tt = w >> 1;
#pragma unroll
                for (int e = 0; e < 2; ++e) {
                    const int st = (w & 1) * 2 + e;
#pragma unroll
                    for (int ks = 0; ks < 4; ++ks) rs_acc[e] = mfma16(frag_row(xct, 136, st * 16, ks * 32, lane), frag_row(qpt, 136, tt * 16, ks * 32, lane), rs_acc[e]);
                }
                const int gt = w & 3, src = w >> 2;
                const LAS bf16_t* gm = (src ? gma : gxa) + q4 * 128 * 16;
                const LAS bf16_t* ft = src ? xin + 2 * 136 : xct;
#pragma unroll
                for (int ks = 0; ks < 4; ++ks) g_acc = mfma16(frag_tr(gm, 16, ks * 32, 0, lane), frag_row(ft, 136, gt * 16, ks * 32, lane), g_acc);
            }
            __syncthreads();
        }
        {
            const int tt = w >> 1;
#pragma unroll
            for (int e = 0; e < 2; ++e) {
                const int st = (w & 1) * 2 + e;
                store_bf16x4(RAWS + ((size_t)task * 64 + tt * 16 + (lane & 15)) * 64 + st * 16 + 4 * (lane >> 4), rs_acc[e]);
            }
            const int gt = w & 3, src = w >> 2;
            *(LAS f32x4*)(gred + (src * 64 + gt * 16 + (lane & 15)) * 16 + 4 * (lane >> 4)) = g_acc;
        }
        __syncthreads();
        if (tid < 256) {
            const int t = tid >> 2, q = tid & 3;
            const f32x4 a = *(const LAS f32x4*)(gred + t * 16 + q * 4), b = *(const LAS f32x4*)(gred + (64 + t) * 16 + q * 4);
            *(f32x4*)(GP + ((size_t)(r0 + t) * 4 + h) * 16 + q * 4) = a + b;
        }
        __syncthreads();
    }
}

constexpr int MS_KLD = 1056, MS_QLD = 1040;
constexpr size_t ACT_MSC = 32u << 20;
static_assert(ACT_MSC >= ACT_CTXV + (size_t)NCTX * 2048 * 2 && ACT_MSC + (size_t)256 * 132 * 192 * 4 <= ACT_BYTES, "msc scratch");
constexpr int MS_SCW = 6 * 64 + 8 + 64;
#define MS_REGIONS(L) \
    lds_t xct = (L);                                                         \
    lds_t qpt = (L) + 64 * MS_KLD;                                           \
    LAS bf16_t* vt = (LAS bf16_t*)((L) + 64 * MS_KLD + 64 * MS_QLD);         \
    LAS bf16_t* St = vt + 4096;                                              \
    LAS bf16_t* vwt = St + 4096;                                             \
    LAS float* scbase = (LAS float*)(vwt + 4096);                            \
    LAS float* red = (LAS float*)qpt;
#define MS_SC(SET) \
    LAS float* sc_b = scbase + (SET) * MS_SCW; LAS float* sc_m = sc_b + 64; LAS float* sc_e = sc_m + 64; LAS float* sc_w = sc_e + 64; \
    LAS float* sc_di = sc_w + 64; LAS float* sc_rs = sc_di + 64; LAS float* sc_misc = sc_rs + 64; LAS float* qn = sc_misc + 8;
DI void phase_mscan(PP p, lds_t lds) {
    const int tid = get_tid(), lane = tid & 63, w = tid >> 6, bid = get_bid();
    if (bid >= 256) return;
    const int grp = bid & 31, sl = bid >> 5, b = grp >> 3, h = (grp >> 1) & 3, d = grp & 1;
    const bf16_t* XC = (const bf16_t*)(p->ws + OFF_ARENA + A_XC);
    const bf16_t* V = (const bf16_t*)(p->ws + OFF_ARENA + A_XM);
    const bf16_t* CTXV = (const bf16_t*)(p->ws + OFF_ACT + ACT_CTXV);
    const bf16_t* RAWS = (const bf16_t*)(p->ws + OFF_ACT + ACT_RAWS);
    const float* GP = (const float*)(p->ws + OFF_ACT + ACT_GP);
    float* MSC = (float*)(p->ws + OFF_ACT + ACT_MSC) + (size_t)bid * 132 * 192;
    bf16_t* H = d == 0 ? (bf16_t*)p->out : (bf16_t*)(p->ws + OFF_ARENA + A_HB);
    static_assert(64 * MS_KLD + 64 * MS_QLD + 3 * 8192 + 2 * MS_SCW * 4 <= LDS_BYTES, "mscan lds");
    {
        const float bias_i = p->m_b_gates[d * 8 + h], bias_f = p->m_b_gates[d * 8 + 4 + h];
        for (int st = w; st < 132; st += 8) {
            const int cid = scan_chunk(b, d, st), t = d ? 63 - lane : lane;
            const float* gp = GP + (size_t)(cid * 64 + t) * 64;
            const float gli = gp[d * 8 + h] + gp[16 + d * 8 + h] + gp[32 + d * 8 + h] + gp[48 + d * 8 + h] + bias_i;
            const float gf = gp[d * 8 + 4 + h] + gp[16 + d * 8 + 4 + h] + gp[32 + d * 8 + 4 + h] + gp[48 + d * 8 + 4 + h] + bias_f;
            float bb = log_sigmoidf_(gf);
#pragma unroll
            for (int o = 1; o < 64; o <<= 1) { const float t_ = __shfl_up(bb, o); if (lane >= o) bb += t_; }
            float pm = gli - bb;
#pragma unroll
            for (int o = 1; o < 64; o <<= 1) { const float t_ = __shfl_up(pm, o); if (lane >= o) pm = fmaxf(pm, t_); }
            float* dst = MSC + (size_t)st * 192;
            dst[lane] = bb; dst[64 + lane] = gli; dst[128 + lane] = pm;
        }
    }
    const int c16o = tid & 63;
    bf16x2_t Mp[2][4][2];
#pragma unroll
    for (int n = 0; n < 2; ++n) {
        const float* mm = (const float*)(p->ws + OFF_MMAT) + (size_t)(h * 128 + 2 * c16o + n) * 16;
#pragma unroll
        for (int o = 0; o < 4; ++o) { Mp[n][o][0] = __builtin_bit_cast(bf16x2_t, pk2(mm[o], mm[4 + o])); Mp[n][o][1] = __builtin_bit_cast(bf16x2_t, pk2(mm[8 + o], mm[12 + o])); }
    }
    f32x4 C[16], Nacc[4];
#pragma unroll
    for (int i = 0; i < 16; ++i) C[i] = (f32x4){0.f, 0.f, 0.f, 0.f};
#pragma unroll
    for (int i = 0; i < 4; ++i) Nacc[i] = (f32x4){0.f, 0.f, 0.f, 0.f};
    float m_prev = 0.f;
    unsigned long long prof_acc = 0;
    u32x4 xcr[8], vr, rr; float g_b = 0.f, g_li = 0.f, g_pm = 0.f;
    asm volatile("s_waitcnt vmcnt(0)" ::: "memory");
    __syncthreads();
    auto prefetch = [&](int st) {
        int tp = get_tid();
        const int tid = tp, lane = tid & 63, w = tid >> 6;
        const int cid = scan_chunk(b, d, st), r0 = cid * 64;
        const bf16_t* xp = XC + (size_t)(r0 + (tid >> 6)) * 2048 + h * 512 + (tid & 63) * 8;
#pragma unroll
        for (int i = 0; i < 8; ++i) xcr[i] = *(const u32x4*)(xp + (size_t)i * 8 * 2048);
        { const int s_ = tid >> 3, chunk = tid & 7;
          vr = cid < NCHL ? *(const u32x4*)(V + (size_t)(r0 + s_) * 2048 + h * 512 + sl * 64 + chunk * 8) : *(const u32x4*)(CTXV + (size_t)(r0 + s_ - NLAT) * 2048 + h * 512 + sl * 64 + chunk * 8);
          rr = *(const u32x4*)(RAWS + ((size_t)(cid * 4 + h) * 64 + s_) * 64 + chunk * 8); }
    };
    auto prefetch_g = [&](int st) { if (w == 0) { const float* src = MSC + (size_t)st * 192; g_b = src[lane]; g_li = src[64 + lane]; g_pm = src[128 + lane]; } };
    auto scalars = [&](int set) {
        if (w == 0) {
            MS_REGIONS(lds) MS_SC(set) (void)xct; (void)vt; (void)red; (void)sc_rs;
            const float my_m = g_b + fmaxf(m_prev, g_pm);
            const float m_new = __shfl(my_m, 63), b_last = __shfl(g_b, 63);
            const int t = d ? 63 - lane : lane;
            sc_b[t] = g_b; sc_m[t] = my_m; sc_e[t] = g_li - g_b; sc_w[t] = __expf(b_last - g_b + g_li - m_new); sc_di[t] = __expf(g_b + m_prev - my_m);
            qn[lane] = 0.f;
            if (lane == 0) sc_misc[0] = __expf(b_last + m_prev - m_new);
            m_prev = m_new;
        }
    };
    prefetch(0);
    prefetch_g(0);
    scalars(0);
    for (int st = 0; st < 132; ++st) {
        const int cid = scan_chunk(b, d, st);
        const bool emit = cid < NCHL;
        int tl = tid, zoff = 0;
        asm volatile("" : "+v"(tl), "+v"(zoff));
        const int tid = tl, lane = tid & 63, w = tid >> 6, cg = w & 3, kh = w >> 2, g4 = lane >> 4, l15 = lane & 15, c16 = tid & 63, srow0 = tid >> 6;
        MS_REGIONS(lds + zoff)
        MS_SC(st & 1)
        unsigned long long pt0 = 0; if (PROF_SEC >= 0) pt0 = __builtin_amdgcn_s_memtime();
        __syncthreads();
        if (PROF_SEC == 3) prof_acc += __builtin_amdgcn_s_memtime() - pt0;
        if (PROF_SEC >= 0) pt0 = __builtin_amdgcn_s_memtime();
        {
            lds_t xw_ = xct + srow0 * MS_KLD + c16 * 16;
            lds_t qw_ = qpt + srow0 * MS_QLD + c16 * 16;
#pragma unroll
            for (int i = 0; i < 8; ++i) {
                const unsigned xw[4] = {xcr[i].x, xcr[i].y, xcr[i].z, xcr[i].w};
                float q[8];
#pragma unroll
                for (int n = 0; n < 2; ++n)
#pragma unroll
                    for (int o = 0; o < 4; ++o)
                        q[4 * n + o] = __builtin_amdgcn_fdot2_f32_bf16(__builtin_bit_cast(bf16x2_t, xw[2 * n + 1]), Mp[n][o][1], __builtin_amdgcn_fdot2_f32_bf16(__builtin_bit_cast(bf16x2_t, xw[2 * n]), Mp[n][o][0], 0.f, false), false);
                u32x4 qv; qv.x = pk2(q[0], q[1]); qv.y = pk2(q[2], q[3]); qv.z = pk2(q[4], q[5]); qv.w = pk2(q[6], q[7]);
                *(LAS u32x4*)(xw_ + i * 8 * MS_KLD) = xcr[i];
                *(LAS u32x4*)(qw_ + i * 8 * MS_QLD) = qv;
            }
        }
        {
            const int t = tid >> 3, s8 = (tid & 7) * 8;
            *(LAS u32x4*)(vt + t * 64 + s8) = vr;
            {
                const float ww = sc_w[t];
                u32x4 o; o.x = pk2(lo_bf(vr.x) * ww, hi_bf(vr.x) * ww); o.y = pk2(lo_bf(vr.y) * ww, hi_bf(vr.y) * ww); o.z = pk2(lo_bf(vr.z) * ww, hi_bf(vr.z) * ww); o.w = pk2(lo_bf(vr.w) * ww, hi_bf(vr.w) * ww);
                *(LAS u32x4*)(vwt + t * 64 + s8) = o;
            }
            if (emit) {
                const unsigned rwv[4] = {rr.x, rr.y, rr.z, rr.w};
                const float base = sc_b[t] - sc_m[t];
                const f32x4 e0 = *(const LAS f32x4*)(sc_e + s8), e1 = *(const LAS f32x4*)(sc_e + s8 + 4);
                float sv[8]; float rsum = 0.f;
#pragma unroll
                for (int j = 0; j < 8; ++j) {
                    const int s_ = s8 + j;
                    const float raw = (j & 1) ? hi_bf(rwv[j >> 1]) : lo_bf(rwv[j >> 1]);
                    const bool keep = d == 0 ? s_ <= t : s_ >= t;
                    const float ex = __expf(base + (j < 4 ? e0[j & 3] : e1[j & 3]));
                    sv[j] = keep ? raw * ex : 0.f;
                    rsum += sv[j];
                }
                u32x4 o; o.x = pk2(sv[0], sv[1]); o.y = pk2(sv[2], sv[3]); o.z = pk2(sv[4], sv[5]); o.w = pk2(sv[6], sv[7]);
                *(LAS u32x4*)(St + t * 64 + s8) = o;
                rsum += __shfl_xor(rsum, 1); rsum += __shfl_xor(rsum, 2); rsum += __shfl_xor(rsum, 4);
                if ((tid & 7) == 0) sc_rs[t] = rsum;
            }
        }
        if (PROF_SEC == 0) prof_acc += __builtin_amdgcn_s_memtime() - pt0;
        if (PROF_SEC >= 0) pt0 = __builtin_amdgcn_s_memtime();
        __syncthreads();
        const int kq = w >> 1, cgp = w & 1;
        const int kq_s = __builtin_amdgcn_readfirstlane(kq), cgp_s = __builtin_amdgcn_readfirstlane(cgp);
        f32x4 acc2[4][2], accq[4];
#pragma unroll
        for (int tt = 0; tt < 4; ++tt) { acc2[tt][0] = (f32x4){0.f, 0.f, 0.f, 0.f}; acc2[tt][1] = acc2[tt][0]; accq[tt] = acc2[tt][0]; }
        if (emit) {
            lds_t qa = qpt + l15 * MS_QLD + (kq * 128 + 4 * g4) * 2;
#pragma unroll
            for (int m = 0; m < 4; ++m) {
                u32x2 qb[1][4][2];
#pragma unroll
                for (int tt = 0; tt < 4; ++tt) { qb[0][tt][0] = *(const LAS u32x2*)(qa + tt * 16 * MS_QLD + m * 64); qb[0][tt][1] = *(const LAS u32x2*)(qa + tt * 16 * MS_QLD + m * 64 + 32); }
                bf16x8 cf[2];
#pragma unroll
                for (int dvt = 0; dvt < 2; ++dvt) {
                    const f32x4 c0 = C[(2 * m) * 2 + dvt], c1 = C[(2 * m + 1) * 2 + dvt];
                    u32x4 cb; cb.x = pk2(c0[0], c0[1]); cb.y = pk2(c0[2], c0[3]); cb.z = pk2(c1[0], c1[1]); cb.w = pk2(c1[2], c1[3]);
                    cf[dvt] = __builtin_bit_cast(bf16x8, cb);
                }
                const bool own = (m >> 1) == cgp_s;
                bf16x8 nf = cf[0];
                if (own) { const int pi = (m & 1) * 2; u32x4 nb; nb.x = pk2(Nacc[pi][0], Nacc[pi][1]); nb.y = pk2(Nacc[pi][2], Nacc[pi][3]); nb.z = pk2(Nacc[pi + 1][0], Nacc[pi + 1][1]); nb.w = pk2(Nacc[pi + 1][2], Nacc[pi + 1][3]); nf = __builtin_bit_cast(bf16x8, nb); }
#pragma unroll
                for (int tt = 0; tt < 4; ++tt) {
                    u32x4 av; av.x = qb[0][tt][0].x; av.y = qb[0][tt][0].y; av.z = qb[0][tt][1].x; av.w = qb[0][tt][1].y;
                    const bf16x8 qf = __builtin_bit_cast(bf16x8, av);
                    acc2[tt][0] = mfma16(cf[0], qf, acc2[tt][0]);
                    acc2[tt][1] = mfma16(cf[1], qf, acc2[tt][1]);
                    if (own) accq[tt] = mfma16(nf, qf, accq[tt]);
                }
            }
#pragma unroll
            for (int tt = 0; tt < 4; ++tt) { const float dd = sc_di[tt * 16 + l15]; acc2[tt][0] = acc2[tt][0] * dd; acc2[tt][1] = acc2[tt][1] * dd; }
            if (kq_s < 2) {
                const bf16x8 vf0 = frag_tr(vt, 64, kq * 32, cgp * 32, lane), vf1 = frag_tr(vt, 64, kq * 32, cgp * 32 + 16, lane);
#pragma unroll
                for (int tt = 0; tt < 4; ++tt) {
                    const bf16x8 sf = frag_row(St, 64, tt * 16, kq * 32, lane);
                    acc2[tt][0] = mfma16(vf0, sf, acc2[tt][0]);
                    acc2[tt][1] = mfma16(vf1, sf, acc2[tt][1]);
                }
            }
            if (g4 == 0) {
#pragma unroll
                for (int tt = 0; tt < 4; ++tt) __hip_atomic_fetch_add((float*)(qn + tt * 16 + l15), accq[tt][0], __ATOMIC_RELAXED, __HIP_MEMORY_SCOPE_WORKGROUP);
            }
        }
        if (st + 1 < 132) prefetch_g(st + 1);
        {
            const float gd = sc_misc[0];
            bf16x8 vb[2][2], wf[2];
#pragma unroll
            for (int ks = 0; ks < 2; ++ks) {
                vb[0][ks] = frag_tr_swp(vwt, 64, ks * 32, cgp * 32, lane);
                vb[1][ks] = frag_tr_swp(vwt, 64, ks * 32, cgp * 32 + 16, lane);
                const int sw = (g4 & 1) * 4;
                const f32x4 w0 = *(const LAS f32x4*)(sc_w + ks * 32 + 8 * g4 + sw), w1 = *(const LAS f32x4*)(sc_w + ks * 32 + 8 * g4 + 4 - sw);
                u32x4 wp; wp.x = pk2(w0[0], w0[1]); wp.y = pk2(w0[2], w0[3]); wp.z = pk2(w1[0], w1[1]); wp.w = pk2(w1[2], w1[3]);
                if (l15 != 0) wp = (u32x4){0u, 0u, 0u, 0u};
                wf[ks] = __builtin_bit_cast(bf16x8, wp);
            }
#pragma unroll
            for (int j = 0; j < 4; ++j) Nacc[j] = Nacc[j] * gd;
            const int swk = (g4 & 1) * 4;
            lds_t ka = xct + (8 * g4 + (l15 >> 2) + swk) * MS_KLD + (kq * 128 + 4 * (l15 & 3)) * 2;
            const int hio = (4 - 2 * swk) * MS_KLD;
            s16x4 kb[2][2][2];
#pragma unroll
            for (int ks = 0; ks < 2; ++ks) {
                kb[0][ks][0] = __builtin_amdgcn_ds_read_tr16_b64_v4i16((LAS s16x4*)(ka + ks * 32 * MS_KLD));
                kb[0][ks][1] = __builtin_amdgcn_ds_read_tr16_b64_v4i16((LAS s16x4*)(ka + ks * 32 * MS_KLD + hio));
            }
#pragma unroll
            for (int i = 0; i < 8; ++i) {
                if (i + 1 < 8) {
#pragma unroll
                    for (int ks = 0; ks < 2; ++ks) {
                        kb[(i + 1) & 1][ks][0] = __builtin_amdgcn_ds_read_tr16_b64_v4i16((LAS s16x4*)(ka + ks * 32 * MS_KLD + (i + 1) * 32));
                        kb[(i + 1) & 1][ks][1] = __builtin_amdgcn_ds_read_tr16_b64_v4i16((LAS s16x4*)(ka + ks * 32 * MS_KLD + hio + (i + 1) * 32));
                    }
                }
                C[2 * i] = C[2 * i] * gd; C[2 * i + 1] = C[2 * i + 1] * gd;
                const bool own = (i >> 2) == cgp_s;
#pragma unroll
                for (int ks = 0; ks < 2; ++ks) {
                    const bf16x8 kf = __builtin_shufflevector(kb[i & 1][ks][0], kb[i & 1][ks][1], 0, 1, 2, 3, 4, 5, 6, 7);
                    C[2 * i] = mfma16(kf, vb[0][ks], C[2 * i]);
                    C[2 * i + 1] = mfma16(kf, vb[1][ks], C[2 * i + 1]);
                    if (own) Nacc[i & 3] = mfma16(kf, wf[ks], Nacc[i & 3]);
                }
            }
        }
        if (st + 1 < 132) prefetch(st + 1);
        if (PROF_SEC == 1) prof_acc += __builtin_amdgcn_s_memtime() - pt0;
        if (PROF_SEC >= 0) pt0 = __builtin_amdgcn_s_memtime();
        __syncthreads();
        if (emit) {
#pragma unroll
            for (int tt = 0; tt < 4; ++tt)
                if (tt != kq_s) {
                    u32x2 r0_, r1_; r0_.x = pk2(acc2[tt][0][0], acc2[tt][0][1]); r0_.y = pk2(acc2[tt][0][2], acc2[tt][0][3]); r1_.x = pk2(acc2[tt][1][0], acc2[tt][1][1]); r1_.y = pk2(acc2[tt][1][2], acc2[tt][1][3]);
                    *(LAS u32x2*)(red + ((((tt * 4 + kq) * 2 + cgp) * 2 + 0) * 64 + lane) * 2) = r0_;
                    *(LAS u32x2*)(red + ((((tt * 4 + kq) * 2 + cgp) * 2 + 1) * 64 + lane) * 2) = r1_;
                }
        }
        if (st + 1 < 132) scalars((st + 1) & 1);
        __syncthreads();
        if (emit) {
            f32x4 o0, o1;
            if (kq_s == 0) { o0 = acc2[0][0]; o1 = acc2[0][1]; } else if (kq_s == 1) { o0 = acc2[1][0]; o1 = acc2[1][1]; } else if (kq_s == 2) { o0 = acc2[2][0]; o1 = acc2[2][1]; } else { o0 = acc2[3][0]; o1 = acc2[3][1]; }
#pragma unroll
            for (int src = 0; src < 4; ++src)
                if (src != kq_s) {
                    const u32x2 r0_ = *(const LAS u32x2*)(red + ((((kq * 4 + src) * 2 + cgp) * 2 + 0) * 64 + lane) * 2), r1_ = *(const LAS u32x2*)(red + ((((kq * 4 + src) * 2 + cgp) * 2 + 1) * 64 + lane) * 2);
                    o0 = o0 + (f32x4){lo_bf(r0_.x), hi_bf(r0_.x), lo_bf(r0_.y), hi_bf(r0_.y)};
                    o1 = o1 + (f32x4){lo_bf(r1_.x), hi_bf(r1_.x), lo_bf(r1_.y), hi_bf(r1_.y)};
                }
            const int t = kq * 16 + l15;
            const float rdn = rcpf_(fmaxf(fabsf(sc_di[t] * qn[t] + sc_rs[t]), __expf(-sc_m[t])));
            bf16_t* hp = H + (size_t)(cid * 64 + t) * 2048 + h * 512 + sl * 64 + cgp * 32 + 4 * g4;
            store_bf16x4(hp, o0 * rdn);
            store_bf16x4(hp + 16, o1 * rdn);
        }
        if (PROF_SEC == 2) prof_acc += __builtin_amdgcn_s_memtime() - pt0;
    }
    if (PROF_SEC >= 0 && bid == 0) { const unsigned long long t0_ = __builtin_amdgcn_s_memtime(); while (__builtin_amdgcn_s_memtime() - t0_ < 4 * prof_acc) __builtin_amdgcn_s_sleep(8); }
}

DI void phase_merge(PP p, bool shadow = false) {
    const int tid = get_tid(), lane = tid & 63;
    const bf16_t* HF = (const bf16_t*)p->out;
    bf16_t* HB = (bf16_t*)(p->ws + OFF_ARENA + A_HB);
    const bf16_t* XC = (const bf16_t*)(p->ws + OFF_ARENA + A_XC);
    const bf16_t* Z = (const bf16_t*)(p->ws + OFF_ARENA + A_XM);
    const int gw = get_bid() * 8 + (tid >> 6), nw = gridDim.x * 8;
    f32x4 ng[4][2], sk[4][2];
#pragma unroll
    for (int hh = 0; hh < 4; ++hh) {
        const int c = hh * 512 + lane * 8;
        ng[hh][0] = *(const f32x4*)(p->m_norm_g + c); ng[hh][1] = *(const f32x4*)(p->m_norm_g + c + 4);
        sk[hh][0] = *(const f32x4*)(p->m_skip + c); sk[hh][1] = *(const f32x4*)(p->m_skip + c + 4);
    }
    for (int r = gw; r < NLAT; r += nw) {
        u32x4 av[4], bv[4], xv[4], zv[4];
#pragma unroll
        for (int hh = 0; hh < 4; ++hh) {
            const size_t o = (size_t)r * 2048 + hh * 512 + lane * 8;
            av[hh] = *(const u32x4*)(HF + o); bv[hh] = *(const u32x4*)(HB + o); xv[hh] = *(const u32x4*)(XC + o); zv[hh] = *(const u32x4*)(Z + o);
        }
#pragma unroll
        for (int hh = 0; hh < 4; ++hh) {
            const size_t o = (size_t)r * 2048 + hh * 512 + lane * 8;
            const unsigned aw[4] = {av[hh].x, av[hh].y, av[hh].z, av[hh].w}, bw[4] = {bv[hh].x, bv[hh].y, bv[hh].z, bv[hh].w};
            const unsigned xw[4] = {xv[hh].x, xv[hh].y, xv[hh].z, xv[hh].w}, zw[4] = {zv[hh].x, zv[hh].y, zv[hh].z, zv[hh].w};
            float hv[8]; float sum = 0.f;
#pragma unroll
            for (int j = 0; j < 4; ++j) { hv[2 * j] = lo_bf(aw[j]) + lo_bf(bw[j]); hv[2 * j + 1] = hi_bf(aw[j]) + hi_bf(bw[j]); sum += hv[2 * j] + hv[2 * j + 1]; }
            const float mean = wave_sum(sum) * (1.f / 512.f);
            float sq = 0.f;
#pragma unroll
            for (int j = 0; j < 8; ++j) { hv[j] -= mean; sq += hv[j] * hv[j]; }
            const float rs = rsqrtf(wave_sum(sq) * (1.f / 512.f) + EPS);
            const f32x4 g0 = ng[hh][0], g1 = ng[hh][1], k0 = sk[hh][0], k1 = sk[hh][1];
            float ov[8];
#pragma unroll
            for (int j = 0; j < 8; ++j) {
                const float xcv = (j & 1) ? hi_bf(xw[j >> 1]) : lo_bf(xw[j >> 1]);
                const float zval = (j & 1) ? hi_bf(zw[j >> 1]) : lo_bf(zw[j >> 1]);
                const float gg = j < 4 ? g0[j & 3] : g1[j & 3], kk = j < 4 ? k0[j & 3] : k1[j & 3];
                ov[j] = (hv[j] * rs * gg + kk * xcv) * siluf_(zval);
            }
            u32x4 v; v.x = pk2(ov[0], ov[1]); v.y = pk2(ov[2], ov[3]); v.z = pk2(ov[4], ov[5]); v.w = pk2(ov[6], ov[7]);
            if (!shadow) *(u32x4*)(HB + o) = v;
        }
    }
}

DI void phase_downproj(PP p, lds_t lds) {
    const bf16_t* A = (const bf16_t*)(p->ws + OFF_ARENA + A_HB);
    float* X = (float*)(p->ws + OFF_ARENA + A_X);
    constexpr int NM = NLAT / 256, NN = 4;
    gemm_multi<64, false>(lds, 2048, 1, NM, NN, 8, 4,
        [&](const U3& u, int r) { return A + (size_t)(u.m * 256 + r) * 2048; },
        [&](const U3& u) { return (const bf16_t*)(p->ws + OFF_WDNT) + (size_t)(u.n * 256) * 2048; },
        [&](const U3& u, const f32x4 (&acc)[8][4], int wr, int wc, int lane) {
            const float* g1 = mods_ptr(p, 1, u.m >> 5, 2);
            epi_each<4>(acc, wr, wc, lane, [&](int r, int c, f32x4 v) {
                const int col = u.n * 256 + c;
                float* xp = X + (size_t)(u.m * 256 + r) * 1024 + col;
                const f32x4 g = *(const f32x4*)(g1 + col);
                *(f32x4*)xp = *(const f32x4*)xp + g * v;
            });
        });
}

DI void phase_dbg_final(PP p, int mode) {
    const int tid = get_tid(), lane = tid & 63;
    const int gw = get_bid() * 8 + (tid >> 6), nw = gridDim.x * 8;
    if (mode == 4) {
        const int* rid = (const int*)(p->ws + OFF_ARENA + A_ROWID);
        for (int r = gw; r < NLAT; r += nw)
            for (int c = lane; c < 1024; c += 64) p->out[(size_t)r * 1024 + c] = (float)rid[(size_t)r * 16 + (c & 15)];
        return;
    }
    if (mode == 7) {
        const bf16_t* y = (const bf16_t*)(p->ws + OFF_ARENA + A_Y);
        for (int r = gw; r < NLAT; r += nw)
            for (int c = lane; c < 1024; c += 64) { const float v = bf2f(y[(size_t)r * 1024 + c]); p->out[(size_t)r * 1024 + c] = (v == v && fabsf(v) < 1e30f) ? 0.f : 1000.f; }
        return;
    }
    if (mode >= 2) {
        const bf16_t* src = mode == 2 ? (const bf16_t*)(p->ws + OFF_ARENA + A_P) : mode == 5 ? (const bf16_t*)(p->ws + OFF_ARENA + A_HDN) : mode == 6 ? (const bf16_t*)(p->ws + OFF_ARENA + A_Y) : (const bf16_t*)(p->ws + OFF_ACT);
        const int ld = mode == 2 ? ABIN : 1024;
        for (int r = gw; r < NLAT; r += nw)
            for (int c = lane; c < 1024; c += 64) p->out[(size_t)r * 1024 + c] = bf2f(src[(size_t)r * ld + (mode == 2 ? c + DBG_COL0 : c)]);
        return;
    }
    const float* X = mode ? (const float*)(p->ws + OFF_ARENA + A_X) : p->x;
    for (int r = gw; r < NLAT; r += nw) {
        f32x4 v[4];
        row_load_f32(X + (size_t)r * 1024, v, lane);
        const float rs = rsqrtf(row_sumsq(v) * (1.f / 1024.f) + EPS);
#pragma unroll
        for (int i = 0; i < 4; ++i) { const f32x4 g = *(const f32x4*)(p->final_g + rcol(lane, i)); *(f32x4*)(p->out + (size_t)r * 1024 + rcol(lane, i)) = v[i] * rs * g; }
    }
}

constexpr int XB_XCNT = 256, XB_XSUB = 1280, XB_XGEN = 2304, XB_TOP = 3328, XB_TOPGEN = 3392, XB_WORDS = 3456;
DI unsigned xb_ld(unsigned* q) { return __hip_atomic_load(q, __ATOMIC_RELAXED, __HIP_MEMORY_SCOPE_AGENT); }
DI unsigned xb_add(unsigned* q, unsigned v) { return __hip_atomic_fetch_add(q, v, __ATOMIC_RELAXED, __HIP_MEMORY_SCOPE_AGENT); }
DI unsigned xb_xcc_id() { return (unsigned)__builtin_amdgcn_s_getreg((3 << 11) | 20) & 0xFu; }
DI void grid_barrier_post(PP p) { if (threadIdx.x == 0) (void)xb_add((unsigned*)(p->ws + OFF_BAR) + XB_XCNT + 64 * xb_xcc_id(), 1u); }
DI void grid_barrier(PP p, unsigned& nbar, unsigned& cfg) {
    asm volatile("s_waitcnt vmcnt(0) lgkmcnt(0)" ::: "memory");
    __syncthreads();
    if (cfg == 0u) {
        unsigned cnew = 0u;
        if (threadIdx.x == 0) {
            unsigned* bar = (unsigned*)(p->ws + OFF_BAR);
            const unsigned x = xb_xcc_id();
            unsigned sum, cnt, mine;
            for (;;) {
                sum = 0u; cnt = 0u; mine = 0u;
#pragma unroll
                for (unsigned j = 0; j < 16; ++j) { const unsigned c = xb_ld(bar + XB_XCNT + 64 * j); sum += c; cnt += c > 0u ? 1u : 0u; mine = j == x ? c : mine; }
                if (sum == gridDim.x) break;
                __builtin_amdgcn_s_sleep(1);
            }
            cnew = mine | (cnt << 16);
        }
        cfg = (unsigned)__builtin_amdgcn_readfirstlane((int)cnew);
    }
    if (threadIdx.x == 0) {
        unsigned* bar = (unsigned*)(p->ws + OFF_BAR);
        const unsigned x = xb_xcc_id();
        const unsigned nloc = cfg & 0xffffu, nx = cfg >> 16;
        const unsigned old = xb_add(bar + XB_XSUB + 64 * x, 1u);
        if (old + 1u == (nbar + 1u) * nloc) {
            __builtin_amdgcn_fence(__ATOMIC_RELEASE, "agent");
            asm volatile("s_waitcnt vmcnt(0)" ::: "memory");
            const unsigned og = xb_add(bar + XB_TOP, 1u);
            if (og + 1u == (nbar + 1u) * nx) xb_add(bar + XB_TOPGEN, 1u);
            else while (xb_ld(bar + XB_TOPGEN) == nbar) __builtin_amdgcn_s_sleep(1);
            __builtin_amdgcn_fence(__ATOMIC_ACQUIRE, "agent");
            xb_add(bar + XB_XGEN + 64 * x, 1u);
            asm volatile("s_waitcnt vmcnt(0)" ::: "memory");
        } else {
            while (xb_ld(bar + XB_XGEN + 64 * x) == nbar) __builtin_amdgcn_s_sleep(1);
            __builtin_amdgcn_fence(__ATOMIC_ACQUIRE, "agent");
            asm volatile("s_waitcnt vmcnt(0)" ::: "memory");
        }
    }
    __syncthreads();
    ++nbar;
}
#define RUN_PHASE(K, CALL) if (ph_lo <= (K) && (K) < ph_hi && ((K) <= DBG_STOP)) { PP p = kp; asm volatile("" : "+s"(p)); CALL; if ((DUP_MASK >> (K)) & 1) { grid_barrier(p, nbar, bcfg); asm volatile("" : "+s"(p)); CALL; } if ((K) + 1 < ph_hi) { grid_barrier(p, nbar, bcfg); if (EXTRA_BARRIERS) grid_barrier(p, nbar, bcfg); } }
__global__ void __launch_bounds__(NTHREADS) mega(Params p_in) {
    extern __shared__ __attribute__((aligned(16))) unsigned char lds_raw[];
    lds_t lds = (lds_t)lds_raw;
    PP kp = (PP)__builtin_amdgcn_kernarg_segment_ptr();
    const int ph_lo = kp->ph_lo, ph_hi = kp->ph_hi;
    unsigned nbar = 0, bcfg = 0;
    grid_barrier_post(kp);
    RUN_PHASE(0, phase_mods(p, lds))
    RUN_PHASE(1, phase_norm(p, 0, NTOK, [&](int r) { return r < NLAT ? p->x + (size_t)r * 1024 : p->ctx + (size_t)(r - NLAT) * 1024; }))
    RUN_PHASE(2, phase_inproj(p, lds))
    RUN_PHASE(3, phase_g1(p, lds))
    RUN_PHASE(4, phase_scan0(p))
    RUN_PHASE(5, phase_g3(p, lds))
    RUN_PHASE(6, phase_outproj0(p, lds))
    RUN_PHASE(7, phase_router(p, lds, 0))
    RUN_PHASE(8, phase_topk(p, lds, 0))
    RUN_PHASE(9, phase_moe_up(p, lds, 0))
    RUN_PHASE(10, phase_moe_down(p, lds, 0))
    RUN_PHASE(11, phase_combine(p, 0))
    RUN_PHASE(12, phase_upproj(p, lds, 0))
#if SHADOW_PH == 13
    if (ph_lo <= 13 && 13 < ph_hi) { PP p = kp; asm volatile("" : "+s"(p)); phase_mfeat(p, lds, true); grid_barrier(p, nbar, bcfg); }
#endif
    RUN_PHASE(13, phase_mfeat(p, lds))
    RUN_PHASE(14, phase_mscan(p, lds))
    RUN_PHASE(15, phase_norm(p, 1, NLAT, [&](int r) { return (const float*)(p->ws + OFF_ARENA + A_X) + (size_t)r * 1024; }))
    RUN_PHASE(16, phase_upproj(p, lds, 1))
#if SHADOW_PH == 17
    if (ph_lo <= 17 && 17 < ph_hi) { PP p = kp; asm volatile("" : "+s"(p)); phase_merge(p, true); grid_barrier(p, nbar, bcfg); }
#endif
    RUN_PHASE(17, phase_merge(p))
    RUN_PHASE(18, phase_downproj(p, lds))
    RUN_PHASE(19, phase_router(p, lds, 1))
    RUN_PHASE(20, phase_topk(p, lds, 1))
    RUN_PHASE(21, phase_moe_up(p, lds, 1))
#if GEMM_PROBE >= 0
    if (ph_lo <= 22 && 22 < ph_hi) { PP p = kp; asm volatile("" : "+s"(p)); phase_moe_down_t<GEMM_PROBE>(p, lds, 1); grid_barrier(p, nbar, bcfg); }
#endif
    RUN_PHASE(22, phase_moe_down(p, lds, 1))
    RUN_PHASE(23, phase_combine(p, 1))
    if (DBG_STOP < 23 && DBG_STOP + 1 < ph_hi) { PP p = kp; asm volatile("" : "+s"(p)); phase_dbg_final(p, DBG_MODE); }
}

extern "C" void kernel_launch(void* const* d_in, const int* in_sizes, int n_in, void* d_out, int out_size, void* d_ws, size_t ws_size, hipStream_t stream) {
    static int grid = 0;
    if (grid == 0) {
        int dev = 0, cus = 0, per_cu = 0;
        hipGetDevice(&dev);
        hipDeviceGetAttribute(&cus, hipDeviceAttributeMultiprocessorCount, dev);
        hipFuncSetAttribute((const void*)mega, hipFuncAttributeMaxDynamicSharedMemorySize, LDS_BYTES);
        hipOccupancyMaxActiveBlocksPerMultiprocessor(&per_cu, (const void*)mega, NTHREADS, LDS_BYTES);
        if (per_cu < 1) { fprintf(stderr, "occupancy query says %d blocks/CU\n", per_cu); per_cu = 1; }
        grid = cus;
        if (ws_size < WS_NEED) { fprintf(stderr, "workspace too small: %zu < %zu\n", ws_size, (size_t)WS_NEED); grid = -1; }
    }
    if (grid < 0) return;
    Params hp{};
    const float** pp = (const float**)&hp;
    for (int i = 0; i < 36; ++i) pp[i] = (const float*)d_in[i];
    hp.out = (float*)d_out; hp.ws = (char*)d_ws; hp.ph_lo = 0; hp.ph_hi = DBG_STOP < 23 ? DBG_STOP + 2 : 24;
    hipMemsetAsync((char*)d_ws + OFF_BAR, 0, XB_WORDS * sizeof(unsigned), stream);
    void* args[] = {&hp};
    hipError_t e = hipLaunchCooperativeKernel((const void*)mega, dim3(grid), dim3(NTHREADS), args, LDS_BYTES, stream);
    if (e != hipSuccess) fprintf(stderr, "cooperative launch failed: %s\n", hipGetErrorString(e));
}
```

```cpp
#include <hip/hip_runtime.h>
#include <hip/hip_cooperative_groups.h>
#include <cstdio>
#include <cstdint>
namespace cg = cooperative_groups;

#define LAS __attribute__((address_space(3)))
#define DI __device__ __forceinline__
typedef unsigned short bf16_t;
typedef short bf16x8 __attribute__((ext_vector_type(8)));
typedef short s16x4 __attribute__((ext_vector_type(4)));
typedef float f32x4 __attribute__((ext_vector_type(4)));
typedef float f32x2 __attribute__((ext_vector_type(2)));
typedef unsigned u32x4 __attribute__((ext_vector_type(4)));
typedef unsigned u32x2 __attribute__((ext_vector_type(2)));
typedef LAS char* lds_t;

constexpr int D = 1024, NBATCH = 4, SEQ = 8192, CTXL = 256;
constexpr int NLAT = NBATCH * SEQ;
constexpr int NCTX = NBATCH * CTXL;
constexpr int NTOK = NLAT + NCTX;
constexpr int NCH = NTOK / 64;
constexpr int NCHL = NLAT / 64;
constexpr int ABIN = 2592;
constexpr int PC_Q = 0, PC_K = 256, PC_V = 512, PC_G = 1024, PC_LRF = 1536, PC_LRB = 1552, PC_RGG = 1568, PC_RGX = 2080;
constexpr float EPS = 1e-6f;
constexpr int NTHREADS = 512;
constexpr int LDS_BYTES = 160 * 1024;
#define DBG_MODE 1
#ifndef DUP_MASK
#define DUP_MASK 0
#endif
#ifndef SHADOW_PH
#define SHADOW_PH -1
#endif
#ifndef PROF_SEC
#define PROF_SEC -1
#endif
#ifndef GEMM_PROBE
#define GEMM_PROBE -1
#endif
#ifndef EXTRA_BARRIERS
#define EXTRA_BARRIERS 0
#endif
#define DBG_STOP 23
#define DBG_COL0 0

constexpr size_t OFF_MODS = 0;
constexpr size_t OFF_GCAT = 245760;
constexpr size_t OFF_MMAT = 376832;
constexpr size_t OFF_BAR = 409600;
constexpr size_t OFF_ZROW = 413696;
constexpr size_t OFF_ACT = 1u << 20;
constexpr size_t ACT_BYTES = (size_t)NTOK * 1024 * 2;
constexpr size_t OFF_ARENA = OFF_ACT + ACT_BYTES;
constexpr size_t A_P = 0;
constexpr size_t A_U = A_P + (size_t)NTOK * ABIN * 2;
constexpr size_t A_LA = A_U + (size_t)NCH * 2 * 4 * 8192 * 4;
constexpr size_t A_UU = A_LA + (size_t)NTOK * 2 * 512 * 4;
constexpr size_t A_DEC = A_UU + (size_t)NTOK * 2 * 512 * 2;
constexpr size_t A_AGGA = A_DEC + (size_t)NCH * 2 * 256 * 4;
constexpr size_t A_AGGH = A_AGGA + (size_t)NCH * 2 * 512 * 4;
constexpr size_t A_L0_END = A_AGGH + (size_t)NCH * 2 * 512 * 4;
constexpr size_t A_X = 0;
constexpr size_t A_PT = A_X + (size_t)NTOK * 1024 * 4;
constexpr size_t A_PE = A_PT + (size_t)NTOK * 16 * 4;
constexpr size_t A_ROWID = A_PE + (size_t)NTOK * 16 * 4;
constexpr size_t A_ROWTOK = A_ROWID + (size_t)NTOK * 16 * 4;
constexpr size_t A_HDN = A_ROWTOK + (size_t)16 * 4352 * 4;
constexpr size_t A_Y = A_HDN + (size_t)16 * 4352 * 1024 * 2;
constexpr size_t A_MOE0_END = A_Y + (size_t)16 * 4352 * 1024 * 2;
constexpr size_t A_XM = A_X + (size_t)NTOK * 1024 * 4;
constexpr size_t A_XC = A_XM + (size_t)NTOK * 2048 * 2;
constexpr size_t A_HB = A_XC + (size_t)NTOK * 2048 * 2;
constexpr size_t A_L1_END = A_HB + (size_t)NLAT * 2048 * 2;
constexpr size_t OFF_SCR = OFF_ARENA + A_X + (size_t)NTOK * 1024 * 2;
constexpr size_t ACT_RAWS = 0;
constexpr size_t ACT_GP = ACT_RAWS + (size_t)NCH * 4 * 4096 * 2;
constexpr size_t ACT_CTXV = ACT_GP + (size_t)NTOK * 64 * 4;
constexpr size_t WS_NEED0 = OFF_ARENA + (A_L1_END > A_L0_END ? A_L1_END : A_L0_END);
constexpr size_t OFF_WUPT = WS_NEED0;
constexpr size_t OFF_WDNT = OFF_WUPT + (size_t)4096 * 1024 * 2;
constexpr size_t WS_NEED = OFF_WDNT + (size_t)1024 * 2048 * 2;
constexpr size_t DO_WIN = 0;
constexpr size_t DO_WOUT = (size_t)2816 * 1024 * 2;
constexpr size_t DO_EXP = 8u << 20;
constexpr size_t EXP_STRIDE = (size_t)3072 * 1024 * 2;
constexpr int GUG = 32;
static_assert(DO_EXP + 16 * EXP_STRIDE <= (size_t)NLAT * 1024 * 4, "d_out staging");
static_assert(A_MOE0_END < A_L1_END, "arena");
static_assert(ACT_CTXV + (size_t)NCTX * 2048 * 2 <= ACT_BYTES, "act region");

struct Params {
    const float *x, *c, *ctx, *c_ctx, *mod_w, *mod_b, *norm1_g, *norm2_g, *ab_w_in, *gla_wa2, *gla_ba, *gla_norm_g;
    const float *rg_conv_w, *rg_conv_b, *rg_wr, *rg_br, *rg_wi, *rg_bi, *rg_lambda, *ab_w_out, *m_w_up, *m_conv_w, *m_conv_b;
    const float *m_wq, *m_wk, *m_wv, *m_w_gates, *m_b_gates, *m_skip, *m_norm_g, *m_w_down, *router_w, *exp_w_gate, *exp_w_up, *exp_w_down, *final_g;
    float* out;
    char* ws;
    int ph_lo, ph_hi;
};

typedef const Params __attribute__((address_space(4)))* PP;

DI int get_tid() { int t = threadIdx.x; asm volatile("" : "+v"(t)); return t; }
DI int get_bid() { int b = blockIdx.x; asm volatile("" : "+s"(b)); return b; }
DI float bf2f(bf16_t h) { return __uint_as_float((unsigned)h << 16); }
DI bf16_t f2bf(float x) { unsigned u = __float_as_uint(x); u += 0x7fffu + ((u >> 16) & 1u); return (bf16_t)(u >> 16); }
typedef __bf16 bf16x2_t __attribute__((ext_vector_type(2)));
DI unsigned pk2n(float lo, float hi) { const f32x2 v = {lo, hi}; return __builtin_bit_cast(unsigned, __builtin_convertvector(v, bf16x2_t)); }
DI unsigned pk2(float lo, float hi) { return pk2n(lo, hi); }
DI float lo_bf(unsigned u) { return __uint_as_float(u << 16); }
DI float hi_bf(unsigned u) { return __uint_as_float(u & 0xffff0000u); }
DI float rcpf_(float x) { return __builtin_amdgcn_rcpf(x); }
DI float sigmoidf_(float x) { return rcpf_(1.f + __expf(-x)); }
DI float siluf_(float x) { return x * rcpf_(1.f + __expf(-x)); }
DI float log_sigmoidf_(float z) { return fminf(z, 0.f) - __logf(1.f + __expf(-fabsf(z))); }
DI float softplusf_(float z) { return fmaxf(z, 0.f) + __logf(1.f + __expf(-fabsf(z))); }
DI float gelu_tanh(float x) { const float u = 0.7978845608028654f * (x + 0.044715f * x * x * x); return x * rcpf_(1.f + __expf(-2.f * u)); }
DI float wave_sum(float v) {
#pragma unroll
    for (int o = 32; o > 0; o >>= 1) v += __shfl_xor(v, o);
    return v;
}
DI f32x4 mfma16(bf16x8 a, bf16x8 b, f32x4 c) { return __builtin_amdgcn_mfma_f32_16x16x32_bf16(a, b, c, 0, 0, 0); }

DI bf16x8 frag_row(const LAS bf16_t* tile, int ld, int r0, int k0, int lane) {
    return *(const LAS bf16x8*)(tile + (r0 + (lane & 15)) * ld + k0 + 8 * (lane >> 4));
}
DI bf16x8 frag_tr(const LAS bf16_t* tile, int ld, int k0, int c0, int lane) {
    const int g = lane >> 4, i = lane & 15, q = i >> 2, p = i & 3;
    const LAS bf16_t* base = tile + (k0 + 8 * g + q) * ld + c0 + 4 * p;
    const s16x4 lo = __builtin_amdgcn_ds_read_tr16_b64_v4i16((LAS s16x4*)base);
    const s16x4 hi = __builtin_amdgcn_ds_read_tr16_b64_v4i16((LAS s16x4*)(base + 4 * ld));
    return __builtin_shufflevector(lo, hi, 0, 1, 2, 3, 4, 5, 6, 7);
}
DI bf16x8 frag_tr_swp(const LAS bf16_t* tile, int ld, int k0, int c0, int lane) {
    const int g = lane >> 4, i = lane & 15, q = i >> 2, p = i & 3, sw = (g & 1) * 4;
    const LAS bf16_t* base = tile + (k0 + 8 * g + q) * ld + c0 + 4 * p;
    const s16x4 lo = __builtin_amdgcn_ds_read_tr16_b64_v4i16((LAS s16x4*)(base + sw * ld));
    const s16x4 hi = __builtin_amdgcn_ds_read_tr16_b64_v4i16((LAS s16x4*)(base + (4 - sw) * ld));
    return __builtin_shufflevector(lo, hi, 0, 1, 2, 3, 4, 5, 6, 7);
}
DI const float* mods_ptr(PP p, int layer, int s, int which) { return (const float*)(p->ws + OFF_MODS) + ((size_t)(layer * 5 + s) * 6 + which) * 1024; }
DI int row_set(int r) { return r < NLAT ? (r >> 13) : 4; }

template <int BN, int BK, int PROBE = 0, class ARow, class BCol, class Epi>
DI void gemm_unit(lds_t lds, int K, int ldb, ARow arow, BCol bcol, Epi epi) {
    constexpr int NT = BN / 64;
    constexpr int LDA = BK + 8, LDB = BN + 16;
    constexpr int A_BYTES = 256 * LDA * 2, B_BYTES = BK * LDB * 2;
    static_assert(2 * A_BYTES + 2 * B_BYTES <= LDS_BYTES, "gemm lds");
    const int tid = get_tid(), lane = tid & 63, w = tid >> 6, wr = w >> 2, wc = w & 3;
    constexpr int ACH = BK / 8, ARP = NTHREADS / ACH, AP = 256 / ARP;
    const int achunk = tid % ACH, arow0 = tid / ACH;
    const bf16_t* ap[AP];
#pragma unroll
    for (int q = 0; q < AP; ++q) ap[q] = arow(arow0 + ARP * q);
    constexpr int CG = BN / 8, KR = NTHREADS / CG, BP = BK / KR;
    const int bc8 = tid % CG, bk0 = tid / CG;
    const float* bp = bcol(bc8 * 8);
    u32x4 areg[AP];
    f32x4 breg[BP][2];
    auto gload = [&](int kt) {
        const int k0 = kt * BK;
#pragma unroll
        for (int q = 0; q < AP; ++q) areg[q] = ap[q] ? *(const u32x4*)(ap[q] + k0 + achunk * 8) : (u32x4){0u, 0u, 0u, 0u};
#pragma unroll
        for (int q = 0; q < BP; ++q) {
            if (bp) { const float* s = bp + (size_t)(k0 + bk0 + KR * q) * ldb; breg[q][0] = *(const f32x4*)s; breg[q][1] = *(const f32x4*)(s + 4); }
            else { breg[q][0] = (f32x4){0.f, 0.f, 0.f, 0.f}; breg[q][1] = breg[q][0]; }
        }
    };
    auto lstore = [&](int buf) {
        LAS bf16_t* As = (LAS bf16_t*)(lds + buf * A_BYTES);
        LAS bf16_t* Bs = (LAS bf16_t*)(lds + 2 * A_BYTES + buf * B_BYTES);
#pragma unroll
        for (int q = 0; q < AP; ++q) *(LAS u32x4*)(As + (arow0 + ARP * q) * LDA + achunk * 8) = areg[q];
#pragma unroll
        for (int q = 0; q < BP; ++q) {
            u32x4 v; v.x = pk2(breg[q][0][0], breg[q][0][1]); v.y = pk2(breg[q][0][2], breg[q][0][3]); v.z = pk2(breg[q][1][0], breg[q][1][1]); v.w = pk2(breg[q][1][2], breg[q][1][3]);
            *(LAS u32x4*)(Bs + (bk0 + KR * q) * LDB + bc8 * 8) = v;
        }
    };
    f32x4 acc[8][NT];
#pragma unroll
    for (int mi = 0; mi < 8; ++mi)
#pragma unroll
        for (int ni = 0; ni < NT; ++ni) acc[mi][ni] = (f32x4){0.f, 0.f, 0.f, 0.f};
    const int nk = K / BK;
    gload(0);
    for (int kt = 0; kt < nk; ++kt) {
        lstore(kt & 1);
        __syncthreads();
        if (kt + 1 < nk && PROBE != 1) gload(kt + 1);
        if (PROBE == 2) continue;
        const LAS bf16_t* As = (const LAS bf16_t*)(lds + (kt & 1) * A_BYTES);
        const LAS bf16_t* Bs = (const LAS bf16_t*)(lds + 2 * A_BYTES + (kt & 1) * B_BYTES);
#pragma unroll
        for (int ks = 0; ks < BK / 32; ++ks) {
            bf16x8 wb[NT];
#pragma unroll
            for (int ni = 0; ni < NT; ++ni) wb[ni] = frag_tr(Bs, LDB, ks * 32, wc * (BN / 4) + ni * 16, lane);
#pragma unroll
            for (int mi = 0; mi < 8; ++mi) {
                const bf16x8 xa = frag_row(As, LDA, wr * 128 + mi * 16, ks * 32, lane);
#pragma unroll
                for (int ni = 0; ni < NT; ++ni) acc[mi][ni] = mfma16(wb[ni], xa, acc[mi][ni]);
            }
        }
    }
    epi(acc, wr, wc, lane);
    __syncthreads();
}


DI int perm32_(int rho) { const int n = rho >> 4, i = rho & 15; return 8 * (i >> 2) + 4 * n + (i & 3); }
template <int BK, bool PERM = false, class ARow, class BRow, class Epi>
DI void gemm_unit_t(lds_t lds, int K, ARow arow, BRow brow, Epi epi) {
    constexpr int NT = 4;
    constexpr int LD = BK + 8;
    constexpr int T_BYTES = 256 * LD * 2;
    static_assert(4 * T_BYTES <= LDS_BYTES, "gemm lds");
    const int tid = get_tid(), lane = tid & 63, w = tid >> 6, wr = w >> 2, wc = w & 3;
    constexpr int CH = BK / 8, RP = NTHREADS / CH, NP = 256 / RP;
    const int chunk = tid % CH, row0 = tid / CH;
    const bf16_t* ap[NP]; const bf16_t* bp[NP];
#pragma unroll
    for (int q = 0; q < NP; ++q) { const int rs_ = row0 + RP * q; ap[q] = arow(rs_); bp[q] = brow(PERM ? (rs_ & ~31) + perm32_(rs_ & 31) : rs_); }
    u32x4 areg[NP], breg[NP];
    auto gload = [&](int kt) {
        const int k0 = kt * BK;
#pragma unroll
        for (int q = 0; q < NP; ++q) {
            areg[q] = ap[q] ? *(const u32x4*)(ap[q] + k0 + chunk * 8) : (u32x4){0u, 0u, 0u, 0u};
            breg[q] = bp[q] ? *(const u32x4*)(bp[q] + k0 + chunk * 8) : (u32x4){0u, 0u, 0u, 0u};
        }
    };
    auto lstore = [&](int buf) {
        LAS bf16_t* As = (LAS bf16_t*)(lds + buf * 2 * T_BYTES);
        LAS bf16_t* Bs = (LAS bf16_t*)(lds + buf * 2 * T_BYTES + T_BYTES);
#pragma unroll
        for (int q = 0; q < NP; ++q) {
            *(LAS u32x4*)(As + (row0 + RP * q) * LD + chunk * 8) = areg[q];
            *(LAS u32x4*)(Bs + (row0 + RP * q) * LD + chunk * 8) = breg[q];
        }
    };
    f32x4 acc[8][NT];
#pragma unroll
    for (int mi = 0; mi < 8; ++mi)
#pragma unroll
        for (int ni = 0; ni < NT; ++ni) acc[mi][ni] = (f32x4){0.f, 0.f, 0.f, 0.f};
    const int nk = K / BK;
    gload(0);
    for (int kt = 0; kt < nk; ++kt) {
        lstore(kt & 1);
        __syncthreads();
        if (kt + 1 < nk) gload(kt + 1);
        const LAS bf16_t* As = (const LAS bf16_t*)(lds + (kt & 1) * 2 * T_BYTES);
        const LAS bf16_t* Bs = (const LAS bf16_t*)(lds + (kt & 1) * 2 * T_BYTES + T_BYTES);
#pragma unroll
        for (int ks = 0; ks < BK / 32; ++ks) {
            bf16x8 wb[NT], xa[8];
#pragma unroll
            for (int ni = 0; ni < NT; ++ni) wb[ni] = frag_row(Bs, LD, wc * 64 + ni * 16, ks * 32, lane);
#pragma unroll
            for (int mi = 0; mi < 8; ++mi) xa[mi] = frag_row(As, LD, wr * 128 + mi * 16, ks * 32, lane);
            __builtin_amdgcn_sched_barrier(0);
#pragma unroll
            for (int mi = 0; mi < 8; ++mi)
#pragma unroll
                for (int ni = 0; ni < NT; ++ni) acc[mi][ni] = mfma16(wb[ni], xa[mi], acc[mi][ni]);
        }
    }
    epi(acc, wr, wc, lane);
    __syncthreads();
}

DI int g_lds_byte(int r, int c) { const int st = (r >> 4) * 2 + (c >> 5), ob = (r & 15) * 64 + (c & 31) * 2; return st * 1024 + (ob ^ (((ob >> 9) & 1) << 5)); }
DI void g_stage_rc(int b, int& R, int& C) { const int st = b >> 10, sb = b & 1023, swz = sb ^ (((sb >> 9) & 1) << 5); R = (st >> 1) * 16 + (swz >> 6); C = (st & 1) * 32 + ((swz & 63) >> 1); }
template <class ARow, class BRow, class Epi>
DI void gemm_unit_g(lds_t lds, int K, ARow arow, BRow brow, Epi epi) {
    constexpr int NT = 4, HTB = 16384;
    const int tid = get_tid(), lane = tid & 63, w = tid >> 6, wr = w >> 2, wc = w & 3, fr = lane & 15, fq = lane >> 4;
    const int wu = __builtin_amdgcn_readfirstlane(w);
    const bf16_t* sp[2][2][2];
#pragma unroll
    for (int i = 0; i < 2; ++i) {
        int R, C; g_stage_rc(tid * 16 + i * 8192, R, C);
#pragma unroll
        for (int h = 0; h < 2; ++h) { sp[0][h][i] = arow(h * 128 + R) + C; sp[1][h][i] = brow(h * 128 + R) + C; }
    }
    auto stage = [&](int buf, int kt) {
        const int k0 = kt * 64;
#pragma unroll
        for (int x = 0; x < 2; ++x)
#pragma unroll
            for (int h = 0; h < 2; ++h)
#pragma unroll
                for (int i = 0; i < 2; ++i)
                    __builtin_amdgcn_global_load_lds((const unsigned*)(sp[x][h][i] + k0), (LAS unsigned*)(lds + (buf * 4 + x * 2 + h) * HTB + wu * 1024 + i * 8192), 16, 0, 0);
    };
    const int aoff = wr * HTB + g_lds_byte(fr, fq * 8);
    const int boff = (2 + (wc >> 1)) * HTB + g_lds_byte((wc & 1) * 64 + fr, fq * 8);
    f32x4 acc[8][NT];
#pragma unroll
    for (int mi = 0; mi < 8; ++mi)
#pragma unroll
        for (int ni = 0; ni < NT; ++ni) acc[mi][ni] = (f32x4){0.f, 0.f, 0.f, 0.f};
    const int nk = K / 64;
    stage(0, 0);
    asm volatile("s_waitcnt vmcnt(0)" ::: "memory");
    __syncthreads();
    for (int kt = 0; kt < nk; ++kt) {
        const int buf = kt & 1;
        if (kt + 1 < nk) stage(buf ^ 1, kt + 1);
#pragma unroll
        for (int ks = 0; ks < 2; ++ks) {
            bf16x8 wb[NT], xa[8];
#pragma unroll
            for (int ni = 0; ni < NT; ++ni) wb[ni] = *(const LAS bf16x8*)(lds + buf * 4 * HTB + boff + ni * 2048 + ks * 1024);
#pragma unroll
            for (int mi = 0; mi < 8; ++mi) xa[mi] = *(const LAS bf16x8*)(lds + buf * 4 * HTB + aoff + mi * 2048 + ks * 1024);
            __builtin_amdgcn_sched_barrier(0);
#pragma unroll
            for (int mi = 0; mi < 8; ++mi)
#pragma unroll
                for (int ni = 0; ni < NT; ++ni) acc[mi][ni] = mfma16(wb[ni], xa[mi], acc[mi][ni]);
        }
        asm volatile("s_waitcnt vmcnt(0)" ::: "memory");
        __syncthreads();
    }
    epi(acc, wr, wc, lane);
    __syncthreads();
}

struct U3 { int b, m, n; };
DI bool xcd_unit(int i, int NB, int NM, int NN, int TM, int TN, U3& u) {
    const int bid = get_bid();
    if (gridDim.x != 256) {
        const long L = (long)i * gridDim.x + bid; if (L >= (long)NB * NM * NN) return false;
        const int r = (int)(L % (NM * NN)); u.b = (int)(L / (NM * NN)); u.m = r % NM; u.n = r / NM; return true;
    }
    const int xcd = bid & 7, slot = bid >> 3, tsz = TM * TN, per = 32 / tsz;
    const int nsm = (NM + TM - 1) / TM, nsn = (NN + TN - 1) / TN, ntot = NB * nsm * nsn;
    int cnt = 0;
    for (int j = 0;; ++j) {
        if ((j * 8) * per >= ntot) return false;
        const int S = (j * 8 + xcd) * per + slot / tsz;
        if (S >= ntot) continue;
        const int within = slot % tsz, sl = S % (nsm * nsn);
        const int pm = (sl % nsm) * TM + within % TM, pn = (sl / nsm) * TN + within / TM;
        if (pm < NM && pn < NN) { if (cnt == i) { u.b = S / (nsm * nsn); u.m = pm; u.n = pn; return true; } ++cnt; }
    }
}
DI bool lin_unit(int i, int NB, int NM, int NN, int TM, int TN, U3& u) {
    const int bid = get_bid();
    const int T = NB * NM * NN, xcd = bid & 7, slot = bid >> 3;
    const bool gen = gridDim.x != 256;
    const int lo = gen ? 0 : (xcd * T) >> 3, hi = gen ? T : ((xcd + 1) * T) >> 3;
    const int idx = gen ? i * (int)gridDim.x + bid : lo + i * 32 + slot;
    if (idx >= hi) return false;
    const int per = NM * NN, r = idx % per, FG = NM / TM, gsz = TM * NN;
    u.b = idx / per;
    if (r < FG * gsz) { const int g = r / gsz, rr = r % gsz; u.n = rr / TM; u.m = g * TM + rr % TM; }
    else { const int rr = r - FG * gsz, h = NM - FG * TM; u.n = rr / h; u.m = FG * TM + rr % h; }
    return true;
}
template <int BK, bool PERM, int XG = 8, bool LIN = false, bool GATHER = false, class ARow, class BBase, class Epi>
DI void gemm_multi(lds_t lds, int K, int NB, int NM, int NN, int TM, int TN, ARow arow, BBase bbase, Epi epi) {
    static_assert(BK == 64, "LDS-DMA staging uses 64-deep K-tiles");
    constexpr int NT = 4, HTB = 16384;
    const int tid = get_tid(), lane = tid & 63, w = tid >> 6, wr = w >> 2, wc = w & 3, fr = lane & 15, fq = lane >> 4;
    const int wu = __builtin_amdgcn_readfirstlane(w);
    U3 cur, nxt;
    if (!(LIN ? lin_unit(0, NB, NM, NN, TM, TN, cur) : xcd_unit(0, NB, NM, NN, TM, TN, cur))) return;
    unsigned sao[2][2]; int pidx[2][2];
    const char* abase;
    if constexpr (GATHER) abase = (const char*)arow.row(arow.idx(cur, 0)) - (1u << 30); else abase = (const char*)arow(cur, 0) - (1u << 30);
    auto fetch_idx = [&](const U3& u) {
        if constexpr (GATHER) {
#pragma unroll
            for (int i = 0; i < 2; ++i) {
                int R, C; g_stage_rc(tid * 16 + i * 8192, R, C);
#pragma unroll
                for (int h = 0; h < 2; ++h) pidx[h][i] = arow.idx(u, h * 128 + R);
            }
        }
    };
    const char* bbp = nullptr;
    unsigned sbo0;
    { int R, C; g_stage_rc(tid * 16, R, C); sbo0 = (unsigned)(((PERM ? (R & ~31) + perm32_(R & 31) : R) * K + C) * 2); }
    auto set_ptrs = [&](const U3& u) {
        bbp = (const char*)bbase(u);
#pragma unroll
        for (int i = 0; i < 2; ++i) {
            int R, C; g_stage_rc(tid * 16 + i * 8192, R, C);
#pragma unroll
            for (int h = 0; h < 2; ++h) {
                if constexpr (GATHER) sao[h][i] = (unsigned)((const char*)(arow.row(pidx[h][i]) + C) - abase);
                else sao[h][i] = (unsigned)((const char*)(arow(u, h * 128 + R) + C) - abase);
            }
        }
    };
    auto stage = [&](int buf, int kt) {
        const int k0 = kt * 128;
#pragma unroll
        for (int h = 0; h < 2; ++h)
#pragma unroll
            for (int i = 0; i < 2; ++i) {
                __builtin_amdgcn_global_load_lds((const unsigned*)(abase + (sao[h][i] + (unsigned)k0)), (LAS unsigned*)(lds + (buf * 4 + h) * HTB + wu * 1024 + i * 8192), 16, 0, 0);
                __builtin_amdgcn_global_load_lds((const unsigned*)(bbp + (sbo0 + (unsigned)((h * 128 + i * 64) * K * 2 + k0))), (LAS unsigned*)(lds + (buf * 4 + 2 + h) * HTB + wu * 1024 + i * 8192), 16, 0, 0);
            }
    };
    auto stage_piece = [&](int buf, int k0, int pc) {
        const int h = pc >> 2, i = (pc >> 1) & 1;
        if ((pc & 1) == 0) __builtin_amdgcn_global_load_lds((const unsigned*)(abase + (sao[h][i] + (unsigned)k0)), (LAS unsigned*)(lds + (buf * 4 + h) * HTB + wu * 1024 + i * 8192), 16, 0, 0);
        else __builtin_amdgcn_global_load_lds((const unsigned*)(bbp + (sbo0 + (unsigned)((h * 128 + i * 64) * K * 2 + k0))), (LAS unsigned*)(lds + (buf * 4 + 2 + h) * HTB + wu * 1024 + i * 8192), 16, 0, 0);
    };
    const int aoff = wr * HTB + g_lds_byte(fr, fq * 8);
    const int boff = (2 + (wc >> 1)) * HTB + g_lds_byte((wc & 1) * 64 + fr, fq * 8);
    const int nk = K / 64;
    fetch_idx(cur);
    set_ptrs(cur);
    stage(0, 0);
    asm volatile("s_waitcnt vmcnt(0)" ::: "memory");
    __syncthreads();
    stage(1, 1);
    for (int ui = 0;; ++ui) {
        const bool has_next = LIN ? lin_unit(ui + 1, NB, NM, NN, TM, TN, nxt) : xcd_unit(ui + 1, NB, NM, NN, TM, TN, nxt);
        f32x4 acc[8][NT];
#pragma unroll
        for (int mi = 0; mi < 8; ++mi)
#pragma unroll
            for (int ni = 0; ni < NT; ++ni) acc[mi][ni] = (f32x4){0.f, 0.f, 0.f, 0.f};
        bf16x8 xa[8], wb[NT];
#pragma unroll
        for (int ni = 0; ni < NT; ++ni) wb[ni] = *(const LAS bf16x8*)(lds + boff + ni * 2048);
#pragma unroll
        for (int mi = 0; mi < 8; ++mi) xa[mi] = *(const LAS bf16x8*)(lds + aoff + mi * 2048);
        for (int kt = 0; kt < nk; ++kt) {
            const int buf = kt & 1;
            static_assert(XG == 8, "the mid-step refill assumes all fragment reads of a k-half are issued together");
            if (GATHER && kt + 3 == nk && has_next) fetch_idx(nxt);
            if (kt + 2 == nk && has_next) set_ptrs(nxt);
            {
                const int nb_ = buf * 4 * HTB + 1024;
#pragma unroll
                for (int mi = 0; mi < 8; ++mi) {
                    __builtin_amdgcn_sched_barrier(0);
#pragma unroll
                    for (int ni = 0; ni < NT; ++ni) acc[mi][ni] = mfma16(wb[ni], xa[mi], acc[mi][ni]);
                    xa[mi] = *(const LAS bf16x8*)(lds + nb_ + aoff + mi * 2048);
                }
                __builtin_amdgcn_sched_barrier(0);
#pragma unroll
                for (int ni = 0; ni < NT; ++ni) wb[ni] = *(const LAS bf16x8*)(lds + nb_ + boff + ni * 2048);
            }
            __builtin_amdgcn_sched_barrier(0);
            asm volatile("s_waitcnt vmcnt(0)" ::: "memory");
            __syncthreads();
            const int ksrc = (kt + 2 < nk ? kt + 2 : kt + 2 - nk) * 128;
            {
                const int nb_ = (buf ^ 1) * 4 * HTB;
#pragma unroll
                for (int mi = 0; mi < 8; ++mi) {
                    __builtin_amdgcn_sched_barrier(0);
#pragma unroll
                    for (int ni = 0; ni < NT; ++ni) acc[mi][ni] = mfma16(wb[ni], xa[mi], acc[mi][ni]);
                    stage_piece(buf, ksrc, mi < 4 ? 2 * mi : 2 * (mi - 4) + 1);
                    xa[mi] = *(const LAS bf16x8*)(lds + nb_ + aoff + mi * 2048);
                }
                __builtin_amdgcn_sched_barrier(0);
#pragma unroll
                for (int ni = 0; ni < NT; ++ni) wb[ni] = *(const LAS bf16x8*)(lds + nb_ + boff + ni * 2048);
            }
            __builtin_amdgcn_sched_barrier(0);
        }
        epi(cur, acc, wr, wc, lane);
        if (!has_next) break;
        cur = nxt;
    }
    asm volatile("s_waitcnt vmcnt(0)" ::: "memory");
    __syncthreads();
}

template <class F>
DI void for_units_xcd(int NB, int NM, int NN, int TM, int TN, F f) {
    const int bid = get_bid();
    if (gridDim.x != 256) {
        for (int u = bid; u < NB * NM * NN; u += gridDim.x) f(u / (NM * NN), (u % (NM * NN)) % NM, (u % (NM * NN)) / NM);
        return;
    }
    const int xcd = bid & 7, slot = bid >> 3, tsz = TM * TN, per = 32 / tsz;
    const int nsm = (NM + TM - 1) / TM, nsn = (NN + TN - 1) / TN, ntot = NB * nsm * nsn;
    for (int j = 0;; ++j) {
        const int S = (j * 8 + xcd) * per + slot / tsz;
        if ((j * 8) * per >= ntot) break;
        if (S >= ntot) continue;
        const int within = slot % tsz, batch = S / (nsm * nsn), sl = S % (nsm * nsn);
        const int pm = (sl % nsm) * TM + within % TM, pn = (sl / nsm) * TN + within / TM;
        if (pm < NM && pn < NN) f(batch, pm, pn);
    }
}

template <int NT, class F>
DI void epi_each(const f32x4 (&acc)[8][NT], int wr, int wc, int lane, F f) {
#pragma unroll
    for (int mi = 0; mi < 8; ++mi)
#pragma unroll
        for (int ni = 0; ni < NT; ++ni) f(wr * 128 + mi * 16 + (lane & 15), wc * (NT * 16) + ni * 16 + 4 * (lane >> 4), acc[mi][ni]);
}
template <class F>
DI void epi_each8(const f32x4 (&acc)[8][4], int wr, int wc, int lane, F f) {
#pragma unroll
    for (int mi = 0; mi < 8; ++mi)
#pragma unroll
        for (int k = 0; k < 2; ++k) f(wr * 128 + mi * 16 + (lane & 15), wc * 64 + k * 32 + 8 * (lane >> 4), acc[mi][2 * k], acc[mi][2 * k + 1]);
}
DI void store_bf16x8(bf16_t* dst, f32x4 a, f32x4 b) { u32x4 o; o.x = pk2(a[0], a[1]); o.y = pk2(a[2], a[3]); o.z = pk2(b[0], b[1]); o.w = pk2(b[2], b[3]); *(u32x4*)dst = o; }
DI void store_bf16x4(bf16_t* dst, f32x4 v) { u32x2 o; o.x = pk2(v[0], v[1]); o.y = pk2(v[2], v[3]); *(u32x2*)dst = o; }

DI int rcol(int lane, int i) { return 8 * lane + 512 * (i >> 1) + 4 * (i & 1); }
DI void row_load_f32(const float* src, f32x4 (&v)[4], int lane) {
#pragma unroll
    for (int i = 0; i < 4; ++i) v[i] = __builtin_nontemporal_load((const f32x4*)(src + rcol(lane, i)));
}
template <bool NT = false>
DI void row_load_bf16(const bf16_t* src, f32x4 (&v)[4], int lane) {
    u32x4 a, b;
    if constexpr (NT) { a = __builtin_nontemporal_load((const u32x4*)(src + 8 * lane)); b = __builtin_nontemporal_load((const u32x4*)(src + 512 + 8 * lane)); }
    else { a = *(const u32x4*)(src + 8 * lane); b = *(const u32x4*)(src + 512 + 8 * lane); }
    v[0] = (f32x4){lo_bf(a.x), hi_bf(a.x), lo_bf(a.y), hi_bf(a.y)}; v[1] = (f32x4){lo_bf(a.z), hi_bf(a.z), lo_bf(a.w), hi_bf(a.w)};
    v[2] = (f32x4){lo_bf(b.x), hi_bf(b.x), lo_bf(b.y), hi_bf(b.y)}; v[3] = (f32x4){lo_bf(b.z), hi_bf(b.z), lo_bf(b.w), hi_bf(b.w)};
}
DI float row_sumsq(const f32x4 (&v)[4]) {
    float s = 0.f;
#pragma unroll
    for (int i = 0; i < 4; ++i) s += v[i][0] * v[i][0] + v[i][1] * v[i][1] + v[i][2] * v[i][2] + v[i][3] * v[i][3];
    return wave_sum(s);
}
DI void row_modulate(f32x4 (&v)[4], float rs, const float* g, const float* sc, const float* sh, int lane) {
#pragma unroll
    for (int i = 0; i < 4; ++i) {
        const int c = rcol(lane, i);
        const f32x4 gg = *(const f32x4*)(g + c), ss = *(const f32x4*)(sc + c), hh = *(const f32x4*)(sh + c);
#pragma unroll
        for (int j = 0; j < 4; ++j) v[i][j] = v[i][j] * rs * gg[j] * (1.f + ss[j]) + hh[j];
    }
}
struct ModCache { f32x4 a[4], b[4]; int s; };
DI void mod_fetch(ModCache& m, int s, const float* g, const float* sc, const float* sh, int lane) {
    if (s == m.s) return;
    m.s = s;
#pragma unroll
    for (int i = 0; i < 4; ++i) {
        const int c = rcol(lane, i);
        const f32x4 gg = *(const f32x4*)(g + c), ss = *(const f32x4*)(sc + c);
        m.b[i] = *(const f32x4*)(sh + c);
#pragma unroll
        for (int j = 0; j < 4; ++j) m.a[i][j] = gg[j] * (1.f + ss[j]);
    }
}
DI void row_modulate_c(f32x4 (&v)[4], float rs, const ModCache& m) {
#pragma unroll
    for (int i = 0; i < 4; ++i)
#pragma unroll
        for (int j = 0; j < 4; ++j) v[i][j] = v[i][j] * rs * m.a[i][j] + m.b[i][j];
}
DI void row_store_bf16(bf16_t* dst, const f32x4 (&v)[4], int lane) {
#pragma unroll
    for (int i = 0; i < 4; i += 2) store_bf16x8(dst + rcol(lane, i), v[i], v[i + 1]);
}


struct CT { const float* W; bf16_t* Wt; int ldw, k0, n0, nvalid, ldt, mode; };
DI int gu_row(int c, int up) { return (c / GUG) * (2 * GUG) + up * GUG + (c % GUG); }
DI CT conv_desc_expert(PP p, int layer, int t) {
    const int e = t / 768, r = t % 768, m = r >> 8, tt = r & 255, kt = tt & 15, nt = tt >> 4;
    bf16_t* base = (bf16_t*)((char*)p->out + DO_EXP + (size_t)e * EXP_STRIDE);
    const size_t woff = ((size_t)layer * 16 + e) * 1048576;
    CT c; c.ldw = 1024; c.k0 = kt * 64; c.n0 = nt * 64; c.nvalid = 1024; c.ldt = 1024;
    if (m == 0) { c.W = p->exp_w_gate + woff; c.Wt = base; c.mode = 1; }
    else if (m == 1) { c.W = p->exp_w_up + woff; c.Wt = base; c.mode = 2; }
    else { c.W = p->exp_w_down + woff; c.Wt = base + (size_t)2048 * 1024; c.mode = 0; }
    return c;
}
constexpr int NCONV_DENSE = 704 + 256 + 1024 + 512;
DI CT conv_desc_dense(PP p, int t) {
    CT c; c.mode = 0;
    if (t < 704) { c.W = p->ab_w_in; c.ldw = ABIN; c.k0 = (t & 15) * 64; c.n0 = (t >> 4) * 64; c.nvalid = ABIN; c.Wt = (bf16_t*)((char*)p->out + DO_WIN); c.ldt = 1024; return c; }
    t -= 704;
    if (t < 256) { c.W = p->ab_w_out; c.ldw = 1024; c.k0 = (t & 15) * 64; c.n0 = (t >> 4) * 64; c.nvalid = 1024; c.Wt = (bf16_t*)((char*)p->out + DO_WOUT); c.ldt = 1024; return c; }
    t -= 256;
    if (t < 1024) { c.W = p->m_w_up; c.ldw = 4096; c.k0 = (t & 15) * 64; c.n0 = (t >> 4) * 64; c.nvalid = 4096; c.Wt = (bf16_t*)(p->ws + OFF_WUPT); c.ldt = 1024; return c; }
    t -= 1024;
    c.W = p->m_w_down; c.ldw = 1024; c.k0 = (t & 31) * 64; c.n0 = (t >> 5) * 64; c.nvalid = 1024; c.Wt = (bf16_t*)(p->ws + OFF_WDNT); c.ldt = 2048;
    return c;
}
DI void conv_load(const CT& c, f32x4& a, f32x4& b) {
    const int tid = get_tid(), k = tid >> 3, c8 = (tid & 7) * 8;
    a = (f32x4){0.f, 0.f, 0.f, 0.f}; b = a;
    if (c.n0 + c8 < c.nvalid) { const float* src = c.W + (size_t)(c.k0 + k) * c.ldw + c.n0 + c8; a = __builtin_nontemporal_load((const f32x4*)src); b = __builtin_nontemporal_load((const f32x4*)(src + 4)); }
}
DI void conv_to_lds(LAS float* t, f32x4 a, f32x4 b) {
    const int tid = get_tid(), k = tid >> 3, c8 = (tid & 7) * 8;
#pragma unroll
    for (int j = 0; j < 4; ++j) { t[k * 65 + c8 + j] = a[j]; t[k * 65 + c8 + 4 + j] = b[j]; }
}
DI void conv_from_lds(const CT& c, const LAS float* t) {
    const int tid = get_tid(), n = tid >> 3, k8 = (tid & 7) * 8;
    float v[8];
#pragma unroll
    for (int j = 0; j < 8; ++j) v[j] = t[(k8 + j) * 65 + n];
    u32x4 o; o.x = pk2(v[0], v[1]); o.y = pk2(v[2], v[3]); o.z = pk2(v[4], v[5]); o.w = pk2(v[6], v[7]);
    const int col = c.n0 + n, row = c.mode == 0 ? col : gu_row(col, c.mode - 1);
    *(u32x4*)(c.Wt + (size_t)row * c.ldt + c.k0 + k8) = o;
}
template <class Desc>
DI void conv_stream(int first, int end, int stride, Desc desc, lds_t lds) {
    constexpr int NB_ = 4, TS = 64 * 65 + 16;
    LAS float* tl = (LAS float*)lds;
    for (int t = first; t < end; t += NB_ * stride) {
        CT c[NB_]; f32x4 a[NB_], b[NB_];
#pragma unroll
        for (int q = 0; q < NB_; ++q) { const int tq = t + q * stride; c[q] = desc(tq < end ? tq : t); conv_load(c[q], a[q], b[q]); }
#pragma unroll
        for (int q = 0; q < NB_; ++q) conv_to_lds(tl + q * TS, a[q], b[q]);
        __syncthreads();
#pragma unroll
        for (int q = 0; q < NB_; ++q) if (t + q * stride < end) conv_from_lds(c[q], tl + q * TS);
        __syncthreads();
    }
}

DI void phase_mods(PP p, lds_t lds) {
    const int tid = get_tid();
    if (get_bid() == 0 && tid < 128) *(u32x4*)(p->ws + OFF_ZROW + tid * 16) = (u32x4){0u, 0u, 0u, 0u};
    LAS float* sil = (LAS float*)lds;
    LAS float* red = sil + 5 * 1024;
    for (int u = get_bid(); u < 192 + 32; u += gridDim.x) {
        if (u < 192) {
            const int layer = u / 96, c0 = (u % 96) * 64;
            for (int i = tid; i < 5 * 1024; i += NTHREADS) { const int s = i >> 10, k = i & 1023; const float cv = s < 4 ? p->c[s * 1024 + k] : p->c_ctx[k]; sil[i] = siluf_(cv); }
            __syncthreads();
            const int col = tid & 63, kp = tid >> 6;
            float a[5] = {0.f, 0.f, 0.f, 0.f, 0.f};
            const float* wp = p->mod_w + (size_t)layer * 1024 * 6144 + c0 + col;
            for (int k0 = kp * 128; k0 < kp * 128 + 128; k0 += 16) {
                float wv[16];
#pragma unroll
                for (int j = 0; j < 16; ++j) wv[j] = __builtin_nontemporal_load(wp + (size_t)(k0 + j) * 6144);
#pragma unroll
                for (int j = 0; j < 16; ++j)
#pragma unroll
                    for (int s = 0; s < 5; ++s) a[s] += sil[s * 1024 + k0 + j] * wv[j];
            }
#pragma unroll
            for (int s = 0; s < 5; ++s) red[(kp * 5 + s) * 64 + col] = a[s];
            __syncthreads();
            if (tid < 320) {
                const int s = tid >> 6, cc = tid & 63;
                float t = p->mod_b[layer * 6144 + c0 + cc];
#pragma unroll
                for (int k = 0; k < 8; ++k) t += red[(k * 5 + s) * 64 + cc];
                ((float*)(p->ws + OFF_MODS))[(size_t)(layer * 5 + s) * 6144 + c0 + cc] = t;
            }
            __syncthreads();
        } else {
            const int f0 = (u - 192) * 64;
            const int fl = tid >> 3, dgp = (tid & 7) * 2, f = f0 + fl, n = f >> 2, i = f & 3;
            bf16_t* gxc = (bf16_t*)(p->ws + OFF_GCAT);
            bf16_t* gxm = gxc + 2048 * 16;
#pragma unroll
            for (int e = 0; e < 2; ++e) {
                const int dg = dgp + e, d = dg >> 3, g = dg & 7;
                const float* wg = p->m_w_gates + (size_t)d * 6144 * 8;
                float a = 0.f, b = 0.f;
#pragma unroll
                for (int o = 0; o < 4; ++o) {
                    a += p->m_wq[n * 16 + i * 4 + o] * wg[(size_t)(4 * n + o) * 8 + g];
                    a += p->m_wk[n * 16 + i * 4 + o] * wg[(size_t)(2048 + 4 * n + o) * 8 + g] * 0.04419417382415922f;
                    b += p->m_wv[n * 16 + i * 4 + o] * wg[(size_t)(4096 + 4 * n + o) * 8 + g];
                }
                gxc[f * 16 + dg] = f2bf(a); gxm[f * 16 + dg] = f2bf(b);
            }
            if (tid < 256) {
                const int nn = (f0 >> 2) + (tid >> 4), e = tid & 15, ii = e >> 2, jj = e & 3;
                float a = 0.f;
#pragma unroll
                for (int o = 0; o < 4; ++o) a += p->m_wq[nn * 16 + ii * 4 + o] * p->m_wk[nn * 16 + jj * 4 + o];
                ((float*)(p->ws + OFF_MMAT))[nn * 16 + e] = a * 0.04419417382415922f;
            }
        }
    }
    __syncthreads();
    conv_stream(get_bid(), NCONV_DENSE + 16 * 768, gridDim.x, [&](int t) { return t < NCONV_DENSE ? conv_desc_dense(p, t) : conv_desc_expert(p, 0, t - NCONV_DENSE); }, lds);
}

template <bool XBF = false, class Src>
DI void phase_norm(PP p, int layer, int nrows, Src src) {
    const int lane = get_tid() & 63, gw = get_bid() * 8 + (get_tid() >> 6), nw = gridDim.x * 8;
    bf16_t* act = (bf16_t*)(p->ws + OFF_ACT);
    ModCache mc; mc.s = -1;
    for (int r = gw; r < nrows; r += nw) {
        f32x4 v[4];
        if constexpr (XBF) row_load_bf16((const bf16_t*)src(r), v, lane); else row_load_f32((const float*)src(r), v, lane);
        const int s = row_set(r);
        mod_fetch(mc, s, p->norm1_g + layer * 1024, mods_ptr(p, layer, s, 1), mods_ptr(p, layer, s, 0), lane);
        const float rs = rsqrtf(row_sumsq(v) * (1.f / 1024.f) + EPS);
        row_modulate_c(v, rs, mc);
        row_store_bf16(act + (size_t)r * 1024, v, lane);
    }
}

DI void phase_inproj(PP p, lds_t lds) {
    const bf16_t* act = (const bf16_t*)(p->ws + OFF_ACT);
    bf16_t* P = (bf16_t*)(p->ws + OFF_ARENA + A_P);
    constexpr int NM = NTOK / 256, NN = 11;
    gemm_multi<64, true, 8, true>(lds, 1024, 1, NM, NN, 8, 4,
        [&](const U3& u, int r) { return act + (size_t)(u.m * 256 + r) * 1024; },
        [&](const U3& u) { return (const bf16_t*)((const char*)p->out + DO_WIN) + (size_t)(u.n * 256) * 1024; },
        [&](const U3& u, const f32x4 (&acc)[8][4], int wr, int wc, int lane) {
            epi_each8(acc, wr, wc, lane, [&](int r, int c, f32x4 v0, f32x4 v1) { const int col = u.n * 256 + c; if (col < ABIN) store_bf16x8(P + (size_t)(u.m * 256 + r) * ABIN + col, v0, v1); });
        });
}

DI void gla_bcum(LAS float* bc, const LAS float* lrt, const LAS float* wat, const LAS float* bat, int d, LAS float* seg_tot) {
    const int tid = get_tid();
    {
        const int c = tid & 63, tq = tid >> 6;
        float wcol[16];
#pragma unroll
        for (int r = 0; r < 16; ++r) wcol[r] = wat[r * 64 + c];
        const float bias = bat[c];
        for (int t = tq * 8; t < tq * 8 + 8; ++t) {
            float z = bias;
#pragma unroll
            for (int r = 0; r < 16; ++r) z += lrt[t * 16 + r] * wcol[r];
            bc[t * 64 + c] = log_sigmoidf_(z) * (1.f / 16.f);
        }
    }
    __syncthreads();
    {
        const int c = tid & 63, seg = tid >> 6;
        float v[8]; float run = 0.f;
#pragma unroll
        for (int j = 0; j < 8; ++j) { const int pp = seg * 8 + j, t = d == 0 ? pp : 63 - pp; run += bc[t * 64 + c]; v[j] = run; }
        LAS float* tot = seg_tot + seg * 64 + c;
        *tot = run;
        __syncthreads();
        float off = 0.f;
#pragma unroll
        for (int k = 0; k < 7; ++k) off += (k < seg) ? seg_tot[k * 64 + c] : 0.f;
#pragma unroll
        for (int j = 0; j < 8; ++j) { const int pp = seg * 8 + j, t = d == 0 ? pp : 63 - pp; bc[t * 64 + c] = v[j] + off; }
    }
    __syncthreads();
}
DI void gla_bcum2(LAS float* bc, const LAS float* lrt, const LAS float* wat, const LAS float* bat, LAS float* seg_tot) {
    const int tid = get_tid(), c = tid & 63, tq = tid >> 6;
#pragma unroll
    for (int d = 0; d < 2; ++d) {
        float wcol[16];
#pragma unroll
        for (int r = 0; r < 16; ++r) wcol[r] = wat[d * 1024 + r * 64 + c];
        const float bias = bat[d * 64 + c];
        for (int t = tq * 8; t < tq * 8 + 8; ++t) {
            float z = bias;
#pragma unroll
            for (int r = 0; r < 16; ++r) z += lrt[d * 1024 + t * 16 + r] * wcol[r];
            bc[d * 4096 + t * 64 + c] = log_sigmoidf_(z) * (1.f / 16.f);
        }
    }
    __syncthreads();
    {
        const int seg = tq;
        float v[2][8];
#pragma unroll
        for (int d = 0; d < 2; ++d) {
            float run = 0.f;
#pragma unroll
            for (int j = 0; j < 8; ++j) { const int pp = seg * 8 + j, t = d == 0 ? pp : 63 - pp; run += bc[d * 4096 + t * 64 + c]; v[d][j] = run; }
            seg_tot[(d * 8 + seg) * 64 + c] = run;
        }
        __syncthreads();
#pragma unroll
        for (int d = 0; d < 2; ++d) {
            float off = 0.f;
#pragma unroll
            for (int k = 0; k < 7; ++k) off += (k < seg) ? seg_tot[(d * 8 + k) * 64 + c] : 0.f;
#pragma unroll
            for (int j = 0; j < 8; ++j) { const int pp = seg * 8 + j, t = d == 0 ? pp : 63 - pp; bc[d * 4096 + t * 64 + c] = v[d][j] + off; }
        }
    }
    __syncthreads();
}
DI void gla_load_decay_inputs(PP p, const bf16_t* P, int r0, int h, LAS float* lrt, LAS float* wat, LAS float* bat, bool loadw) {
    const int tid = get_tid();
    if (tid < 256) {
        const int d = tid >> 7, t = (tid >> 1) & 63, half = tid & 1;
        const u32x4 v = *(const u32x4*)(P + (size_t)(r0 + t) * ABIN + PC_LRF + d * 16 + half * 8);
        LAS float* o = lrt + (d * 64 + t) * 16 + half * 8;
        o[0] = lo_bf(v.x); o[1] = hi_bf(v.x); o[2] = lo_bf(v.y); o[3] = hi_bf(v.y); o[4] = lo_bf(v.z); o[5] = hi_bf(v.z); o[6] = lo_bf(v.w); o[7] = hi_bf(v.w);
    }
    if (loadw) {
        const int i = tid * 4, d = i >> 10, r = (i >> 6) & 15, c = i & 63;
        *(LAS f32x4*)(wat + i) = *(const f32x4*)(p->gla_wa2 + (size_t)(d * 16 + r) * 256 + h * 64 + c);
        if (tid < 128) bat[tid] = p->gla_ba[(tid >> 6) * 256 + h * 64 + (tid & 63)];
    }
}

DI void phase_g1(PP p, lds_t lds) {
    const int tid = get_tid(), lane = tid & 63, w = tid >> 6;
    const bf16_t* P = (const bf16_t*)(p->ws + OFF_ARENA + A_P);
    bf16_t* U = (bf16_t*)(p->ws + OFF_ARENA + A_U);
    float* DEC = (float*)(p->ws + OFF_ARENA + A_DEC);
    float* LA = (float*)(p->ws + OFF_ARENA + A_LA);
    bf16_t* UU = (bf16_t*)(p->ws + OFF_ARENA + A_UU);
    float* AGGA = (float*)(p->ws + OFF_ARENA + A_AGGA);
    float* AGGH = (float*)(p->ws + OFF_ARENA + A_AGGH);
    constexpr int NGLA = NCH * 4, NLRU = NCH * 4;
    unsigned long long pg0 = 0, pg_acc = 0; if (PROF_SEC >= 10) pg0 = __builtin_amdgcn_s_memtime();
    int h_loaded = -1;
    for (int task = get_bid(); task < NGLA; task += gridDim.x) {
        {
            const int ch = task >> 2, h = task & 3, r0 = ch * 64;
            LAS float* lrt = (LAS float*)lds;
            LAS float* wat = lrt + 2048;
            LAS float* bat = wat + 2048;
            LAS float* bc = bat + 128;
            LAS bf16_t* kt = (LAS bf16_t*)(bc + 8192);
            LAS bf16_t* ktd = kt + 64 * 72;
            LAS bf16_t* vt = ktd + 2 * 64 * 72;
            gla_load_decay_inputs(p, P, r0, h, lrt, wat, bat, h != h_loaded); h_loaded = h;
            { const int row = tid >> 3, chunk = tid & 7; *(LAS u32x4*)(kt + row * 72 + chunk * 8) = *(const u32x4*)(P + (size_t)(r0 + row) * ABIN + PC_K + h * 64 + chunk * 8); }
#pragma unroll
            for (int q = 0; q < 2; ++q) { const int i = tid + 512 * q, row = i >> 4, chunk = i & 15; *(LAS u32x4*)(vt + row * 136 + chunk * 8) = *(const u32x4*)(P + (size_t)(r0 + row) * ABIN + PC_V + h * 128 + chunk * 8); }
            __syncthreads();
            gla_bcum2(bc, lrt, wat, bat, (LAS float*)(vt + 64 * 136));
            {
                const int t = tid >> 3, c8 = (tid & 7) * 8;
#pragma unroll
                for (int d = 0; d < 2; ++d) {
                    const LAS float* b = bc + d * 4096;
                    const int tl = d == 0 ? 63 : 0;
                    float o[8];
#pragma unroll
                    for (int j = 0; j < 8; ++j) o[j] = bf2f(kt[t * 72 + c8 + j]) * __expf(b[tl * 64 + c8 + j] - b[t * 64 + c8 + j]);
                    u32x4 v; v.x = pk2(o[0], o[1]); v.y = pk2(o[2], o[3]); v.z = pk2(o[4], o[5]); v.w = pk2(o[6], o[7]);
                    *(LAS u32x4*)(ktd + d * 64 * 72 + t * 72 + c8) = v;
                }
                if (tid < 128) { const int d = tid >> 6, c = tid & 63; DEC[(size_t)(ch * 2 + d) * 256 + h * 64 + c] = __expf(bc[d * 4096 + (d == 0 ? 63 : 0) * 64 + c]); }
            }
            __syncthreads();
            {
                const int d = w >> 2, dkt = w & 3;
                const LAS bf16_t* kd = ktd + d * 64 * 72;
                bf16x8 kb[2];
#pragma unroll
                for (int ks = 0; ks < 2; ++ks) kb[ks] = frag_tr(kd, 72, ks * 32, dkt * 16, lane);
                bf16_t* Ud = U + ((size_t)(ch * 2 + d) * 4 + h) * 8192;
#pragma unroll
                for (int dvt = 0; dvt < 8; ++dvt) {
                    f32x4 acc = {0.f, 0.f, 0.f, 0.f};
#pragma unroll
                    for (int ks = 0; ks < 2; ++ks) acc = mfma16(frag_tr(vt, 136, ks * 32, dvt * 16, lane), kb[ks], acc);
                    store_bf16x4(Ud + (dkt * 16 + (lane & 15)) * 128 + dvt * 16 + 4 * (lane >> 4), acc);
                }
            }
            __syncthreads();
        }
    }
    if (PROF_SEC == 10) pg_acc = __builtin_amdgcn_s_memtime() - pg0;
    if (PROF_SEC >= 10) pg0 = __builtin_amdgcn_s_memtime();
    int cq_loaded = -1;
    bf16x8 wf[4][2]; f32x4 bvq[4], coefq[4];
    for (int t2 = get_bid(); t2 < NLRU; t2 += gridDim.x) {
        {
            const int ch = t2 >> 2, cq = t2 & 3, r0 = ch * 64;
            const int seg_lo = ch < NCHL ? r0 : NLAT + ((r0 - NLAT) >> 8) * 256, seg_hi = ch < NCHL ? r0 + 64 : seg_lo + 256;
            LAS bf16_t* xin = (LAS bf16_t*)lds;
            LAS bf16_t* xb = xin + 67 * 136;
            LAS float* lat = (LAS float*)(xb + 64 * 136);
            LAS bf16_t* git = (LAS bf16_t*)(lat + 2 * 64 * 128);
            LAS float* cwl = (LAS float*)(git + 2 * 64 * 128);
            if (cq != cq_loaded) {
                cq_loaded = cq;
                for (int i = tid; i < 640; i += NTHREADS) cwl[i] = i < 512 ? p->rg_conv_w[(i >> 7) * 512 + cq * 128 + (i & 127)] : p->rg_conv_b[cq * 128 + i - 512];
                const int blk = w & 1, d = (w >> 1) & 1, mat = w >> 2, n = cq * 2 + blk;
                const float* W = (mat ? p->rg_wi : p->rg_wr) + (size_t)(d * 8 + n) * 4096;
                const float* bias = (mat ? p->rg_bi : p->rg_br) + d * 512 + n * 64;
#pragma unroll
                for (int ot = 0; ot < 4; ++ot) {
#pragma unroll
                    for (int ks = 0; ks < 2; ++ks) {
                        const float* src = W + (size_t)(ks * 32 + 8 * (lane >> 4)) * 64 + ot * 16 + (lane & 15);
                        float f[8];
#pragma unroll
                        for (int j = 0; j < 8; ++j) f[j] = src[j * 64];
                        u32x4 v; v.x = pk2n(f[0], f[1]); v.y = pk2n(f[2], f[3]); v.z = pk2n(f[4], f[5]); v.w = pk2n(f[6], f[7]);
                        wf[ot][ks] = __builtin_bit_cast(bf16x8, v);
                    }
                    const int o = ot * 16 + 4 * (lane >> 4);
                    bvq[ot] = *(const f32x4*)(bias + o);
                    const f32x4 lam = *(const f32x4*)(p->rg_lambda + d * 512 + n * 64 + o);
#pragma unroll
                    for (int j = 0; j < 4; ++j) coefq[ot][j] = -8.f * softplusf_(-lam[j]);
                }
            }
            for (int i = tid; i < 67 * 16; i += NTHREADS) {
                const int row = i >> 4, chunk = i & 15, r = r0 - 2 + row;
                u32x4 v = {0u, 0u, 0u, 0u};
                if (r >= seg_lo && r < seg_hi) v = __builtin_nontemporal_load((const u32x4*)(P + (size_t)r * ABIN + PC_RGX + cq * 128 + chunk * 8));
                *(LAS u32x4*)(xin + row * 136 + chunk * 8) = v;
            }
            __syncthreads();
            {
                const int t = tid >> 3, c16 = (tid & 7) * 16;
                float o[16];
#pragma unroll
                for (int j = 0; j < 16; ++j) o[j] = cwl[512 + c16 + j];
#pragma unroll
                for (int tap = 0; tap < 4; ++tap)
#pragma unroll
                    for (int j = 0; j < 16; ++j) o[j] += cwl[tap * 128 + c16 + j] * bf2f(xin[(t + tap) * 136 + c16 + j]);
#pragma unroll
                for (int j = 0; j < 16; j += 8) {
                    u32x4 v; v.x = pk2(o[j], o[j + 1]); v.y = pk2(o[j + 2], o[j + 3]); v.z = pk2(o[j + 4], o[j + 5]); v.w = pk2(o[j + 6], o[j + 7]);
                    *(LAS u32x4*)(xb + t * 136 + c16 + j) = v;
                }
            }
            __syncthreads();
            {
                const int blk = w & 1, d = (w >> 1) & 1, mat = w >> 2;
#pragma unroll
                for (int tt = 0; tt < 4; ++tt) {
                    bf16x8 xf[2];
#pragma unroll
                    for (int ks = 0; ks < 2; ++ks) xf[ks] = frag_row(xb, 136, tt * 16, blk * 64 + ks * 32, lane);
#pragma unroll
                    for (int ot = 0; ot < 4; ++ot) {
                        f32x4 acc = {0.f, 0.f, 0.f, 0.f};
#pragma unroll
                        for (int ks = 0; ks < 2; ++ks) acc = mfma16(wf[ot][ks], xf[ks], acc);
                        const int t = tt * 16 + (lane & 15), o = ot * 16 + 4 * (lane >> 4), c = blk * 64 + o;
                        const f32x4 bv = bvq[ot];
                        if (mat == 0) {
                            f32x4 la;
#pragma unroll
                            for (int j = 0; j < 4; ++j) la[j] = coefq[ot][j] * sigmoidf_(acc[j] + bv[j]);
                            *(LAS f32x4*)(lat + (d * 64 + t) * 128 + c) = la;
                        } else {
                            float gi[4];
#pragma unroll
                            for (int j = 0; j < 4; ++j) gi[j] = sigmoidf_(acc[j] + bv[j]) * bf2f(xb[t * 136 + c + j]);
                            u32x2 v; v.x = pk2(gi[0], gi[1]); v.y = pk2(gi[2], gi[3]);
                            *(LAS u32x2*)(git + (d * 64 + t) * 128 + c) = v;
                        }
                    }
                }
            }
            __syncthreads();
            {
                const int c4 = (tid & 31) * 4, rest = tid >> 5, d = rest >> 3, t0 = (rest & 7) * 8, gc = cq * 128 + c4;
#pragma unroll
                for (int j = 0; j < 8; ++j) {
                    const int t = t0 + j;
                    const f32x4 la = *(const LAS f32x4*)(lat + (d * 64 + t) * 128 + c4);
                    const u32x2 gg = *(const LAS u32x2*)(git + (d * 64 + t) * 128 + c4);
                    f32x4 av; float u[4];
                    const float gi[4] = {lo_bf(gg.x), hi_bf(gg.x), lo_bf(gg.y), hi_bf(gg.y)};
#pragma unroll
                    for (int e = 0; e < 4; ++e) { av[e] = __expf(la[e]); u[e] = __builtin_amdgcn_sqrtf(fmaxf(1.f - av[e] * av[e], 0.f)) * gi[e]; }
                    u32x2 uo; uo.x = pk2(u[0], u[1]); uo.y = pk2(u[2], u[3]);
                    *(f32x4*)(LA + ((size_t)(r0 + t) * 2 + d) * 512 + gc) = av;
                    *(u32x2*)(UU + ((size_t)(r0 + t) * 2 + d) * 512 + gc) = uo;
                    *(LAS f32x4*)(lat + (d * 64 + t) * 128 + c4) = av;
                    *(LAS u32x2*)(git + (d * 64 + t) * 128 + c4) = uo;
                }
            }
            __syncthreads();
            {
                const int half = tid >> 8, d = (tid >> 7) & 1, c = tid & 127, gc = cq * 128 + c;
                float hacc = 0.f, aprod = 1.f;
#pragma unroll 8
                for (int s_ = 0; s_ < 32; ++s_) {
                    const int pp = half * 32 + s_, t = d == 0 ? pp : 63 - pp;
                    const float a = lat[(d * 64 + t) * 128 + c], u = bf2f(git[(d * 64 + t) * 128 + c]);
                    hacc = a * hacc + u; aprod *= a;
                }
                LAS float* comb = (LAS float*)xin;
                comb[(half * 256 + d * 128 + c) * 2] = aprod; comb[(half * 256 + d * 128 + c) * 2 + 1] = hacc;
                __syncthreads();
                if (half == 0) {
                    const float a1 = comb[(256 + d * 128 + c) * 2], h1 = comb[(256 + d * 128 + c) * 2 + 1];
                    AGGA[(size_t)(ch * 2 + d) * 512 + gc] = aprod * a1;
                    AGGH[(size_t)(ch * 2 + d) * 512 + gc] = a1 * hacc + h1;
                }
            }
            __syncthreads();
        }
    }
    if (PROF_SEC == 11) pg_acc = __builtin_amdgcn_s_memtime() - pg0;
    if (PROF_SEC >= 10 && get_bid() == 0) { const unsigned long long t0_ = __builtin_amdgcn_s_memtime(); while (__builtin_amdgcn_s_memtime() - t0_ < 4 * pg_acc) __builtin_amdgcn_s_sleep(8); }
}

DI int scan_chunk(int b, int d, int st) {
    if (st < 4) return NCHL + b * 4 + (d == 0 ? st : 3 - st);
    const int j = st - 4;
    return b * 128 + (d == 0 ? j : 127 - j);
}

DI void phase_scan0(PP p) {
    bf16_t* U = (bf16_t*)(p->ws + OFF_ARENA + A_U);
    const float* DEC = (const float*)(p->ws + OFF_ARENA + A_DEC);
    const float* AGGA = (const float*)(p->ws + OFF_ARENA + A_AGGA);
    float* AGGH = (float*)(p->ws + OFF_ARENA + A_AGGH);
    const int gid = get_bid() * NTHREADS + get_tid(), nthr = gridDim.x * NTHREADS;
    constexpr int DEPTH = 33;
    for (int idx = gid; idx < 65536 + 4096; idx += nthr) {
        if (idx < 65536) {
            const int dv4 = idx & 31, dk = (idx >> 5) & 63, h = (idx >> 11) & 3, d = (idx >> 13) & 1, b = idx >> 14;
            f32x4 S = {0.f, 0.f, 0.f, 0.f};
            for (int st = 0; st < 132; st += DEPTH) {
                u32x2 u[DEPTH]; float dc[DEPTH]; bf16_t* ptr[DEPTH];
#pragma unroll
                for (int q = 0; q < DEPTH; ++q) {
                    const int cid = scan_chunk(b, d, st + q);
                    ptr[q] = U + ((size_t)(cid * 2 + d) * 4 + h) * 8192 + dk * 128 + dv4 * 4;
                    u[q] = *(const u32x2*)ptr[q];
                    dc[q] = DEC[(size_t)(cid * 2 + d) * 256 + h * 64 + dk];
                }
#pragma unroll
                for (int q = 0; q < DEPTH; ++q) {
                    store_bf16x4(ptr[q], S);
                    const f32x4 uf = {lo_bf(u[q].x), hi_bf(u[q].x), lo_bf(u[q].y), hi_bf(u[q].y)};
                    S = S * dc[q] + uf;
                }
            }
        } else {
            const int i2 = idx - 65536, c = i2 & 511, d = (i2 >> 9) & 1, b = i2 >> 10;
            float hs = 0.f;
            for (int st = 0; st < 132; st += DEPTH) {
                float a[DEPTH], hh[DEPTH]; float* ptr[DEPTH];
#pragma unroll
                for (int q = 0; q < DEPTH; ++q) {
                    const int cid = scan_chunk(b, d, st + q);
                    ptr[q] = AGGH + (size_t)(cid * 2 + d) * 512 + c;
                    hh[q] = *ptr[q]; a[q] = AGGA[(size_t)(cid * 2 + d) * 512 + c];
                }
#pragma unroll
                for (int q = 0; q < DEPTH; ++q) { *ptr[q] = hs; hs = a[q] * hs + hh[q]; }
            }
        }
    }
}

DI void phase_g3(PP p, lds_t lds) {
    const int tid = get_tid(), lane = tid & 63, w = tid >> 6;
    const bf16_t* P = (const bf16_t*)(p->ws + OFF_ARENA + A_P);
    const bf16_t* U = (const bf16_t*)(p->ws + OFF_ARENA + A_U);
    const float* LA = (const float*)(p->ws + OFF_ARENA + A_LA);
    const bf16_t* UU = (const bf16_t*)(p->ws + OFF_ARENA + A_UU);
    const float* HST = (const float*)(p->ws + OFF_ARENA + A_AGGH);
    bf16_t* act = (bf16_t*)(p->ws + OFF_ACT);
    constexpr int NGLA = NCH * 4;
    int h_loaded = -1;
    for (int task = get_bid(); task < NGLA + NCH; task += gridDim.x) {
        if (task < NGLA) {
            const int ch = task >> 2, h = task & 3, r0 = ch * 64;
            LAS float* lrt = (LAS float*)lds;
            LAS float* wat = lrt + 2048;
            LAS float* bat = wat + 2048;
            LAS float* bc = bat + 128;
            LAS bf16_t* qt = (LAS bf16_t*)(bc + 8192);
            LAS bf16_t* kt = qt + 64 * 72;
            LAS bf16_t* qtd = kt + 64 * 72;
            LAS bf16_t* ktd = qtd + 64 * 72;
            LAS bf16_t* at = ktd + 64 * 72;
            LAS bf16_t* vt = at + 64 * 72;
            LAS bf16_t* St = vt + 64 * 136;
            LAS float* segt = (LAS float*)(St + 64 * 136);
            LAS float* ot = bc;
            gla_load_decay_inputs(p, P, r0, h, lrt, wat, bat, h != h_loaded); h_loaded = h;
            { const int row = tid >> 3, chunk = tid & 7;
              *(LAS u32x4*)(qt + row * 72 + chunk * 8) = __builtin_nontemporal_load((const u32x4*)(P + (size_t)(r0 + row) * ABIN + PC_Q + h * 64 + chunk * 8));
              *(LAS u32x4*)(kt + row * 72 + chunk * 8) = __builtin_nontemporal_load((const u32x4*)(P + (size_t)(r0 + row) * ABIN + PC_K + h * 64 + chunk * 8)); }
#pragma unroll
            for (int q = 0; q < 2; ++q) { const int i = tid + 512 * q, row = i >> 4, chunk = i & 15; *(LAS u32x4*)(vt + row * 136 + chunk * 8) = __builtin_nontemporal_load((const u32x4*)(P + (size_t)(r0 + row) * ABIN + PC_V + h * 128 + chunk * 8)); }
            __syncthreads();
            f32x4 oacc[4];
#pragma unroll
            for (int i = 0; i < 4; ++i) oacc[i] = (f32x4){0.f, 0.f, 0.f, 0.f};
            const int ott = w & 3, odv0 = (w >> 2) * 4;
            gla_bcum2(bc, lrt, wat, bat, segt);
            for (int d = 0; d < 2; ++d) {
                {
                    const int t = tid >> 3, c8 = (tid & 7) * 8;
                    float qo[8], ko[8];
#pragma unroll
                    for (int j = 0; j < 8; ++j) { const float e = __expf(bc[d * 4096 + t * 64 + c8 + j]); qo[j] = bf2f(qt[t * 72 + c8 + j]) * 0.125f * e; ko[j] = bf2f(kt[t * 72 + c8 + j]) * rcpf_(e); }
                    u32x4 v; v.x = pk2(qo[0], qo[1]); v.y = pk2(qo[2], qo[3]); v.z = pk2(qo[4], qo[5]); v.w = pk2(qo[6], qo[7]);
                    *(LAS u32x4*)(qtd + t * 72 + c8) = v;
                    v.x = pk2(ko[0], ko[1]); v.y = pk2(ko[2], ko[3]); v.z = pk2(ko[4], ko[5]); v.w = pk2(ko[6], ko[7]);
                    *(LAS u32x4*)(ktd + t * 72 + c8) = v;
                    const int dk = tid >> 3, dv16 = (tid & 7) * 16;
                    const bf16_t* src = U + ((size_t)(ch * 2 + d) * 4 + h) * 8192 + dk * 128 + dv16;
                    const u32x4 s0 = *(const u32x4*)src, s1 = *(const u32x4*)(src + 8);
                    *(LAS u32x4*)(St + dk * 136 + dv16) = s0;
                    *(LAS u32x4*)(St + dk * 136 + dv16 + 8) = s1;
                }
                __syncthreads();
                {
                    const int tt = w >> 1;
#pragma unroll
                    for (int e = 0; e < 2; ++e) {
                        const int st = (w & 1) * 2 + e;
                        f32x4 acc = {0.f, 0.f, 0.f, 0.f};
#pragma unroll
                        for (int ks = 0; ks < 2; ++ks) acc = mfma16(frag_row(ktd, 72, st * 16, ks * 32, lane), frag_row(qtd, 72, tt * 16, ks * 32, lane), acc);
                        const int t = tt * 16 + (lane & 15), s0 = st * 16 + 4 * (lane >> 4);
                        float a[4];
#pragma unroll
                        for (int j = 0; j < 4; ++j) { const int s = s0 + j; a[j] = (d == 0 ? s <= t : s >= t) ? acc[j] : 0.f; }
                        u32x2 v; v.x = pk2(a[0], a[1]); v.y = pk2(a[2], a[3]);
                        *(LAS u32x2*)(at + t * 72 + s0) = v;
                    }
                }
                __syncthreads();
                {
                    bf16x8 af[2], qf[2];
#pragma unroll
                    for (int ks = 0; ks < 2; ++ks) { af[ks] = frag_row(at, 72, ott * 16, ks * 32, lane); qf[ks] = frag_row(qtd, 72, ott * 16, ks * 32, lane); }
#pragma unroll
                    for (int i = 0; i < 4; ++i) {
                        const int dvt = odv0 + i;
#pragma unroll
                        for (int ks = 0; ks < 2; ++ks) {
                            oacc[i] = mfma16(frag_tr(vt, 136, ks * 32, dvt * 16, lane), af[ks], oacc[i]);
                            oacc[i] = mfma16(frag_tr(St, 136, ks * 32, dvt * 16, lane), qf[ks], oacc[i]);
                        }
                    }
                }
                __syncthreads();
            }
#pragma unroll
            for (int i = 0; i < 4; ++i) *(LAS f32x4*)(ot + (ott * 16 + (lane & 15)) * 132 + (odv0 + i) * 16 + 4 * (lane >> 4)) = oacc[i];
            __syncthreads();
            {
                const int t = tid >> 3, dv16 = (tid & 7) * 16;
                float o[16]; float ss = 0.f;
#pragma unroll
                for (int j = 0; j < 16; ++j) { o[j] = ot[t * 132 + dv16 + j]; ss += o[j] * o[j]; }
                ss += __shfl_xor(ss, 1); ss += __shfl_xor(ss, 2); ss += __shfl_xor(ss, 4);
                const float rs = rsqrtf(ss * (1.f / 128.f) + EPS);
                const bf16_t* gp = P + (size_t)(r0 + t) * ABIN + PC_G + h * 128 + dv16;
                const u32x4 g0 = __builtin_nontemporal_load((const u32x4*)gp), g1 = __builtin_nontemporal_load((const u32x4*)(gp + 8));
                const unsigned gw[8] = {g0.x, g0.y, g0.z, g0.w, g1.x, g1.y, g1.z, g1.w};
                float r[16], gn[16];
#pragma unroll
                for (int j4 = 0; j4 < 4; ++j4) { const f32x4 gv = *(const f32x4*)(p->gla_norm_g + h * 128 + dv16 + 4 * j4); gn[4 * j4] = gv[0]; gn[4 * j4 + 1] = gv[1]; gn[4 * j4 + 2] = gv[2]; gn[4 * j4 + 3] = gv[3]; }
#pragma unroll
                for (int j = 0; j < 8; ++j) {
                    r[2 * j] = o[2 * j] * rs * gn[2 * j] * siluf_(lo_bf(gw[j]));
                    r[2 * j + 1] = o[2 * j + 1] * rs * gn[2 * j + 1] * siluf_(hi_bf(gw[j]));
                }
                bf16_t* dst = act + (size_t)(r0 + t) * 1024 + h * 128 + dv16;
                u32x4 v; v.x = pk2(r[0], r[1]); v.y = pk2(r[2], r[3]); v.z = pk2(r[4], r[5]); v.w = pk2(r[6], r[7]);
                *(u32x4*)dst = v;
                v.x = pk2(r[8], r[9]); v.y = pk2(r[10], r[11]); v.z = pk2(r[12], r[13]); v.w = pk2(r[14], r[15]);
                *(u32x4*)(dst + 8) = v;
            }
            __syncthreads();
        } else {
            const int ch = task - NGLA, r0 = ch * 64;
            LAS unsigned* hq = (LAS unsigned*)lds;
            {
                int tl = tid; asm volatile("" : "+v"(tl));
                const int d = tl >> 8, cp = tl & 255;
                f32x2 hs = *(const f32x2*)(HST + (size_t)(ch * 2 + d) * 512 + 2 * cp);
                const long gstep = d ? -1024 : 1024;
                const int lstep = d ? -256 : 256;
                const float* lap = LA + ((size_t)(r0 + (d ? 63 : 0)) * 2 + d) * 512 + 2 * cp;
                const bf16_t* uup = UU + ((size_t)(r0 + (d ? 63 : 0)) * 2 + d) * 512 + 2 * cp;
                LAS unsigned* hw = hq + (d * 64 + (d ? 63 : 0)) * 256 + cp;
                f32x2 a0[16], a1[16]; unsigned u0[16], u1[16];
#define LRU_LOADB(A_, U_) _Pragma("unroll") for (int j = 0; j < 16; ++j) { A_[j] = __builtin_nontemporal_load((const f32x2*)lap); U_[j] = __builtin_nontemporal_load((const unsigned*)uup); lap += gstep; uup += gstep; }
#define LRU_STEPB(A_, U_) _Pragma("unroll") for (int j = 0; j < 16; ++j) { hs[0] = A_[j][0] * hs[0] + lo_bf(U_[j]); hs[1] = A_[j][1] * hs[1] + hi_bf(U_[j]); *hw = pk2(hs[0], hs[1]); hw += lstep; }
                LRU_LOADB(a0, u0)
                LRU_LOADB(a1, u1)
                LRU_STEPB(a0, u0)
                LRU_LOADB(a0, u0)
                LRU_STEPB(a1, u1)
                LRU_LOADB(a1, u1)
                LRU_STEPB(a0, u0)
                LRU_STEPB(a1, u1)
#undef LRU_LOADB
#undef LRU_STEPB
            }
            __syncthreads();
#pragma unroll
            for (int q = 0; q < 8; ++q) {
                const int i = tid + NTHREADS * q, row = i >> 6, c8 = (i & 63) * 8;
                const u32x4 hf = *(const LAS u32x4*)(hq + row * 256 + (c8 >> 1)), hb = *(const LAS u32x4*)(hq + (64 + row) * 256 + (c8 >> 1));
                const u32x4 gg = __builtin_nontemporal_load((const u32x4*)(P + (size_t)(r0 + row) * ABIN + PC_RGG + c8));
                const unsigned fw[4] = {hf.x, hf.y, hf.z, hf.w}, bw[4] = {hb.x, hb.y, hb.z, hb.w}, gw[4] = {gg.x, gg.y, gg.z, gg.w};
                unsigned o[4];
#pragma unroll
                for (int j = 0; j < 4; ++j) o[j] = pk2((lo_bf(fw[j]) + lo_bf(bw[j])) * gelu_tanh(lo_bf(gw[j])), (hi_bf(fw[j]) + hi_bf(bw[j])) * gelu_tanh(hi_bf(gw[j])));
                u32x4 ov; ov.x = o[0]; ov.y = o[1]; ov.z = o[2]; ov.w = o[3];
                *(u32x4*)(act + (size_t)(r0 + row) * 1024 + 512 + c8) = ov;
            }
            __syncthreads();
        }
    }
}


DI void phase_outproj0(PP p, lds_t lds) {
    const bf16_t* act = (const bf16_t*)(p->ws + OFF_ACT);
    bf16_t* X = (bf16_t*)(p->ws + OFF_ARENA + A_X);
    constexpr int NM = NTOK / 256, NN = 4;
    gemm_multi<64, true>(lds, 1024, 1, NM, NN, 8, 4,
        [&](const U3& u, int r) { return act + (size_t)(u.m * 256 + r) * 1024; },
        [&](const U3& u) { return (const bf16_t*)((const char*)p->out + DO_WOUT) + (size_t)(u.n * 256) * 1024; },
        [&](const U3& u, const f32x4 (&acc)[8][4], int wr, int wc, int lane) {
            const int pm = u.m, pn = u.n, set = row_set(pm * 256);
            const float* g1 = mods_ptr(p, 0, set, 2);
            const float* xin = pm * 256 < NLAT ? p->x + (size_t)pm * 256 * 1024 : p->ctx + (size_t)(pm * 256 - NLAT) * 1024;
            const int c0 = pn * 256 + wc * 64 + 8 * (lane >> 4);
            f32x4 g[4];
#pragma unroll
            for (int k = 0; k < 2; ++k) { g[2 * k] = *(const f32x4*)(g1 + c0 + k * 32); g[2 * k + 1] = *(const f32x4*)(g1 + c0 + k * 32 + 4); }
            const float* xr = xin + (size_t)(wr * 128 + (lane & 15)) * 1024 + c0;
            bf16_t* Xr = X + (size_t)(pm * 256 + wr * 128 + (lane & 15)) * 1024 + c0;
#pragma unroll
            for (int mi = 0; mi < 8; ++mi) {
                f32x4 xi[4];
#pragma unroll
                for (int k = 0; k < 2; ++k) { xi[2 * k] = __builtin_nontemporal_load((const f32x4*)(xr + mi * 16 * 1024 + k * 32)); xi[2 * k + 1] = __builtin_nontemporal_load((const f32x4*)(xr + mi * 16 * 1024 + k * 32 + 4)); }
#pragma unroll
                for (int k = 0; k < 2; ++k) store_bf16x8(Xr + mi * 16 * 1024 + k * 32, xi[2 * k] + g[2 * k] * acc[mi][2 * k], xi[2 * k + 1] + g[2 * k + 1] * acc[mi][2 * k + 1]);
                asm volatile("" ::: "memory");
            }
        });
}

struct MoeBufs { float* PT; float* PE; int* ROWID; int* ROWTOK; bf16_t* HDN; bf16_t* Y; int rpe; int nrows; };
DI MoeBufs moe_bufs(PP p, int layer) {
    MoeBufs m;
    char* a = p->ws + OFF_ARENA;
    if (layer == 0) { m.PT = (float*)(a + A_PT); m.PE = (float*)(a + A_PE); m.ROWID = (int*)(a + A_ROWID); m.ROWTOK = (int*)(a + A_ROWTOK); m.HDN = (bf16_t*)(a + A_HDN); m.Y = (bf16_t*)(a + A_Y); m.rpe = 4352; m.nrows = NTOK; }
    else { m.PT = (float*)(a + A_HB); m.PE = (float*)(a + A_HB + (size_t)NTOK * 64); m.ROWID = (int*)(a + A_HB + (size_t)NTOK * 128); m.ROWTOK = (int*)(a + A_HB + (size_t)NTOK * 192); m.HDN = (bf16_t*)(a + A_XM); m.Y = (bf16_t*)(a + A_XC); m.rpe = 4096; m.nrows = NLAT; }
    return m;
}

DI void phase_router(PP p, lds_t lds, int layer) {
    const int tid = get_tid(), lane = tid & 63;
    const MoeBufs m = moe_bufs(p, layer);
    const bf16_t* X = (const bf16_t*)(p->ws + OFF_ARENA + A_X);
    bf16_t* act = (bf16_t*)(p->ws + OFF_ACT);
    LAS float* rwT = (LAS float*)lds;
    {
        f32x4 wv[8];
#pragma unroll
        for (int q = 0; q < 8; ++q) wv[q] = *(const f32x4*)(p->router_w + (size_t)layer * 16384 + (size_t)(tid + NTHREADS * q) * 4);
#pragma unroll
        for (int q = 0; q < 8; ++q) {
            const int i4 = (tid + NTHREADS * q) * 4, k = i4 >> 4, e0 = i4 & 15;
#pragma unroll
            for (int j = 0; j < 4; ++j) rwT[(e0 + j) * 1024 + k] = wv[q][j];
        }
    }
    __syncthreads();
    const int gw = get_bid() * 8 + (tid >> 6), nw = gridDim.x * 8;
    ModCache mc; mc.s = -1;
    for (int r = gw; r < m.nrows; r += 2 * nw) {
        const int r1 = r + nw;
        const bool has1 = r1 < m.nrows;
        const int r1c = has1 ? r1 : r;
        f32x4 v0[4], v1[4];
        row_load_bf16<true>(X + (size_t)r * 1024, v0, lane);
        row_load_bf16<true>(X + (size_t)r1c * 1024, v1, lane);
        {
            const int set = row_set(r);
            mod_fetch(mc, set, p->norm2_g + layer * 1024, mods_ptr(p, layer, set, 4), mods_ptr(p, layer, set, 3), lane);
            const float rs = rsqrtf(row_sumsq(v0) * (1.f / 1024.f) + EPS);
            row_modulate_c(v0, rs, mc);
            row_store_bf16(act + (size_t)r * 1024, v0, lane);
        }
        {
            const int set = row_set(r1c);
            mod_fetch(mc, set, p->norm2_g + layer * 1024, mods_ptr(p, layer, set, 4), mods_ptr(p, layer, set, 3), lane);
            const float rs = rsqrtf(row_sumsq(v1) * (1.f / 1024.f) + EPS);
            row_modulate_c(v1, rs, mc);
            row_store_bf16(act + (size_t)r1c * 1024, v1, lane);
        }
        float pa[32];
#pragma unroll
        for (int e = 0; e < 16; ++e) {
            float a0 = 0.f, a1 = 0.f;
#pragma unroll
            for (int i = 0; i < 4; ++i) {
                const f32x4 wv = *(const LAS f32x4*)(rwT + e * 1024 + rcol(lane, i));
                a0 += v0[i][0] * wv[0] + v0[i][1] * wv[1] + v0[i][2] * wv[2] + v0[i][3] * wv[3];
                a1 += v1[i][0] * wv[0] + v1[i][1] * wv[1] + v1[i][2] * wv[2] + v1[i][3] * wv[3];
            }
            pa[e] = a0; pa[16 + e] = a1;
            if ((e & 3) == 3) asm volatile("" ::: "memory");
        }
        float k16[16], k8[8], k4[4], k2[2];
        { const bool hi = lane & 32;
#pragma unroll
          for (int j = 0; j < 16; ++j) { const float snd = hi ? pa[j] : pa[j + 16]; k16[j] = (hi ? pa[j + 16] : pa[j]) + __shfl_xor(snd, 32); } }
        { const bool hi = lane & 16;
#pragma unroll
          for (int j = 0; j < 8; ++j) { const float snd = hi ? k16[j] : k16[j + 8]; k8[j] = (hi ? k16[j + 8] : k16[j]) + __shfl_xor(snd, 16); } }
        { const bool hi = lane & 8;
#pragma unroll
          for (int j = 0; j < 4; ++j) { const float snd = hi ? k8[j] : k8[j + 4]; k4[j] = (hi ? k8[j + 4] : k8[j]) + __shfl_xor(snd, 8); } }
        { const bool hi = lane & 4;
#pragma unroll
          for (int j = 0; j < 2; ++j) { const float snd = hi ? k4[j] : k4[j + 2]; k2[j] = (hi ? k4[j + 2] : k4[j]) + __shfl_xor(snd, 4); } }
        float lgt;
        { const bool hi = lane & 2; const float snd = hi ? k2[0] : k2[1]; lgt = (hi ? k2[1] : k2[0]) + __shfl_xor(snd, 2); }
        lgt += __shfl_xor(lgt, 1);
        float mx = lgt;
#pragma unroll
        for (int o = 2; o < 32; o <<= 1) mx = fmaxf(mx, __shfl_xor(mx, o));
        const float ex = __expf(lgt - mx);
        float sum = ex;
#pragma unroll
        for (int o = 2; o < 32; o <<= 1) sum += __shfl_xor(sum, o);
        const float mine = ex * rcpf_(sum);
        const bool second = lane & 32;
        if ((lane & 1) == 0 && (!second || has1)) {
            const int e = (lane >> 1) & 15, rr = second ? r1 : r;
            m.PT[(size_t)rr * 16 + e] = mine;
            if (rr < NLAT) m.PE[((size_t)(rr >> 13) * 16 + e) * 8192 + (rr & 8191)] = mine;
            else { const int rc = rr - NLAT; m.PE[(size_t)NBATCH * 16 * 8192 + ((size_t)(rc >> 8) * 16 + e) * 256 + (rc & 255)] = mine; }
        }
    }
}

DI int block_excl_scan(int v, LAS int* tmp, int* total) {
    const int tid = get_tid(), lane = tid & 63, w = tid >> 6;
    int inc = v;
#pragma unroll
    for (int o = 1; o < 64; o <<= 1) { const int t = __shfl_up(inc, o); if (lane >= o) inc += t; }
    __syncthreads();
    if (lane == 63) tmp[w] = inc;
    __syncthreads();
    int base = 0, tot = 0;
#pragma unroll
    for (int i = 0; i < 8; ++i) { const int t = tmp[i]; if (i < w) base += t; tot += t; }
    *total = tot;
    return base + inc - v;
}

DI void phase_topk(PP p, lds_t lds, int layer) {
    const int tid = get_tid();
    const MoeBufs m = moe_bufs(p, layer);
    LAS unsigned* keys = (LAS unsigned*)lds;
    LAS int* hist = (LAS int*)(keys + 8192);
    LAS int* tmp = hist + 256;
    LAS int* sel = tmp + 16;
    const int ntask = layer == 0 ? 128 : 64;
    if (layer == 1 && get_bid() >= 64) {
        conv_stream(get_bid() - 64, 16 * 768, gridDim.x - 64, [&](int t) { return conv_desc_expert(p, 1, t); }, lds);
        return;
    }
    for (int task = get_bid(); task < ntask; task += gridDim.x) {
        const bool isctx = task >= 64;
        const int b = (task & 63) >> 4, e = task & 15;
        const int n = isctx ? 256 : 8192, cap = isctx ? 32 : 1024;
        const float* src = isctx ? m.PE + (size_t)NBATCH * 16 * 8192 + ((size_t)b * 16 + e) * 256 : m.PE + ((size_t)b * 16 + e) * 8192;
        {
            u32x4 kv[4];
#pragma unroll
            for (int q = 0; q < 4; ++q) { const int i4 = (tid + NTHREADS * q) * 4; kv[q] = (u32x4){0u, 0u, 0u, 0u}; if (i4 < n) kv[q] = *(const u32x4*)(src + i4); }
#pragma unroll
            for (int q = 0; q < 4; ++q) { const int i4 = (tid + NTHREADS * q) * 4; if (i4 < n) *(LAS u32x4*)(keys + i4) = kv[q]; }
        }
        __syncthreads();
        unsigned prefix = 0u, mask = 0u; int kk = cap;
        for (int pass = 3; pass >= 0; --pass) {
            const int shift = pass * 8;
            if (tid < 256) hist[tid] = 0;
            __syncthreads();
            for (int i = tid; i < n; i += NTHREADS) { const unsigned k = keys[i]; if ((k & mask) == prefix) __hip_atomic_fetch_add((int*)(hist + ((k >> shift) & 255)), 1, __ATOMIC_RELAXED, __HIP_MEMORY_SCOPE_WORKGROUP); }
            __syncthreads();
            if (tid < 256) {
                int above = 0;
                for (int j = tid + 1; j < 256; ++j) above += hist[j];
                const int mineh = hist[tid];
                if (above < kk && kk <= above + mineh) { sel[0] = tid; sel[1] = above; }
            }
            __syncthreads();
            prefix |= (unsigned)sel[0] << shift; mask |= 0xffu << shift; kk -= sel[1];
            __syncthreads();
        }
        const unsigned T = prefix; const int need_eq = kk;
        const int ipt = n / NTHREADS > 0 ? n / NTHREADS : 1;
        const int i0 = tid * ipt;
        int cgt = 0, ceq = 0;
        if (i0 < n) for (int j = 0; j < ipt; ++j) { const unsigned k = keys[i0 + j]; cgt += k > T; ceq += k == T; }
        int tot;
        const int egt = block_excl_scan(cgt, tmp, &tot);
        const int eeq = block_excl_scan(ceq, tmp, &tot);
        const int slot0 = e * m.rpe + (isctx ? 4096 + b * 32 : b * 1024);
        const int row0 = isctx ? NLAT + b * 256 : b * 8192;
        if (i0 < n) {
            int ngt = egt, neq = eeq;
            for (int j = 0; j < ipt; ++j) {
                const unsigned k = keys[i0 + j];
                int slot = -1;
                if (k > T) { slot = slot0 + ngt + (neq < need_eq ? neq : need_eq); ++ngt; }
                else if (k == T) { if (neq < need_eq) slot = slot0 + ngt + neq; ++neq; }
                m.ROWID[(size_t)(row0 + i0 + j) * 16 + e] = slot;
                if (slot >= 0) m.ROWTOK[slot] = row0 + i0 + j;
            }
        }
        if (isctx && b == 0 && layer == 0) for (int i = tid; i < 128; i += NTHREADS) m.ROWTOK[e * m.rpe + 4224 + i] = -1;
        __syncthreads();
    }
}

DI void phase_moe_up(PP p, lds_t lds, int layer) {
    const MoeBufs m = moe_bufs(p, layer);
    const bf16_t* act = (const bf16_t*)(p->ws + OFF_ACT);
    auto run = [&](int NM, int mt0, int TM, int TN) {
        struct { const int* rt; const bf16_t* act; int rpe, mt0;
                 DI int idx(const U3& u, int r) const { return rt[u.b * rpe + (mt0 + u.m) * 256 + r]; }
                 DI const bf16_t* row(int tok) const { return act + (size_t)(tok < 0 ? 0 : tok) * 1024; } } ga{m.ROWTOK, act, m.rpe, mt0};
        gemm_multi<64, true, 8, false, true>(lds, 1024, 16, NM, 8, TM, TN, ga,
            [&](const U3& u) { return (const bf16_t*)((const char*)p->out + DO_EXP + (size_t)u.b * EXP_STRIDE) + (size_t)(u.n * 256) * 1024; },
            [&](const U3& u, const f32x4 (&acc)[8][4], int wr, int wc, int lane) {
                bf16_t* H = m.HDN + ((size_t)u.b * m.rpe + (mt0 + u.m) * 256) * 1024 + u.n * 128;
#pragma unroll
                for (int mi = 0; mi < 8; ++mi) {
                    f32x4 h0, h1;
#pragma unroll
                    for (int j = 0; j < 4; ++j) { h0[j] = siluf_(acc[mi][0][j]) * acc[mi][2][j]; h1[j] = siluf_(acc[mi][1][j]) * acc[mi][3][j]; }
                    store_bf16x8(H + (size_t)(wr * 128 + mi * 16 + (lane & 15)) * 1024 + wc * 32 + 8 * (lane >> 4), h0, h1);
                }
            });
    };
    run(16, 0, 4, 8);
    if (layer == 0) run(1, 16, 1, 8);
}

template <int PROBE>
DI void phase_moe_down_t(PP p, lds_t lds, int layer) {
    const MoeBufs m = moe_bufs(p, layer);
    auto run = [&](int NM, int mt0, int TM, int TN) {
        gemm_multi<64, true>(lds, 1024, 16, NM, 4, TM, TN,
            [&](const U3& u, int r) { return m.HDN + ((size_t)u.b * m.rpe + (mt0 + u.m) * 256 + r) * 1024; },
            [&](const U3& u) { return (const bf16_t*)((const char*)p->out + DO_EXP + (size_t)u.b * EXP_STRIDE) + (size_t)(2048 + u.n * 256) * 1024; },
            [&](const U3& u, const f32x4 (&acc)[8][4], int wr, int wc, int lane) {
                bf16_t* Y = m.Y + ((size_t)u.b * m.rpe + (mt0 + u.m) * 256) * 1024 + u.n * 256;
                epi_each8(acc, wr, wc, lane, [&](int r, int c, f32x4 v0, f32x4 v1) { store_bf16x8(Y + (size_t)r * 1024 + c, v0, v1); });
            });
    };
    run(16, 0, 8, 4);
    if (layer == 0) run(1, 16, 1, 4);
}

DI void phase_moe_down(PP p, lds_t lds, int layer) { phase_moe_down_t<0>(p, lds, layer); }

DI void phase_combine(PP p, int layer) {
    const int tid = get_tid(), lane = tid & 63;
    const MoeBufs m = moe_bufs(p, layer);
    bf16_t* X = (bf16_t*)(p->ws + OFF_ARENA + A_X);
    bf16_t* act = (bf16_t*)(p->ws + OFF_ACT);
    const int gw = get_bid() * 8 + (tid >> 6), nw = gridDim.x * 8;
    ModCache mc; mc.s = -1; f32x4 g2v[4]; int g2s = -1;
    for (int r = gw; r < m.nrows; r += nw) {
        f32x4 v[4], a[4];
        row_load_bf16<true>(X + (size_t)r * 1024, v, lane);
#pragma unroll
        for (int i = 0; i < 4; ++i) a[i] = (f32x4){0.f, 0.f, 0.f, 0.f};
        int rid = -1; float pe = 0.f;
        if (lane < 16) { rid = m.ROWID[(size_t)r * 16 + lane]; pe = m.PT[(size_t)r * 16 + lane]; }
        unsigned long long mask = __ballot(rid >= 0);
        while (mask) {
            int ee[4];
#pragma unroll
            for (int q = 0; q < 4; ++q) { ee[q] = mask ? __builtin_ctzll(mask) : 63; mask &= mask - 1; }
            u32x4 y0[4], y1[4]; float pq[4];
#pragma unroll
            for (int q = 0; q < 4; ++q) {
                const int rq = __shfl(rid, ee[q]); pq[q] = rq >= 0 ? __shfl(pe, ee[q]) : 0.f;
                const bf16_t* y = m.Y + (size_t)(rq >= 0 ? rq : 0) * 1024;
                y0[q] = __builtin_nontemporal_load((const u32x4*)(y + 8 * lane)); y1[q] = __builtin_nontemporal_load((const u32x4*)(y + 512 + 8 * lane));
            }
#pragma unroll
            for (int q = 0; q < 4; ++q) {
                const float w_ = pq[q];
                a[0][0] += w_ * lo_bf(y0[q].x); a[0][1] += w_ * hi_bf(y0[q].x); a[0][2] += w_ * lo_bf(y0[q].y); a[0][3] += w_ * hi_bf(y0[q].y);
                a[1][0] += w_ * lo_bf(y0[q].z); a[1][1] += w_ * hi_bf(y0[q].z); a[1][2] += w_ * lo_bf(y0[q].w); a[1][3] += w_ * hi_bf(y0[q].w);
                a[2][0] += w_ * lo_bf(y1[q].x); a[2][1] += w_ * hi_bf(y1[q].x); a[2][2] += w_ * lo_bf(y1[q].y); a[2][3] += w_ * hi_bf(y1[q].y);
                a[3][0] += w_ * lo_bf(y1[q].z); a[3][1] += w_ * hi_bf(y1[q].z); a[3][2] += w_ * lo_bf(y1[q].w); a[3][3] += w_ * hi_bf(y1[q].w);
            }
        }
        const int set = row_set(r);
        if (set != g2s) {
            g2s = set;
            const float* g2 = mods_ptr(p, layer, set, 5);
#pragma unroll
            for (int i = 0; i < 4; ++i) g2v[i] = *(const f32x4*)(g2 + rcol(lane, i));
        }
#pragma unroll
        for (int i = 0; i < 4; ++i) v[i] = v[i] + g2v[i] * a[i];
        const float rs = rsqrtf(row_sumsq(v) * (1.f / 1024.f) + EPS);
        if (layer == 0) {
            row_store_bf16(X + (size_t)r * 1024, v, lane);
            mod_fetch(mc, set, p->norm1_g + 1024, mods_ptr(p, 1, set, 1), mods_ptr(p, 1, set, 0), lane);
            row_modulate_c(v, rs, mc);
            row_store_bf16(act + (size_t)r * 1024, v, lane);
        } else {
            if (mc.s != 0) { mc.s = 0;
#pragma unroll
                for (int i = 0; i < 4; ++i) mc.a[i] = *(const f32x4*)(p->final_g + rcol(lane, i)); }
#pragma unroll
            for (int i = 0; i < 4; ++i) *(f32x4*)(p->out + (size_t)r * 1024 + rcol(lane, i)) = v[i] * rs * mc.a[i];
        }
    }
}


DI void phase_upproj(PP p, lds_t lds, int half) {
    const bf16_t* act = (const bf16_t*)(p->ws + OFF_ACT);
    bf16_t* O = (bf16_t*)(p->ws + OFF_ARENA + A_XM);
    const int NM = half == 0 ? NTOK / 256 : NLAT / 256, NN = 8;
    gemm_multi<64, true>(lds, 1024, 1, NM, NN, 8, 4,
        [&](const U3& u, int r) { return act + (size_t)(u.m * 256 + r) * 1024; },
        [&](const U3& u) { return (const bf16_t*)(p->ws + OFF_WUPT) + (size_t)(half * 2048 + u.n * 256) * 1024; },
        [&](const U3& u, const f32x4 (&acc)[8][4], int wr, int wc, int lane) {
            epi_each8(acc, wr, wc, lane, [&](int r, int c, f32x4 v0, f32x4 v1) { store_bf16x8(O + (size_t)(u.m * 256 + r) * 2048 + u.n * 256 + c, v0, v1); });
        });
}

DI void phase_mfeat(PP p, lds_t lds, bool shadow = false) {
    const int tid = get_tid(), lane = tid & 63, w = tid >> 6;
    bf16_t* XM = (bf16_t*)(p->ws + OFF_ARENA + A_XM);
    bf16_t* XC = (bf16_t*)(p->ws + OFF_ARENA + A_XC);
    bf16_t* CTXV = (bf16_t*)(p->ws + OFF_SCR + ACT_CTXV);
    bf16_t* RAWS = (bf16_t*)(p->ws + OFF_SCR + ACT_RAWS);
    float* GP = (float*)(p->ws + OFF_SCR + ACT_GP);
    const bf16_t* GC = (const bf16_t*)(p->ws + OFF_GCAT);
    const float* MM = (const float*)(p->ws + OFF_MMAT);
    LAS bf16_t* xin = (LAS bf16_t*)lds;
    LAS bf16_t* xct = xin + 67 * 136;
    LAS bf16_t* qpt = xct + 64 * 136;
    LAS float* gred = (LAS float*)(qpt + 64 * 136);
    LAS bf16_t* gxa = (LAS bf16_t*)(gred + 2048);
    LAS bf16_t* gma = gxa + 512 * 16;
    LAS float* mqa = (LAS float*)(gma + 512 * 16);
    LAS float* wva = mqa + 2048;
    LAS float* cwa = wva + 2048;
    int h_loaded = -1;
    u32x4 xr[3];
    auto load_xin = [&](int task, int q4) {
        const int ch = task >> 2, hh = task & 3, r0 = ch * 64, col0 = hh * 512 + q4 * 128;
        const int seg_lo = ch < NCHL ? r0 : NLAT + ((r0 - NLAT) >> 8) * 256, seg_hi = ch < NCHL ? r0 + 64 : seg_lo + 256;
#pragma unroll
        for (int k = 0; k < 3; ++k) {
            const int i = tid + k * NTHREADS, row = i >> 4, chunk = i & 15, r = r0 - 2 + row;
            xr[k] = (u32x4){0u, 0u, 0u, 0u};
            if (i < 67 * 16 && r >= seg_lo && r < seg_hi) xr[k] = __builtin_nontemporal_load((const u32x4*)(XM + (size_t)r * 2048 + col0 + chunk * 8));
        }
    };
    const int task0 = get_bid();
    if (task0 < NCH * 4) load_xin(task0, 0);
    for (int task = task0; task < NCH * 4; task += gridDim.x) {
        const int ch = task >> 2, h = task & 3, r0 = ch * 64;
        if (h != h_loaded) {
            h_loaded = h;
            for (int i = tid; i < 1024; i += NTHREADS) { *(LAS u32x4*)(gxa + i * 8) = *(const u32x4*)(GC + (size_t)h * 512 * 16 + i * 8); *(LAS u32x4*)(gma + i * 8) = *(const u32x4*)(GC + (size_t)(2048 + h * 512) * 16 + i * 8); }
            for (int i = tid; i < 2048; i += NTHREADS) { const int nb_ = i >> 4, ii = (i >> 2) & 3, o_ = i & 3, j_ = (((nb_ & 3) * 4 + ii) * 32 + (nb_ >> 2)) * 4 + o_; mqa[j_] = bf2f(f2bf(MM[(size_t)h * 2048 + i])); wva[j_] = p->m_wv[(size_t)h * 2048 + i]; }
            for (int i = tid; i < 2560; i += NTHREADS) { const int tap_ = i >> 9, c_ = i & 511; cwa[((tap_ * 4 + ((c_ >> 2) & 3)) * 32 + (c_ >> 4)) * 4 + (c_ & 3)] = i < 2048 ? p->m_conv_w[(size_t)tap_ * 2048 + h * 512 + c_] : p->m_conv_b[h * 512 + c_]; }
        }
        f32x4 rs_acc[2] = {{0.f, 0.f, 0.f, 0.f}, {0.f, 0.f, 0.f, 0.f}};
        f32x4 g_acc = {0.f, 0.f, 0.f, 0.f};
        for (int q4 = 0; q4 < 4; ++q4) {
            const int col0 = h * 512 + q4 * 128;
#pragma unroll
            for (int k = 0; k < 3; ++k) { const int i = tid + k * NTHREADS; if (i < 67 * 16) *(LAS u32x4*)(xin + (i >> 4) * 136 + (i & 15) * 8) = xr[k]; }
            __syncthreads();
            if (q4 < 3) load_xin(task, q4 + 1); else if (task + (int)gridDim.x < NCH * 4) load_xin(task + gridDim.x, 0);
            {
                const int t = tid >> 3, c16 = (tid & 7) * 16, hc = q4 * 128 + c16;
                float xc[16], xm[16];
                {
                    const u32x4 a0 = *(const LAS u32x4*)(xin + (t + 2) * 136 + c16), a1 = *(const LAS u32x4*)(xin + (t + 2) * 136 + c16 + 8);
                    const unsigned aw[8] = {a0.x, a0.y, a0.z, a0.w, a1.x, a1.y, a1.z, a1.w};
#pragma unroll
                    for (int j = 0; j < 8; ++j) { xm[2 * j] = lo_bf(aw[j]); xm[2 * j + 1] = hi_bf(aw[j]); }
#pragma unroll
                    for (int j4 = 0; j4 < 4; ++j4) { const f32x4 bb = *(const LAS f32x4*)(cwa + ((16 + j4) * 32 + (hc >> 4)) * 4); xc[4 * j4] = bb[0]; xc[4 * j4 + 1] = bb[1]; xc[4 * j4 + 2] = bb[2]; xc[4 * j4 + 3] = bb[3]; }
                }
#pragma unroll
                for (int tap = 0; tap < 4; ++tap) {
                    const u32x4 a0 = *(const LAS u32x4*)(xin + (t + tap) * 136 + c16), a1 = *(const LAS u32x4*)(xin + (t + tap) * 136 + c16 + 8);
                    const unsigned aw[8] = {a0.x, a0.y, a0.z, a0.w, a1.x, a1.y, a1.z, a1.w};
#pragma unroll
                    for (int j4 = 0; j4 < 4; ++j4) {
                        const f32x4 ww = *(const LAS f32x4*)(cwa + ((tap * 4 + j4) * 32 + (hc >> 4)) * 4);
                        xc[4 * j4] += ww[0] * lo_bf(aw[2 * j4]); xc[4 * j4 + 1] += ww[1] * hi_bf(aw[2 * j4]); xc[4 * j4 + 2] += ww[2] * lo_bf(aw[2 * j4 + 1]); xc[4 * j4 + 3] += ww[3] * hi_bf(aw[2 * j4 + 1]);
                    }
                }
                unsigned xcp[8];
#pragma unroll
                for (int j = 0; j < 8; ++j) { xcp[j] = pk2(siluf_(xc[2 * j]), siluf_(xc[2 * j + 1])); xc[2 * j] = lo_bf(xcp[j]); xc[2 * j + 1] = hi_bf(xcp[j]); }
                float vv[16], qp[16];
#pragma unroll
                for (int n = 0; n < 4; ++n) {
                    const int g_ = hc >> 4;
                    f32x4 a = {0.f, 0.f, 0.f, 0.f}, bq = a;
#pragma unroll
                    for (int i = 0; i < 4; ++i) {
                        const f32x4 wr_ = *(const LAS f32x4*)(wva + ((n * 4 + i) * 32 + g_) * 4), mr_ = *(const LAS f32x4*)(mqa + ((n * 4 + i) * 32 + g_) * 4);
                        a = a + wr_ * xm[4 * n + i]; bq = bq + mr_ * xc[4 * n + i];
                    }
#pragma unroll
                    for (int o = 0; o < 4; ++o) { vv[4 * n + o] = a[o]; qp[4 * n + o] = bq[o]; }
                }
                u32x4 v0, v1;
                v0.x = xcp[0]; v0.y = xcp[1]; v0.z = xcp[2]; v0.w = xcp[3]; v1.x = xcp[4]; v1.y = xcp[5]; v1.z = xcp[6]; v1.w = xcp[7];
                *(LAS u32x4*)(xct + t * 136 + c16) = v0; *(LAS u32x4*)(xct + t * 136 + c16 + 8) = v1;
                bf16_t* xcg = XC + (size_t)(r0 + t) * 2048 + col0 + c16;
                *(u32x4*)xcg = v0; *(u32x4*)(xcg + 8) = v1;
                v0.x = pk2(qp[0], qp[1]); v0.y = pk2(qp[2], qp[3]); v0.z = pk2(qp[4], qp[5]); v0.w = pk2(qp[6], qp[7]);
                v1.x = pk2(qp[8], qp[9]); v1.y = pk2(qp[10], qp[11]); v1.z = pk2(qp[12], qp[13]); v1.w = pk2(qp[14], qp[15]);
                *(LAS u32x4*)(qpt + t * 136 + c16) = v0; *(LAS u32x4*)(qpt + t * 136 + c16 + 8) = v1;
                v0.x = pk2(vv[0], vv[1]); v0.y = pk2(vv[2], vv[3]); v0.z = pk2(vv[4], vv[5]); v0.w = pk2(vv[6], vv[7]);
                v1.x = pk2(vv[8], vv[9]); v1.y = pk2(vv[10], vv[11]); v1.z = pk2(vv[12], vv[13]); v1.w = pk2(vv[14], vv[15]);
                bf16_t* vg = ch < NCHL ? XM + (size_t)(r0 + t) * 2048 + col0 + c16 : CTXV + (size_t)(r0 + t - NLAT) * 2048 + col0 + c16;
                if (!shadow) { *(u32x4*)vg = v0; *(u32x4*)(vg + 8) = v1; }
            }
            __syncthreads();
            {
                const int tt = w >> 1;
#pragma unroll
                for (int e = 0; e < 2; ++e) {
                    const int st = (w & 1) * 2 + e;
#pragma unroll
                    for (int ks = 0; ks < 4; ++ks) rs_acc[e] = mfma16(frag_row(xct, 136, st * 16, ks * 32, lane), frag_row(qpt, 136, tt * 16, ks * 32, lane), rs_acc[e]);
                }
                const int gt = w & 3, src = w >> 2;
                const LAS bf16_t* gm = (src ? gma : gxa) + q4 * 128 * 16;
                const LAS bf16_t* ft = src ? xin + 2 * 136 : xct;
#pragma unroll
                for (int ks = 0; ks < 4; ++ks) g_acc = mfma16(frag_tr(gm, 16, ks * 32, 0, lane), frag_row(ft, 136, gt * 16, ks * 32, lane), g_acc);
            }
            __syncthreads();
        }
        {
            const int tt = w >> 1;
#pragma unroll
            for (int e = 0; e < 2; ++e) {
                const int st = (w & 1) * 2 + e;
                store_bf16x4(RAWS + ((size_t)task * 64 + tt * 16 + (lane & 15)) * 64 + st * 16 + 4 * (lane >> 4), rs_acc[e]);
            }
            const int gt = w & 3, src = w >> 2;
            *(LAS f32x4*)(gred + (src * 64 + gt * 16 + (lane & 15)) * 16 + 4 * (lane >> 4)) = g_acc;
        }
        __syncthreads();
        if (tid < 256) {
            const int t = tid >> 2, q = tid & 3;
            const f32x4 a = *(const LAS f32x4*)(gred + t * 16 + q * 4), b = *(const LAS f32x4*)(gred + (64 + t) * 16 + q * 4);
            *(f32x4*)(GP + ((size_t)(r0 + t) * 4 + h) * 16 + q * 4) = a + b;
        }
        __syncthreads();
    }
}

constexpr int MS_KLD = 1056, MS_QLD = 1040;
constexpr size_t ACT_MSC = 32u << 20;
static_assert(ACT_MSC >= ACT_CTXV + (size_t)NCTX * 2048 * 2 && ACT_MSC + (size_t)256 * 132 * 192 * 4 <= ACT_BYTES, "msc scratch");
constexpr int MS_SCW = 6 * 64 + 8 + 64;
#define MS_REGIONS(L) \
    lds_t xct = (L);                                                         \
    lds_t qpt = (L) + 64 * MS_KLD;                                           \
    LAS bf16_t* vt = (LAS bf16_t*)((L) + 64 * MS_KLD + 64 * MS_QLD);         \
    LAS bf16_t* St = vt + 4096;                                              \
    LAS bf16_t* vwt = St + 4096;                                             \
    LAS float* scbase = (LAS float*)(vwt + 4096);                            \
    LAS float* red = (LAS float*)qpt;
#define MS_SC(SET) \
    LAS float* sc_b = scbase + (SET) * MS_SCW; LAS float* sc_m = sc_b + 64; LAS float* sc_e = sc_m + 64; LAS float* sc_w = sc_e + 64; \
    LAS float* sc_di = sc_w + 64; LAS float* sc_rs = sc_di + 64; LAS float* sc_misc = sc_rs + 64; LAS float* qn = sc_misc + 8;
DI void phase_mscan(PP p, lds_t lds) {
    const int tid = get_tid(), lane = tid & 63, w = tid >> 6, bid = get_bid();
    if (bid >= 256) return;
    const int grp = bid & 31, sl = bid >> 5, b = grp >> 3, h = (grp >> 1) & 3, d = grp & 1;
    const bf16_t* XC = (const bf16_t*)(p->ws + OFF_ARENA + A_XC);
    const bf16_t* V = (const bf16_t*)(p->ws + OFF_ARENA + A_XM);
    const bf16_t* CTXV = (const bf16_t*)(p->ws + OFF_SCR + ACT_CTXV);
    const bf16_t* RAWS = (const bf16_t*)(p->ws + OFF_SCR + ACT_RAWS);
    const float* GP = (const float*)(p->ws + OFF_SCR + ACT_GP);
    float* MSC = (float*)(p->ws + OFF_SCR + ACT_MSC) + (size_t)bid * 132 * 192;
    bf16_t* H = d == 0 ? (bf16_t*)p->out : (bf16_t*)(p->ws + OFF_ARENA + A_HB);
    static_assert(64 * MS_KLD + 64 * MS_QLD + 3 * 8192 + 2 * MS_SCW * 4 <= LDS_BYTES, "mscan lds");
    {
        const float bias_i = p->m_b_gates[d * 8 + h], bias_f = p->m_b_gates[d * 8 + 4 + h];
        for (int st = w; st < 132; st += 8) {
            const int cid = scan_chunk(b, d, st), t = d ? 63 - lane : lane;
            const float* gp = GP + (size_t)(cid * 64 + t) * 64;
            const float gli = gp[d * 8 + h] + gp[16 + d * 8 + h] + gp[32 + d * 8 + h] + gp[48 + d * 8 + h] + bias_i;
            const float gf = gp[d * 8 + 4 + h] + gp[16 + d * 8 + 4 + h] + gp[32 + d * 8 + 4 + h] + gp[48 + d * 8 + 4 + h] + bias_f;
            float bb = log_sigmoidf_(gf);
#pragma unroll
            for (int o = 1; o < 64; o <<= 1) { const float t_ = __shfl_up(bb, o); if (lane >= o) bb += t_; }
            float pm = gli - bb;
#pragma unroll
            for (int o = 1; o < 64; o <<= 1) { const float t_ = __shfl_up(pm, o); if (lane >= o) pm = fmaxf(pm, t_); }
            float* dst = MSC + (size_t)st * 192;
            dst[lane] = bb; dst[64 + lane] = gli; dst[128 + lane] = pm;
        }
    }
    const int c16o = tid & 63;
    bf16x2_t Mp[2][4][2];
#pragma unroll
    for (int n = 0; n < 2; ++n) {
        const float* mm = (const float*)(p->ws + OFF_MMAT) + (size_t)(h * 128 + 2 * c16o + n) * 16;
#pragma unroll
        for (int o = 0; o < 4; ++o) { Mp[n][o][0] = __builtin_bit_cast(bf16x2_t, pk2(mm[o], mm[4 + o])); Mp[n][o][1] = __builtin_bit_cast(bf16x2_t, pk2(mm[8 + o], mm[12 + o])); }
    }
    f32x4 C[16], Nacc[4];
#pragma unroll
    for (int i = 0; i < 16; ++i) C[i] = (f32x4){0.f, 0.f, 0.f, 0.f};
#pragma unroll
    for (int i = 0; i < 4; ++i) Nacc[i] = (f32x4){0.f, 0.f, 0.f, 0.f};
    float m_prev = 0.f;
    unsigned long long prof_acc = 0;
    u32x4 xcr[8], vr, rr; float g_b = 0.f, g_li = 0.f, g_pm = 0.f;
    asm volatile("s_waitcnt vmcnt(0)" ::: "memory");
    __syncthreads();
    auto prefetch = [&](int st) {
        int tp = get_tid();
        const int tid = tp, lane = tid & 63, w = tid >> 6;
        const int cid = scan_chunk(b, d, st), r0 = cid * 64;
        const bf16_t* xp = XC + (size_t)(r0 + (tid >> 6)) * 2048 + h * 512 + (tid & 63) * 8;
#pragma unroll
        for (int i = 0; i < 8; ++i) xcr[i] = *(const u32x4*)(xp + (size_t)i * 8 * 2048);
        { const int s_ = tid >> 3, chunk = tid & 7;
          vr = cid < NCHL ? *(const u32x4*)(V + (size_t)(r0 + s_) * 2048 + h * 512 + sl * 64 + chunk * 8) : *(const u32x4*)(CTXV + (size_t)(r0 + s_ - NLAT) * 2048 + h * 512 + sl * 64 + chunk * 8);
          rr = *(const u32x4*)(RAWS + ((size_t)(cid * 4 + h) * 64 + s_) * 64 + chunk * 8); }
    };
    auto prefetch_g = [&](int st) { if (w == 0) { const float* src = MSC + (size_t)st * 192; g_b = src[lane]; g_li = src[64 + lane]; g_pm = src[128 + lane]; } };
    auto scalars = [&](int set) {
        if (w == 0) {
            MS_REGIONS(lds) MS_SC(set) (void)xct; (void)vt; (void)red; (void)sc_rs;
            const float my_m = g_b + fmaxf(m_prev, g_pm);
            const float m_new = __shfl(my_m, 63), b_last = __shfl(g_b, 63);
            const int t = d ? 63 - lane : lane;
            sc_b[t] = g_b; sc_m[t] = my_m; sc_e[t] = g_li - g_b; sc_w[t] = __expf(b_last - g_b + g_li - m_new); sc_di[t] = __expf(g_b + m_prev - my_m);
            qn[lane] = 0.f;
            if (lane == 0) sc_misc[0] = __expf(b_last + m_prev - m_new);
            m_prev = m_new;
        }
    };
    prefetch(0);
    prefetch_g(0);
    scalars(0);
    for (int st = 0; st < 132; ++st) {
        const int cid = scan_chunk(b, d, st);
        const bool emit = cid < NCHL;
        int tl = tid, zoff = 0;
        asm volatile("" : "+v"(tl), "+v"(zoff));
        const int tid = tl, lane = tid & 63, w = tid >> 6, cg = w & 3, kh = w >> 2, g4 = lane >> 4, l15 = lane & 15, c16 = tid & 63, srow0 = tid >> 6;
        MS_REGIONS(lds + zoff)
        MS_SC(st & 1)
        unsigned long long pt0 = 0; if (PROF_SEC >= 0) pt0 = __builtin_amdgcn_s_memtime();
        __syncthreads();
        if (PROF_SEC == 3) prof_acc += __builtin_amdgcn_s_memtime() - pt0;
        if (PROF_SEC >= 0) pt0 = __builtin_amdgcn_s_memtime();
        {
            lds_t xw_ = xct + srow0 * MS_KLD + c16 * 16;
            lds_t qw_ = qpt + srow0 * MS_QLD + c16 * 16;
#pragma unroll
            for (int i = 0; i < 8; ++i) {
                const unsigned xw[4] = {xcr[i].x, xcr[i].y, xcr[i].z, xcr[i].w};
                float q[8];
#pragma unroll
                for (int n = 0; n < 2; ++n)
#pragma unroll
                    for (int o = 0; o < 4; ++o)
                        q[4 * n + o] = __builtin_amdgcn_fdot2_f32_bf16(__builtin_bit_cast(bf16x2_t, xw[2 * n + 1]), Mp[n][o][1], __builtin_amdgcn_fdot2_f32_bf16(__builtin_bit_cast(bf16x2_t, xw[2 * n]), Mp[n][o][0], 0.f, false), false);
                u32x4 qv; qv.x = pk2(q[0], q[1]); qv.y = pk2(q[2], q[3]); qv.z = pk2(q[4], q[5]); qv.w = pk2(q[6], q[7]);
                *(LAS u32x4*)(xw_ + i * 8 * MS_KLD) = xcr[i];
                *(LAS u32x4*)(qw_ + i * 8 * MS_QLD) = qv;
            }
        }
        {
            const int t = tid >> 3, s8 = (tid & 7) * 8;
            *(LAS u32x4*)(vt + t * 64 + s8) = vr;
            {
                const float ww = sc_w[t];
                u32x4 o; o.x = pk2(lo_bf(vr.x) * ww, hi_bf(vr.x) * ww); o.y = pk2(lo_bf(vr.y) * ww, hi_bf(vr.y) * ww); o.z = pk2(lo_bf(vr.z) * ww, hi_bf(vr.z) * ww); o.w = pk2(lo_bf(vr.w) * ww, hi_bf(vr.w) * ww);
                *(LAS u32x4*)(vwt + t * 64 + s8) = o;
            }
            if (emit) {
                const unsigned rwv[4] = {rr.x, rr.y, rr.z, rr.w};
                const float base = sc_b[t] - sc_m[t];
                const f32x4 e0 = *(const LAS f32x4*)(sc_e + s8), e1 = *(const LAS f32x4*)(sc_e + s8 + 4);
                float sv[8]; float rsum = 0.f;
#pragma unroll
                for (int j = 0; j < 8; ++j) {
                    const int s_ = s8 + j;
                    const float raw = (j & 1) ? hi_bf(rwv[j >> 1]) : lo_bf(rwv[j >> 1]);
                    const bool keep = d == 0 ? s_ <= t : s_ >= t;
                    const float ex = __expf(base + (j < 4 ? e0[j & 3] : e1[j & 3]));
                    sv[j] = keep ? raw * ex : 0.f;
                    rsum += sv[j];
                }
                u32x4 o; o.x = pk2(sv[0], sv[1]); o.y = pk2(sv[2], sv[3]); o.z = pk2(sv[4], sv[5]); o.w = pk2(sv[6], sv[7]);
                *(LAS u32x4*)(St + t * 64 + s8) = o;
                rsum += __shfl_xor(rsum, 1); rsum += __shfl_xor(rsum, 2); rsum += __shfl_xor(rsum, 4);
                if ((tid & 7) == 0) sc_rs[t] = rsum;
            }
        }
        if (PROF_SEC == 0) prof_acc += __builtin_amdgcn_s_memtime() - pt0;
        if (PROF_SEC >= 0) pt0 = __builtin_amdgcn_s_memtime();
        __syncthreads();
        const int kq = w >> 1, cgp = w & 1;
        const int kq_s = __builtin_amdgcn_readfirstlane(kq), cgp_s = __builtin_amdgcn_readfirstlane(cgp);
        f32x4 acc2[4][2], accq[4];
#pragma unroll
        for (int tt = 0; tt < 4; ++tt) { acc2[tt][0] = (f32x4){0.f, 0.f, 0.f, 0.f}; acc2[tt][1] = acc2[tt][0]; accq[tt] = acc2[tt][0]; }
        if (emit) {
            lds_t qa = qpt + l15 * MS_QLD + (kq * 128 + 4 * g4) * 2;
#pragma unroll
            for (int m = 0; m < 4; ++m) {
                u32x2 qb[1][4][2];
#pragma unroll
                for (int tt = 0; tt < 4; ++tt) { qb[0][tt][0] = *(const LAS u32x2*)(qa + tt * 16 * MS_QLD + m * 64); qb[0][tt][1] = *(const LAS u32x2*)(qa + tt * 16 * MS_QLD + m * 64 + 32); }
                bf16x8 cf[2];
#pragma unroll
                for (int dvt = 0; dvt < 2; ++dvt) {
                    const f32x4 c0 = C[(2 * m) * 2 + dvt], c1 = C[(2 * m + 1) * 2 + dvt];
                    u32x4 cb; cb.x = pk2(c0[0], c0[1]); cb.y = pk2(c0[2], c0[3]); cb.z = pk2(c1[0], c1[1]); cb.w = pk2(c1[2], c1[3]);
                    cf[dvt] = __builtin_bit_cast(bf16x8, cb);
                }
                const bool own = (m >> 1) == cgp_s;
                bf16x8 nf = cf[0];
                if (own) { const int pi = (m & 1) * 2; u32x4 nb; nb.x = pk2(Nacc[pi][0], Nacc[pi][1]); nb.y = pk2(Nacc[pi][2], Nacc[pi][3]); nb.z = pk2(Nacc[pi + 1][0], Nacc[pi + 1][1]); nb.w = pk2(Nacc[pi + 1][2], Nacc[pi + 1][3]); nf = __builtin_bit_cast(bf16x8, nb); }
#pragma unroll
                for (int tt = 0; tt < 4; ++tt) {
                    u32x4 av; av.x = qb[0][tt][0].x; av.y = qb[0][tt][0].y; av.z = qb[0][tt][1].x; av.w = qb[0][tt][1].y;
                    const bf16x8 qf = __builtin_bit_cast(bf16x8, av);
                    acc2[tt][0] = mfma16(cf[0], qf, acc2[tt][0]);
                    acc2[tt][1] = mfma16(cf[1], qf, acc2[tt][1]);
                    if (own) accq[tt] = mfma16(nf, qf, accq[tt]);
                }
            }
#pragma unroll
            for (int tt = 0; tt < 4; ++tt) { const float dd = sc_di[tt * 16 + l15]; acc2[tt][0] = acc2[tt][0] * dd; acc2[tt][1] = acc2[tt][1] * dd; }
            if (kq_s < 2) {
                const bf16x8 vf0 = frag_tr(vt, 64, kq * 32, cgp * 32, lane), vf1 = frag_tr(vt, 64, kq * 32, cgp * 32 + 16, lane);
#pragma unroll
                for (int tt = 0; tt < 4; ++tt) {
                    const bf16x8 sf = frag_row(St, 64, tt * 16, kq * 32, lane);
                    acc2[tt][0] = mfma16(vf0, sf, acc2[tt][0]);
                    acc2[tt][1] = mfma16(vf1, sf, acc2[tt][1]);
                }
            }
            if (g4 == 0) {
#pragma unroll
                for (int tt = 0; tt < 4; ++tt) __hip_atomic_fetch_add((float*)(qn + tt * 16 + l15), accq[tt][0], __ATOMIC_RELAXED, __HIP_MEMORY_SCOPE_WORKGROUP);
            }
        }
        if (st + 1 < 132) prefetch_g(st + 1);
        {
            const float gd = sc_misc[0];
            bf16x8 vb[2][2], wf[2];
#pragma unroll
            for (int ks = 0; ks < 2; ++ks) {
                vb[0][ks] = frag_tr_swp(vwt, 64, ks * 32, cgp * 32, lane);
                vb[1][ks] = frag_tr_swp(vwt, 64, ks * 32, cgp * 32 + 16, lane);
                const int sw = (g4 & 1) * 4;
                const f32x4 w0 = *(const LAS f32x4*)(sc_w + ks * 32 + 8 * g4 + sw), w1 = *(const LAS f32x4*)(sc_w + ks * 32 + 8 * g4 + 4 - sw);
                u32x4 wp; wp.x = pk2(w0[0], w0[1]); wp.y = pk2(w0[2], w0[3]); wp.z = pk2(w1[0], w1[1]); wp.w = pk2(w1[2], w1[3]);
                if (l15 != 0) wp = (u32x4){0u, 0u, 0u, 0u};
                wf[ks] = __builtin_bit_cast(bf16x8, wp);
            }
#pragma unroll
            for (int j = 0; j < 4; ++j) Nacc[j] = Nacc[j] * gd;
            const int swk = (g4 & 1) * 4;
            lds_t ka = xct + (8 * g4 + (l15 >> 2) + swk) * MS_KLD + (kq * 128 + 4 * (l15 & 3)) * 2;
            const int hio = (4 - 2 * swk) * MS_KLD;
            s16x4 kb[2][2][2];
#pragma unroll
            for (int ks = 0; ks < 2; ++ks) {
                kb[0][ks][0] = __builtin_amdgcn_ds_read_tr16_b64_v4i16((LAS s16x4*)(ka + ks * 32 * MS_KLD));
                kb[0][ks][1] = __builtin_amdgcn_ds_read_tr16_b64_v4i16((LAS s16x4*)(ka + ks * 32 * MS_KLD + hio));
            }
#pragma unroll
            for (int i = 0; i < 8; ++i) {
                if (i + 1 < 8) {
#pragma unroll
                    for (int ks = 0; ks < 2; ++ks) {
                        kb[(i + 1) & 1][ks][0] = __builtin_amdgcn_ds_read_tr16_b64_v4i16((LAS s16x4*)(ka + ks * 32 * MS_KLD + (i + 1) * 32));
                        kb[(i + 1) & 1][ks][1] = __builtin_amdgcn_ds_read_tr16_b64_v4i16((LAS s16x4*)(ka + ks * 32 * MS_KLD + hio + (i + 1) * 32));
                    }
                }
                C[2 * i] = C[2 * i] * gd; C[2 * i + 1] = C[2 * i + 1] * gd;
                const bool own = (i >> 2) == cgp_s;
#pragma unroll
                for (int ks = 0; ks < 2; ++ks) {
                    const bf16x8 kf = __builtin_shufflevector(kb[i & 1][ks][0], kb[i & 1][ks][1], 0, 1, 2, 3, 4, 5, 6, 7);
                    C[2 * i] = mfma16(kf, vb[0][ks], C[2 * i]);
                    C[2 * i + 1] = mfma16(kf, vb[1][ks], C[2 * i + 1]);
                    if (own) Nacc[i & 3] = mfma16(kf, wf[ks], Nacc[i & 3]);
                }
            }
        }
        if (st + 1 < 132) prefetch(st + 1);
        if (PROF_SEC == 1) prof_acc += __builtin_amdgcn_s_memtime() - pt0;
        if (PROF_SEC >= 0) pt0 = __builtin_amdgcn_s_memtime();
        __syncthreads();
        if (emit) {
#pragma unroll
            for (int tt = 0; tt < 4; ++tt)
                if (tt != kq_s) {
                    u32x2 r0_, r1_; r0_.x = pk2(acc2[tt][0][0], acc2[tt][0][1]); r0_.y = pk2(acc2[tt][0][2], acc2[tt][0][3]); r1_.x = pk2(acc2[tt][1][0], acc2[tt][1][1]); r1_.y = pk2(acc2[tt][1][2], acc2[tt][1][3]);
                    *(LAS u32x2*)(red + ((((tt * 4 + kq) * 2 + cgp) * 2 + 0) * 64 + lane) * 2) = r0_;
                    *(LAS u32x2*)(red + ((((tt * 4 + kq) * 2 + cgp) * 2 + 1) * 64 + lane) * 2) = r1_;
                }
        }
        if (st + 1 < 132) scalars((st + 1) & 1);
        __syncthreads();
        if (emit) {
            f32x4 o0, o1;
            if (kq_s == 0) { o0 = acc2[0][0]; o1 = acc2[0][1]; } else if (kq_s == 1) { o0 = acc2[1][0]; o1 = acc2[1][1]; } else if (kq_s == 2) { o0 = acc2[2][0]; o1 = acc2[2][1]; } else { o0 = acc2[3][0]; o1 = acc2[3][1]; }
#pragma unroll
            for (int src = 0; src < 4; ++src)
                if (src != kq_s) {
                    const u32x2 r0_ = *(const LAS u32x2*)(red + ((((kq * 4 + src) * 2 + cgp) * 2 + 0) * 64 + lane) * 2), r1_ = *(const LAS u32x2*)(red + ((((kq * 4 + src) * 2 + cgp) * 2 + 1) * 64 + lane) * 2);
                    o0 = o0 + (f32x4){lo_bf(r0_.x), hi_bf(r0_.x), lo_bf(r0_.y), hi_bf(r0_.y)};
                    o1 = o1 + (f32x4){lo_bf(r1_.x), hi_bf(r1_.x), lo_bf(r1_.y), hi_bf(r1_.y)};
                }
            const int t = kq * 16 + l15;
            const float rdn = rcpf_(fmaxf(fabsf(sc_di[t] * qn[t] + sc_rs[t]), __expf(-sc_m[t])));
            bf16_t* hp = H + (size_t)(cid * 64 + t) * 2048 + h * 512 + sl * 64 + cgp * 32 + 4 * g4;
            store_bf16x4(hp, o0 * rdn);
            store_bf16x4(hp + 16, o1 * rdn);
        }
        if (PROF_SEC == 2) prof_acc += __builtin_amdgcn_s_memtime() - pt0;
    }
    if (PROF_SEC >= 0 && bid == 0) { const unsigned long long t0_ = __builtin_amdgcn_s_memtime(); while (__builtin_amdgcn_s_memtime() - t0_ < 4 * prof_acc) __builtin_amdgcn_s_sleep(8); }
}

DI void phase_merge(PP p, bool shadow = false) {
    const int tid = get_tid(), lane = tid & 63;
    const bf16_t* HF = (const bf16_t*)p->out;
    bf16_t* HB = (bf16_t*)(p->ws + OFF_ARENA + A_HB);
    const bf16_t* XC = (const bf16_t*)(p->ws + OFF_ARENA + A_XC);
    const bf16_t* Z = (const bf16_t*)(p->ws + OFF_ARENA + A_XM);
    const int gw = get_bid() * 8 + (tid >> 6), nw = gridDim.x * 8;
    f32x4 ng[4][2], sk[4][2];
#pragma unroll
    for (int hh = 0; hh < 4; ++hh) {
        const int c = hh * 512 + lane * 8;
        ng[hh][0] = *(const f32x4*)(p->m_norm_g + c); ng[hh][1] = *(const f32x4*)(p->m_norm_g + c + 4);
        sk[hh][0] = *(const f32x4*)(p->m_skip + c); sk[hh][1] = *(const f32x4*)(p->m_skip + c + 4);
    }
    for (int r = gw; r < NLAT; r += nw) {
        u32x4 av[4], bv[4], xv[4], zv[4];
#pragma unroll
        for (int hh = 0; hh < 4; ++hh) {
            const size_t o = (size_t)r * 2048 + hh * 512 + lane * 8;
            av[hh] = __builtin_nontemporal_load((const u32x4*)(HF + o)); bv[hh] = __builtin_nontemporal_load((const u32x4*)(HB + o));
            xv[hh] = __builtin_nontemporal_load((const u32x4*)(XC + o)); zv[hh] = __builtin_nontemporal_load((const u32x4*)(Z + o));
        }
#pragma unroll
        for (int hh = 0; hh < 4; ++hh) {
            const size_t o = (size_t)r * 2048 + hh * 512 + lane * 8;
            const unsigned aw[4] = {av[hh].x, av[hh].y, av[hh].z, av[hh].w}, bw[4] = {bv[hh].x, bv[hh].y, bv[hh].z, bv[hh].w};
            const unsigned xw[4] = {xv[hh].x, xv[hh].y, xv[hh].z, xv[hh].w}, zw[4] = {zv[hh].x, zv[hh].y, zv[hh].z, zv[hh].w};
            float hv[8]; float sum = 0.f;
#pragma unroll
            for (int j = 0; j < 4; ++j) { hv[2 * j] = lo_bf(aw[j]) + lo_bf(bw[j]); hv[2 * j + 1] = hi_bf(aw[j]) + hi_bf(bw[j]); sum += hv[2 * j] + hv[2 * j + 1]; }
            const float mean = wave_sum(sum) * (1.f / 512.f);
            float sq = 0.f;
#pragma unroll
            for (int j = 0; j < 8; ++j) { hv[j] -= mean; sq += hv[j] * hv[j]; }
            const float rs = rsqrtf(wave_sum(sq) * (1.f / 512.f) + EPS);
            const f32x4 g0 = ng[hh][0], g1 = ng[hh][1], k0 = sk[hh][0], k1 = sk[hh][1];
            float ov[8];
#pragma unroll
            for (int j = 0; j < 8; ++j) {
                const float xcv = (j & 1) ? hi_bf(xw[j >> 1]) : lo_bf(xw[j >> 1]);
                const float zval = (j & 1) ? hi_bf(zw[j >> 1]) : lo_bf(zw[j >> 1]);
                const float gg = j < 4 ? g0[j & 3] : g1[j & 3], kk = j < 4 ? k0[j & 3] : k1[j & 3];
                ov[j] = (hv[j] * rs * gg + kk * xcv) * siluf_(zval);
            }
            u32x4 v; v.x = pk2(ov[0], ov[1]); v.y = pk2(ov[2], ov[3]); v.z = pk2(ov[4], ov[5]); v.w = pk2(ov[6], ov[7]);
            if (!shadow) *(u32x4*)(HB + o) = v;
        }
    }
}

DI void phase_downproj(PP p, lds_t lds) {
    const bf16_t* A = (const bf16_t*)(p->ws + OFF_ARENA + A_HB);
    bf16_t* X = (bf16_t*)(p->ws + OFF_ARENA + A_X);
    constexpr int NM = NLAT / 256, NN = 4;
    gemm_multi<64, true>(lds, 2048, 1, NM, NN, 8, 4,
        [&](const U3& u, int r) { return A + (size_t)(u.m * 256 + r) * 2048; },
        [&](const U3& u) { return (const bf16_t*)(p->ws + OFF_WDNT) + (size_t)(u.n * 256) * 2048; },
        [&](const U3& u, const f32x4 (&acc)[8][4], int wr, int wc, int lane) {
            const float* g1 = mods_ptr(p, 1, u.m >> 5, 2);
            epi_each8(acc, wr, wc, lane, [&](int r, int c, f32x4 v0, f32x4 v1) {
                const int col = u.n * 256 + c;
                bf16_t* xp = X + (size_t)(u.m * 256 + r) * 1024 + col;
                const f32x4 g0 = *(const f32x4*)(g1 + col), g1v = *(const f32x4*)(g1 + col + 4);
                const u32x4 xo = *(const u32x4*)xp;
                store_bf16x8(xp, (f32x4){lo_bf(xo.x), hi_bf(xo.x), lo_bf(xo.y), hi_bf(xo.y)} + g0 * v0, (f32x4){lo_bf(xo.z), hi_bf(xo.z), lo_bf(xo.w), hi_bf(xo.w)} + g1v * v1);
            });
        });
}

DI void phase_dbg_final(PP p, int mode) {
    const int tid = get_tid(), lane = tid & 63;
    const int gw = get_bid() * 8 + (tid >> 6), nw = gridDim.x * 8;
    if (mode == 4) {
        const int* rid = (const int*)(p->ws + OFF_ARENA + A_ROWID);
        for (int r = gw; r < NLAT; r += nw)
            for (int c = lane; c < 1024; c += 64) p->out[(size_t)r * 1024 + c] = (float)rid[(size_t)r * 16 + (c & 15)];
        return;
    }
    if (mode == 7) {
        const bf16_t* y = (const bf16_t*)(p->ws + OFF_ARENA + A_Y);
        for (int r = gw; r < NLAT; r += nw)
            for (int c = lane; c < 1024; c += 64) { const float v = bf2f(y[(size_t)r * 1024 + c]); p->out[(size_t)r * 1024 + c] = (v == v && fabsf(v) < 1e30f) ? 0.f : 1000.f; }
        return;
    }
    if (mode >= 2) {
        const bf16_t* src = mode == 2 ? (const bf16_t*)(p->ws + OFF_ARENA + A_P) : mode == 5 ? (const bf16_t*)(p->ws + OFF_ARENA + A_HDN) : mode == 6 ? (const bf16_t*)(p->ws + OFF_ARENA + A_Y) : (const bf16_t*)(p->ws + OFF_ACT);
        const int ld = mode == 2 ? ABIN : 1024;
        for (int r = gw; r < NLAT; r += nw)
            for (int c = lane; c < 1024; c += 64) p->out[(size_t)r * 1024 + c] = bf2f(src[(size_t)r * ld + (mode == 2 ? c + DBG_COL0 : c)]);
        return;
    }
    for (int r = gw; r < NLAT; r += nw) {
        f32x4 v[4];
        if (mode) row_load_bf16((const bf16_t*)(p->ws + OFF_ARENA + A_X) + (size_t)r * 1024, v, lane); else row_load_f32(p->x + (size_t)r * 1024, v, lane);
        const float rs = rsqrtf(row_sumsq(v) * (1.f / 1024.f) + EPS);
#pragma unroll
        for (int i = 0; i < 4; ++i) { const f32x4 g = *(const f32x4*)(p->final_g + rcol(lane, i)); *(f32x4*)(p->out + (size_t)r * 1024 + rcol(lane, i)) = v[i] * rs * g; }
    }
}

constexpr int XB_XCNT = 256, XB_XSUB = 1280, XB_XGEN = 2304, XB_TOP = 3328, XB_TOPGEN = 3392, XB_WORDS = 3456;
DI unsigned xb_ld(unsigned* q) { return __hip_atomic_load(q, __ATOMIC_RELAXED, __HIP_MEMORY_SCOPE_AGENT); }
DI unsigned xb_add(unsigned* q, unsigned v) { return __hip_atomic_fetch_add(q, v, __ATOMIC_RELAXED, __HIP_MEMORY_SCOPE_AGENT); }
DI unsigned xb_xcc_id() { return (unsigned)__builtin_amdgcn_s_getreg((3 << 11) | 20) & 0xFu; }
DI void grid_barrier_post(PP p) { if (threadIdx.x == 0) (void)xb_add((unsigned*)(p->ws + OFF_BAR) + XB_XCNT + 64 * xb_xcc_id(), 1u); }
DI void grid_barrier(PP p, unsigned& nbar, unsigned& cfg) {
    asm volatile("s_waitcnt vmcnt(0) lgkmcnt(0)" ::: "memory");
    __syncthreads();
    if (cfg == 0u) {
        unsigned cnew = 0u;
        if (threadIdx.x == 0) {
            unsigned* bar = (unsigned*)(p->ws + OFF_BAR);
            const unsigned x = xb_xcc_id();
            unsigned sum, cnt, mine;
            for (;;) {
                sum = 0u; cnt = 0u; mine = 0u;
#pragma unroll
                for (unsigned j = 0; j < 16; ++j) { const unsigned c = xb_ld(bar + XB_XCNT + 64 * j); sum += c; cnt += c > 0u ? 1u : 0u; mine = j == x ? c : mine; }
                if (sum == gridDim.x) break;
                __builtin_amdgcn_s_sleep(1);
            }
            cnew = mine | (cnt << 16);
        }
        cfg = (unsigned)__builtin_amdgcn_readfirstlane((int)cnew);
    }
    if (threadIdx.x == 0) {
        unsigned* bar = (unsigned*)(p->ws + OFF_BAR);
        const unsigned x = xb_xcc_id();
        const unsigned nloc = cfg & 0xffffu, nx = cfg >> 16;
        const unsigned old = xb_add(bar + XB_XSUB + 64 * x, 1u);
        if (old + 1u == (nbar + 1u) * nloc) {
            __builtin_amdgcn_fence(__ATOMIC_RELEASE, "agent");
            asm volatile("s_waitcnt vmcnt(0)" ::: "memory");
            const unsigned tgt = (nbar + 1u) * nx;
            const unsigned og = xb_add(bar + XB_TOP, 1u);
            if (og + 1u != tgt) while ((int)(xb_ld(bar + XB_TOP) - tgt) < 0) __builtin_amdgcn_s_sleep(1);
            __builtin_amdgcn_fence(__ATOMIC_ACQUIRE, "agent");
            xb_add(bar + XB_XGEN + 64 * x, 1u);
            asm volatile("s_waitcnt vmcnt(0)" ::: "memory");
        } else {
            while (xb_ld(bar + XB_XGEN + 64 * x) == nbar) __builtin_amdgcn_s_sleep(1);
            __builtin_amdgcn_fence(__ATOMIC_ACQUIRE, "agent");
            asm volatile("s_waitcnt vmcnt(0)" ::: "memory");
        }
    }
    __syncthreads();
    ++nbar;
}
#define RUN_PHASE(K, CALL) if (ph_lo <= (K) && (K) < ph_hi && ((K) <= DBG_STOP)) { PP p = kp; asm volatile("" : "+s"(p)); CALL; if ((DUP_MASK >> (K)) & 1) { grid_barrier(p, nbar, bcfg); asm volatile("" : "+s"(p)); CALL; } if ((K) + 1 < ph_hi) { grid_barrier(p, nbar, bcfg); if (EXTRA_BARRIERS) grid_barrier(p, nbar, bcfg); } }
__global__ void __launch_bounds__(NTHREADS) mega(Params p_in) {
    extern __shared__ __attribute__((aligned(16))) unsigned char lds_raw[];
    lds_t lds = (lds_t)lds_raw;
    PP kp = (PP)__builtin_amdgcn_kernarg_segment_ptr();
    const int ph_lo = kp->ph_lo, ph_hi = kp->ph_hi;
    unsigned nbar = 0, bcfg = 0;
    grid_barrier_post(kp);
    RUN_PHASE(0, phase_mods(p, lds))
    RUN_PHASE(1, phase_norm(p, 0, NTOK, [&](int r) { return r < NLAT ? p->x + (size_t)r * 1024 : p->ctx + (size_t)(r - NLAT) * 1024; }))
    RUN_PHASE(2, phase_inproj(p, lds))
    RUN_PHASE(3, phase_g1(p, lds))
    RUN_PHASE(4, phase_scan0(p))
    RUN_PHASE(5, phase_g3(p, lds))
    RUN_PHASE(6, phase_outproj0(p, lds))
    RUN_PHASE(7, phase_router(p, lds, 0))
    RUN_PHASE(8, phase_topk(p, lds, 0))
    RUN_PHASE(9, phase_moe_up(p, lds, 0))
    RUN_PHASE(10, phase_moe_down(p, lds, 0))
    RUN_PHASE(11, phase_combine(p, 0))
    RUN_PHASE(12, phase_upproj(p, lds, 0))
#if SHADOW_PH == 13
    if (ph_lo <= 13 && 13 < ph_hi) { PP p = kp; asm volatile("" : "+s"(p)); phase_mfeat(p, lds, true); grid_barrier(p, nbar, bcfg); }
#endif
    RUN_PHASE(13, phase_mfeat(p, lds))
    RUN_PHASE(14, phase_mscan(p, lds))
    RUN_PHASE(16, phase_upproj(p, lds, 1))
#if SHADOW_PH == 17
    if (ph_lo <= 17 && 17 < ph_hi) { PP p = kp; asm volatile("" : "+s"(p)); phase_merge(p, true); grid_barrier(p, nbar, bcfg); }
#endif
    RUN_PHASE(17, phase_merge(p))
    RUN_PHASE(18, phase_downproj(p, lds))
    RUN_PHASE(19, phase_router(p, lds, 1))
    RUN_PHASE(20, phase_topk(p, lds, 1))
    RUN_PHASE(21, phase_moe_up(p, lds, 1))
#if GEMM_PROBE >= 0
    if (ph_lo <= 22 && 22 < ph_hi) { PP p = kp; asm volatile("" : "+s"(p)); phase_moe_down_t<GEMM_PROBE>(p, lds, 1); grid_barrier(p, nbar, bcfg); }
#endif
    RUN_PHASE(22, phase_moe_down(p, lds, 1))
    RUN_PHASE(23, phase_combine(p, 1))
    if (DBG_STOP < 23 && DBG_STOP + 1 < ph_hi) { PP p = kp; asm volatile("" : "+s"(p)); phase_dbg_final(p, DBG_MODE); }
}

extern "C" void kernel_launch(void* const* d_in, const int* in_sizes, int n_in, void* d_out, int out_size, void* d_ws, size_t ws_size, hipStream_t stream) {
    static int grid = 0;
    if (grid == 0) {
        int dev = 0, cus = 0, per_cu = 0;
        hipGetDevice(&dev);
        hipDeviceGetAttribute(&cus, hipDeviceAttributeMultiprocessorCount, dev);
        hipFuncSetAttribute((const void*)mega, hipFuncAttributeMaxDynamicSharedMemorySize, LDS_BYTES);
        hipOccupancyMaxActiveBlocksPerMultiprocessor(&per_cu, (const void*)mega, NTHREADS, LDS_BYTES);
        if (per_cu < 1) { fprintf(stderr, "occupancy query says %d blocks/CU\n", per_cu); per_cu = 1; }
        grid = cus;
        if (ws_size < WS_NEED) { fprintf(stderr, "workspace too small: %zu < %zu\n", ws_size, (size_t)WS_NEED); grid = -1; }
    }
    if (grid < 0) return;
    Params hp{};
    const float** pp = (const float**)&hp;
    for (int i = 0; i < 36; ++i) pp[i] = (const float*)d_in[i];
    hp.out = (float*)d_out; hp.ws = (char*)d_ws; hp.ph_lo = 0; hp.ph_hi = DBG_STOP < 23 ? DBG_STOP + 2 : 24;
    hipMemsetAsync((char*)d_ws + OFF_BAR, 0, XB_WORDS * sizeof(unsigned), stream);
    void* args[] = {&hp};
    hipError_t e = hipLaunchCooperativeKernel((const void*)mega, dim3(grid), dim3(NTHREADS), args, LDS_BYTES, stream);
    if (e != hipSuccess) fprintf(stderr, "cooperative launch failed: %s\n", hipGetErrorString(e));
}
```
